# Optimizing an MI355X kernel written in HIP

```python
import jax
import jax.numpy as jnp
from jax import lax
import numpy as np

D_MODEL = 1024
BATCH = 8
SEQ = 2048
DEPTH = 2

CTX_LEN = 256
GRID_W = 64
EPS = 1e-6
ROPE_THETA = 10000.0
Q_BLOCK = 128

D_MIX = D_MODEL
N_MIXERS = 4
GROUP_W = D_MIX // N_MIXERS

A_HEADS = 4
A_HEAD_DIM = GROUP_W // A_HEADS
CHUNK = 128

CONV_W = 3

C_HEADS = 4
C_KV_HEADS = 2
C_GROUP = C_HEADS // C_KV_HEADS
C_HEAD_DIM = GROUP_W // C_HEADS
C_SCALE = C_HEAD_DIM ** -0.5

D_HEADS = 4
D_V = GROUP_W // D_HEADS
D_NOPE = D_V
D_ROPE = D_NOPE // 2
D_Q_LORA = D_MIX // 4
D_KV_LORA = D_MIX // 8
D_SCALE = (D_NOPE + D_ROPE) ** -0.5

IN_SPLITS = (GROUP_W, GROUP_W,
             GROUP_W, GROUP_W, GROUP_W,
             C_HEADS * C_HEAD_DIM, C_KV_HEADS * C_HEAD_DIM, C_KV_HEADS * C_HEAD_DIM,
             D_Q_LORA, D_KV_LORA, D_ROPE)
IN_COLS = sum(IN_SPLITS)
IN_SPLIT_IDX = tuple(int(i) for i in np.cumsum(IN_SPLITS)[:-1])

N_GROUPS = 4
EXPERTS_PER_GROUP = 4
N_EXPERTS = N_GROUPS * EXPERTS_PER_GROUP
TOP_K = 2
D_EXPERT = D_MODEL // 4

kernel_name = 'hybrid_head_group_moe_dit'


def _rms_norm(x, gain):
    xf = x.astype(jnp.float32)
    y = xf * lax.rsqrt(jnp.mean(xf * xf, axis=-1, keepdims=True) + EPS)
    return (y * gain.astype(jnp.float32)).astype(x.dtype)


def _modulate(h, shift, scale):
    return h * (1 + scale) + shift


def _axial_rope(rows, rot_dim):
    row = jnp.repeat(jnp.arange(rows, dtype=jnp.float32), GRID_W)
    col = jnp.tile(jnp.arange(GRID_W, dtype=jnp.float32), rows)
    n_freq = rot_dim // 4
    inv_freq = ROPE_THETA ** (-jnp.arange(n_freq, dtype=jnp.float32) / n_freq)
    ang = jnp.concatenate([row[:, None] * inv_freq, col[:, None] * inv_freq], axis=-1)
    return jnp.cos(ang), jnp.sin(ang)


def _apply_rope(x, cos, sin):
    xp = x.astype(jnp.float32).reshape(*x.shape[:-1], x.shape[-1] // 2, 2)
    x0, x1 = xp[..., 0], xp[..., 1]
    cs, sn = cos[None, :, None, :], sin[None, :, None, :]
    out = jnp.stack([x0 * cs - x1 * sn, x0 * sn + x1 * cs], axis=-1)
    return out.reshape(x.shape).astype(x.dtype)


def _attention(q, k, v, scale):
    s = jnp.einsum('bqhgd,bkhd->bhgqk', q, k).astype(jnp.float32) * scale
    p = jax.nn.softmax(s, axis=-1).astype(v.dtype)
    return jnp.einsum('bhgqk,bkhd->bqhgd', p, v)


def _blocked_attention(q, k, v, scale):
    b, n = q.shape[:2]
    qb = jnp.moveaxis(q.reshape(b, n // Q_BLOCK, Q_BLOCK, *q.shape[2:]), 1, 0)
    ob = lax.map(lambda qblk: _attention(qblk, k, v, scale), qb)
    return jnp.moveaxis(ob, 0, 1).reshape(b, n, *ob.shape[3:])


def _chunk_sgu(u, v, v_gain, w_s, b_s):
    b, n, _ = u.shape
    u = jax.nn.gelu(u)
    v = _rms_norm(jax.nn.gelu(v).reshape(b, n // CHUNK, CHUNK, A_HEADS, A_HEAD_DIM),
                  v_gain.reshape(A_HEADS, A_HEAD_DIM))
    mixed = jnp.einsum('hij,bcjhd->bcihd', w_s, v) + b_s.T[:, :, None]
    return u * mixed.reshape(b, n, GROUP_W)


def _short_conv(bg, cg, xin, w_conv):
    z = cg * xin
    z = lax.conv_general_dilated(z, w_conv[:, None, :], window_strides=(1,),
                                 padding=((CONV_W // 2, CONV_W // 2),),
                                 dimension_numbers=('NWC', 'WIO', 'NWC'),
                                 feature_group_count=GROUP_W)
    return bg * z


def _gqa_qkv(q, k, v, q_gain, k_gain, rope):
    b, n = q.shape[:2]
    q = _rms_norm(q.reshape(b, n, C_HEADS, C_HEAD_DIM), q_gain)
    k = _rms_norm(k.reshape(b, n, C_KV_HEADS, C_HEAD_DIM), k_gain)
    v = v.reshape(b, n, C_KV_HEADS, C_HEAD_DIM)
    if rope is not None:
        q = _apply_rope(q, *rope)
        k = _apply_rope(k, *rope)
    return q.reshape(b, n, C_KV_HEADS, C_GROUP, C_HEAD_DIM), k, v


def _mla_qkv(cq, ckv, kr, qa_gain, w_qb, kva_gain, w_kvb, q_gain, k_gain, rope):
    b, n = cq.shape[:2]
    q = (_rms_norm(cq, qa_gain) @ w_qb).reshape(b, n, D_HEADS, D_NOPE + D_ROPE)
    kv = (_rms_norm(ckv, kva_gain) @ w_kvb).reshape(b, n, D_HEADS, D_NOPE + D_V)
    q_nope = _rms_norm(q[..., :D_NOPE], q_gain[:D_NOPE])
    q_rope = _rms_norm(q[..., D_NOPE:], q_gain[D_NOPE:])
    k_nope = _rms_norm(kv[..., :D_NOPE], k_gain[:D_NOPE])
    k_rope = _rms_norm(kr[:, :, None, :], k_gain[D_NOPE:])
    if rope is not None:
        q_rope = _apply_rope(q_rope, *rope)
        k_rope = _apply_rope(k_rope, *rope)
    q = jnp.concatenate([q_nope, q_rope], axis=-1)[:, :, :, None, :]
    k = jnp.concatenate([k_nope, jnp.broadcast_to(k_rope, (b, n, D_HEADS, D_ROPE))], axis=-1)
    return q, k, kv[..., D_NOPE:]


def _merge_groups(ys, g_group_out, w_out):
    y = jnp.concatenate([yy.reshape(*yy.shape[:2], GROUP_W) for yy in ys], axis=-1)
    b, n = y.shape[:2]
    y = _rms_norm(y.reshape(b, n, N_MIXERS, GROUP_W), g_group_out.reshape(N_MIXERS, GROUP_W))
    return y.reshape(b, n, D_MIX) @ w_out


def _hier_moe(h, w_rg, b_rg, w_re, b_re, w_up, w_down):
    group_p = jax.nn.softmax((h @ w_rg + b_rg).astype(jnp.float32), axis=-1)
    g_w, g_idx = lax.top_k(group_p, 1)
    e_logits = (h @ w_re + b_re).astype(jnp.float32).reshape(*h.shape[:-1], N_GROUPS, EXPERTS_PER_GROUP)
    e_logits = jnp.take_along_axis(e_logits, g_idx[..., None], axis=-2)[..., 0, :]
    e_w, e_idx = lax.top_k(jax.nn.softmax(e_logits, axis=-1), TOP_K)
    e_w = e_w / jnp.sum(e_w, axis=-1, keepdims=True)
    expert_id = g_idx * EXPERTS_PER_GROUP + e_idx
    combine = jnp.sum(jax.nn.one_hot(expert_id, N_EXPERTS, dtype=jnp.float32) * (g_w * e_w)[..., None],
                      axis=-2).astype(h.dtype)
    gate, up = jnp.split(jnp.einsum('bld,edf->blef', h, w_up), 2, axis=-1)
    return jnp.einsum('blef,efd->bld', jax.nn.silu(gate) * up * combine[..., None], w_down)


def _layer(x, xc, sc, scc, rope_c, rope_d, p, update_ctx):
    (w_mod, b_mod, g_attn_norm, w_in, sgu_v_gain, sgu_w, sgu_b, conv_w,
     gqa_q_gain, gqa_k_gain, mla_qa_gain, mla_w_qb, mla_kva_gain, mla_w_kvb,
     mla_q_gain, mla_k_gain, g_group_out, w_out, g_ffn_norm,
     w_rg, b_rg, w_re, b_re, w_up, w_down) = p
    shift1, scale1, gate1, shift2, scale2, gate2 = jnp.split((sc @ w_mod + b_mod)[:, None, :], 6, axis=-1)
    shift1c, scale1c, gate1c, shift2c, scale2c, gate2c = jnp.split(scc @ w_mod + b_mod, 6, axis=-1)

    h = _modulate(_rms_norm(x, g_attn_norm), shift1, scale1)
    hc = _modulate(_rms_norm(xc, g_attn_norm), shift1c, scale1c)
    a_u, a_v, b_b, b_c, b_x, c_q, c_k, c_v, d_cq, d_ckv, d_kr = jnp.split(h @ w_in, IN_SPLIT_IDX, axis=-1)
    (a_uc, a_vc, b_bc, b_cc, b_xc, c_qc, c_kc, c_vc,
     d_cqc, d_ckvc, d_krc) = jnp.split(hc @ w_in, IN_SPLIT_IDX, axis=-1)
    mla_p = (mla_qa_gain, mla_w_qb, mla_kva_gain, mla_w_kvb, mla_q_gain, mla_k_gain)

    qC_c, kC_c, vC_c = _gqa_qkv(c_qc, c_kc, c_vc, gqa_q_gain, gqa_k_gain, None)
    qD_c, kD_c, vD_c = _mla_qkv(d_cqc, d_ckvc, d_krc, *mla_p, None)
    qC, kC, vC = _gqa_qkv(c_q, c_k, c_v, gqa_q_gain, gqa_k_gain, rope_c)
    qD, kD, vD = _mla_qkv(d_cq, d_ckv, d_kr, *mla_p, rope_d)

    yC = _blocked_attention(qC, jnp.concatenate([kC_c, kC], axis=1), jnp.concatenate([vC_c, vC], axis=1), C_SCALE)
    yD = _blocked_attention(qD, jnp.concatenate([kD_c, kD], axis=1), jnp.concatenate([vD_c, vD], axis=1), D_SCALE)
    yA = _chunk_sgu(a_u, a_v, sgu_v_gain, sgu_w, sgu_b)
    yB = _short_conv(b_b, b_c, b_x, conv_w)
    x = x + gate1 * _merge_groups((yA, yB, yC, yD), g_group_out, w_out)
    x = x + gate2 * _hier_moe(_modulate(_rms_norm(x, g_ffn_norm), shift2, scale2),
                              w_rg, b_rg, w_re, b_re, w_up, w_down)

    if update_ctx:
        yc = _merge_groups((_chunk_sgu(a_uc, a_vc, sgu_v_gain, sgu_w, sgu_b),
                            _short_conv(b_bc, b_cc, b_xc, conv_w),
                            _attention(qC_c, kC_c, vC_c, C_SCALE),
                            _attention(qD_c, kD_c, vD_c, D_SCALE)), g_group_out, w_out)
        xc = xc + gate1c * yc
        xc = xc + gate2c * _hier_moe(_modulate(_rms_norm(xc, g_ffn_norm), shift2c, scale2c),
                                     w_rg, b_rg, w_re, b_re, w_up, w_down)
    return x, xc


def setup_inputs(seed: int = 0) -> dict:
    key = jax.random.key(seed)
    ks = jax.random.split(key, 32)
    L, D = DEPTH, D_MODEL
    f32 = jnp.float32

    def nrm(k, shape, scale):
        return jax.random.normal(k, shape, f32) * scale

    def gain(k, shape):
        return 1.0 + 0.05 * jax.random.normal(k, shape, f32)

    return {
        'x': nrm(ks[0], (BATCH, SEQ, D), 1.0),
        'c': nrm(ks[1], (BATCH, D), 1.0),
        'ctx': nrm(ks[2], (BATCH, CTX_LEN, D), 1.0),
        'c_ctx': nrm(ks[3], (D,), 1.0),
        'w_mod': nrm(ks[4], (L, D, 6 * D), 0.5 * D ** -0.5),
        'b_mod': nrm(ks[5], (L, 6 * D), 0.02),
        'g_attn_norm': gain(ks[6], (L, D)),
        'w_in': nrm(ks[7], (L, D, IN_COLS), D ** -0.5),
        'sgu_v_gain': gain(ks[8], (L, GROUP_W)),
        'sgu_w': nrm(ks[9], (L, A_HEADS, CHUNK, CHUNK), CHUNK ** -0.5),
        'sgu_b': gain(ks[10], (L, A_HEADS, CHUNK)),
        'conv_w': nrm(ks[11], (L, CONV_W, GROUP_W), CONV_W ** -0.5),
        'gqa_q_gain': gain(ks[12], (L, C_HEAD_DIM)),
        'gqa_k_gain': gain(ks[13], (L, C_HEAD_DIM)),
        'mla_qa_gain': gain(ks[14], (L, D_Q_LORA)),
        'mla_w_qb': nrm(ks[15], (L, D_Q_LORA, D_HEADS * (D_NOPE + D_ROPE)), D_Q_LORA ** -0.5),
        'mla_kva_gain': gain(ks[16], (L, D_KV_LORA)),
        'mla_w_kvb': nrm(ks[17], (L, D_KV_LORA, D_HEADS * (D_NOPE + D_V)), D_KV_LORA ** -0.5),
        'mla_q_gain': gain(ks[18], (L, D_NOPE + D_ROPE)),
        'mla_k_gain': gain(ks[19], (L, D_NOPE + D_ROPE)),
        'g_group_out': gain(ks[20], (L, D_MIX)),
        'w_out': nrm(ks[21], (L, D_MIX, D), D_MIX ** -0.5),
        'g_ffn_norm': gain(ks[22], (L, D)),
        'w_router_group': nrm(ks[23], (L, D, N_GROUPS), D ** -0.5),
        'b_router_group': nrm(ks[24], (L, N_GROUPS), 0.01),
        'w_router_expert': nrm(ks[25], (L, D, N_EXPERTS), D ** -0.5),
        'b_router_expert': nrm(ks[26], (L, N_EXPERTS), 0.01),
        'w_expert_up': nrm(ks[27], (L, N_EXPERTS, D, 2 * D_EXPERT), D ** -0.5),
        'w_expert_down': nrm(ks[28], (L, N_EXPERTS, D_EXPERT, D), D_EXPERT ** -0.5),
    }


def reference(x, c, ctx, c_ctx, w_mod, b_mod, g_attn_norm, w_in, sgu_v_gain, sgu_w, sgu_b, conv_w,
              gqa_q_gain, gqa_k_gain, mla_qa_gain, mla_w_qb, mla_kva_gain, mla_w_kvb, mla_q_gain,
              mla_k_gain, g_group_out, w_out, g_ffn_norm, w_router_group, b_router_group,
              w_router_expert, b_router_expert, w_expert_up, w_expert_down):
    rows = x.shape[1] // GRID_W
    rope_c = _axial_rope(rows, C_HEAD_DIM)
    rope_d = _axial_rope(rows, D_ROPE)
    sc = jax.nn.silu(c)
    scc = jax.nn.silu(c_ctx)
    xc = ctx
    for l in range(DEPTH):
        p = (w_mod[l], b_mod[l], g_attn_norm[l], w_in[l], sgu_v_gain[l], sgu_w[l], sgu_b[l], conv_w[l],
             gqa_q_gain[l], gqa_k_gain[l], mla_qa_gain[l], mla_w_qb[l], mla_kva_gain[l], mla_w_kvb[l],
             mla_q_gain[l], mla_k_gain[l], g_group_out[l], w_out[l], g_ffn_norm[l],
             w_router_group[l], b_router_group[l], w_router_expert[l], b_router_expert[l],
             w_expert_up[l], w_expert_down[l])
        x, xc = _layer(x, xc, sc, scc, rope_c, rope_d, p, l < DEPTH - 1)
    return x
```

```cpp
#include <hip/hip_runtime.h>
#include <cstdio>
#include <cstdint>

#ifndef MODE_SINGLE
#define MODE_SINGLE 0
#endif
#ifndef DBG_CHECK
#define DBG_CHECK 0
#endif

#define DEV __device__ __forceinline__
#define LAS __attribute__((address_space(3)))
typedef unsigned short bf16_t;
typedef short bf16x8 __attribute__((ext_vector_type(8)));
typedef float f32x4 __attribute__((ext_vector_type(4)));
typedef float f32x16 __attribute__((ext_vector_type(16)));
typedef unsigned u32x4 __attribute__((ext_vector_type(4)));
typedef unsigned u32x2 __attribute__((ext_vector_type(2)));

constexpr int DM = 1024, NB = 8, SEQ = 2048, CL = 256, NL = 2;
constexpr int NLAT = NB * SEQ, NCTX = NB * CL, NTOK = NLAT + NCTX;
constexpr int KEYS = CL + SEQ;
constexpr int INC = 2208, INCP = 2304;
constexpr int OFF_AU = 0, OFF_AV = 256, OFF_BB = 512, OFF_BC = 768, OFF_BX = 1024, OFF_CQ = 1280, OFF_CK = 1536, OFF_CV = 1664,
              OFF_DCQ = 1792, OFF_DCKV = 2048, OFF_DKR = 2176;
constexpr float EPS = 1e-6f;
constexpr float LOG2E = 1.4426950408889634f;
constexpr float C_SCALE = 0.125f, D_SCALE = 0.10206207261596577f;
constexpr int NBUCKET = 24;
constexpr int MAXMT = NTOK / 128 + NBUCKET;
constexpr int NTHREADS = 256;
constexpr int LDS_BYTES = 65536 + 64;

constexpr size_t al256(size_t x) { return (x + 255) & ~(size_t)255; }
constexpr size_t WS_BAR   = 0;
constexpr size_t WS_CNT   = 16384;
constexpr size_t WS_ZERO_BYTES = 16384 + 1024;
constexpr size_t WS_MODV  = al256(WS_CNT + 1024);
constexpr size_t WS_RW    = al256(WS_MODV + (size_t)NL * 9 * 6144 * 4);
constexpr size_t WS_RC    = al256(WS_RW + (size_t)NL * 9 * 1024 * 20 * 4);
constexpr size_t WS_ROPEC = al256(WS_RC + (size_t)NL * 9 * 32 * 4);
constexpr size_t WS_ROPED = al256(WS_ROPEC + (size_t)2 * 2048 * 32 * 4);
constexpr size_t WS_WIN   = al256(WS_ROPED + (size_t)2 * 2048 * 16 * 4);
constexpr size_t WS_WOUT  = al256(WS_WIN + (size_t)NL * INCP * 1024 * 2);
constexpr size_t WS_WUP   = al256(WS_WOUT + (size_t)NL * 1024 * 1024 * 2);
constexpr size_t WS_WDN   = al256(WS_WUP + (size_t)NL * 16 * 512 * 1024 * 2);
constexpr size_t WS_WQB   = al256(WS_WDN + (size_t)NL * 16 * 1024 * 256 * 2);
constexpr size_t WS_WKVB  = al256(WS_WQB + (size_t)NL * 384 * 256 * 2);
constexpr size_t WS_WSG   = al256(WS_WKVB + (size_t)NL * 512 * 128 * 2);
constexpr size_t WS_XC    = al256(WS_WSG + (size_t)NL * 4 * 128 * 128 * 2);
constexpr size_t WS_ACT   = al256(WS_XC + (size_t)NCTX * 1024 * 4);
constexpr size_t WS_P     = al256(WS_ACT + (size_t)NTOK * 1024 * 2);
constexpr size_t WS_QRAW  = WS_P;
constexpr size_t WS_KVRAW = al256(WS_QRAW + (size_t)NTOK * 384 * 2);
constexpr size_t WS_HBUF  = WS_P;
constexpr size_t WS_QC    = al256(WS_P + (size_t)NTOK * INC * 2);
constexpr size_t WS_KC    = al256(WS_QC + (size_t)NB * 4 * KEYS * 64 * 2);
constexpr size_t WS_VCT   = al256(WS_KC + (size_t)NB * 2 * KEYS * 64 * 2);
constexpr size_t WS_QD    = al256(WS_VCT + (size_t)NB * 2 * 64 * KEYS * 2);
constexpr size_t WS_CQN   = WS_QD;
constexpr size_t WS_CKVN  = WS_QD + (size_t)NTOK * 256 * 2;
constexpr size_t WS_KD    = al256(WS_QD + (size_t)NB * 4 * KEYS * 96 * 2);
constexpr size_t WS_VDT   = al256(WS_KD + (size_t)NB * 4 * KEYS * 96 * 2);
constexpr size_t WS_LTOK  = al256(WS_VDT + (size_t)NB * 4 * 64 * KEYS * 2);
constexpr size_t WS_LW    = al256(WS_LTOK + (size_t)NBUCKET * NTOK * 4);
constexpr size_t WS_DBG   = al256(WS_LW + (size_t)NBUCKET * NTOK * 8);
constexpr size_t WS_END   = WS_DBG + (1 << 20);
static_assert((size_t)NTOK * 384 * 2 + (size_t)NTOK * 512 * 2 + 512 <= (size_t)NTOK * INC * 2, "QRAW/KVRAW overlay");
static_assert((size_t)MAXMT * 128 * 512 * 2 <= (size_t)NTOK * INC * 2, "Hbuf overlay");
static_assert((size_t)NTOK * 384 * 2 <= (size_t)NB * 4 * KEYS * 96 * 2, "CQN/CKVN overlay");

struct Params {
    const float* in[29];
    float* out;
    char* ws;
};
enum { I_X = 0, I_C, I_CTX, I_CCTX, I_WMOD, I_BMOD, I_GATTN, I_WIN, I_SGUVG, I_SGUW, I_SGUB, I_CONVW, I_GQAQG, I_GQAKG, I_QAG, I_WQB, I_KVAG, I_WKVB,
       I_MLAQG, I_MLAKG, I_GGO, I_WOUT, I_GFFN, I_WRG, I_BRG, I_WRE, I_BRE, I_WUP, I_WDN };

DEV bf16_t f2bf(float f) { unsigned u = __float_as_uint(f); u += 0x7fffu + ((u >> 16) & 1u); return (bf16_t)(u >> 16); }
DEV float bf2f(bf16_t h) { return __uint_as_float(((unsigned)h) << 16); }
DEV unsigned pk2(float a, float b) { return (unsigned)f2bf(a) | ((unsigned)f2bf(b) << 16); }
DEV float bflo(unsigned u) { return __uint_as_float(u << 16); }
DEV float bfhi(unsigned u) { return __uint_as_float(u & 0xffff0000u); }
DEV float wave_sum(float v) {
#pragma unroll
    for (int o = 32; o >= 1; o >>= 1) v += __shfl_xor(v, o);
    return v;
}
DEV float grp_sum16(float v) { v += __shfl_xor(v, 1); v += __shfl_xor(v, 2); v += __shfl_xor(v, 4); v += __shfl_xor(v, 8); return v; }
DEV float gelu_tanh(float x) { const float u = 0.7978845608028654f * (x + 0.044715f * x * x * x); return 0.5f * x * (1.f + tanhf(u)); }
DEV float silu_f(float x) { return x / (1.f + __expf(-x)); }
DEV void tok_info(int tok, int& b, int& pos, int& key, bool& isctx) {
    if (tok < NLAT) { b = tok >> 11; pos = tok & 2047; key = CL + pos; isctx = false; }
    else { const int c = tok - NLAT; b = c >> 8; pos = c & 255; key = pos; isctx = true; }
}
DEV bf16x8 lds_r128(LAS const char* p) { return *(LAS const bf16x8*)p; }

struct Ctx {
    Params p; int layer; int bid, nb; LAS char* lds;
    DEV const float* in(int i) const { return p.in[i]; }
    template <class T> DEV T* ws(size_t off) const { return (T*)(p.ws + off); }
    DEV const float* modv(int mb, int chunk) const { return ws<float>(WS_MODV) + ((size_t)(layer * 9 + mb) * 6 + chunk) * 1024; }
    DEV const float* xsrc(int tok) const {
        if (layer == 0) return tok < NLAT ? p.in[I_X] + (size_t)tok * DM : p.in[I_CTX] + (size_t)(tok - NLAT) * DM;
        return tok < NLAT ? p.out + (size_t)tok * DM : ws<float>(WS_XC) + (size_t)(tok - NLAT) * DM;
    }
    DEV float* xdst(int tok) const { return tok < NLAT ? p.out + (size_t)tok * DM : ws<float>(WS_XC) + (size_t)(tok - NLAT) * DM; }
    DEV int ntok_tail() const { return layer == NL - 1 ? NLAT : NTOK; }
};

struct GemmDesc {
    const bf16_t* A; int lda; const int* rowidx; int nvalid;
    const bf16_t* B0; const bf16_t* B1; int ldb; int ksplit; int K;
};
template <class Epi>
DEV void gemm_tile(const GemmDesc& g, int m0, int n0, LAS char* lds, const Epi& epi) {
    const int tid = threadIdx.x, lane = tid & 63, wave = tid >> 6, wm = wave >> 1, wn = wave & 1;
    const int lr = tid >> 3, kc = tid & 7;
    int aoff[4], boff[4];
#pragma unroll
    for (int i = 0; i < 4; ++i) {
        const int r = lr + 32 * i;
        const int srow = g.rowidx ? g.rowidx[(r < g.nvalid) ? r : 0] : (m0 + r);
        aoff[i] = srow * g.lda + kc * 8;
        boff[i] = (n0 + r) * g.ldb + kc * 8;
    }
    const int ldsw = lr * 128 + ((kc ^ ((lr >> 1) & 7)) << 4);
    f32x4 acc[4][4];
#pragma unroll
    for (int i = 0; i < 4; ++i)
#pragma unroll
        for (int j = 0; j < 4; ++j) acc[i][j] = (f32x4){0.f, 0.f, 0.f, 0.f};
    u32x4 ra[4], rb[4];
    const int nk = g.K / 64;
    __syncthreads();
    {
        const bf16_t* Bb = (0 < g.ksplit) ? g.B0 : g.B1;
#pragma unroll
        for (int i = 0; i < 4; ++i) { ra[i] = *(const u32x4*)(g.A + aoff[i]); rb[i] = *(const u32x4*)(Bb + boff[i]); }
#pragma unroll
        for (int i = 0; i < 4; ++i) { *(LAS u32x4*)(lds + ldsw + 4096 * i) = ra[i]; *(LAS u32x4*)(lds + 16384 + ldsw + 4096 * i) = rb[i]; }
    }
    __syncthreads();
    const int swz = (lane >> 1) & 7, q = lane >> 4;
    const int arow = (64 * wm + (lane & 15)) * 128, brow = (64 * wn + (lane & 15)) * 128;
    for (int kt = 0; kt < nk; ++kt) {
        const int cur = kt & 1;
        if (kt + 1 < nk) {
            const int k0 = (kt + 1) * 64;
            const bf16_t* Bb = (k0 < g.ksplit) ? g.B0 + k0 : g.B1 + (k0 - g.ksplit);
#pragma unroll
            for (int i = 0; i < 4; ++i) { ra[i] = *(const u32x4*)(g.A + aoff[i] + k0); rb[i] = *(const u32x4*)(Bb + boff[i]); }
        }
        LAS const char* As = lds + cur * 32768; LAS const char* Bs = As + 16384;
#pragma unroll
        for (int ks = 0; ks < 2; ++ks) {
            const int ch = ((4 * ks + q) ^ swz) << 4;
            bf16x8 af[4], bfr[4];
#pragma unroll
            for (int f = 0; f < 4; ++f) { af[f] = lds_r128(As + arow + f * 2048 + ch); bfr[f] = lds_r128(Bs + brow + f * 2048 + ch); }
#pragma unroll
            for (int nf = 0; nf < 4; ++nf)
#pragma unroll
                for (int mf = 0; mf < 4; ++mf) acc[nf][mf] = __builtin_amdgcn_mfma_f32_16x16x32_bf16(bfr[nf], af[mf], acc[nf][mf], 0, 0, 0);
        }
        if (kt + 1 < nk) {
            LAS char* An = lds + (cur ^ 1) * 32768;
#pragma unroll
            for (int i = 0; i < 4; ++i) { *(LAS u32x4*)(An + ldsw + 4096 * i) = ra[i]; *(LAS u32x4*)(An + 16384 + ldsw + 4096 * i) = rb[i]; }
        }
        __syncthreads();
    }
    epi(acc, 64 * wm, n0 + 64 * wn, lane);
}

DEV void p0_transpose(const float* W, int K, int N, bf16_t* WT, int kt, int nt, bool upperm, LAS float* scr) {
    const int tid = threadIdx.x, nn = tid & 63, kq = tid >> 6;
    const int n_in = nt * 64 + nn;
#pragma unroll 4
    for (int i = 0; i < 16; ++i) { const int kk = kq + 4 * i; scr[kk * 65 + nn] = (n_in < N) ? W[(size_t)(kt * 64 + kk) * N + n_in] : 0.f; }
    __syncthreads();
    const int nl = tid >> 2, kcq = tid & 3, n = nt * 64 + nl;
    if (n < N) {
        int drow = n;
        if (upperm) { const int type = n >> 8, j = n & 255; drow = 128 * (j >> 6) + 64 * ((j >> 5) & 1) + 16 * (((j >> 4) & 1) + 2 * type) + (j & 15); }
        unsigned o[8];
#pragma unroll
        for (int j = 0; j < 8; ++j) o[j] = pk2(scr[(kcq * 16 + 2 * j) * 65 + nl], scr[(kcq * 16 + 2 * j + 1) * 65 + nl]);
        bf16_t* d = WT + (size_t)drow * K + kt * 64 + kcq * 16;
        *(u32x4*)d = (u32x4){o[0], o[1], o[2], o[3]};
        *(u32x4*)(d + 8) = (u32x4){o[4], o[5], o[6], o[7]};
    }
    __syncthreads();
}
constexpr int T_IN = 16 * 35, T_OUT = 16 * 16, T_UP = 16 * 16 * 8, T_DN = 16 * 4 * 16, T_QB = 4 * 6, T_KVB = 2 * 8;
constexpr int T_LAYER = T_IN + T_OUT + T_UP + T_DN + T_QB + T_KVB;
constexpr int P0_TR = NL * T_LAYER, P0_WSG = 64, P0_MODV = NL * 96, P0_ROPE = 384, P0_PAD = 96;
constexpr int P0_ITEMS = P0_TR + P0_WSG + P0_MODV + P0_ROPE + P0_PAD;

DEV void phase_p0(const Ctx& c) {
    const int tid = threadIdx.x;
    LAS float* scr = (LAS float*)c.lds;
    for (int it = c.bid; it < P0_ITEMS; it += c.nb) {
        int r = it;
        if (r < P0_TR) {
            const int l = r / T_LAYER; r -= l * T_LAYER;
            if (r < T_IN) { p0_transpose(c.in(I_WIN) + (size_t)l * 1024 * INC, 1024, INC, c.ws<bf16_t>(WS_WIN) + (size_t)l * INCP * 1024, r / 35, r % 35, false, scr); continue; } r -= T_IN;
            if (r < T_OUT) { p0_transpose(c.in(I_WOUT) + (size_t)l * 1024 * 1024, 1024, 1024, c.ws<bf16_t>(WS_WOUT) + (size_t)l * 1024 * 1024, r / 16, r % 16, false, scr); continue; } r -= T_OUT;
            if (r < T_UP) { const int e = r / 128, q = r % 128;
                p0_transpose(c.in(I_WUP) + ((size_t)l * 16 + e) * 1024 * 512, 1024, 512, c.ws<bf16_t>(WS_WUP) + ((size_t)l * 16 + e) * 512 * 1024, q / 8, q % 8, true, scr); continue; } r -= T_UP;
            if (r < T_DN) { const int e = r / 64, q = r % 64;
                p0_transpose(c.in(I_WDN) + ((size_t)l * 16 + e) * 256 * 1024, 256, 1024, c.ws<bf16_t>(WS_WDN) + ((size_t)l * 16 + e) * 1024 * 256, q / 16, q % 16, false, scr); continue; } r -= T_DN;
            if (r < T_QB) { p0_transpose(c.in(I_WQB) + (size_t)l * 256 * 384, 256, 384, c.ws<bf16_t>(WS_WQB) + (size_t)l * 384 * 256, r / 6, r % 6, false, scr); continue; } r -= T_QB;
            p0_transpose(c.in(I_WKVB) + (size_t)l * 128 * 512, 128, 512, c.ws<bf16_t>(WS_WKVB) + (size_t)l * 512 * 128, r / 8, r % 8, false, scr); continue;
        }
        r -= P0_TR;
        if (r < P0_WSG) {
            const size_t e0 = ((size_t)r * 256 + tid) * 8; const float* s = c.in(I_SGUW) + e0;
            const f32x4 a = *(const f32x4*)s, b = *(const f32x4*)(s + 4);
            *(u32x4*)(c.ws<bf16_t>(WS_WSG) + e0) = (u32x4){pk2(a[0], a[1]), pk2(a[2], a[3]), pk2(b[0], b[1]), pk2(b[2], b[3])};
            continue;
        }
        r -= P0_WSG;
        if (r < P0_MODV) {
            const int l = r / 96, n0 = (r % 96) * 64;
            LAS float* sc = scr;
            LAS float* red = scr + 9 * 1024;
            __syncthreads();
            for (int i = tid; i < 9 * 1024; i += 256) { const int mb = i >> 10, k = i & 1023; sc[i] = silu_f(mb < 8 ? c.in(I_C)[mb * 1024 + k] : c.in(I_CCTX)[k]); }
            __syncthreads();
            const int kq = tid >> 6, nl = tid & 63;
            float a[9];
#pragma unroll
            for (int j = 0; j < 9; ++j) a[j] = 0.f;
            const float* wp = c.in(I_WMOD) + (size_t)l * 1024 * 6144 + n0 + nl;
#pragma unroll 4
            for (int k = kq * 256; k < kq * 256 + 256; ++k) { const float w = wp[(size_t)k * 6144];
#pragma unroll
                for (int j = 0; j < 9; ++j) a[j] += sc[j * 1024 + k] * w; }
#pragma unroll
            for (int j = 0; j < 9; ++j) red[(kq * 9 + j) * 64 + nl] = a[j];
            __syncthreads();
            for (int i = tid; i < 9 * 64; i += 256) { const int mb = i >> 6, n = i & 63;
                const float v = red[(0 * 9 + mb) * 64 + n] + red[(1 * 9 + mb) * 64 + n] + red[(2 * 9 + mb) * 64 + n] + red[(3 * 9 + mb) * 64 + n];
                c.ws<float>(WS_MODV)[(size_t)(l * 9 + mb) * 6144 + n0 + n] = v + c.in(I_BMOD)[l * 6144 + n0 + n]; }
            __syncthreads();
            continue;
        }
        r -= P0_MODV;
        if (r < P0_ROPE) {
            const int idx = r * 256 + tid;
            if (idx < 2048 * 32) { const int s = idx >> 5, i = idx & 31, f = i & 15; const float pos = (float)((i < 16) ? (s >> 6) : (s & 63));
                const float inv = powf(10000.f, -(float)f / 16.f), ang = pos * inv;
                c.ws<float>(WS_ROPEC)[idx] = cosf(ang); c.ws<float>(WS_ROPEC)[2048 * 32 + idx] = sinf(ang); }
            else { const int j = idx - 2048 * 32, s = j >> 4, i = j & 15, f = i & 7; const float pos = (float)((i < 8) ? (s >> 6) : (s & 63));
                const float inv = powf(10000.f, -(float)f / 8.f), ang = pos * inv;
                c.ws<float>(WS_ROPED)[j] = cosf(ang); c.ws<float>(WS_ROPED)[2048 * 16 + j] = sinf(ang); }
            continue;
        }
        r -= P0_ROPE;
        {
            const int e = (r * 256 + tid) * 8, l = e / (96 * 1024), o = e % (96 * 1024);
            *(u32x4*)(c.ws<bf16_t>(WS_WIN) + ((size_t)l * INCP + INC) * 1024 + o) = (u32x4){0u, 0u, 0u, 0u};
        }
    }
}

constexpr int A_RW_ITEMS = NL * 9 * 1024 / 256;
constexpr int A_RC_ITEMS = NL * 9 * 20 / 4;
DEV void phase_a(const Ctx& c) {
    const int tid = threadIdx.x, lane = tid & 63, wave = tid >> 6;
    const float* g = c.in(I_GATTN) + c.layer * 1024;
    bf16_t* H = c.ws<bf16_t>(WS_ACT);
    for (int tok = c.bid * 4 + wave; tok < NTOK; tok += c.nb * 4) {
        const int mb = tok < NLAT ? (tok >> 11) : 8;
        const float* x = c.xsrc(tok); const float* sh = c.modv(mb, 0); const float* scl = c.modv(mb, 1);
        f32x4 v[4]; float ss = 0.f;
#pragma unroll
        for (int i = 0; i < 4; ++i) { v[i] = *(const f32x4*)(x + i * 256 + lane * 4); ss += v[i][0] * v[i][0] + v[i][1] * v[i][1] + v[i][2] * v[i][2] + v[i][3] * v[i][3]; }
        const float r = rsqrtf(wave_sum(ss) * (1.f / 1024.f) + EPS);
#pragma unroll
        for (int i = 0; i < 4; ++i) { const int e = i * 256 + lane * 4;
            const f32x4 gg = *(const f32x4*)(g + e), s1 = *(const f32x4*)(scl + e), s0 = *(const f32x4*)(sh + e);
            float o[4];
#pragma unroll
            for (int j = 0; j < 4; ++j) o[j] = v[i][j] * r * gg[j] * (1.f + s1[j]) + s0[j];
            *(u32x2*)(H + (size_t)tok * 1024 + e) = (u32x2){pk2(o[0], o[1]), pk2(o[2], o[3])}; }
    }
    if (c.layer == 0) {
        for (int it = c.bid; it < A_RW_ITEMS + A_RC_ITEMS; it += c.nb) {
            if (it < A_RW_ITEMS) {
                const int idx = it * 256 + tid, l = idx / (9 * 1024), mb = (idx >> 10) % 9, k = idx & 1023;
                const float* mv = c.ws<float>(WS_MODV) + (size_t)(l * 9 + mb) * 6144;
                const float gm = c.in(I_GFFN)[l * 1024 + k] * (1.f + mv[4 * 1024 + k]);
                float* o = c.ws<float>(WS_RW) + (size_t)idx * 20;
                const float* wg = c.in(I_WRG) + ((size_t)l * 1024 + k) * 4; const float* we = c.in(I_WRE) + ((size_t)l * 1024 + k) * 16;
#pragma unroll
                for (int j = 0; j < 4; ++j) o[j] = gm * wg[j];
#pragma unroll
                for (int j = 0; j < 16; ++j) o[4 + j] = gm * we[j];
            } else {
                const int idx = (it - A_RW_ITEMS) * 4 + wave, l = idx / 180, mb = (idx / 20) % 9, j = idx % 20;
                const float* mv = c.ws<float>(WS_MODV) + (size_t)(l * 9 + mb) * 6144 + 3 * 1024;
                float a = 0.f;
                for (int k = lane; k < 1024; k += 64) { const float w = (j < 4) ? c.in(I_WRG)[((size_t)l * 1024 + k) * 4 + j] : c.in(I_WRE)[((size_t)l * 1024 + k) * 16 + (j - 4)]; a += mv[k] * w; }
                a = wave_sum(a);
                if (lane == 0) c.ws<float>(WS_RC)[(l * 9 + mb) * 32 + j] = a + ((j < 4) ? c.in(I_BRG)[l * 4 + j] : c.in(I_BRE)[l * 16 + j - 4]);
            }
        }
    }
}

DEV void phase_b(const Ctx& c) {
    bf16_t* P = c.ws<bf16_t>(WS_P);
    GemmDesc g; g.A = c.ws<bf16_t>(WS_ACT); g.lda = 1024; g.rowidx = nullptr; g.nvalid = 0;
    g.B0 = c.ws<bf16_t>(WS_WIN) + (size_t)c.layer * INCP * 1024; g.B1 = g.B0; g.ldb = 1024; g.ksplit = 1 << 30; g.K = 1024;
    constexpr int NT_N = INCP / 128, NT_M = NTOK / 128;
    for (int t = c.bid; t < NT_M * NT_N; t += c.nb) {
        const int mt = t / NT_N, nt = t % NT_N, m0 = mt * 128;
        gemm_tile(g, m0, nt * 128, c.lds, [&](const f32x4 (&acc)[4][4], int mb, int nbase, int lane) {
#pragma unroll
            for (int nf = 0; nf < 4; ++nf) { const int n = nbase + 16 * nf + 4 * (lane >> 4);
                if (n < INC) {
#pragma unroll
                    for (int mf = 0; mf < 4; ++mf) { const int m = m0 + mb + 16 * mf + (lane & 15); const f32x4 a = acc[nf][mf];
                        *(u32x2*)(P + (size_t)m * INC + n) = (u32x2){pk2(a[0], a[1]), pk2(a[2], a[3])}; } } }
        });
    }
}

constexpr int C_PREP_ITEMS = NTOK / 64, C_SGU_ITEMS = (NTOK / 128) * 4;
constexpr int VT_LD = 72;
DEV void rope2(float& a, float& b, float cs, float sn) { const float x0 = a, x1 = b; a = x0 * cs - x1 * sn; b = x0 * sn + x1 * cs; }
DEV void phase_c_prep(const Ctx& c, int item) {
    const int tid = threadIdx.x, lane = tid & 63, wave = tid >> 6, li = lane & 15, l = c.layer;
    const bf16_t* P = c.ws<bf16_t>(WS_P);
    LAS bf16_t* vt = (LAS bf16_t*)c.lds;
    const int tok0 = item * 64;
    int b0, pos0, key0; bool isctx; tok_info(tok0, b0, pos0, key0, isctx);
    const float* cosC = c.ws<float>(WS_ROPEC); const float* sinC = cosC + 2048 * 32;
    const float* cosD = c.ws<float>(WS_ROPED); const float* sinD = cosD + 2048 * 16;
    const int seqlen = isctx ? CL : SEQ;
    __syncthreads();
    for (int i = 0; i < 16; ++i) {
        const int tl = wave * 16 + i, tok = tok0 + tl, pos = pos0 + tl, key = key0 + tl;
        const bf16_t* pr = P + (size_t)tok * INC;
        {
            const u32x2 raw = *(const u32x2*)(pr + OFF_CQ + 4 * lane);
            float q[4] = {bflo(raw[0]), bfhi(raw[0]), bflo(raw[1]), bfhi(raw[1])};
            const float r = rsqrtf(grp_sum16(q[0] * q[0] + q[1] * q[1] + q[2] * q[2] + q[3] * q[3]) * (1.f / 64.f) + EPS);
            const f32x4 gg = *(const f32x4*)(c.in(I_GQAQG) + l * 64 + 4 * li);
#pragma unroll
            for (int j = 0; j < 4; ++j) q[j] = q[j] * r * gg[j];
            if (!isctx) { const float* cs = cosC + pos * 32 + 2 * li; const float* sn = sinC + pos * 32 + 2 * li; rope2(q[0], q[1], cs[0], sn[0]); rope2(q[2], q[3], cs[1], sn[1]); }
            const float sc = C_SCALE * LOG2E;
            *(u32x2*)(c.ws<bf16_t>(WS_QC) + ((size_t)(b0 * 4 + (lane >> 4)) * KEYS + key) * 64 + 4 * li) = (u32x2){pk2(q[0] * sc, q[1] * sc), pk2(q[2] * sc, q[3] * sc)};
        }
        {
            const int col = lane < 32 ? OFF_CK + 4 * lane : OFF_CV + 4 * (lane - 32);
            const u32x2 raw = *(const u32x2*)(pr + col);
            float k[4] = {bflo(raw[0]), bfhi(raw[0]), bflo(raw[1]), bfhi(raw[1])};
            const int kvh = (lane >> 4) & 1;
            const float r = rsqrtf(grp_sum16(k[0] * k[0] + k[1] * k[1] + k[2] * k[2] + k[3] * k[3]) * (1.f / 64.f) + EPS);
            if (lane < 32) {
                const f32x4 gg = *(const f32x4*)(c.in(I_GQAKG) + l * 64 + 4 * li);
#pragma unroll
                for (int j = 0; j < 4; ++j) k[j] = k[j] * r * gg[j];
                if (!isctx) { const float* cs = cosC + pos * 32 + 2 * li; const float* sn = sinC + pos * 32 + 2 * li; rope2(k[0], k[1], cs[0], sn[0]); rope2(k[2], k[3], cs[1], sn[1]); }
                *(u32x2*)(c.ws<bf16_t>(WS_KC) + ((size_t)(b0 * 2 + kvh) * KEYS + key) * 64 + 4 * li) = (u32x2){pk2(k[0], k[1]), pk2(k[2], k[3])};
            } else {
                const unsigned short e0 = (unsigned short)(raw[0] & 0xffffu), e1 = (unsigned short)(raw[0] >> 16), e2 = (unsigned short)(raw[1] & 0xffffu), e3 = (unsigned short)(raw[1] >> 16);
                LAS bf16_t* d = vt + (kvh * 64 + 4 * li) * VT_LD + tl;
                d[0] = e0; d[VT_LD] = e1; d[2 * VT_LD] = e2; d[3 * VT_LD] = e3;
            }
        }
        {
            const u32x2 raw = *(const u32x2*)(pr + OFF_DCQ + 4 * lane);
            float q[4] = {bflo(raw[0]), bfhi(raw[0]), bflo(raw[1]), bfhi(raw[1])};
            const float r = rsqrtf(wave_sum(q[0] * q[0] + q[1] * q[1] + q[2] * q[2] + q[3] * q[3]) * (1.f / 256.f) + EPS);
            const f32x4 gg = *(const f32x4*)(c.in(I_QAG) + l * 256 + 4 * lane);
            *(u32x2*)(c.ws<bf16_t>(WS_CQN) + (size_t)tok * 256 + 4 * lane) = (u32x2){pk2(q[0] * r * gg[0], q[1] * r * gg[1]), pk2(q[2] * r * gg[2], q[3] * r * gg[3])};
        }
        {
            const int col = lane < 32 ? OFF_DCKV + 4 * lane : OFF_DKR + 4 * ((lane - 32) & 7);
            const u32x2 raw = *(const u32x2*)(pr + col);
            float v[4] = {bflo(raw[0]), bfhi(raw[0]), bflo(raw[1]), bfhi(raw[1])};
            float s = v[0] * v[0] + v[1] * v[1] + v[2] * v[2] + v[3] * v[3];
            s += __shfl_xor(s, 1); s += __shfl_xor(s, 2); s += __shfl_xor(s, 4);
            const float s8 = s;
            s += __shfl_xor(s, 8); s += __shfl_xor(s, 16);
            if (lane < 32) {
                const float r = rsqrtf(s * (1.f / 128.f) + EPS);
                const f32x4 gg = *(const f32x4*)(c.in(I_KVAG) + l * 128 + 4 * lane);
                *(u32x2*)(c.ws<bf16_t>(WS_CKVN) + (size_t)tok * 128 + 4 * lane) = (u32x2){pk2(v[0] * r * gg[0], v[1] * r * gg[1]), pk2(v[2] * r * gg[2], v[3] * r * gg[3])};
            } else if (lane < 40) {
                const int e = 4 * (lane - 32);
                const float r = rsqrtf(s8 * (1.f / 32.f) + EPS);
                const f32x4 gg = *(const f32x4*)(c.in(I_MLAKG) + l * 96 + 64 + e);
#pragma unroll
                for (int j = 0; j < 4; ++j) v[j] = v[j] * r * gg[j];
                if (!isctx) { const int p0 = 2 * (lane - 32); const float* cs = cosD + pos * 16 + p0; const float* sn = sinD + pos * 16 + p0; rope2(v[0], v[1], cs[0], sn[0]); rope2(v[2], v[3], cs[1], sn[1]); }
                const u32x2 o = (u32x2){pk2(v[0], v[1]), pk2(v[2], v[3])};
#pragma unroll
                for (int h = 0; h < 4; ++h) *(u32x2*)(c.ws<bf16_t>(WS_KD) + ((size_t)(b0 * 4 + h) * KEYS + key) * 96 + 64 + e) = o;
            }
        }
        {
            const int ch = 4 * lane;
            const u32x2 rbb = *(const u32x2*)(pr + OFF_BB + ch);
            float z[3][4];
#pragma unroll
            for (int d = 0; d < 3; ++d) {
                const int pp = pos + d - 1; const bool ok = (pp >= 0) && (pp < seqlen);
                const bf16_t* prr = P + (size_t)(tok + (ok ? d - 1 : 0)) * INC;
                const u32x2 rc = *(const u32x2*)(prr + OFF_BC + ch), rx = *(const u32x2*)(prr + OFF_BX + ch);
                const float m = ok ? 1.f : 0.f;
                z[d][0] = m * bflo(rc[0]) * bflo(rx[0]); z[d][1] = m * bfhi(rc[0]) * bfhi(rx[0]); z[d][2] = m * bflo(rc[1]) * bflo(rx[1]); z[d][3] = m * bfhi(rc[1]) * bfhi(rx[1]);
            }
            const float* cw = c.in(I_CONVW) + l * 768 + ch;
            const f32x4 w0 = *(const f32x4*)cw, w1 = *(const f32x4*)(cw + 256), w2 = *(const f32x4*)(cw + 512);
            const float bb[4] = {bflo(rbb[0]), bfhi(rbb[0]), bflo(rbb[1]), bfhi(rbb[1])};
            float y[4];
#pragma unroll
            for (int j = 0; j < 4; ++j) y[j] = bb[j] * (w0[j] * z[0][j] + w1[j] * z[1][j] + w2[j] * z[2][j]);
            *(u32x2*)(c.ws<bf16_t>(WS_ACT) + (size_t)tok * 1024 + 256 + ch) = (u32x2){pk2(y[0], y[1]), pk2(y[2], y[3])};
        }
    }
    __syncthreads();
    {
        const int row = tid >> 1, half = tid & 1, kvh = row >> 6, d = row & 63;
        bf16_t* dst = c.ws<bf16_t>(WS_VCT) + ((size_t)(b0 * 2 + kvh) * 64 + d) * KEYS + key0 + 32 * half;
        LAS const bf16_t* src = vt + row * VT_LD + 32 * half;
#pragma unroll
        for (int j = 0; j < 4; ++j) *(u32x4*)(dst + 8 * j) = *(LAS const u32x4*)(src + 8 * j);
    }
    __syncthreads();
}
constexpr int SG_LD = 272;
DEV void phase_c_sgu(const Ctx& c, int item) {
    const int tid = threadIdx.x, lane = tid & 63, wave = tid >> 6, l = c.layer;
    const int chunk = item >> 2, h = item & 3, tok0 = chunk * 128;
    const bf16_t* P = c.ws<bf16_t>(WS_P);
    LAS char* Wt = c.lds;
    LAS char* vT = c.lds + 128 * SG_LD;
    __syncthreads();
    {
        const bf16_t* Wsrc = c.ws<bf16_t>(WS_WSG) + (size_t)(l * 4 + h) * 128 * 128;
#pragma unroll
        for (int i = 0; i < 8; ++i) { const int ci = tid + 256 * i, r = ci >> 4, kc = ci & 15; *(LAS u32x4*)(Wt + r * SG_LD + kc * 16) = *(const u32x4*)(Wsrc + r * 128 + kc * 8); }
        const int j = tid >> 1, half = tid & 1;
        const bf16_t* vp = P + (size_t)(tok0 + j) * INC + OFF_AV + 64 * h + 32 * half;
        float v[32]; float ss = 0.f;
#pragma unroll
        for (int q = 0; q < 4; ++q) { const u32x4 raw = *(const u32x4*)(vp + 8 * q);
#pragma unroll
            for (int e = 0; e < 4; ++e) { const float a = gelu_tanh(bflo(raw[e])), b = gelu_tanh(bfhi(raw[e])); v[8 * q + 2 * e] = a; v[8 * q + 2 * e + 1] = b; ss += a * a + b * b; } }
        ss += __shfl_xor(ss, 1);
        const float r = rsqrtf(ss * (1.f / 64.f) + EPS);
        const float* vg = c.in(I_SGUVG) + l * 256 + 64 * h + 32 * half;
#pragma unroll
        for (int e = 0; e < 32; ++e) *(LAS bf16_t*)(vT + (32 * half + e) * SG_LD + j * 2) = f2bf(v[e] * r * vg[e]);
    }
    __syncthreads();
    f32x4 acc[4][2];
#pragma unroll
    for (int a = 0; a < 4; ++a) { acc[a][0] = (f32x4){0.f, 0.f, 0.f, 0.f}; acc[a][1] = acc[a][0]; }
    const int q = lane >> 4, li = lane & 15;
#pragma unroll
    for (int ks = 0; ks < 4; ++ks) {
        bf16x8 af[4], bfr[2];
#pragma unroll
        for (int df = 0; df < 4; ++df) af[df] = lds_r128(vT + (16 * df + li) * SG_LD + (4 * ks + q) * 16);
#pragma unroll
        for (int f = 0; f < 2; ++f) bfr[f] = lds_r128(Wt + (32 * wave + 16 * f + li) * SG_LD + (4 * ks + q) * 16);
#pragma unroll
        for (int df = 0; df < 4; ++df)
#pragma unroll
            for (int f = 0; f < 2; ++f) acc[df][f] = __builtin_amdgcn_mfma_f32_16x16x32_bf16(af[df], bfr[f], acc[df][f], 0, 0, 0);
    }
    bf16_t* Y = c.ws<bf16_t>(WS_ACT);
#pragma unroll
    for (int f = 0; f < 2; ++f) {
        const int i = 32 * wave + 16 * f + li, tok = tok0 + i;
        const float bs = c.in(I_SGUB)[(l * 4 + h) * 128 + i];
#pragma unroll
        for (int df = 0; df < 4; ++df) {
            const int d0 = 16 * df + 4 * q;
            const u32x2 ur = *(const u32x2*)(P + (size_t)tok * INC + OFF_AU + 64 * h + d0);
            const float u[4] = {gelu_tanh(bflo(ur[0])), gelu_tanh(bfhi(ur[0])), gelu_tanh(bflo(ur[1])), gelu_tanh(bfhi(ur[1]))};
            const f32x4 a = acc[df][f];
            *(u32x2*)(Y + (size_t)tok * 1024 + 64 * h + d0) = (u32x2){pk2(u[0] * (a[0] + bs), u[1] * (a[1] + bs)), pk2(u[2] * (a[2] + bs), u[3] * (a[3] + bs))};
        }
    }
}
DEV void phase_c(const Ctx& c) {
    for (int it = c.bid; it < C_SGU_ITEMS + C_PREP_ITEMS; it += c.nb) {
        if (it < C_SGU_ITEMS) phase_c_sgu(c, it); else phase_c_prep(c, it - C_SGU_ITEMS);
    }
}

DEV void phase_d0(const Ctx& c) {
    constexpr int NT_M = NTOK / 128, TQ = NT_M * 3, TKV = NT_M * 4;
    for (int t = c.bid; t < TQ + TKV; t += c.nb) {
        GemmDesc g; g.rowidx = nullptr; g.nvalid = 0; g.ksplit = 1 << 30;
        bf16_t* O; int ldo, mt, nt;
        if (t < TQ) { mt = t / 3; nt = t % 3; g.A = c.ws<bf16_t>(WS_CQN); g.lda = 256; g.K = 256; g.B0 = c.ws<bf16_t>(WS_WQB) + (size_t)c.layer * 384 * 256; g.ldb = 256; O = c.ws<bf16_t>(WS_QRAW); ldo = 384; }
        else { const int u = t - TQ; mt = u / 4; nt = u % 4; g.A = c.ws<bf16_t>(WS_CKVN); g.lda = 128; g.K = 128; g.B0 = c.ws<bf16_t>(WS_WKVB) + (size_t)c.layer * 512 * 128; g.ldb = 128; O = c.ws<bf16_t>(WS_KVRAW); ldo = 512; }
        g.B1 = g.B0;
        const int m0 = mt * 128;
        gemm_tile(g, m0, nt * 128, c.lds, [&](const f32x4 (&acc)[4][4], int mb, int nbase, int lane) {
#pragma unroll
            for (int nf = 0; nf < 4; ++nf) { const int n = nbase + 16 * nf + 4 * (lane >> 4);
#pragma unroll
                for (int mf = 0; mf < 4; ++mf) { const int m = m0 + mb + 16 * mf + (lane & 15); const f32x4 a = acc[nf][mf];
                    *(u32x2*)(O + (size_t)m * ldo + n) = (u32x2){pk2(a[0], a[1]), pk2(a[2], a[3])}; } }
        });
    }
}

DEV void phase_d1(const Ctx& c) {
    const int tid = threadIdx.x, lane = tid & 63, wave = tid >> 6, li = lane & 15, hd = lane >> 4, l = c.layer;
    LAS bf16_t* vt = (LAS bf16_t*)c.lds;
    const bf16_t* QR = c.ws<bf16_t>(WS_QRAW); const bf16_t* KVR = c.ws<bf16_t>(WS_KVRAW);
    const float* cosD = c.ws<float>(WS_ROPED); const float* sinD = cosD + 2048 * 16;
    for (int item = c.bid; item < NTOK / 64; item += c.nb) {
        const int tok0 = item * 64;
        int b0, pos0, key0; bool isctx; tok_info(tok0, b0, pos0, key0, isctx);
        __syncthreads();
        for (int i = 0; i < 16; ++i) {
            const int tl = wave * 16 + i, tok = tok0 + tl, pos = pos0 + tl, key = key0 + tl;
            {
                const u32x2 rn = *(const u32x2*)(QR + (size_t)tok * 384 + 96 * hd + 4 * li);
                const unsigned rr = *(const unsigned*)(QR + (size_t)tok * 384 + 96 * hd + 64 + 2 * li);
                float qn[4] = {bflo(rn[0]), bfhi(rn[0]), bflo(rn[1]), bfhi(rn[1])}; float qr[2] = {bflo(rr), bfhi(rr)};
                const float r_n = rsqrtf(grp_sum16(qn[0] * qn[0] + qn[1] * qn[1] + qn[2] * qn[2] + qn[3] * qn[3]) * (1.f / 64.f) + EPS);
                const float r_r = rsqrtf(grp_sum16(qr[0] * qr[0] + qr[1] * qr[1]) * (1.f / 32.f) + EPS);
                const float* qg = c.in(I_MLAQG) + l * 96;
                const float sc = D_SCALE * LOG2E;
#pragma unroll
                for (int j = 0; j < 4; ++j) qn[j] = qn[j] * r_n * qg[4 * li + j] * sc;
                qr[0] = qr[0] * r_r * qg[64 + 2 * li]; qr[1] = qr[1] * r_r * qg[64 + 2 * li + 1];
                if (!isctx) rope2(qr[0], qr[1], cosD[pos * 16 + li], sinD[pos * 16 + li]);
                bf16_t* qd = c.ws<bf16_t>(WS_QD) + ((size_t)(b0 * 4 + hd) * KEYS + key) * 96;
                *(u32x2*)(qd + 4 * li) = (u32x2){pk2(qn[0], qn[1]), pk2(qn[2], qn[3])};
                *(unsigned*)(qd + 64 + 2 * li) = pk2(qr[0] * sc, qr[1] * sc);
            }
            {
                const u32x2 rk = *(const u32x2*)(KVR + (size_t)tok * 512 + 128 * hd + 4 * li);
                const u32x2 rv = *(const u32x2*)(KVR + (size_t)tok * 512 + 128 * hd + 64 + 4 * li);
                float k[4] = {bflo(rk[0]), bfhi(rk[0]), bflo(rk[1]), bfhi(rk[1])};
                const float r = rsqrtf(grp_sum16(k[0] * k[0] + k[1] * k[1] + k[2] * k[2] + k[3] * k[3]) * (1.f / 64.f) + EPS);
                const float* kg = c.in(I_MLAKG) + l * 96 + 4 * li;
                *(u32x2*)(c.ws<bf16_t>(WS_KD) + ((size_t)(b0 * 4 + hd) * KEYS + key) * 96 + 4 * li) = (u32x2){pk2(k[0] * r * kg[0], k[1] * r * kg[1]), pk2(k[2] * r * kg[2], k[3] * r * kg[3])};
                LAS bf16_t* d = vt + (hd * 64 + 4 * li) * VT_LD + tl;
                d[0] = (bf16_t)(rv[0] & 0xffffu); d[VT_LD] = (bf16_t)(rv[0] >> 16); d[2 * VT_LD] = (bf16_t)(rv[1] & 0xffffu); d[3 * VT_LD] = (bf16_t)(rv[1] >> 16);
            }
        }
        __syncthreads();
        {
            const int row = tid, h = row >> 6, d = row & 63;
            bf16_t* dst = c.ws<bf16_t>(WS_VDT) + ((size_t)(b0 * 4 + h) * 64 + d) * KEYS + key0;
            LAS const bf16_t* src = vt + row * VT_LD;
#pragma unroll
            for (int j = 0; j < 8; ++j) *(u32x4*)(dst + 8 * j) = *(LAS const u32x4*)(src + 8 * j);
        }
    }
}

constexpr int AT_KN = 0, AT_KR = 8192, AT_V = 12288, AT_STAGE = 21504, AT_VLD = 136;
template <int DK>
DEV void attn_item(const bf16_t* Q, const bf16_t* K, const bf16_t* Vt, int nkeys, bf16_t* Yrow, LAS char* lds) {
    const int tid = threadIdx.x, lane = tid & 63, wave = tid >> 6, l31 = lane & 31, h5 = lane >> 5;
    constexpr int NS = DK / 16;
    bf16x8 qf[NS];
#pragma unroll
    for (int s = 0; s < NS; ++s) qf[s] = *(const bf16x8*)(Q + (size_t)(32 * wave + l31) * DK + 16 * s + 8 * h5);
    f32x16 oacc[2];
#pragma unroll
    for (int i = 0; i < 16; ++i) { oacc[0][i] = 0.f; oacc[1][i] = 0.f; }
    float mrun = -1e30f, lsum = 0.f;
    const int kr_ = tid >> 3, kc_ = tid & 7;
    const int rr_ = tid >> 2, rc_ = tid & 3;
    u32x4 rk[2], rv[2], rrp;
    const int nt = nkeys / 64;
    auto gload = [&](int t) {
        const int k0 = t * 64;
#pragma unroll
        for (int i = 0; i < 2; ++i) { rk[i] = *(const u32x4*)(K + (size_t)(k0 + kr_ + 32 * i) * DK + kc_ * 8); rv[i] = *(const u32x4*)(Vt + (size_t)(kr_ + 32 * i) * KEYS + k0 + kc_ * 8); }
        if (DK == 96) rrp = *(const u32x4*)(K + (size_t)(k0 + rr_) * DK + 64 + rc_ * 8);
    };
    auto lstore = [&](int st) {
        LAS char* base = lds + st * AT_STAGE;
#pragma unroll
        for (int i = 0; i < 2; ++i) { const int r = kr_ + 32 * i;
            *(LAS u32x4*)(base + AT_KN + r * 128 + ((kc_ ^ ((r >> 1) & 7)) << 4)) = rk[i];
            LAS char* vd = base + AT_V + r * AT_VLD + kc_ * 16;
            *(LAS u32x2*)vd = (u32x2){rv[i][0], rv[i][1]}; *(LAS u32x2*)(vd + 8) = (u32x2){rv[i][2], rv[i][3]}; }
        if (DK == 96) *(LAS u32x4*)(base + AT_KR + rr_ * 64 + ((rc_ ^ ((rr_ >> 2) & 3)) << 4)) = rrp;
    };
    __syncthreads();
    gload(0); lstore(0);
    __syncthreads();
    for (int t = 0; t < nt; ++t) {
        const int cur = t & 1;
        if (t + 1 < nt) gload(t + 1);
        LAS const char* base = lds + cur * AT_STAGE;
        f32x16 sacc[2];
#pragma unroll
        for (int kt2 = 0; kt2 < 2; ++kt2) {
#pragma unroll
            for (int i = 0; i < 16; ++i) sacc[kt2][i] = 0.f;
            const int row = 32 * kt2 + l31;
#pragma unroll
            for (int s = 0; s < 4; ++s) { const bf16x8 kf = lds_r128(base + AT_KN + row * 128 + (((2 * s + h5) ^ ((row >> 1) & 7)) << 4));
                sacc[kt2] = __builtin_amdgcn_mfma_f32_32x32x16_bf16(kf, qf[s], sacc[kt2], 0, 0, 0); }
            if (DK == 96) {
#pragma unroll
                for (int s = 0; s < 2; ++s) { const bf16x8 kf = lds_r128(base + AT_KR + row * 64 + (((2 * s + h5) ^ ((row >> 2) & 3)) << 4));
                    sacc[kt2] = __builtin_amdgcn_mfma_f32_32x32x16_bf16(kf, qf[4 + s], sacc[kt2], 0, 0, 0); }
            }
        }
        float mt = sacc[0][0];
#pragma unroll
        for (int i = 1; i < 16; ++i) mt = fmaxf(mt, sacc[0][i]);
#pragma unroll
        for (int i = 0; i < 16; ++i) mt = fmaxf(mt, sacc[1][i]);
        mt = fmaxf(mt, __shfl_xor(mt, 32));
        const float mnew = fmaxf(mrun, mt), alpha = exp2f(mrun - mnew);
        mrun = mnew;
        float ps = 0.f;
#pragma unroll
        for (int kt2 = 0; kt2 < 2; ++kt2)
#pragma unroll
            for (int i = 0; i < 16; ++i) { const float p = exp2f(sacc[kt2][i] - mnew); sacc[kt2][i] = p; ps += p; }
        lsum = lsum * alpha + ps;
#pragma unroll
        for (int i = 0; i < 16; ++i) { oacc[0][i] *= alpha; oacc[1][i] *= alpha; }
        bf16x8 pf[2][2];
#pragma unroll
        for (int kt2 = 0; kt2 < 2; ++kt2)
#pragma unroll
            for (int s2 = 0; s2 < 2; ++s2) {
                u32x4 w;
#pragma unroll
                for (int j = 0; j < 4; ++j) w[j] = pk2(sacc[kt2][8 * s2 + 2 * j], sacc[kt2][8 * s2 + 2 * j + 1]);
                pf[kt2][s2] = __builtin_bit_cast(bf16x8, w);
            }
#pragma unroll
        for (int dt = 0; dt < 2; ++dt)
#pragma unroll
            for (int kt2 = 0; kt2 < 2; ++kt2)
#pragma unroll
                for (int s2 = 0; s2 < 2; ++s2) {
                    LAS const char* vp = base + AT_V + (32 * dt + l31) * AT_VLD + (32 * kt2 + 16 * s2 + 4 * h5) * 2;
                    const u32x2 lo = *(LAS const u32x2*)vp, hi = *(LAS const u32x2*)(vp + 16);
                    const bf16x8 vf = __builtin_bit_cast(bf16x8, (u32x4){lo[0], lo[1], hi[0], hi[1]});
                    oacc[dt] = __builtin_amdgcn_mfma_f32_32x32x16_bf16(vf, pf[kt2][s2], oacc[dt], 0, 0, 0);
                }
        if (t + 1 < nt) lstore(cur ^ 1);
        __syncthreads();
    }
    const float ltot = lsum + __shfl_xor(lsum, 32), inv = 1.f / ltot;
    bf16_t* yr = Yrow + (size_t)(32 * wave + l31) * 1024;
#pragma unroll
    for (int dt = 0; dt < 2; ++dt)
#pragma unroll
        for (int g = 0; g < 4; ++g) {
            const int d0 = 32 * dt + 8 * g + 4 * h5;
            *(u32x2*)(yr + d0) = (u32x2){pk2(oacc[dt][4 * g] * inv, oacc[dt][4 * g + 1] * inv), pk2(oacc[dt][4 * g + 2] * inv, oacc[dt][4 * g + 3] * inv)};
        }
}
DEV void phase_d(const Ctx& c) {
    const int nlat = 1024, nctx = (c.layer == NL - 1) ? 0 : 128;
    bf16_t* Y = c.ws<bf16_t>(WS_ACT);
    for (int it = c.bid; it < nlat + nctx; it += c.nb) {
        int type, b, h, qpos0, nkeys, tok0;
        if (it < nlat) { type = it >> 9; const int r = it & 511; b = r >> 6; h = (r >> 4) & 3; const int qb = r & 15; qpos0 = CL + 128 * qb; nkeys = KEYS; tok0 = b * SEQ + 128 * qb; }
        else { const int u = it - nlat; type = u >> 6; const int r = u & 63; b = r >> 3; h = (r >> 1) & 3; const int qb = r & 1; qpos0 = 128 * qb; nkeys = CL; tok0 = NLAT + b * CL + 128 * qb; }
        if (type == 0) {
            attn_item<96>(c.ws<bf16_t>(WS_QD) + ((size_t)(b * 4 + h) * KEYS + qpos0) * 96, c.ws<bf16_t>(WS_KD) + (size_t)(b * 4 + h) * KEYS * 96,
                          c.ws<bf16_t>(WS_VDT) + (size_t)(b * 4 + h) * 64 * KEYS, nkeys, Y + (size_t)tok0 * 1024 + 768 + 64 * h, c.lds);
        } else {
            attn_item<64>(c.ws<bf16_t>(WS_QC) + ((size_t)(b * 4 + h) * KEYS + qpos0) * 64, c.ws<bf16_t>(WS_KC) + (size_t)(b * 2 + (h >> 1)) * KEYS * 64,
                          c.ws<bf16_t>(WS_VCT) + (size_t)(b * 2 + (h >> 1)) * 64 * KEYS, nkeys, Y + (size_t)tok0 * 1024 + 512 + 64 * h, c.lds);
        }
    }
}

DEV void phase_e0(const Ctx& c) {
    const int tid = threadIdx.x, lane = tid & 63, wave = tid >> 6;
    bf16_t* Y = c.ws<bf16_t>(WS_ACT); const float* gg = c.in(I_GGO) + c.layer * 1024;
    const int ntok = c.ntok_tail();
    for (int tok = c.bid * 4 + wave; tok < ntok; tok += c.nb * 4) {
#pragma unroll
        for (int g = 0; g < 4; ++g) {
            bf16_t* p = Y + (size_t)tok * 1024 + g * 256 + 4 * lane;
            const u32x2 raw = *(const u32x2*)p;
            const float v[4] = {bflo(raw[0]), bfhi(raw[0]), bflo(raw[1]), bfhi(raw[1])};
            const float r = rsqrtf(wave_sum(v[0] * v[0] + v[1] * v[1] + v[2] * v[2] + v[3] * v[3]) * (1.f / 256.f) + EPS);
            const f32x4 gn = *(const f32x4*)(gg + g * 256 + 4 * lane);
            *(u32x2*)p = (u32x2){pk2(v[0] * r * gn[0], v[1] * r * gn[1]), pk2(v[2] * r * gn[2], v[3] * r * gn[3])};
        }
    }
}
DEV void phase_e(const Ctx& c) {
    GemmDesc g; g.A = c.ws<bf16_t>(WS_ACT); g.lda = 1024; g.rowidx = nullptr; g.nvalid = 0;
    g.B0 = c.ws<bf16_t>(WS_WOUT) + (size_t)c.layer * 1024 * 1024; g.B1 = g.B0; g.ldb = 1024; g.ksplit = 1 << 30; g.K = 1024;
    const int ntm = c.ntok_tail() / 128;
    for (int t = c.bid; t < ntm * 8; t += c.nb) {
        const int mt = t >> 3, nt = t & 7, m0 = mt * 128;
        const int mbi = m0 < NLAT ? (m0 >> 11) : 8;
        const float* gate = c.modv(mbi, 2);
        gemm_tile(g, m0, nt * 128, c.lds, [&](const f32x4 (&acc)[4][4], int mb, int nbase, int lane) {
#pragma unroll
            for (int nf = 0; nf < 4; ++nf) { const int n = nbase + 16 * nf + 4 * (lane >> 4); const f32x4 gt = *(const f32x4*)(gate + n);
#pragma unroll
                for (int mf = 0; mf < 4; ++mf) { const int m = m0 + mb + 16 * mf + (lane & 15);
                    const f32x4 xv = *(const f32x4*)(c.xsrc(m) + n); const f32x4 a = acc[nf][mf];
                    *(f32x4*)(c.xdst(m) + n) = (f32x4){xv[0] + gt[0] * a[0], xv[1] + gt[1] * a[1], xv[2] + gt[2] * a[2], xv[3] + gt[3] * a[3]}; } }
        });
    }
}

DEV void phase_f(const Ctx& c) {
    const int tid = threadIdx.x, lane = tid & 63, wave = tid >> 6, l = c.layer;
    LAS float* xs = (LAS float*)c.lds;
    LAS float* lg = xs + 64 * 33;
    LAS float* rs = lg + 64 * 20;
    int* cnt = c.ws<int>(WS_CNT) + l * 32;
    int* ltok = c.ws<int>(WS_LTOK); float* lw = c.ws<float>(WS_LW);
    bf16_t* H = c.ws<bf16_t>(WS_ACT);
    const int nitems = c.ntok_tail() / 64;
    for (int item = c.bid; item < nitems; item += c.nb) {
        const int tok0 = item * 64, mb = tok0 < NLAT ? (tok0 >> 11) : 8;
        const float* RW = c.ws<float>(WS_RW) + (size_t)(l * 9 + mb) * 1024 * 20;
        const int t = tid & 63, cg = __builtin_amdgcn_readfirstlane(tid >> 6);
        float a[5] = {0.f, 0.f, 0.f, 0.f, 0.f}; float ss = 0.f;
        const int lr = tid >> 3, lc = tid & 7;
        for (int k0 = 0; k0 < 1024; k0 += 32) {
            __syncthreads();
#pragma unroll
            for (int i = 0; i < 2; ++i) { const int r = lr + 32 * i; const f32x4 v = *(const f32x4*)(c.xdst(tok0 + r) + k0 + 4 * lc);
                xs[r * 33 + 4 * lc] = v[0]; xs[r * 33 + 4 * lc + 1] = v[1]; xs[r * 33 + 4 * lc + 2] = v[2]; xs[r * 33 + 4 * lc + 3] = v[3]; }
            __syncthreads();
#pragma unroll 8
            for (int k = 0; k < 32; ++k) { const float x = xs[t * 33 + k]; ss += x * x; const float* w = RW + (size_t)(k0 + k) * 20 + 5 * cg;
#pragma unroll
                for (int j = 0; j < 5; ++j) a[j] += x * w[j]; }
        }
        const float r = rsqrtf(ss * (1.f / 1024.f) + EPS);
        const float* RC = c.ws<float>(WS_RC) + (l * 9 + mb) * 32;
#pragma unroll
        for (int j = 0; j < 5; ++j) lg[t * 20 + 5 * cg + j] = r * a[j] + RC[5 * cg + j];
        if (cg == 0) rs[t] = r;
        __syncthreads();
        if (tid < 64) {
            const float* L = (const float*)0; (void)L;
            float gl[4], el[4];
#pragma unroll
            for (int j = 0; j < 4; ++j) gl[j] = lg[t * 20 + j];
            int gi = 0; float gmx = gl[0];
#pragma unroll
            for (int j = 1; j < 4; ++j) if (gl[j] > gmx) { gmx = gl[j]; gi = j; }
            float gs = 0.f;
#pragma unroll
            for (int j = 0; j < 4; ++j) gs += __expf(gl[j] - gmx);
            const float gw = 1.f / gs;
#pragma unroll
            for (int j = 0; j < 4; ++j) el[j] = lg[t * 20 + 4 + 4 * gi + j];
            int e1 = 0; float m1 = el[0];
#pragma unroll
            for (int j = 1; j < 4; ++j) if (el[j] > m1) { m1 = el[j]; e1 = j; }
            int e2 = -1; float m2 = -3.0e38f;
#pragma unroll
            for (int j = 0; j < 4; ++j) if (j != e1 && el[j] > m2) { m2 = el[j]; e2 = j; }
            const float p2 = __expf(m2 - m1), w1 = gw / (1.f + p2), w2 = gw * p2 / (1.f + p2);
            const int ea = e1 < e2 ? e1 : e2, eb = e1 < e2 ? e2 : e1; const float wa = e1 < e2 ? w1 : w2, wb = e1 < e2 ? w2 : w1;
            const int pidx = ea == 0 ? eb - 1 : (ea == 1 ? eb + 1 : 5);
            const int bucket = gi * 6 + pidx;
            const int pos = atomicAdd(&cnt[bucket], 1);
            ltok[bucket * NTOK + pos] = tok0 + t;
            lw[((size_t)bucket * NTOK + pos) * 2] = wa; lw[((size_t)bucket * NTOK + pos) * 2 + 1] = wb;
        }
        const float* gf = c.in(I_GFFN) + l * 1024; const float* sh = c.modv(mb, 3); const float* scl = c.modv(mb, 4);
        for (int i = 0; i < 16; ++i) {
            const int tl = wave * 16 + i, tok = tok0 + tl; const float rr = rs[tl];
            const float* x = c.xdst(tok);
#pragma unroll
            for (int q = 0; q < 4; ++q) { const int e = q * 256 + lane * 4;
                const f32x4 v = *(const f32x4*)(x + e), gg = *(const f32x4*)(gf + e), s1 = *(const f32x4*)(scl + e), s0 = *(const f32x4*)(sh + e);
                float o[4];
#pragma unroll
                for (int j = 0; j < 4; ++j) o[j] = v[j] * rr * gg[j] * (1.f + s1[j]) + s0[j];
                *(u32x2*)(H + (size_t)tok * 1024 + e) = (u32x2){pk2(o[0], o[1]), pk2(o[2], o[3])}; }
        }
        __syncthreads();
    }
}

struct MoeMap { int tile0[NBUCKET + 1]; };
DEV void moe_find(const int* cnt, int mg, int& bucket, int& mt, int& total) {
    int acc = 0; bucket = -1; mt = 0;
    for (int b = 0; b < NBUCKET; ++b) { const int n = (cnt[b] + 127) >> 7; if (bucket < 0 && mg < acc + n) { bucket = b; mt = mg - acc; } acc += n; }
    total = acc;
}
DEV void pair_of(int pidx, int& ea, int& eb) { ea = pidx < 3 ? 0 : (pidx < 5 ? 1 : 2); eb = pidx < 3 ? pidx + 1 : (pidx < 5 ? pidx - 1 : 3); }
DEV void phase_g(const Ctx& c) {
    const int l = c.layer; const int* cnt = c.ws<int>(WS_CNT) + l * 32;
    int total = 0; { int b, m; moe_find(cnt, 0, b, m, total); }
    bf16_t* HB = c.ws<bf16_t>(WS_HBUF);
    for (int t = c.bid; t < total * 8; t += c.nb) {
        const int mg = t >> 3, nt = t & 7; int bucket, mt, tt; moe_find(cnt, mg, bucket, mt, tt);
        int ea, eb; pair_of(bucket % 6, ea, eb); const int grp = bucket / 6;
        const int e = grp * 4 + ((nt < 4) ? ea : eb);
        const int nvalid = min(128, cnt[bucket] - mt * 128);
        const int* rows = c.ws<int>(WS_LTOK) + bucket * NTOK + mt * 128;
        const float* wts = c.ws<float>(WS_LW) + ((size_t)bucket * NTOK + mt * 128) * 2 + ((nt < 4) ? 0 : 1);
        GemmDesc g; g.A = c.ws<bf16_t>(WS_ACT); g.lda = 1024; g.rowidx = rows; g.nvalid = nvalid;
        g.B0 = c.ws<bf16_t>(WS_WUP) + ((size_t)l * 16 + e) * 512 * 1024; g.B1 = g.B0; g.ldb = 1024; g.ksplit = 1 << 30; g.K = 1024;
        const int hcol0 = (nt >> 2) * 256 + (nt & 3) * 64;
        gemm_tile(g, 0, (nt & 3) * 128, c.lds, [&](const f32x4 (&acc)[4][4], int mb, int nbase, int lane) {
            const int wc = (nbase >> 6) & 1;
#pragma unroll
            for (int mf = 0; mf < 4; ++mf) { const int r = mb + 16 * mf + (lane & 15); const bool ok = r < nvalid; const float w = ok ? wts[2 * r] : 0.f;
#pragma unroll
                for (int f = 0; f < 2; ++f) { const f32x4 gt = acc[f][mf], up = acc[f + 2][mf]; float o[4];
#pragma unroll
                    for (int j = 0; j < 4; ++j) o[j] = ok ? silu_f(gt[j]) * up[j] * w : 0.f;
                    *(u32x2*)(HB + ((size_t)mg * 128 + r) * 512 + hcol0 + 32 * wc + 16 * f + 4 * (lane >> 4)) = (u32x2){pk2(o[0], o[1]), pk2(o[2], o[3])}; } }
        });
    }
}
DEV void phase_h(const Ctx& c) {
    const int l = c.layer; const int* cnt = c.ws<int>(WS_CNT) + l * 32;
    int total = 0; { int b, m; moe_find(cnt, 0, b, m, total); }
    for (int t = c.bid; t < total * 8; t += c.nb) {
        const int mg = t >> 3, nt = t & 7; int bucket, mt, tt; moe_find(cnt, mg, bucket, mt, tt);
        int ea, eb; pair_of(bucket % 6, ea, eb); const int grp = bucket / 6;
        const int nvalid = min(128, cnt[bucket] - mt * 128);
        const int* rows = c.ws<int>(WS_LTOK) + bucket * NTOK + mt * 128;
        GemmDesc g; g.A = c.ws<bf16_t>(WS_HBUF); g.lda = 512; g.rowidx = nullptr; g.nvalid = 0;
        g.B0 = c.ws<bf16_t>(WS_WDN) + ((size_t)l * 16 + grp * 4 + ea) * 1024 * 256; g.B1 = c.ws<bf16_t>(WS_WDN) + ((size_t)l * 16 + grp * 4 + eb) * 1024 * 256; g.ldb = 256; g.ksplit = 256; g.K = 512;
        gemm_tile(g, mg * 128, nt * 128, c.lds, [&](const f32x4 (&acc)[4][4], int mb, int nbase, int lane) {
#pragma unroll
            for (int mf = 0; mf < 4; ++mf) { const int r = mb + 16 * mf + (lane & 15);
                if (r < nvalid) { const int tok = rows[r]; const int mbi = tok < NLAT ? (tok >> 11) : 8; const float* gate = c.modv(mbi, 5); float* x = c.xdst(tok);
#pragma unroll
                    for (int nf = 0; nf < 4; ++nf) { const int n = nbase + 16 * nf + 4 * (lane >> 4); const f32x4 gt = *(const f32x4*)(gate + n), xv = *(const f32x4*)(x + n), a = acc[nf][mf];
                        *(f32x4*)(x + n) = (f32x4){xv[0] + gt[0] * a[0], xv[1] + gt[1] * a[1], xv[2] + gt[2] * a[2], xv[3] + gt[3] * a[3]}; } } }
        });
    }
}

constexpr int PH_P0 = 0, PH_A = 1, PH_B = 2, PH_C = 3, PH_D0 = 4, PH_D1 = 5, PH_D = 6, PH_E0 = 7, PH_E = 8, PH_F = 9, PH_G = 10, PH_H = 11, PH_PER_LAYER = 11;
DEV void run_phase(const Ctx& c, int ph) {
    switch (ph) {
        case PH_P0: phase_p0(c); break;
        case PH_A: phase_a(c); break;
        case PH_B: phase_b(c); break;
        case PH_C: phase_c(c); break;
        case PH_D0: phase_d0(c); break;
        case PH_D1: phase_d1(c); break;
        case PH_D: phase_d(c); break;
        case PH_E0: phase_e0(c); break;
        case PH_E: phase_e(c); break;
        case PH_F: phase_f(c); break;
        case PH_G: phase_g(c); break;
        case PH_H: phase_h(c); break;
    }
}

extern __shared__ __attribute__((aligned(16))) char smem_dyn[];

__global__ void __launch_bounds__(NTHREADS, 2) k_phase(Params p, int layer, int ph) {
    Ctx c; c.p = p; c.layer = layer; c.bid = blockIdx.x; c.nb = gridDim.x; c.lds = (LAS char*)smem_dyn;
    run_phase(c, ph);
}

extern "C" void kernel_launch(void* const* d_in, const int* in_sizes, int n_in, void* d_out, int out_size, void* d_ws, size_t ws_size, hipStream_t stream) {
    static int grid = 0;
    if (grid == 0) {
        if (n_in != 29 || ws_size < WS_END) { fprintf(stderr, "kernel_launch: unexpected n_in %d or workspace %zu < %zu\n", n_in, ws_size, (size_t)WS_END); grid = -1; return; }
        int dev = 0, cus = 0, per_cu = 0;
        hipGetDevice(&dev); hipDeviceGetAttribute(&cus, hipDeviceAttributeMultiprocessorCount, dev);
        hipFuncSetAttribute((const void*)k_phase, hipFuncAttributeMaxDynamicSharedMemorySize, LDS_BYTES);
        hipOccupancyMaxActiveBlocksPerMultiprocessor(&per_cu, (const void*)k_phase, NTHREADS, LDS_BYTES);
        if (per_cu < 1) per_cu = 1; if (per_cu > 2) per_cu = 2;
        grid = cus * per_cu;
    }
    if (grid < 0) return;
    Params p{};
    for (int i = 0; i < 29; ++i) p.in[i] = (const float*)d_in[i];
    p.out = (float*)d_out; p.ws = (char*)d_ws;
    hipMemsetAsync((char*)d_ws + WS_BAR, 0, WS_ZERO_BYTES, stream);
    hipLaunchKernelGGL(k_phase, dim3(grid), dim3(NTHREADS), LDS_BYTES, stream, p, 0, PH_P0);
    for (int l = 0; l < NL; ++l)
        for (int ph = PH_A; ph <= PH_H; ++ph) hipLaunchKernelGGL(k_phase, dim3(grid), dim3(NTHREADS), LDS_BYTES, stream, p, l, ph);
}
```

```cpp
#include <hip/hip_runtime.h>
#include <cstdio>
#include <cstdint>

#ifndef MODE_SINGLE
#define MODE_SINGLE 1
#endif
#ifndef DBG_CHECK
#define DBG_CHECK 0
#endif

#define DEV __device__ __forceinline__
#define LAS __attribute__((address_space(3)))
typedef unsigned short bf16_t;
typedef short bf16x8 __attribute__((ext_vector_type(8)));
typedef float f32x4 __attribute__((ext_vector_type(4)));
typedef float f32x16 __attribute__((ext_vector_type(16)));
typedef unsigned u32x4 __attribute__((ext_vector_type(4)));
typedef unsigned u32x2 __attribute__((ext_vector_type(2)));

constexpr int DM = 1024, NB = 8, SEQ = 2048, CL = 256, NL = 2;
constexpr int NLAT = NB * SEQ, NCTX = NB * CL, NTOK = NLAT + NCTX;
constexpr int KEYS = CL + SEQ;
constexpr int INC = 2208, INCP = 2304;
constexpr int OFF_AU = 0, OFF_AV = 256, OFF_BB = 512, OFF_BC = 768, OFF_BX = 1024, OFF_CQ = 1280, OFF_CK = 1536, OFF_CV = 1664,
              OFF_DCQ = 1792, OFF_DCKV = 2048, OFF_DKR = 2176;
constexpr float EPS = 1e-6f;
constexpr float LOG2E = 1.4426950408889634f;
constexpr float C_SCALE = 0.125f, D_SCALE = 0.10206207261596577f;
constexpr int NBUCKET = 24;
constexpr int MAXMT = NTOK / 128 + NBUCKET;
constexpr int NTHREADS = 256;
constexpr int LDS_BYTES = 65536 + 64;

constexpr size_t al256(size_t x) { return (x + 255) & ~(size_t)255; }
constexpr size_t WS_BAR   = 0;
constexpr size_t WS_CNT   = 16384;
constexpr size_t WS_ZERO_BYTES = 16384 + 1024;
constexpr size_t WS_MODV  = al256(WS_CNT + 1024);
constexpr size_t WS_RW    = al256(WS_MODV + (size_t)NL * 9 * 6144 * 4);
constexpr size_t WS_RC    = al256(WS_RW + (size_t)NL * 9 * 1024 * 20 * 4);
constexpr size_t WS_ROPEC = al256(WS_RC + (size_t)NL * 9 * 32 * 4);
constexpr size_t WS_ROPED = al256(WS_ROPEC + (size_t)2 * 2048 * 32 * 4);
constexpr size_t WS_WIN   = al256(WS_ROPED + (size_t)2 * 2048 * 16 * 4);
constexpr size_t WS_WOUT  = al256(WS_WIN + (size_t)NL * INCP * 1024 * 2);
constexpr size_t WS_WUP   = al256(WS_WOUT + (size_t)NL * 1024 * 1024 * 2);
constexpr size_t WS_WDN   = al256(WS_WUP + (size_t)NL * 16 * 512 * 1024 * 2);
constexpr size_t WS_WQB   = al256(WS_WDN + (size_t)NL * 16 * 1024 * 256 * 2);
constexpr size_t WS_WKVB  = al256(WS_WQB + (size_t)NL * 384 * 256 * 2);
constexpr size_t WS_WSG   = al256(WS_WKVB + (size_t)NL * 512 * 128 * 2);
constexpr size_t WS_XC    = al256(WS_WSG + (size_t)NL * 4 * 128 * 128 * 2);
constexpr size_t WS_ACT   = al256(WS_XC + (size_t)NCTX * 1024 * 4);
constexpr size_t WS_P     = al256(WS_ACT + (size_t)NTOK * 1024 * 2);
constexpr size_t WS_QRAW  = WS_P;
constexpr size_t WS_KVRAW = al256(WS_QRAW + (size_t)NTOK * 384 * 2);
constexpr size_t WS_HBUF  = WS_P;
constexpr size_t WS_QC    = al256(WS_P + (size_t)NTOK * INC * 2);
constexpr size_t WS_KC    = al256(WS_QC + (size_t)NB * 4 * KEYS * 64 * 2);
constexpr size_t WS_VCT   = al256(WS_KC + (size_t)NB * 2 * KEYS * 64 * 2);
constexpr size_t WS_QD    = al256(WS_VCT + (size_t)NB * 2 * 64 * KEYS * 2);
constexpr size_t WS_CQN   = WS_QD;
constexpr size_t WS_CKVN  = WS_QD + (size_t)NTOK * 256 * 2;
constexpr size_t WS_KD    = al256(WS_QD + (size_t)NB * 4 * KEYS * 96 * 2);
constexpr size_t WS_VDT   = al256(WS_KD + (size_t)NB * 4 * KEYS * 96 * 2);
constexpr size_t WS_LTOK  = al256(WS_VDT + (size_t)NB * 4 * 64 * KEYS * 2);
constexpr size_t WS_LW    = al256(WS_LTOK + (size_t)NBUCKET * NTOK * 4);
constexpr size_t WS_DBG   = al256(WS_LW + (size_t)NBUCKET * NTOK * 8);
constexpr size_t WS_END   = WS_DBG + (1 << 20);
static_assert((size_t)NTOK * 384 * 2 + (size_t)NTOK * 512 * 2 + 512 <= (size_t)NTOK * INC * 2, "QRAW/KVRAW overlay");
static_assert((size_t)MAXMT * 128 * 512 * 2 <= (size_t)NTOK * INC * 2, "Hbuf overlay");
static_assert((size_t)NTOK * 384 * 2 <= (size_t)NB * 4 * KEYS * 96 * 2, "CQN/CKVN overlay");

struct Params {
    const float* in[29];
    float* out;
    char* ws;
};
enum { I_X = 0, I_C, I_CTX, I_CCTX, I_WMOD, I_BMOD, I_GATTN, I_WIN, I_SGUVG, I_SGUW, I_SGUB, I_CONVW, I_GQAQG, I_GQAKG, I_QAG, I_WQB, I_KVAG, I_WKVB,
       I_MLAQG, I_MLAKG, I_GGO, I_WOUT, I_GFFN, I_WRG, I_BRG, I_WRE, I_BRE, I_WUP, I_WDN };

DEV bf16_t f2bf(float f) { unsigned u = __float_as_uint(f); u += 0x7fffu + ((u >> 16) & 1u); return (bf16_t)(u >> 16); }
DEV float bf2f(bf16_t h) { return __uint_as_float(((unsigned)h) << 16); }
DEV unsigned pk2(float a, float b) { return (unsigned)f2bf(a) | ((unsigned)f2bf(b) << 16); }
DEV float bflo(unsigned u) { return __uint_as_float(u << 16); }
DEV float bfhi(unsigned u) { return __uint_as_float(u & 0xffff0000u); }
DEV float wave_sum(float v) {
#pragma unroll
    for (int o = 32; o >= 1; o >>= 1) v += __shfl_xor(v, o);
    return v;
}
DEV float grp_sum16(float v) { v += __shfl_xor(v, 1); v += __shfl_xor(v, 2); v += __shfl_xor(v, 4); v += __shfl_xor(v, 8); return v; }
DEV float gelu_tanh(float x) { const float u = 0.7978845608028654f * (x + 0.044715f * x * x * x); return 0.5f * x * (1.f + tanhf(u)); }
DEV float silu_f(float x) { return x / (1.f + __expf(-x)); }
DEV void tok_info(int tok, int& b, int& pos, int& key, bool& isctx) {
    if (tok < NLAT) { b = tok >> 11; pos = tok & 2047; key = CL + pos; isctx = false; }
    else { const int c = tok - NLAT; b = c >> 8; pos = c & 255; key = pos; isctx = true; }
}
DEV bf16x8 lds_r128(LAS const char* p) { return *(LAS const bf16x8*)p; }

typedef const __attribute__((address_space(4))) Params* ParamsPtr;
struct Ctx {
    ParamsPtr p; int layer; int bid, nb, tid; LAS char* lds;
    DEV const float* in(int i) const { return p->in[i]; }
    template <class T> DEV T* ws(size_t off) const { return (T*)(p->ws + off); }
    DEV const float* modv(int mb, int chunk) const { return ws<float>(WS_MODV) + ((size_t)(layer * 9 + mb) * 6 + chunk) * 1024; }
    DEV const float* xsrc(int tok) const {
        if (layer == 0) return tok < NLAT ? p->in[I_X] + (size_t)tok * DM : p->in[I_CTX] + (size_t)(tok - NLAT) * DM;
        return tok < NLAT ? p->out + (size_t)tok * DM : ws<float>(WS_XC) + (size_t)(tok - NLAT) * DM;
    }
    DEV float* xdst(int tok) const { return tok < NLAT ? p->out + (size_t)tok * DM : ws<float>(WS_XC) + (size_t)(tok - NLAT) * DM; }
    DEV int ntok_tail() const { return layer == NL - 1 ? NLAT : NTOK; }
};

struct GemmDesc {
    const bf16_t* A; int lda; const int* rowidx; int nvalid;
    const bf16_t* B0; const bf16_t* B1; int ldb; int ksplit; int K;
};
template <class Epi>
DEV void gemm_tile(const GemmDesc& g, int m0, int n0, LAS char* lds, int tid, const Epi& epi) {
    const int lane = tid & 63, wave = tid >> 6, wm = wave >> 1, wn = wave & 1;
    const int lr = tid >> 3, kc = tid & 7;
    int aoff[4], boff[4];
#pragma unroll
    for (int i = 0; i < 4; ++i) {
        const int r = lr + 32 * i;
        const int srow = g.rowidx ? g.rowidx[(r < g.nvalid) ? r : 0] : (m0 + r);
        aoff[i] = srow * g.lda + kc * 8;
        boff[i] = (n0 + r) * g.ldb + kc * 8;
    }
    const int ldsw = lr * 128 + ((kc ^ ((lr >> 1) & 7)) << 4);
    f32x4 acc[4][4];
#pragma unroll
    for (int i = 0; i < 4; ++i)
#pragma unroll
        for (int j = 0; j < 4; ++j) acc[i][j] = (f32x4){0.f, 0.f, 0.f, 0.f};
    u32x4 ra[4], rb[4];
    const int nk = g.K / 64;
    __syncthreads();
    {
        const bf16_t* Bb = (0 < g.ksplit) ? g.B0 : g.B1;
#pragma unroll
        for (int i = 0; i < 4; ++i) { ra[i] = *(const u32x4*)(g.A + aoff[i]); rb[i] = *(const u32x4*)(Bb + boff[i]); }
#pragma unroll
        for (int i = 0; i < 4; ++i) { *(LAS u32x4*)(lds + ldsw + 4096 * i) = ra[i]; *(LAS u32x4*)(lds + 16384 + ldsw + 4096 * i) = rb[i]; }
    }
    __syncthreads();
    const int swz = (lane >> 1) & 7, q = lane >> 4;
    const int arow = (64 * wm + (lane & 15)) * 128, brow = (64 * wn + (lane & 15)) * 128;
    for (int kt = 0; kt < nk; ++kt) {
        const int cur = kt & 1;
        if (kt + 1 < nk) {
            const int k0 = (kt + 1) * 64;
            const bf16_t* Bb = (k0 < g.ksplit) ? g.B0 + k0 : g.B1 + (k0 - g.ksplit);
#pragma unroll
            for (int i = 0; i < 4; ++i) { ra[i] = *(const u32x4*)(g.A + aoff[i] + k0); rb[i] = *(const u32x4*)(Bb + boff[i]); }
        }
        LAS const char* As = lds + cur * 32768; LAS const char* Bs = As + 16384;
#pragma unroll
        for (int ks = 0; ks < 2; ++ks) {
            const int ch = ((4 * ks + q) ^ swz) << 4;
            bf16x8 af[4], bfr[4];
#pragma unroll
            for (int f = 0; f < 4; ++f) { af[f] = lds_r128(As + arow + f * 2048 + ch); bfr[f] = lds_r128(Bs + brow + f * 2048 + ch); }
#pragma unroll
            for (int nf = 0; nf < 4; ++nf)
#pragma unroll
                for (int mf = 0; mf < 4; ++mf) acc[nf][mf] = __builtin_amdgcn_mfma_f32_16x16x32_bf16(bfr[nf], af[mf], acc[nf][mf], 0, 0, 0);
        }
        if (kt + 1 < nk) {
            LAS char* An = lds + (cur ^ 1) * 32768;
#pragma unroll
            for (int i = 0; i < 4; ++i) { *(LAS u32x4*)(An + ldsw + 4096 * i) = ra[i]; *(LAS u32x4*)(An + 16384 + ldsw + 4096 * i) = rb[i]; }
        }
        __syncthreads();
    }
    epi(acc, 64 * wm, n0 + 64 * wn, lane);
}

DEV void p0_transpose(const float* W, int K, int N, bf16_t* WT, int kt, int nt, bool upperm, LAS float* scr, int tid) {
    const int nn = tid & 63, kq = tid >> 6;
    const int n_in = nt * 64 + nn;
#pragma unroll 4
    for (int i = 0; i < 16; ++i) { const int kk = kq + 4 * i; scr[kk * 65 + nn] = (n_in < N) ? W[(size_t)(kt * 64 + kk) * N + n_in] : 0.f; }
    __syncthreads();
    const int nl = tid >> 2, kcq = tid & 3, n = nt * 64 + nl;
    if (n < N) {
        int drow = n;
        if (upperm) { const int type = n >> 8, j = n & 255; drow = 128 * (j >> 6) + 64 * ((j >> 5) & 1) + 16 * (((j >> 4) & 1) + 2 * type) + (j & 15); }
        unsigned o[8];
#pragma unroll
        for (int j = 0; j < 8; ++j) o[j] = pk2(scr[(kcq * 16 + 2 * j) * 65 + nl], scr[(kcq * 16 + 2 * j + 1) * 65 + nl]);
        bf16_t* d = WT + (size_t)drow * K + kt * 64 + kcq * 16;
        *(u32x4*)d = (u32x4){o[0], o[1], o[2], o[3]};
        *(u32x4*)(d + 8) = (u32x4){o[4], o[5], o[6], o[7]};
    }
    __syncthreads();
}
constexpr int T_IN = 16 * 35, T_OUT = 16 * 16, T_UP = 16 * 16 * 8, T_DN = 16 * 4 * 16, T_QB = 4 * 6, T_KVB = 2 * 8;
constexpr int T_LAYER = T_IN + T_OUT + T_UP + T_DN + T_QB + T_KVB;
constexpr int P0_TR = NL * T_LAYER, P0_WSG = 64, P0_MODV = NL * 96, P0_ROPE = 384, P0_PAD = 96;
constexpr int P0_ITEMS = P0_TR + P0_WSG + P0_MODV + P0_ROPE + P0_PAD;

DEV void phase_p0(const Ctx& c) {
    const int tid = c.tid;
    LAS float* scr = (LAS float*)c.lds;
    for (int it = c.bid; it < P0_ITEMS; it += c.nb) {
        int r = it;
        if (r < P0_TR) {
            const int l = r / T_LAYER; r -= l * T_LAYER;
            if (r < T_IN) { p0_transpose(c.in(I_WIN) + (size_t)l * 1024 * INC, 1024, INC, c.ws<bf16_t>(WS_WIN) + (size_t)l * INCP * 1024, r / 35, r % 35, false, scr, tid); continue; } r -= T_IN;
            if (r < T_OUT) { p0_transpose(c.in(I_WOUT) + (size_t)l * 1024 * 1024, 1024, 1024, c.ws<bf16_t>(WS_WOUT) + (size_t)l * 1024 * 1024, r / 16, r % 16, false, scr, tid); continue; } r -= T_OUT;
            if (r < T_UP) { const int e = r / 128, q = r % 128;
                p0_transpose(c.in(I_WUP) + ((size_t)l * 16 + e) * 1024 * 512, 1024, 512, c.ws<bf16_t>(WS_WUP) + ((size_t)l * 16 + e) * 512 * 1024, q / 8, q % 8, true, scr, tid); continue; } r -= T_UP;
            if (r < T_DN) { const int e = r / 64, q = r % 64;
                p0_transpose(c.in(I_WDN) + ((size_t)l * 16 + e) * 256 * 1024, 256, 1024, c.ws<bf16_t>(WS_WDN) + ((size_t)l * 16 + e) * 1024 * 256, q / 16, q % 16, false, scr, tid); continue; } r -= T_DN;
            if (r < T_QB) { p0_transpose(c.in(I_WQB) + (size_t)l * 256 * 384, 256, 384, c.ws<bf16_t>(WS_WQB) + (size_t)l * 384 * 256, r / 6, r % 6, false, scr, tid); continue; } r -= T_QB;
            p0_transpose(c.in(I_WKVB) + (size_t)l * 128 * 512, 128, 512, c.ws<bf16_t>(WS_WKVB) + (size_t)l * 512 * 128, r / 8, r % 8, false, scr, tid); continue;
        }
        r -= P0_TR;
        if (r < P0_WSG) {
            const size_t e0 = ((size_t)r * 256 + tid) * 8; const float* s = c.in(I_SGUW) + e0;
            const f32x4 a = *(const f32x4*)s, b = *(const f32x4*)(s + 4);
            *(u32x4*)(c.ws<bf16_t>(WS_WSG) + e0) = (u32x4){pk2(a[0], a[1]), pk2(a[2], a[3]), pk2(b[0], b[1]), pk2(b[2], b[3])};
            continue;
        }
        r -= P0_WSG;
        if (r < P0_MODV) {
            const int l = r / 96, n0 = (r % 96) * 64;
            LAS float* sc = scr;
            LAS float* red = scr + 9 * 1024;
            __syncthreads();
            for (int i = tid; i < 9 * 1024; i += 256) { const int mb = i >> 10, k = i & 1023; sc[i] = silu_f(mb < 8 ? c.in(I_C)[mb * 1024 + k] : c.in(I_CCTX)[k]); }
            __syncthreads();
            const int kq = tid >> 6, nl = tid & 63;
            float a[9];
#pragma unroll
            for (int j = 0; j < 9; ++j) a[j] = 0.f;
            const float* wp = c.in(I_WMOD) + (size_t)l * 1024 * 6144 + n0 + nl;
#pragma unroll 4
            for (int k = kq * 256; k < kq * 256 + 256; ++k) { const float w = wp[(size_t)k * 6144];
#pragma unroll
                for (int j = 0; j < 9; ++j) a[j] += sc[j * 1024 + k] * w; }
#pragma unroll
            for (int j = 0; j < 9; ++j) red[(kq * 9 + j) * 64 + nl] = a[j];
            __syncthreads();
            for (int i = tid; i < 9 * 64; i += 256) { const int mb = i >> 6, n = i & 63;
                const float v = red[(0 * 9 + mb) * 64 + n] + red[(1 * 9 + mb) * 64 + n] + red[(2 * 9 + mb) * 64 + n] + red[(3 * 9 + mb) * 64 + n];
                c.ws<float>(WS_MODV)[(size_t)(l * 9 + mb) * 6144 + n0 + n] = v + c.in(I_BMOD)[l * 6144 + n0 + n]; }
            __syncthreads();
            continue;
        }
        r -= P0_MODV;
        if (r < P0_ROPE) {
            const int idx = r * 256 + tid;
            if (idx < 2048 * 32) { const int s = idx >> 5, i = idx & 31, f = i & 15; const float pos = (float)((i < 16) ? (s >> 6) : (s & 63));
                const float inv = powf(10000.f, -(float)f / 16.f), ang = pos * inv;
                c.ws<float>(WS_ROPEC)[idx] = cosf(ang); c.ws<float>(WS_ROPEC)[2048 * 32 + idx] = sinf(ang); }
            else { const int j = idx - 2048 * 32, s = j >> 4, i = j & 15, f = i & 7; const float pos = (float)((i < 8) ? (s >> 6) : (s & 63));
                const float inv = powf(10000.f, -(float)f / 8.f), ang = pos * inv;
                c.ws<float>(WS_ROPED)[j] = cosf(ang); c.ws<float>(WS_ROPED)[2048 * 16 + j] = sinf(ang); }
            continue;
        }
        r -= P0_ROPE;
        {
            const int e = (r * 256 + tid) * 8, l = e / (96 * 1024), o = e % (96 * 1024);
            *(u32x4*)(c.ws<bf16_t>(WS_WIN) + ((size_t)l * INCP + INC) * 1024 + o) = (u32x4){0u, 0u, 0u, 0u};
        }
    }
}

constexpr int A_RW_ITEMS = NL * 9 * 1024 / 256;
constexpr int A_RC_ITEMS = NL * 9 * 20 / 4;
DEV void phase_a(const Ctx& c) {
    const int tid = c.tid, lane = tid & 63, wave = tid >> 6;
    const float* g = c.in(I_GATTN) + c.layer * 1024;
    bf16_t* H = c.ws<bf16_t>(WS_ACT);
    for (int tok = c.bid * 4 + wave; tok < NTOK; tok += c.nb * 4) {
        const int mb = tok < NLAT ? (tok >> 11) : 8;
        const float* x = c.xsrc(tok); const float* sh = c.modv(mb, 0); const float* scl = c.modv(mb, 1);
        f32x4 v[4]; float ss = 0.f;
#pragma unroll
        for (int i = 0; i < 4; ++i) { v[i] = *(const f32x4*)(x + i * 256 + lane * 4); ss += v[i][0] * v[i][0] + v[i][1] * v[i][1] + v[i][2] * v[i][2] + v[i][3] * v[i][3]; }
        const float r = rsqrtf(wave_sum(ss) * (1.f / 1024.f) + EPS);
#pragma unroll
        for (int i = 0; i < 4; ++i) { const int e = i * 256 + lane * 4;
            const f32x4 gg = *(const f32x4*)(g + e), s1 = *(const f32x4*)(scl + e), s0 = *(const f32x4*)(sh + e);
            float o[4];
#pragma unroll
            for (int j = 0; j < 4; ++j) o[j] = v[i][j] * r * gg[j] * (1.f + s1[j]) + s0[j];
            *(u32x2*)(H + (size_t)tok * 1024 + e) = (u32x2){pk2(o[0], o[1]), pk2(o[2], o[3])}; }
    }
    if (c.layer == 0) {
        for (int it = c.bid; it < A_RW_ITEMS + A_RC_ITEMS; it += c.nb) {
            if (it < A_RW_ITEMS) {
                const int idx = it * 256 + tid, l = idx / (9 * 1024), mb = (idx >> 10) % 9, k = idx & 1023;
                const float* mv = c.ws<float>(WS_MODV) + (size_t)(l * 9 + mb) * 6144;
                const float gm = c.in(I_GFFN)[l * 1024 + k] * (1.f + mv[4 * 1024 + k]);
                float* o = c.ws<float>(WS_RW) + (size_t)idx * 20;
                const float* wg = c.in(I_WRG) + ((size_t)l * 1024 + k) * 4; const float* we = c.in(I_WRE) + ((size_t)l * 1024 + k) * 16;
#pragma unroll
                for (int j = 0; j < 4; ++j) o[j] = gm * wg[j];
#pragma unroll
                for (int j = 0; j < 16; ++j) o[4 + j] = gm * we[j];
            } else {
                const int idx = (it - A_RW_ITEMS) * 4 + wave, l = idx / 180, mb = (idx / 20) % 9, j = idx % 20;
                const float* mv = c.ws<float>(WS_MODV) + (size_t)(l * 9 + mb) * 6144 + 3 * 1024;
                float a = 0.f;
                for (int k = lane; k < 1024; k += 64) { const float w = (j < 4) ? c.in(I_WRG)[((size_t)l * 1024 + k) * 4 + j] : c.in(I_WRE)[((size_t)l * 1024 + k) * 16 + (j - 4)]; a += mv[k] * w; }
                a = wave_sum(a);
                if (lane == 0) c.ws<float>(WS_RC)[(l * 9 + mb) * 32 + j] = a + ((j < 4) ? c.in(I_BRG)[l * 4 + j] : c.in(I_BRE)[l * 16 + j - 4]);
            }
        }
    }
}

DEV void phase_b(const Ctx& c) {
    bf16_t* P = c.ws<bf16_t>(WS_P);
    GemmDesc g; g.A = c.ws<bf16_t>(WS_ACT); g.lda = 1024; g.rowidx = nullptr; g.nvalid = 0;
    g.B0 = c.ws<bf16_t>(WS_WIN) + (size_t)c.layer * INCP * 1024; g.B1 = g.B0; g.ldb = 1024; g.ksplit = 1 << 30; g.K = 1024;
    constexpr int NT_N = INCP / 128, NT_M = NTOK / 128;
    for (int t = c.bid; t < NT_M * NT_N; t += c.nb) {
        const int mt = t / NT_N, nt = t % NT_N, m0 = mt * 128;
        gemm_tile(g, m0, nt * 128, c.lds, c.tid, [&](const f32x4 (&acc)[4][4], int mb, int nbase, int lane) {
#pragma unroll
            for (int nf = 0; nf < 4; ++nf) { const int n = nbase + 16 * nf + 4 * (lane >> 4);
                if (n < INC) {
#pragma unroll
                    for (int mf = 0; mf < 4; ++mf) { const int m = m0 + mb + 16 * mf + (lane & 15); const f32x4 a = acc[nf][mf];
                        *(u32x2*)(P + (size_t)m * INC + n) = (u32x2){pk2(a[0], a[1]), pk2(a[2], a[3])}; } } }
        });
    }
}

constexpr int C_PREP_ITEMS = NTOK / 64, C_SGU_ITEMS = (NTOK / 128) * 4;
constexpr int VT_LD = 72;
DEV void rope2(float& a, float& b, float cs, float sn) { const float x0 = a, x1 = b; a = x0 * cs - x1 * sn; b = x0 * sn + x1 * cs; }
DEV void phase_c_prep(const Ctx& c, int item) {
    const int tid = c.tid, lane = tid & 63, wave = tid >> 6, li = lane & 15, l = c.layer;
    const bf16_t* P = c.ws<bf16_t>(WS_P);
    LAS bf16_t* vt = (LAS bf16_t*)c.lds;
    const int tok0 = item * 64;
    int b0, pos0, key0; bool isctx; tok_info(tok0, b0, pos0, key0, isctx);
    const float* cosC = c.ws<float>(WS_ROPEC); const float* sinC = cosC + 2048 * 32;
    const float* cosD = c.ws<float>(WS_ROPED); const float* sinD = cosD + 2048 * 16;
    const int seqlen = isctx ? CL : SEQ;
    __syncthreads();
    for (int i = 0; i < 16; ++i) {
        const int tl = wave * 16 + i, tok = tok0 + tl, pos = pos0 + tl, key = key0 + tl;
        const bf16_t* pr = P + (size_t)tok * INC;
        {
            const u32x2 raw = *(const u32x2*)(pr + OFF_CQ + 4 * lane);
            float q[4] = {bflo(raw[0]), bfhi(raw[0]), bflo(raw[1]), bfhi(raw[1])};
            const float r = rsqrtf(grp_sum16(q[0] * q[0] + q[1] * q[1] + q[2] * q[2] + q[3] * q[3]) * (1.f / 64.f) + EPS);
            const f32x4 gg = *(const f32x4*)(c.in(I_GQAQG) + l * 64 + 4 * li);
#pragma unroll
            for (int j = 0; j < 4; ++j) q[j] = q[j] * r * gg[j];
            if (!isctx) { const float* cs = cosC + pos * 32 + 2 * li; const float* sn = sinC + pos * 32 + 2 * li; rope2(q[0], q[1], cs[0], sn[0]); rope2(q[2], q[3], cs[1], sn[1]); }
            const float sc = C_SCALE * LOG2E;
            *(u32x2*)(c.ws<bf16_t>(WS_QC) + ((size_t)(b0 * 4 + (lane >> 4)) * KEYS + key) * 64 + 4 * li) = (u32x2){pk2(q[0] * sc, q[1] * sc), pk2(q[2] * sc, q[3] * sc)};
        }
        {
            const int col = lane < 32 ? OFF_CK + 4 * lane : OFF_CV + 4 * (lane - 32);
            const u32x2 raw = *(const u32x2*)(pr + col);
            float k[4] = {bflo(raw[0]), bfhi(raw[0]), bflo(raw[1]), bfhi(raw[1])};
            const int kvh = (lane >> 4) & 1;
            const float r = rsqrtf(grp_sum16(k[0] * k[0] + k[1] * k[1] + k[2] * k[2] + k[3] * k[3]) * (1.f / 64.f) + EPS);
            if (lane < 32) {
                const f32x4 gg = *(const f32x4*)(c.in(I_GQAKG) + l * 64 + 4 * li);
#pragma unroll
                for (int j = 0; j < 4; ++j) k[j] = k[j] * r * gg[j];
                if (!isctx) { const float* cs = cosC + pos * 32 + 2 * li; const float* sn = sinC + pos * 32 + 2 * li; rope2(k[0], k[1], cs[0], sn[0]); rope2(k[2], k[3], cs[1], sn[1]); }
                *(u32x2*)(c.ws<bf16_t>(WS_KC) + ((size_t)(b0 * 2 + kvh) * KEYS + key) * 64 + 4 * li) = (u32x2){pk2(k[0], k[1]), pk2(k[2], k[3])};
            } else {
                const unsigned short e0 = (unsigned short)(raw[0] & 0xffffu), e1 = (unsigned short)(raw[0] >> 16), e2 = (unsigned short)(raw[1] & 0xffffu), e3 = (unsigned short)(raw[1] >> 16);
                LAS bf16_t* d = vt + (kvh * 64 + 4 * li) * VT_LD + tl;
                d[0] = e0; d[VT_LD] = e1; d[2 * VT_LD] = e2; d[3 * VT_LD] = e3;
            }
        }
        {
            const u32x2 raw = *(const u32x2*)(pr + OFF_DCQ + 4 * lane);
            float q[4] = {bflo(raw[0]), bfhi(raw[0]), bflo(raw[1]), bfhi(raw[1])};
            const float r = rsqrtf(wave_sum(q[0] * q[0] + q[1] * q[1] + q[2] * q[2] + q[3] * q[3]) * (1.f / 256.f) + EPS);
            const f32x4 gg = *(const f32x4*)(c.in(I_QAG) + l * 256 + 4 * lane);
            *(u32x2*)(c.ws<bf16_t>(WS_CQN) + (size_t)tok * 256 + 4 * lane) = (u32x2){pk2(q[0] * r * gg[0], q[1] * r * gg[1]), pk2(q[2] * r * gg[2], q[3] * r * gg[3])};
        }
        {
            const int col = lane < 32 ? OFF_DCKV + 4 * lane : OFF_DKR + 4 * ((lane - 32) & 7);
            const u32x2 raw = *(const u32x2*)(pr + col);
            float v[4] = {bflo(raw[0]), bfhi(raw[0]), bflo(raw[1]), bfhi(raw[1])};
            float s = v[0] * v[0] + v[1] * v[1] + v[2] * v[2] + v[3] * v[3];
            s += __shfl_xor(s, 1); s += __shfl_xor(s, 2); s += __shfl_xor(s, 4);
            const float s8 = s;
            s += __shfl_xor(s, 8); s += __shfl_xor(s, 16);
            if (lane < 32) {
                const float r = rsqrtf(s * (1.f / 128.f) + EPS);
                const f32x4 gg = *(const f32x4*)(c.in(I_KVAG) + l * 128 + 4 * lane);
                *(u32x2*)(c.ws<bf16_t>(WS_CKVN) + (size_t)tok * 128 + 4 * lane) = (u32x2){pk2(v[0] * r * gg[0], v[1] * r * gg[1]), pk2(v[2] * r * gg[2], v[3] * r * gg[3])};
            } else if (lane < 40) {
                const int e = 4 * (lane - 32);
                const float r = rsqrtf(s8 * (1.f / 32.f) + EPS);
                const f32x4 gg = *(const f32x4*)(c.in(I_MLAKG) + l * 96 + 64 + e);
#pragma unroll
                for (int j = 0; j < 4; ++j) v[j] = v[j] * r * gg[j];
                if (!isctx) { const int p0 = 2 * (lane - 32); const float* cs = cosD + pos * 16 + p0; const float* sn = sinD + pos * 16 + p0; rope2(v[0], v[1], cs[0], sn[0]); rope2(v[2], v[3], cs[1], sn[1]); }
                const u32x2 o = (u32x2){pk2(v[0], v[1]), pk2(v[2], v[3])};
#pragma unroll
                for (int h = 0; h < 4; ++h) *(u32x2*)(c.ws<bf16_t>(WS_KD) + ((size_t)(b0 * 4 + h) * KEYS + key) * 96 + 64 + e) = o;
            }
        }
        {
            const int ch = 4 * lane;
            const u32x2 rbb = *(const u32x2*)(pr + OFF_BB + ch);
            float z[3][4];
#pragma unroll
            for (int d = 0; d < 3; ++d) {
                const int pp = pos + d - 1; const bool ok = (pp >= 0) && (pp < seqlen);
                const bf16_t* prr = P + (size_t)(tok + (ok ? d - 1 : 0)) * INC;
                const u32x2 rc = *(const u32x2*)(prr + OFF_BC + ch), rx = *(const u32x2*)(prr + OFF_BX + ch);
                const float m = ok ? 1.f : 0.f;
                z[d][0] = m * bflo(rc[0]) * bflo(rx[0]); z[d][1] = m * bfhi(rc[0]) * bfhi(rx[0]); z[d][2] = m * bflo(rc[1]) * bflo(rx[1]); z[d][3] = m * bfhi(rc[1]) * bfhi(rx[1]);
            }
            const float* cw = c.in(I_CONVW) + l * 768 + ch;
            const f32x4 w0 = *(const f32x4*)cw, w1 = *(const f32x4*)(cw + 256), w2 = *(const f32x4*)(cw + 512);
            const float bb[4] = {bflo(rbb[0]), bfhi(rbb[0]), bflo(rbb[1]), bfhi(rbb[1])};
            float y[4];
#pragma unroll
            for (int j = 0; j < 4; ++j) y[j] = bb[j] * (w0[j] * z[0][j] + w1[j] * z[1][j] + w2[j] * z[2][j]);
            *(u32x2*)(c.ws<bf16_t>(WS_ACT) + (size_t)tok * 1024 + 256 + ch) = (u32x2){pk2(y[0], y[1]), pk2(y[2], y[3])};
        }
    }
    __syncthreads();
    {
        const int row = tid >> 1, half = tid & 1, kvh = row >> 6, d = row & 63;
        bf16_t* dst = c.ws<bf16_t>(WS_VCT) + ((size_t)(b0 * 2 + kvh) * 64 + d) * KEYS + key0 + 32 * half;
        LAS const bf16_t* src = vt + row * VT_LD + 32 * half;
#pragma unroll
        for (int j = 0; j < 4; ++j) *(u32x4*)(dst + 8 * j) = *(LAS const u32x4*)(src + 8 * j);
    }
    __syncthreads();
}
constexpr int SG_LD = 272;
DEV void phase_c_sgu(const Ctx& c, int item) {
    const int tid = c.tid, lane = tid & 63, wave = tid >> 6, l = c.layer;
    const int chunk = item >> 2, h = item & 3, tok0 = chunk * 128;
    const bf16_t* P = c.ws<bf16_t>(WS_P);
    LAS char* Wt = c.lds;
    LAS char* vT = c.lds + 128 * SG_LD;
    __syncthreads();
    {
        const bf16_t* Wsrc = c.ws<bf16_t>(WS_WSG) + (size_t)(l * 4 + h) * 128 * 128;
#pragma unroll
        for (int i = 0; i < 8; ++i) { const int ci = tid + 256 * i, r = ci >> 4, kc = ci & 15; *(LAS u32x4*)(Wt + r * SG_LD + kc * 16) = *(const u32x4*)(Wsrc + r * 128 + kc * 8); }
        const int j = tid >> 1, half = tid & 1;
        const bf16_t* vp = P + (size_t)(tok0 + j) * INC + OFF_AV + 64 * h + 32 * half;
        float v[32]; float ss = 0.f;
#pragma unroll
        for (int q = 0; q < 4; ++q) { const u32x4 raw = *(const u32x4*)(vp + 8 * q);
#pragma unroll
            for (int e = 0; e < 4; ++e) { const float a = gelu_tanh(bflo(raw[e])), b = gelu_tanh(bfhi(raw[e])); v[8 * q + 2 * e] = a; v[8 * q + 2 * e + 1] = b; ss += a * a + b * b; } }
        ss += __shfl_xor(ss, 1);
        const float r = rsqrtf(ss * (1.f / 64.f) + EPS);
        const float* vg = c.in(I_SGUVG) + l * 256 + 64 * h + 32 * half;
#pragma unroll
        for (int e = 0; e < 32; ++e) *(LAS bf16_t*)(vT + (32 * half + e) * SG_LD + j * 2) = f2bf(v[e] * r * vg[e]);
    }
    __syncthreads();
    f32x4 acc[4][2];
#pragma unroll
    for (int a = 0; a < 4; ++a) { acc[a][0] = (f32x4){0.f, 0.f, 0.f, 0.f}; acc[a][1] = acc[a][0]; }
    const int q = lane >> 4, li = lane & 15;
#pragma unroll
    for (int ks = 0; ks < 4; ++ks) {
        bf16x8 af[4], bfr[2];
#pragma unroll
        for (int df = 0; df < 4; ++df) af[df] = lds_r128(vT + (16 * df + li) * SG_LD + (4 * ks + q) * 16);
#pragma unroll
        for (int f = 0; f < 2; ++f) bfr[f] = lds_r128(Wt + (32 * wave + 16 * f + li) * SG_LD + (4 * ks + q) * 16);
#pragma unroll
        for (int df = 0; df < 4; ++df)
#pragma unroll
            for (int f = 0; f < 2; ++f) acc[df][f] = __builtin_amdgcn_mfma_f32_16x16x32_bf16(af[df], bfr[f], acc[df][f], 0, 0, 0);
    }
    bf16_t* Y = c.ws<bf16_t>(WS_ACT);
#pragma unroll
    for (int f = 0; f < 2; ++f) {
        const int i = 32 * wave + 16 * f + li, tok = tok0 + i;
        const float bs = c.in(I_SGUB)[(l * 4 + h) * 128 + i];
#pragma unroll
        for (int df = 0; df < 4; ++df) {
            const int d0 = 16 * df + 4 * q;
            const u32x2 ur = *(const u32x2*)(P + (size_t)tok * INC + OFF_AU + 64 * h + d0);
            const float u[4] = {gelu_tanh(bflo(ur[0])), gelu_tanh(bfhi(ur[0])), gelu_tanh(bflo(ur[1])), gelu_tanh(bfhi(ur[1]))};
            const f32x4 a = acc[df][f];
            *(u32x2*)(Y + (size_t)tok * 1024 + 64 * h + d0) = (u32x2){pk2(u[0] * (a[0] + bs), u[1] * (a[1] + bs)), pk2(u[2] * (a[2] + bs), u[3] * (a[3] + bs))};
        }
    }
}
DEV void phase_c(const Ctx& c) {
    for (int it = c.bid; it < C_SGU_ITEMS + C_PREP_ITEMS; it += c.nb) {
        if (it < C_SGU_ITEMS) phase_c_sgu(c, it); else phase_c_prep(c, it - C_SGU_ITEMS);
    }
}

DEV void phase_d0(const Ctx& c) {
    constexpr int NT_M = NTOK / 128, TQ = NT_M * 3, TKV = NT_M * 4;
    for (int t = c.bid; t < TQ + TKV; t += c.nb) {
        GemmDesc g; g.rowidx = nullptr; g.nvalid = 0; g.ksplit = 1 << 30;
        bf16_t* O; int ldo, mt, nt;
        if (t < TQ) { mt = t / 3; nt = t % 3; g.A = c.ws<bf16_t>(WS_CQN); g.lda = 256; g.K = 256; g.B0 = c.ws<bf16_t>(WS_WQB) + (size_t)c.layer * 384 * 256; g.ldb = 256; O = c.ws<bf16_t>(WS_QRAW); ldo = 384; }
        else { const int u = t - TQ; mt = u / 4; nt = u % 4; g.A = c.ws<bf16_t>(WS_CKVN); g.lda = 128; g.K = 128; g.B0 = c.ws<bf16_t>(WS_WKVB) + (size_t)c.layer * 512 * 128; g.ldb = 128; O = c.ws<bf16_t>(WS_KVRAW); ldo = 512; }
        g.B1 = g.B0;
        const int m0 = mt * 128;
        gemm_tile(g, m0, nt * 128, c.lds, c.tid, [&](const f32x4 (&acc)[4][4], int mb, int nbase, int lane) {
#pragma unroll
            for (int nf = 0; nf < 4; ++nf) { const int n = nbase + 16 * nf + 4 * (lane >> 4);
#pragma unroll
                for (int mf = 0; mf < 4; ++mf) { const int m = m0 + mb + 16 * mf + (lane & 15); const f32x4 a = acc[nf][mf];
                    *(u32x2*)(O + (size_t)m * ldo + n) = (u32x2){pk2(a[0], a[1]), pk2(a[2], a[3])}; } }
        });
    }
}

DEV void phase_d1(const Ctx& c) {
    const int tid = c.tid, lane = tid & 63, wave = tid >> 6, li = lane & 15, hd = lane >> 4, l = c.layer;
    LAS bf16_t* vt = (LAS bf16_t*)c.lds;
    const bf16_t* QR = c.ws<bf16_t>(WS_QRAW); const bf16_t* KVR = c.ws<bf16_t>(WS_KVRAW);
    const float* cosD = c.ws<float>(WS_ROPED); const float* sinD = cosD + 2048 * 16;
    for (int item = c.bid; item < NTOK / 64; item += c.nb) {
        const int tok0 = item * 64;
        int b0, pos0, key0; bool isctx; tok_info(tok0, b0, pos0, key0, isctx);
        __syncthreads();
        for (int i = 0; i < 16; ++i) {
            const int tl = wave * 16 + i, tok = tok0 + tl, pos = pos0 + tl, key = key0 + tl;
            {
                const u32x2 rn = *(const u32x2*)(QR + (size_t)tok * 384 + 96 * hd + 4 * li);
                const unsigned rr = *(const unsigned*)(QR + (size_t)tok * 384 + 96 * hd + 64 + 2 * li);
                float qn[4] = {bflo(rn[0]), bfhi(rn[0]), bflo(rn[1]), bfhi(rn[1])}; float qr[2] = {bflo(rr), bfhi(rr)};
                const float r_n = rsqrtf(grp_sum16(qn[0] * qn[0] + qn[1] * qn[1] + qn[2] * qn[2] + qn[3] * qn[3]) * (1.f / 64.f) + EPS);
                const float r_r = rsqrtf(grp_sum16(qr[0] * qr[0] + qr[1] * qr[1]) * (1.f / 32.f) + EPS);
                const float* qg = c.in(I_MLAQG) + l * 96;
                const float sc = D_SCALE * LOG2E;
#pragma unroll
                for (int j = 0; j < 4; ++j) qn[j] = qn[j] * r_n * qg[4 * li + j] * sc;
                qr[0] = qr[0] * r_r * qg[64 + 2 * li]; qr[1] = qr[1] * r_r * qg[64 + 2 * li + 1];
                if (!isctx) rope2(qr[0], qr[1], cosD[pos * 16 + li], sinD[pos * 16 + li]);
                bf16_t* qd = c.ws<bf16_t>(WS_QD) + ((size_t)(b0 * 4 + hd) * KEYS + key) * 96;
                *(u32x2*)(qd + 4 * li) = (u32x2){pk2(qn[0], qn[1]), pk2(qn[2], qn[3])};
                *(unsigned*)(qd + 64 + 2 * li) = pk2(qr[0] * sc, qr[1] * sc);
            }
            {
                const u32x2 rk = *(const u32x2*)(KVR + (size_t)tok * 512 + 128 * hd + 4 * li);
                const u32x2 rv = *(const u32x2*)(KVR + (size_t)tok * 512 + 128 * hd + 64 + 4 * li);
                float k[4] = {bflo(rk[0]), bfhi(rk[0]), bflo(rk[1]), bfhi(rk[1])};
                const float r = rsqrtf(grp_sum16(k[0] * k[0] + k[1] * k[1] + k[2] * k[2] + k[3] * k[3]) * (1.f / 64.f) + EPS);
                const float* kg = c.in(I_MLAKG) + l * 96 + 4 * li;
                *(u32x2*)(c.ws<bf16_t>(WS_KD) + ((size_t)(b0 * 4 + hd) * KEYS + key) * 96 + 4 * li) = (u32x2){pk2(k[0] * r * kg[0], k[1] * r * kg[1]), pk2(k[2] * r * kg[2], k[3] * r * kg[3])};
                LAS bf16_t* d = vt + (hd * 64 + 4 * li) * VT_LD + tl;
                d[0] = (bf16_t)(rv[0] & 0xffffu); d[VT_LD] = (bf16_t)(rv[0] >> 16); d[2 * VT_LD] = (bf16_t)(rv[1] & 0xffffu); d[3 * VT_LD] = (bf16_t)(rv[1] >> 16);
            }
        }
        __syncthreads();
        {
            const int row = tid, h = row >> 6, d = row & 63;
            bf16_t* dst = c.ws<bf16_t>(WS_VDT) + ((size_t)(b0 * 4 + h) * 64 + d) * KEYS + key0;
            LAS const bf16_t* src = vt + row * VT_LD;
#pragma unroll
            for (int j = 0; j < 8; ++j) *(u32x4*)(dst + 8 * j) = *(LAS const u32x4*)(src + 8 * j);
        }
    }
}

constexpr int AT_KN = 0, AT_KR = 8192, AT_V = 12288, AT_STAGE = 21504, AT_VLD = 136;
template <int DK>
DEV void attn_item(const bf16_t* Q, const bf16_t* K, const bf16_t* Vt, int nkeys, bf16_t* Yrow, LAS char* lds, int tid) {
    const int lane = tid & 63, wave = tid >> 6, l31 = lane & 31, h5 = lane >> 5;
    constexpr int NS = DK / 16;
    bf16x8 qf[NS];
#pragma unroll
    for (int s = 0; s < NS; ++s) qf[s] = *(const bf16x8*)(Q + (size_t)(32 * wave + l31) * DK + 16 * s + 8 * h5);
    f32x16 oacc[2];
#pragma unroll
    for (int i = 0; i < 16; ++i) { oacc[0][i] = 0.f; oacc[1][i] = 0.f; }
    float mrun = -1e30f, lsum = 0.f;
    const int kr_ = tid >> 3, kc_ = tid & 7;
    const int rr_ = tid >> 2, rc_ = tid & 3;
    u32x4 rk[2], rv[2], rrp;
    const int nt = nkeys / 64;
    auto gload = [&](int t) {
        const int k0 = t * 64;
#pragma unroll
        for (int i = 0; i < 2; ++i) { rk[i] = *(const u32x4*)(K + (size_t)(k0 + kr_ + 32 * i) * DK + kc_ * 8); rv[i] = *(const u32x4*)(Vt + (size_t)(kr_ + 32 * i) * KEYS + k0 + kc_ * 8); }
        if (DK == 96) rrp = *(const u32x4*)(K + (size_t)(k0 + rr_) * DK + 64 + rc_ * 8);
    };
    auto lstore = [&](int st) {
        LAS char* base = lds + st * AT_STAGE;
#pragma unroll
        for (int i = 0; i < 2; ++i) { const int r = kr_ + 32 * i;
            *(LAS u32x4*)(base + AT_KN + r * 128 + ((kc_ ^ ((r >> 1) & 7)) << 4)) = rk[i];
            LAS char* vd = base + AT_V + r * AT_VLD + kc_ * 16;
            *(LAS u32x2*)vd = (u32x2){rv[i][0], rv[i][1]}; *(LAS u32x2*)(vd + 8) = (u32x2){rv[i][2], rv[i][3]}; }
        if (DK == 96) *(LAS u32x4*)(base + AT_KR + rr_ * 64 + ((rc_ ^ ((rr_ >> 2) & 3)) << 4)) = rrp;
    };
    __syncthreads();
    gload(0); lstore(0);
    __syncthreads();
    for (int t = 0; t < nt; ++t) {
        const int cur = t & 1;
        if (t + 1 < nt) gload(t + 1);
        LAS const char* base = lds + cur * AT_STAGE;
        f32x16 sacc[2];
#pragma unroll
        for (int kt2 = 0; kt2 < 2; ++kt2) {
#pragma unroll
            for (int i = 0; i < 16; ++i) sacc[kt2][i] = 0.f;
            const int row = 32 * kt2 + l31;
#pragma unroll
            for (int s = 0; s < 4; ++s) { const bf16x8 kf = lds_r128(base + AT_KN + row * 128 + (((2 * s + h5) ^ ((row >> 1) & 7)) << 4));
                sacc[kt2] = __builtin_amdgcn_mfma_f32_32x32x16_bf16(kf, qf[s], sacc[kt2], 0, 0, 0); }
            if (DK == 96) {
#pragma unroll
                for (int s = 0; s < 2; ++s) { const bf16x8 kf = lds_r128(base + AT_KR + row * 64 + (((2 * s + h5) ^ ((row >> 2) & 3)) << 4));
                    sacc[kt2] = __builtin_amdgcn_mfma_f32_32x32x16_bf16(kf, qf[4 + s], sacc[kt2], 0, 0, 0); }
            }
        }
        float mt = sacc[0][0];
#pragma unroll
        for (int i = 1; i < 16; ++i) mt = fmaxf(mt, sacc[0][i]);
#pragma unroll
        for (int i = 0; i < 16; ++i) mt = fmaxf(mt, sacc[1][i]);
        mt = fmaxf(mt, __shfl_xor(mt, 32));
        const float mnew = fmaxf(mrun, mt), alpha = exp2f(mrun - mnew);
        mrun = mnew;
        float ps = 0.f;
#pragma unroll
        for (int kt2 = 0; kt2 < 2; ++kt2)
#pragma unroll
            for (int i = 0; i < 16; ++i) { const float p = exp2f(sacc[kt2][i] - mnew); sacc[kt2][i] = p; ps += p; }
        lsum = lsum * alpha + ps;
#pragma unroll
        for (int i = 0; i < 16; ++i) { oacc[0][i] *= alpha; oacc[1][i] *= alpha; }
        bf16x8 pf[2][2];
#pragma unroll
        for (int kt2 = 0; kt2 < 2; ++kt2)
#pragma unroll
            for (int s2 = 0; s2 < 2; ++s2) {
                u32x4 w;
#pragma unroll
                for (int j = 0; j < 4; ++j) w[j] = pk2(sacc[kt2][8 * s2 + 2 * j], sacc[kt2][8 * s2 + 2 * j + 1]);
                pf[kt2][s2] = __builtin_bit_cast(bf16x8, w);
            }
#pragma unroll
        for (int dt = 0; dt < 2; ++dt)
#pragma unroll
            for (int kt2 = 0; kt2 < 2; ++kt2)
#pragma unroll
                for (int s2 = 0; s2 < 2; ++s2) {
                    LAS const char* vp = base + AT_V + (32 * dt + l31) * AT_VLD + (32 * kt2 + 16 * s2 + 4 * h5) * 2;
                    const u32x2 lo = *(LAS const u32x2*)vp, hi = *(LAS const u32x2*)(vp + 16);
                    const bf16x8 vf = __builtin_bit_cast(bf16x8, (u32x4){lo[0], lo[1], hi[0], hi[1]});
                    oacc[dt] = __builtin_amdgcn_mfma_f32_32x32x16_bf16(vf, pf[kt2][s2], oacc[dt], 0, 0, 0);
                }
        if (t + 1 < nt) lstore(cur ^ 1);
        __syncthreads();
    }
    const float ltot = lsum + __shfl_xor(lsum, 32), inv = 1.f / ltot;
    bf16_t* yr = Yrow + (size_t)(32 * wave + l31) * 1024;
#pragma unroll
    for (int dt = 0; dt < 2; ++dt)
#pragma unroll
        for (int g = 0; g < 4; ++g) {
            const int d0 = 32 * dt + 8 * g + 4 * h5;
            *(u32x2*)(yr + d0) = (u32x2){pk2(oacc[dt][4 * g] * inv, oacc[dt][4 * g + 1] * inv), pk2(oacc[dt][4 * g + 2] * inv, oacc[dt][4 * g + 3] * inv)};
        }
}
DEV void phase_d(const Ctx& c) {
    const int nlat = 1024, nctx = (c.layer == NL - 1) ? 0 : 128;
    bf16_t* Y = c.ws<bf16_t>(WS_ACT);
    for (int it = c.bid; it < nlat + nctx; it += c.nb) {
        int type, b, h, qpos0, nkeys, tok0;
        if (it < nlat) { type = it >> 9; const int r = it & 511; b = r >> 6; h = (r >> 4) & 3; const int qb = r & 15; qpos0 = CL + 128 * qb; nkeys = KEYS; tok0 = b * SEQ + 128 * qb; }
        else { const int u = it - nlat; type = u >> 6; const int r = u & 63; b = r >> 3; h = (r >> 1) & 3; const int qb = r & 1; qpos0 = 128 * qb; nkeys = CL; tok0 = NLAT + b * CL + 128 * qb; }
        if (type == 0) {
            attn_item<96>(c.ws<bf16_t>(WS_QD) + ((size_t)(b * 4 + h) * KEYS + qpos0) * 96, c.ws<bf16_t>(WS_KD) + (size_t)(b * 4 + h) * KEYS * 96,
                          c.ws<bf16_t>(WS_VDT) + (size_t)(b * 4 + h) * 64 * KEYS, nkeys, Y + (size_t)tok0 * 1024 + 768 + 64 * h, c.lds, c.tid);
        } else {
            attn_item<64>(c.ws<bf16_t>(WS_QC) + ((size_t)(b * 4 + h) * KEYS + qpos0) * 64, c.ws<bf16_t>(WS_KC) + (size_t)(b * 2 + (h >> 1)) * KEYS * 64,
                          c.ws<bf16_t>(WS_VCT) + (size_t)(b * 2 + (h >> 1)) * 64 * KEYS, nkeys, Y + (size_t)tok0 * 1024 + 512 + 64 * h, c.lds, c.tid);
        }
    }
}

DEV void phase_e0(const Ctx& c) {
    const int tid = c.tid, lane = tid & 63, wave = tid >> 6;
    bf16_t* Y = c.ws<bf16_t>(WS_ACT); const float* gg = c.in(I_GGO) + c.layer * 1024;
    const int ntok = c.ntok_tail();
    for (int tok = c.bid * 4 + wave; tok < ntok; tok += c.nb * 4) {
#pragma unroll
        for (int g = 0; g < 4; ++g) {
            bf16_t* p = Y + (size_t)tok * 1024 + g * 256 + 4 * lane;
            const u32x2 raw = *(const u32x2*)p;
            const float v[4] = {bflo(raw[0]), bfhi(raw[0]), bflo(raw[1]), bfhi(raw[1])};
            const float r = rsqrtf(wave_sum(v[0] * v[0] + v[1] * v[1] + v[2] * v[2] + v[3] * v[3]) * (1.f / 256.f) + EPS);
            const f32x4 gn = *(const f32x4*)(gg + g * 256 + 4 * lane);
            *(u32x2*)p = (u32x2){pk2(v[0] * r * gn[0], v[1] * r * gn[1]), pk2(v[2] * r * gn[2], v[3] * r * gn[3])};
        }
    }
}
DEV void phase_e(const Ctx& c) {
    GemmDesc g; g.A = c.ws<bf16_t>(WS_ACT); g.lda = 1024; g.rowidx = nullptr; g.nvalid = 0;
    g.B0 = c.ws<bf16_t>(WS_WOUT) + (size_t)c.layer * 1024 * 1024; g.B1 = g.B0; g.ldb = 1024; g.ksplit = 1 << 30; g.K = 1024;
    const int ntm = c.ntok_tail() / 128;
    for (int t = c.bid; t < ntm * 8; t += c.nb) {
        const int mt = t >> 3, nt = t & 7, m0 = mt * 128;
        const int mbi = m0 < NLAT ? (m0 >> 11) : 8;
        const float* gate = c.modv(mbi, 2);
        gemm_tile(g, m0, nt * 128, c.lds, c.tid, [&](const f32x4 (&acc)[4][4], int mb, int nbase, int lane) {
#pragma unroll
            for (int nf = 0; nf < 4; ++nf) { const int n = nbase + 16 * nf + 4 * (lane >> 4); const f32x4 gt = *(const f32x4*)(gate + n);
#pragma unroll
                for (int mf = 0; mf < 4; ++mf) { const int m = m0 + mb + 16 * mf + (lane & 15);
                    const f32x4 xv = *(const f32x4*)(c.xsrc(m) + n); const f32x4 a = acc[nf][mf];
                    *(f32x4*)(c.xdst(m) + n) = (f32x4){xv[0] + gt[0] * a[0], xv[1] + gt[1] * a[1], xv[2] + gt[2] * a[2], xv[3] + gt[3] * a[3]}; } }
        });
    }
}

DEV void phase_f(const Ctx& c) {
    const int tid = c.tid, lane = tid & 63, wave = tid >> 6, l = c.layer;
    LAS float* xs = (LAS float*)c.lds;
    LAS float* lg = xs + 64 * 33;
    LAS float* rs = lg + 64 * 20;
    int* cnt = c.ws<int>(WS_CNT) + l * 32;
    int* ltok = c.ws<int>(WS_LTOK); float* lw = c.ws<float>(WS_LW);
    bf16_t* H = c.ws<bf16_t>(WS_ACT);
    const int nitems = c.ntok_tail() / 64;
    for (int item = c.bid; item < nitems; item += c.nb) {
        const int tok0 = item * 64, mb = tok0 < NLAT ? (tok0 >> 11) : 8;
        const float* RW = c.ws<float>(WS_RW) + (size_t)(l * 9 + mb) * 1024 * 20;
        const int t = tid & 63, cg = __builtin_amdgcn_readfirstlane(tid >> 6);
        float a[5] = {0.f, 0.f, 0.f, 0.f, 0.f}; float ss = 0.f;
        const int lr = tid >> 3, lc = tid & 7;
        for (int k0 = 0; k0 < 1024; k0 += 32) {
            __syncthreads();
#pragma unroll
            for (int i = 0; i < 2; ++i) { const int r = lr + 32 * i; const f32x4 v = *(const f32x4*)(c.xdst(tok0 + r) + k0 + 4 * lc);
                xs[r * 33 + 4 * lc] = v[0]; xs[r * 33 + 4 * lc + 1] = v[1]; xs[r * 33 + 4 * lc + 2] = v[2]; xs[r * 33 + 4 * lc + 3] = v[3]; }
            __syncthreads();
#pragma unroll 8
            for (int k = 0; k < 32; ++k) { const float x = xs[t * 33 + k]; ss += x * x; const float* w = RW + (size_t)(k0 + k) * 20 + 5 * cg;
#pragma unroll
                for (int j = 0; j < 5; ++j) a[j] += x * w[j]; }
        }
        const float r = rsqrtf(ss * (1.f / 1024.f) + EPS);
        const float* RC = c.ws<float>(WS_RC) + (l * 9 + mb) * 32;
#pragma unroll
        for (int j = 0; j < 5; ++j) lg[t * 20 + 5 * cg + j] = r * a[j] + RC[5 * cg + j];
        if (cg == 0) rs[t] = r;
        __syncthreads();
        if (tid < 64) {
            const float* L = (const float*)0; (void)L;
            float gl[4], el[4];
#pragma unroll
            for (int j = 0; j < 4; ++j) gl[j] = lg[t * 20 + j];
            int gi = 0; float gmx = gl[0];
#pragma unroll
            for (int j = 1; j < 4; ++j) if (gl[j] > gmx) { gmx = gl[j]; gi = j; }
            float gs = 0.f;
#pragma unroll
            for (int j = 0; j < 4; ++j) gs += __expf(gl[j] - gmx);
            const float gw = 1.f / gs;
#pragma unroll
            for (int j = 0; j < 4; ++j) el[j] = lg[t * 20 + 4 + 4 * gi + j];
            int e1 = 0; float m1 = el[0];
#pragma unroll
            for (int j = 1; j < 4; ++j) if (el[j] > m1) { m1 = el[j]; e1 = j; }
            int e2 = -1; float m2 = -3.0e38f;
#pragma unroll
            for (int j = 0; j < 4; ++j) if (j != e1 && el[j] > m2) { m2 = el[j]; e2 = j; }
            const float p2 = __expf(m2 - m1), w1 = gw / (1.f + p2), w2 = gw * p2 / (1.f + p2);
            const int ea = e1 < e2 ? e1 : e2, eb = e1 < e2 ? e2 : e1; const float wa = e1 < e2 ? w1 : w2, wb = e1 < e2 ? w2 : w1;
            const int pidx = ea == 0 ? eb - 1 : (ea == 1 ? eb + 1 : 5);
            const int bucket = gi * 6 + pidx;
            const int pos = atomicAdd(&cnt[bucket], 1);
            ltok[bucket * NTOK + pos] = tok0 + t;
            lw[((size_t)bucket * NTOK + pos) * 2] = wa; lw[((size_t)bucket * NTOK + pos) * 2 + 1] = wb;
        }
        const float* gf = c.in(I_GFFN) + l * 1024; const float* sh = c.modv(mb, 3); const float* scl = c.modv(mb, 4);
        for (int i = 0; i < 16; ++i) {
            const int tl = wave * 16 + i, tok = tok0 + tl; const float rr = rs[tl];
            const float* x = c.xdst(tok);
#pragma unroll
            for (int q = 0; q < 4; ++q) { const int e = q * 256 + lane * 4;
                const f32x4 v = *(const f32x4*)(x + e), gg = *(const f32x4*)(gf + e), s1 = *(const f32x4*)(scl + e), s0 = *(const f32x4*)(sh + e);
                float o[4];
#pragma unroll
                for (int j = 0; j < 4; ++j) o[j] = v[j] * rr * gg[j] * (1.f + s1[j]) + s0[j];
                *(u32x2*)(H + (size_t)tok * 1024 + e) = (u32x2){pk2(o[0], o[1]), pk2(o[2], o[3])}; }
        }
        __syncthreads();
    }
}

struct MoeMap { int tile0[NBUCKET + 1]; };
DEV void moe_find(const int* cnt, int mg, int& bucket, int& mt, int& total) {
    int acc = 0; bucket = -1; mt = 0;
    for (int b = 0; b < NBUCKET; ++b) { const int n = (cnt[b] + 127) >> 7; if (bucket < 0 && mg < acc + n) { bucket = b; mt = mg - acc; } acc += n; }
    total = acc;
}
DEV void pair_of(int pidx, int& ea, int& eb) { ea = pidx < 3 ? 0 : (pidx < 5 ? 1 : 2); eb = pidx < 3 ? pidx + 1 : (pidx < 5 ? pidx - 1 : 3); }
DEV void phase_g(const Ctx& c) {
    const int l = c.layer; const int* cnt = c.ws<int>(WS_CNT) + l * 32;
    int total = 0; { int b, m; moe_find(cnt, 0, b, m, total); }
    bf16_t* HB = c.ws<bf16_t>(WS_HBUF);
    for (int t = c.bid; t < total * 8; t += c.nb) {
        const int mg = t >> 3, nt = t & 7; int bucket, mt, tt; moe_find(cnt, mg, bucket, mt, tt);
        int ea, eb; pair_of(bucket % 6, ea, eb); const int grp = bucket / 6;
        const int e = grp * 4 + ((nt < 4) ? ea : eb);
        const int nvalid = min(128, cnt[bucket] - mt * 128);
        const int* rows = c.ws<int>(WS_LTOK) + bucket * NTOK + mt * 128;
        const float* wts = c.ws<float>(WS_LW) + ((size_t)bucket * NTOK + mt * 128) * 2 + ((nt < 4) ? 0 : 1);
        GemmDesc g; g.A = c.ws<bf16_t>(WS_ACT); g.lda = 1024; g.rowidx = rows; g.nvalid = nvalid;
        g.B0 = c.ws<bf16_t>(WS_WUP) + ((size_t)l * 16 + e) * 512 * 1024; g.B1 = g.B0; g.ldb = 1024; g.ksplit = 1 << 30; g.K = 1024;
        const int hcol0 = (nt >> 2) * 256 + (nt & 3) * 64;
        gemm_tile(g, 0, (nt & 3) * 128, c.lds, c.tid, [&](const f32x4 (&acc)[4][4], int mb, int nbase, int lane) {
            const int wc = (nbase >> 6) & 1;
#pragma unroll
            for (int mf = 0; mf < 4; ++mf) { const int r = mb + 16 * mf + (lane & 15); const bool ok = r < nvalid; const float w = ok ? wts[2 * r] : 0.f;
#pragma unroll
                for (int f = 0; f < 2; ++f) { const f32x4 gt = acc[f][mf], up = acc[f + 2][mf]; float o[4];
#pragma unroll
                    for (int j = 0; j < 4; ++j) o[j] = ok ? silu_f(gt[j]) * up[j] * w : 0.f;
                    *(u32x2*)(HB + ((size_t)mg * 128 + r) * 512 + hcol0 + 32 * wc + 16 * f + 4 * (lane >> 4)) = (u32x2){pk2(o[0], o[1]), pk2(o[2], o[3])}; } }
        });
    }
}
DEV void phase_h(const Ctx& c) {
    const int l = c.layer; const int* cnt = c.ws<int>(WS_CNT) + l * 32;
    int total = 0; { int b, m; moe_find(cnt, 0, b, m, total); }
    for (int t = c.bid; t < total * 8; t += c.nb) {
        const int mg = t >> 3, nt = t & 7; int bucket, mt, tt; moe_find(cnt, mg, bucket, mt, tt);
        int ea, eb; pair_of(bucket % 6, ea, eb); const int grp = bucket / 6;
        const int nvalid = min(128, cnt[bucket] - mt * 128);
        const int* rows = c.ws<int>(WS_LTOK) + bucket * NTOK + mt * 128;
        GemmDesc g; g.A = c.ws<bf16_t>(WS_HBUF); g.lda = 512; g.rowidx = nullptr; g.nvalid = 0;
        g.B0 = c.ws<bf16_t>(WS_WDN) + ((size_t)l * 16 + grp * 4 + ea) * 1024 * 256; g.B1 = c.ws<bf16_t>(WS_WDN) + ((size_t)l * 16 + grp * 4 + eb) * 1024 * 256; g.ldb = 256; g.ksplit = 256; g.K = 512;
        gemm_tile(g, mg * 128, nt * 128, c.lds, c.tid, [&](const f32x4 (&acc)[4][4], int mb, int nbase, int lane) {
#pragma unroll
            for (int mf = 0; mf < 4; ++mf) { const int r = mb + 16 * mf + (lane & 15);
                if (r < nvalid) { const int tok = rows[r]; const int mbi = tok < NLAT ? (tok >> 11) : 8; const float* gate = c.modv(mbi, 5); float* x = c.xdst(tok);
#pragma unroll
                    for (int nf = 0; nf < 4; ++nf) { const int n = nbase + 16 * nf + 4 * (lane >> 4); const f32x4 gt = *(const f32x4*)(gate + n), xv = *(const f32x4*)(x + n), a = acc[nf][mf];
                        *(f32x4*)(x + n) = (f32x4){xv[0] + gt[0] * a[0], xv[1] + gt[1] * a[1], xv[2] + gt[2] * a[2], xv[3] + gt[3] * a[3]}; } } }
        });
    }
}

constexpr int PH_P0 = 0, PH_A = 1, PH_B = 2, PH_C = 3, PH_D0 = 4, PH_D1 = 5, PH_D = 6, PH_E0 = 7, PH_E = 8, PH_F = 9, PH_G = 10, PH_H = 11, PH_PER_LAYER = 11;
DEV void run_phase(const Ctx& c, int ph) {
    switch (ph) {
        case PH_P0: phase_p0(c); break;
        case PH_A: phase_a(c); break;
        case PH_B: phase_b(c); break;
        case PH_C: phase_c(c); break;
        case PH_D0: phase_d0(c); break;
        case PH_D1: phase_d1(c); break;
        case PH_D: phase_d(c); break;
        case PH_E0: phase_e0(c); break;
        case PH_E: phase_e(c); break;
        case PH_F: phase_f(c); break;
        case PH_G: phase_g(c); break;
        case PH_H: phase_h(c); break;
    }
}

extern __shared__ __attribute__((aligned(16))) char smem_dyn[];

#define XB_TMO      128
#define XB_XCNT(j)  (256  + 64 * (j))
#define XB_XSUB(j)  (1280 + 64 * (j))
#define XB_XGEN(j)  (2304 + 64 * (j))
#define XB_TOP      3328
#define XB_TOPGEN   3392
#define XCD_BAR_WORDS 3456
#define XB_SPIN_CAP (1u << 22)
DEV unsigned xb_ld(unsigned* p)              { return __hip_atomic_load(p, __ATOMIC_RELAXED, __HIP_MEMORY_SCOPE_AGENT); }
DEV unsigned xb_add(unsigned* p, unsigned v) { return __hip_atomic_fetch_add(p, v, __ATOMIC_RELAXED, __HIP_MEMORY_SCOPE_AGENT); }
DEV unsigned xb_xcc_id() { return (unsigned)__builtin_amdgcn_s_getreg((3 << 11) | 20) & 0xFu; }
#define XB_SPIN(cond, bar) do { unsigned _sp = 0; while (cond) { __builtin_amdgcn_s_sleep(1); \
    if ((++_sp & 255u) == 0u) { if (xb_ld(&(bar)[XB_TMO])) break; if (_sp > XB_SPIN_CAP) { atomicAdd(&(bar)[XB_TMO], 1u); break; } } } } while (0)
struct XcdBarrier { unsigned* bar; unsigned x; volatile LAS unsigned* st; };
DEV XcdBarrier xcd_barrier_post(unsigned* bar, volatile LAS unsigned* st) {
    XcdBarrier b; b.bar = bar; b.x = xb_xcc_id(); b.st = st;
    if (threadIdx.x == 0) (void)xb_add(&bar[XB_XCNT(b.x)], 1u);
    return b;
}
DEV void xcd_barrier_complete(unsigned* bar, unsigned x, unsigned& nloc, unsigned& nx) {
    const unsigned G = gridDim.x * gridDim.y * gridDim.z;
    unsigned sum, cnt, mine, sp = 0u;
    for (;;) {
        sum = 0u; cnt = 0u; mine = 0u;
#pragma unroll
        for (unsigned j = 0; j < 16; ++j) { const unsigned c = xb_ld(&bar[XB_XCNT(j)]); sum += c; cnt += (c > 0u) ? 1u : 0u; mine = (j == x) ? c : mine; }
        if (sum == G) break;
        __builtin_amdgcn_s_sleep(1);
        if ((++sp & 255u) == 0u) { if (xb_ld(&bar[XB_TMO])) break; if (sp > XB_SPIN_CAP) { atomicAdd(&bar[XB_TMO], 1u); break; } }
    }
    nloc = mine > 0u ? mine : 1u; nx = cnt > 0u ? cnt : 1u;
}
DEV void xcd_barrier(const XcdBarrier& b) {
    asm volatile("s_waitcnt vmcnt(0)" ::: "memory");
    __syncthreads();
    if (threadIdx.x == 0) {
        unsigned* bar = b.bar;
        __builtin_amdgcn_s_waitcnt(0);
        unsigned nloc = b.st[0], nx = b.st[1];
        if (nloc == 0u) { xcd_barrier_complete(bar, b.x, nloc, nx); b.st[0] = nloc; b.st[1] = nx; }
        const unsigned old = xb_add(&bar[XB_XSUB(b.x)], 1u);
        const unsigned gen = old / nloc;
        if (old + 1u == (gen + 1u) * nloc) {
            __builtin_amdgcn_fence(__ATOMIC_RELEASE, "agent");
            asm volatile("s_waitcnt vmcnt(0)" ::: "memory");
            const unsigned og = xb_add(&bar[XB_TOP], 1u);
            const unsigned tg = og / nx;
            if (og + 1u == (tg + 1u) * nx) xb_add(&bar[XB_TOPGEN], 1u);
            else XB_SPIN(xb_ld(&bar[XB_TOPGEN]) == tg, bar);
            __builtin_amdgcn_fence(__ATOMIC_ACQUIRE, "agent");
            xb_add(&bar[XB_XGEN(b.x)], 1u);
            asm volatile("s_waitcnt vmcnt(0)" ::: "memory");
        } else {
            XB_SPIN(xb_ld(&bar[XB_XGEN(b.x)]) == gen, bar);
            __builtin_amdgcn_fence(__ATOMIC_ACQUIRE, "agent");
            asm volatile("s_waitcnt vmcnt(0)" ::: "memory");
        }
    }
    __syncthreads();
}
static_assert(XCD_BAR_WORDS * 4 <= 16384, "barrier words");


__global__ void __launch_bounds__(NTHREADS, 2) k_phase(Params p, int layer, int ph) {
    Ctx c; c.p = (ParamsPtr)__builtin_amdgcn_kernarg_segment_ptr(); c.layer = layer; c.bid = blockIdx.x; c.nb = gridDim.x; c.tid = threadIdx.x; c.lds = (LAS char*)smem_dyn;
    run_phase(c, ph);
}


__global__ void __launch_bounds__(NTHREADS, 2) k_mega(Params p) {
    ParamsPtr pp = (ParamsPtr)__builtin_amdgcn_kernarg_segment_ptr();
    Ctx c; c.p = pp; c.layer = 0; c.bid = blockIdx.x; c.nb = gridDim.x; c.tid = threadIdx.x; c.lds = (LAS char*)smem_dyn;
    volatile LAS unsigned* st = (volatile LAS unsigned*)(c.lds + 65536);
    if (threadIdx.x == 0) { st[0] = 0u; st[1] = 0u; st[2] = 0u; st[3] = 0u; }
    __syncthreads();
    XcdBarrier xb = xcd_barrier_post((unsigned*)(pp->ws + WS_BAR), st);
#pragma unroll 1
    for (int step = 0; step < 1 + NL * PH_PER_LAYER; ++step) {
        if (step) xcd_barrier(xb);
        { ParamsPtr q = pp; int t_ = threadIdx.x, b_ = blockIdx.x, n_ = gridDim.x; asm volatile("" : "+s"(q), "+v"(t_), "+s"(b_), "+s"(n_)); c.p = q; c.tid = t_; c.bid = b_; c.nb = n_; }
        c.layer = step ? (step - 1) / PH_PER_LAYER : 0;
        run_phase(c, step ? 1 + (step - 1) % PH_PER_LAYER : 0);
    }
}

extern "C" void kernel_launch(void* const* d_in, const int* in_sizes, int n_in, void* d_out, int out_size, void* d_ws, size_t ws_size, hipStream_t stream) {
    static int grid = 0;
    if (grid == 0) {
        if (n_in != 29 || ws_size < WS_END) { fprintf(stderr, "kernel_launch: unexpected n_in %d or workspace %zu < %zu\n", n_in, ws_size, (size_t)WS_END); grid = -1; return; }
        int dev = 0, cus = 0, per_cu = 0;
        (void)hipGetDevice(&dev); (void)hipDeviceGetAttribute(&cus, hipDeviceAttributeMultiprocessorCount, dev);
#if MODE_SINGLE
        const void* kfn = (const void*)k_mega;
#else
        const void* kfn = (const void*)k_phase;
#endif
        (void)hipFuncSetAttribute(kfn, hipFuncAttributeMaxDynamicSharedMemorySize, LDS_BYTES);
        (void)hipOccupancyMaxActiveBlocksPerMultiprocessor(&per_cu, kfn, NTHREADS, LDS_BYTES);
        if (per_cu < 1) per_cu = 1; if (per_cu > 2) per_cu = 2;
        grid = cus * per_cu;
    }
    if (grid < 0) return;
    Params p{};
    for (int i = 0; i < 29; ++i) p.in[i] = (const float*)d_in[i];
    p.out = (float*)d_out; p.ws = (char*)d_ws;
    (void)hipMemsetAsync((char*)d_ws + WS_BAR, 0, WS_ZERO_BYTES, stream);
#if MODE_SINGLE
    void* args[] = {&p};
    hipError_t e = hipLaunchCooperativeKernel((const void*)k_mega, dim3(grid), dim3(NTHREADS), args, LDS_BYTES, stream);
    if (e != hipSuccess) fprintf(stderr, "kernel_launch: cooperative launch failed: %s (grid %d)\n", hipGetErrorString(e), grid);
#else
    hipLaunchKernelGGL(k_phase, dim3(grid), dim3(NTHREADS), LDS_BYTES, stream, p, 0, PH_P0);
    for (int l = 0; l < NL; ++l)
        for (int ph = PH_A; ph <= PH_H; ++ph) hipLaunchKernelGGL(k_phase, dim3(grid), dim3(NTHREADS), LDS_BYTES, stream, p, l, ph);
#endif
}
```

```cpp
#include <hip/hip_runtime.h>
#include <cstdio>
#include <cstdint>

#ifndef MODE_SINGLE
#define MODE_SINGLE 1
#endif
#ifndef EXP_BAR2
#define EXP_BAR2 0
#endif
#ifndef PROBE_P1
#define PROBE_P1 -2
#define PROBE_P2 -2
#endif
#ifndef EXP_REP
#define EXP_REP -1
#endif

#define DEV __device__ __forceinline__
#define LAS __attribute__((address_space(3)))
typedef unsigned short bf16_t;
typedef short bf16x8 __attribute__((ext_vector_type(8)));
typedef float f32x4 __attribute__((ext_vector_type(4)));
typedef float f32x16 __attribute__((ext_vector_type(16)));
typedef unsigned u32x4 __attribute__((ext_vector_type(4)));
typedef unsigned u32x2 __attribute__((ext_vector_type(2)));

constexpr int DM = 1024, NB = 8, SEQ = 2048, CL = 256, NL = 2;
constexpr int NLAT = NB * SEQ, NCTX = NB * CL, NTOK = NLAT + NCTX;
constexpr int KEYS = CL + SEQ;
constexpr int INC = 2208, INCP = 2304;
constexpr int OFF_AU = 0, OFF_AV = 256, OFF_BB = 512, OFF_BC = 768, OFF_BX = 1024, OFF_CQ = 1280, OFF_CK = 1536, OFF_CV = 1664,
              OFF_DCQ = 1792, OFF_DCKV = 2048, OFF_DKR = 2176;
constexpr float EPS = 1e-6f;
constexpr float LOG2E = 1.4426950408889634f;
constexpr float C_SCALE = 0.125f, D_SCALE = 0.10206207261596577f;
constexpr int NBUCKET = 24;
constexpr int MAXMT = NTOK / 256 + NBUCKET;
constexpr int NTHREADS = 512, NW = 8;
constexpr int LDS_BAR = 2 * (256 + 256) * 128, LDS_BYTES = LDS_BAR + 64;

constexpr size_t al256(size_t x) { return (x + 255) & ~(size_t)255; }
constexpr size_t WS_BAR   = 0;
constexpr size_t WS_CNT   = 16384;
constexpr size_t WS_ZERO_BYTES = 16384 + 8192;
constexpr size_t WS_MODV  = al256(WS_CNT + 8192);
constexpr size_t WS_RW    = al256(WS_MODV + (size_t)NL * 9 * 6144 * 4);
constexpr size_t WS_RC    = al256(WS_RW + (size_t)NL * 9 * 2 * 32 * 1024 * 2);
constexpr size_t WS_GM    = al256(WS_RC + (size_t)NL * 9 * 32 * 4);
constexpr size_t WS_ROPEC = al256(WS_GM + (size_t)NL * 9 * 1024 * 4);
constexpr size_t WS_ROPED = al256(WS_ROPEC + (size_t)2 * 2048 * 32 * 4);
constexpr size_t WS_WIN   = al256(WS_ROPED + (size_t)2 * 2048 * 16 * 4);
constexpr size_t WS_WOUT  = al256(WS_WIN + (size_t)NL * INCP * 1024 * 2);
constexpr size_t WS_WUP   = al256(WS_WOUT + (size_t)NL * 1024 * 1024 * 2);
constexpr size_t WS_WDN   = al256(WS_WUP + (size_t)16 * 512 * 1024 * 2);
constexpr size_t WS_WQB   = al256(WS_WDN + (size_t)16 * 1024 * 256 * 2);
constexpr size_t WS_WKVB  = al256(WS_WQB + (size_t)NL * 384 * 256 * 2);
constexpr size_t WS_WSG   = al256(WS_WKVB + (size_t)NL * 512 * 128 * 2);
constexpr size_t WS_XS    = al256(WS_WSG + (size_t)NL * 4 * 128 * 128 * 2);
constexpr size_t WS_ACT   = al256(WS_XS + (size_t)NTOK * 1024 * 2);
constexpr size_t WS_P     = al256(WS_ACT + (size_t)NTOK * 1024 * 2);
constexpr size_t WS_QRAW  = WS_P;
constexpr size_t WS_KVRAW = al256(WS_QRAW + (size_t)NTOK * 384 * 2);
constexpr size_t WS_HBUF  = WS_P;
constexpr size_t WS_QC    = al256(WS_P + (size_t)NTOK * INC * 2);
constexpr size_t WS_KC    = al256(WS_QC + (size_t)NB * 4 * KEYS * 64 * 2);
constexpr size_t WS_VCT   = al256(WS_KC + (size_t)NB * 2 * KEYS * 64 * 2);
constexpr size_t WS_QD    = al256(WS_VCT + (size_t)NB * 2 * 64 * KEYS * 2);
constexpr size_t WS_CQN   = WS_QD;
constexpr size_t WS_CKVN  = WS_QD + (size_t)NTOK * 256 * 2;
constexpr size_t WS_KD    = al256(WS_QD + (size_t)NB * 4 * KEYS * 96 * 2);
constexpr size_t WS_VDT   = al256(WS_KD + (size_t)NB * 4 * KEYS * 96 * 2);
constexpr size_t WS_LTOK  = al256(WS_VDT + (size_t)NB * 4 * 64 * KEYS * 2);
constexpr size_t WS_LW    = al256(WS_LTOK + (size_t)NBUCKET * NTOK * 4);
constexpr size_t WS_SSQ   = al256(WS_LW + (size_t)NBUCKET * NTOK * 8);
constexpr size_t WS_DBG   = al256(WS_SSQ + (size_t)NTOK * 8 * 4);
constexpr size_t WS_END   = WS_DBG + (1 << 20);
static_assert(WS_END <= ((size_t)256 << 20), "workspace");
static_assert((size_t)MAXMT * 256 * 512 * 2 <= (size_t)NTOK * INC * 2, "Hbuf overlay");
static_assert((size_t)NTOK * 384 * 2 <= (size_t)NB * 4 * KEYS * 96 * 2, "CQN/CKVN overlay");

struct Params {
    const float* in[29];
    float* out;
    char* ws;
};
enum { I_X = 0, I_C, I_CTX, I_CCTX, I_WMOD, I_BMOD, I_GATTN, I_WIN, I_SGUVG, I_SGUW, I_SGUB, I_CONVW, I_GQAQG, I_GQAKG, I_QAG, I_WQB, I_KVAG, I_WKVB,
       I_MLAQG, I_MLAKG, I_GGO, I_WOUT, I_GFFN, I_WRG, I_BRG, I_WRE, I_BRE, I_WUP, I_WDN };

DEV bf16_t f2bf(float f) { unsigned u = __float_as_uint(f); u += 0x7fffu + ((u >> 16) & 1u); return (bf16_t)(u >> 16); }
DEV float bf2f(bf16_t h) { return __uint_as_float(((unsigned)h) << 16); }
typedef __bf16 bf16x2_t __attribute__((ext_vector_type(2)));
typedef float f32x2 __attribute__((ext_vector_type(2)));
DEV unsigned pk2(float a, float b) { const f32x2 v = {a, b}; return __builtin_bit_cast(unsigned, __builtin_convertvector(v, bf16x2_t)); }
DEV float bflo(unsigned u) { return __uint_as_float(u << 16); }
DEV float bfhi(unsigned u) { return __uint_as_float(u & 0xffff0000u); }
template <int M> DEV float xlane(float v) {
    const int i = __builtin_bit_cast(int, v);
    if constexpr (M == 1) return __builtin_bit_cast(float, __builtin_amdgcn_mov_dpp(i, 0xB1, 0xF, 0xF, true));
    else if constexpr (M == 2) return __builtin_bit_cast(float, __builtin_amdgcn_mov_dpp(i, 0x4E, 0xF, 0xF, true));
    else if constexpr (M == 8) return __builtin_bit_cast(float, __builtin_amdgcn_mov_dpp(i, 0x128, 0xF, 0xF, true));
    else if constexpr (M == 4 || M == 16) return __builtin_bit_cast(float, __builtin_amdgcn_ds_swizzle(i, (M << 10) | 0x1F));
    else { static_assert(M == 32, "xlane"); const auto r = __builtin_amdgcn_permlane32_swap((unsigned)i, (unsigned)i, false, false);
        return __builtin_bit_cast(float, (int)(r[0] ^ r[1] ^ (unsigned)i)); }
}
DEV float wave_sum(float v) { v += xlane<32>(v); v += xlane<16>(v); v += xlane<8>(v); v += xlane<4>(v); v += xlane<2>(v); v += xlane<1>(v); return v; }
DEV float wave_max(float v) { v = fmaxf(v, xlane<32>(v)); v = fmaxf(v, xlane<16>(v)); v = fmaxf(v, xlane<8>(v)); v = fmaxf(v, xlane<4>(v)); v = fmaxf(v, xlane<2>(v)); return fmaxf(v, xlane<1>(v)); }
DEV float grp_sum16(float v) { v += xlane<1>(v); v += xlane<2>(v); v += xlane<4>(v); v += xlane<8>(v); return v; }
DEV float silu_f(float x) { return x / (1.f + __expf(-x)); }
DEV float gelu_fast(float x) { const float u = 1.5957691216057308f * (x + 0.044715f * x * x * x); return x * __builtin_amdgcn_rcpf(1.f + __expf(-u)); }
DEV void tok_info(int tok, int& b, int& pos, int& key, bool& isctx) {
    if (tok < NLAT) { b = tok >> 11; pos = tok & 2047; key = CL + pos; isctx = false; }
    else { const int c = tok - NLAT; b = c >> 8; pos = c & 255; key = pos; isctx = true; }
}
DEV bf16x8 lds_r128(LAS const char* p) { return *(LAS const bf16x8*)p; }

typedef const __attribute__((address_space(4))) Params* ParamsPtr;
struct Ctx {
    ParamsPtr p; int layer; int bid, nb, tid; LAS char* lds;
    DEV const float* in(int i) const { return p->in[i]; }
    template <class T> DEV T* ws(size_t off) const { return (T*)(p->ws + off); }
    DEV const float* modv(int mb, int chunk) const { return ws<float>(WS_MODV) + ((size_t)(layer * 9 + mb) * 6 + chunk) * 1024; }
    DEV const float* xin(int tok) const { return tok < NLAT ? p->in[I_X] + (size_t)tok * DM : p->in[I_CTX] + (size_t)(tok - NLAT) * DM; }
    DEV bf16_t* xs(int tok) const { return ws<bf16_t>(WS_XS) + (size_t)tok * DM; }
    DEV f32x4 xload4(int tok, int n) const {
        if (layer == 0) return *(const f32x4*)(xin(tok) + n);
        const u32x2 r = *(const u32x2*)(xs(tok) + n); return (f32x4){bflo(r[0]), bfhi(r[0]), bflo(r[1]), bfhi(r[1])};
    }
    DEV f32x4 xsload4(int tok, int n) const { const u32x2 r = *(const u32x2*)(xs(tok) + n); return (f32x4){bflo(r[0]), bfhi(r[0]), bflo(r[1]), bfhi(r[1])}; }
    DEV void xsstore4(int tok, int n, float a, float b, float c2, float d) const { *(u32x2*)(xs(tok) + n) = (u32x2){pk2(a, b), pk2(c2, d)}; }
    DEV int ntok_tail() const { return layer == NL - 1 ? NLAT : NTOK; }
};

struct GemmDesc {
    const bf16_t* A; int lda; const int* rowidx; int nvalid;
    const bf16_t* B0; const bf16_t* B1; int ldb; int ksplit; int K;
};
template <int WN_, int MF, class Epi>
DEV void gemm_tile(const GemmDesc& g, int m0, int n0, LAS char* lds, int tid, const Epi& epi) {
    constexpr int BM = (8 / WN_) * 16 * MF, BN = 64 * WN_, NPA = BM / 8, APW = (NPA + 7) / 8, BP = WN_, STAGE = (BM + BN) * 128;
    static_assert(BM % 8 == 0 && 2 * STAGE <= LDS_BAR, "tile does not fit");
    const int lane = tid & 63, wave = __builtin_amdgcn_readfirstlane(tid >> 6), wm = wave / WN_, wn = wave % WN_;
    int aoff[APW], boff[BP];
#pragma unroll
    for (int j = 0; j < APW; ++j) {
        const int pc = (j * 8 + wave < NPA) ? j * 8 + wave : wave;
        const int r = pc * 8 + (lane >> 3), kc = (lane & 7) ^ ((r >> 1) & 7);
        const int srow = g.rowidx ? g.rowidx[(r < g.nvalid) ? r : 0] : (m0 + r);
        aoff[j] = srow * g.lda + kc * 8;
    }
#pragma unroll
    for (int j = 0; j < BP; ++j) {
        const int r = (j * 8 + wave) * 8 + (lane >> 3), kc = (lane & 7) ^ ((r >> 1) & 7);
        boff[j] = (n0 + r) * g.ldb + kc * 8;
    }
    f32x4 acc[4][MF];
#pragma unroll
    for (int i = 0; i < 4; ++i)
#pragma unroll
        for (int j = 0; j < MF; ++j) acc[i][j] = (f32x4){0.f, 0.f, 0.f, 0.f};
    const int nk = g.K / 64;
    const int swz = (lane >> 1) & 7, q = lane >> 4;
    const int arow = (16 * MF * wm + (lane & 15)) * 128, brow = (64 * wn + (lane & 15)) * 128;
    LAS char* pieceA = lds + wave * 1024;
    LAS char* pieceB = lds + BM * 128 + wave * 1024;
#define GT_STAGE(KT, ST) { const int k0_ = (KT) * 64; const bf16_t* Bb_ = (k0_ < g.ksplit) ? g.B0 + k0_ : g.B1 + (k0_ - g.ksplit); \
        _Pragma("unroll") for (int j = 0; j < APW; ++j) if (NPA % 8 == 0 || j * 8 + wave < NPA) __builtin_amdgcn_global_load_lds((const void*)(g.A + aoff[j] + k0_), (LAS void*)(pieceA + (ST) * STAGE + j * 8192), 16, 0, 0); \
        _Pragma("unroll") for (int j = 0; j < BP; ++j) __builtin_amdgcn_global_load_lds((const void*)(Bb_ + boff[j]), (LAS void*)(pieceB + (ST) * STAGE + j * 8192), 16, 0, 0); }
#define GT_COMPUTE(ST) { LAS const char* As_ = lds + (ST) * STAGE; LAS const char* Bs_ = As_ + BM * 128; \
        _Pragma("unroll") for (int ks = 0; ks < 2; ++ks) { const int ch = ((4 * ks + q) ^ swz) << 4; bf16x8 bfr[4]; \
            _Pragma("unroll") for (int f = 0; f < 4; ++f) bfr[f] = lds_r128(Bs_ + brow + f * 2048 + ch); \
            _Pragma("unroll") for (int mh = 0; mh < MF; mh += 4) { bf16x8 af[4]; \
                _Pragma("unroll") for (int f = 0; f < 4; ++f) af[f] = lds_r128(As_ + arow + (mh + f) * 2048 + ch); \
                _Pragma("unroll") for (int mf = 0; mf < 4; ++mf) _Pragma("unroll") for (int nf = 0; nf < 4; ++nf) \
                    acc[nf][mh + mf] = __builtin_amdgcn_mfma_f32_16x16x32_bf16(bfr[nf], af[mf], acc[nf][mh + mf], 0, 0, 0); } } }
    __syncthreads();
    GT_STAGE(0, 0);
    asm volatile("s_waitcnt vmcnt(0)" ::: "memory");
    __syncthreads();
#pragma unroll 1
    for (int kt = 0; kt < nk; kt += 2) {
        GT_STAGE(kt + 1, 1);
        GT_COMPUTE(0);
        asm volatile("s_waitcnt vmcnt(0)" ::: "memory");
        __syncthreads();
        if (kt + 2 < nk) GT_STAGE(kt + 2, 0);
        GT_COMPUTE(1);
        asm volatile("s_waitcnt vmcnt(0)" ::: "memory");
        __syncthreads();
    }
#undef GT_STAGE
#undef GT_COMPUTE
    {
        int lane_e = lane, mb_e = 16 * MF * wm, nb_e = n0 + 64 * wn;
        asm volatile("" : "+v"(lane_e), "+v"(mb_e), "+v"(nb_e));
        epi(acc, mb_e, __builtin_amdgcn_readfirstlane(nb_e), lane_e);
    }
}

DEV int p8_lds_lo(int fr, int fq) { return (fr * 64 + fq * 16) ^ ((fr >> 3) << 5); }
DEV void p8_stage_rc(int b, int& R, int& C) { const int st = b >> 10, sb = b & 1023, swz = sb ^ (((sb >> 9) & 1) << 5); R = (st >> 1) * 16 + (swz >> 6); C = (st & 1) * 32 + ((swz & 63) >> 1); }
template <class Epi>
DEV void gemm_tile8p(const GemmDesc& g, int m0, int n0, LAS char* lds, int tid, const Epi& epi) {
    const int wid = __builtin_amdgcn_readfirstlane(tid >> 6), lane = tid & 63, wr = wid >> 2, wc = wid & 3, fr = lane & 15, fq = lane >> 4;
    int aoff[2][2], boff[2][2];
#pragma unroll
    for (int i = 0; i < 2; ++i) { int R, C; p8_stage_rc(tid * 16 + i * 8192, R, C);
#pragma unroll
        for (int h = 0; h < 2; ++h) { const int r = h * 128 + R;
            const int srow = g.rowidx ? g.rowidx[(r < g.nvalid) ? r : 0] : (m0 + r);
            aoff[h][i] = srow * g.lda + C; boff[h][i] = (n0 + r) * g.ldb + C; } }
    const int lo = p8_lds_lo(fr, fq);
    LAS char* const stg = lds + wid * 1024;
    LAS const char* const rdA = lds + wr * 8192 + lo;
    LAS const char* const rdB = lds + 65536 + wc * 4096 + lo;
    f32x4 acc[2][2][4][2];
#pragma unroll
    for (int a = 0; a < 2; ++a)
#pragma unroll
        for (int b = 0; b < 2; ++b)
#pragma unroll
            for (int m = 0; m < 4; ++m) { acc[a][b][m][0] = (f32x4){0.f, 0.f, 0.f, 0.f}; acc[a][b][m][1] = acc[a][b][m][0]; }
    bf16x8 At[4][2], B0[2][2], B1[2][2];
    const int nt = g.K / 64;
#define P8_BOFF(kt) (((kt) * 64 < g.ksplit) ? g.B0 + (kt) * 64 : g.B1 + ((kt) * 64 - g.ksplit))
#define STAGE_A(b, h, kt) { _Pragma("unroll") for (int i_ = 0; i_ < 2; ++i_) __builtin_amdgcn_global_load_lds((const void*)(g.A + aoff[h][i_] + (kt) * 64), (LAS void*)(stg + ((b) * 2 + (h)) * 16384 + i_ * 8192), 16, 0, 0); }
#define STAGE_B(b, h, kt) { const bf16_t* Bb_ = P8_BOFF(kt); _Pragma("unroll") for (int i_ = 0; i_ < 2; ++i_) __builtin_amdgcn_global_load_lds((const void*)(Bb_ + boff[h][i_]), (LAS void*)(stg + 65536 + ((b) * 2 + (h)) * 16384 + i_ * 8192), 16, 0, 0); }
#define LDA(b, h) { _Pragma("unroll") for (int m = 0; m < 4; ++m) _Pragma("unroll") for (int k = 0; k < 2; ++k) At[m][k] = lds_r128(rdA + ((b) * 2 + (h)) * 16384 + (m * 2 + k) * 1024); }
#define LDB(dst, b, h) { _Pragma("unroll") for (int n = 0; n < 2; ++n) _Pragma("unroll") for (int k = 0; k < 2; ++k) dst[n][k] = lds_r128(rdB + ((b) * 2 + (h)) * 16384 + (n * 2 + k) * 1024); }
#define MMA(ai, bj, Bx) { __builtin_amdgcn_s_setprio(1); \
        _Pragma("unroll") for (int m = 0; m < 4; ++m) _Pragma("unroll") for (int n = 0; n < 2; ++n) _Pragma("unroll") for (int k = 0; k < 2; ++k) \
            acc[ai][bj][m][n] = __builtin_amdgcn_mfma_f32_16x16x32_bf16(Bx[n][k], At[m][k], acc[ai][bj][m][n], 0, 0, 0); \
        __builtin_amdgcn_s_setprio(0); }
#define WAIT_V(n) asm volatile("s_waitcnt vmcnt(" #n ")" ::: "memory")
#define WAIT_L(n) asm volatile("s_waitcnt lgkmcnt(" #n ")" ::: "memory")
#define BAR __builtin_amdgcn_s_barrier()
#define SCHED __builtin_amdgcn_sched_barrier(0)
    __syncthreads();
    STAGE_B(0, 0, 0); STAGE_A(0, 0, 0); STAGE_B(0, 1, 0); STAGE_A(0, 1, 0);
    if (wr == 1) BAR;
    WAIT_V(4); BAR;
    STAGE_B(1, 0, 1); STAGE_A(1, 0, 1); STAGE_B(1, 1, 1);
    WAIT_V(6); BAR;
#pragma unroll 1
    for (int t = 0; t < nt - 2; t += 2) {
        LDB(B0, 0, 0); SCHED; LDA(0, 0); STAGE_A(1, 1, t + 1);
        WAIT_L(8); BAR; WAIT_L(0); MMA(0, 0, B0); BAR; SCHED;
        LDB(B1, 0, 1); STAGE_B(0, 0, t + 2);
        BAR; WAIT_L(0); MMA(0, 1, B1); BAR;
        LDA(0, 1); STAGE_A(0, 0, t + 2);
        BAR; WAIT_L(0); MMA(1, 0, B0); BAR; SCHED;
        STAGE_B(0, 1, t + 2);
        WAIT_V(6); BAR; MMA(1, 1, B1); BAR;
        LDB(B0, 1, 0); SCHED; LDA(1, 0); STAGE_A(0, 1, t + 2);
        WAIT_L(8); BAR; WAIT_L(0); MMA(0, 0, B0); BAR; SCHED;
        LDB(B1, 1, 1); STAGE_B(1, 0, t + 3);
        BAR; WAIT_L(0); MMA(0, 1, B1); BAR;
        LDA(1, 1); STAGE_A(1, 0, t + 3);
        BAR; WAIT_L(0); MMA(1, 0, B0); BAR; SCHED;
        STAGE_B(1, 1, t + 3);
        WAIT_V(6); BAR; MMA(1, 1, B1); BAR;
    }
    {
        LDB(B0, 0, 0); LDA(0, 0); STAGE_A(1, 1, nt - 1);
        BAR; WAIT_L(0); MMA(0, 0, B0); BAR;
        LDB(B1, 0, 1); BAR; WAIT_L(0); MMA(0, 1, B1); BAR;
        LDA(0, 1); WAIT_V(4); BAR; WAIT_L(0); MMA(1, 0, B0); MMA(1, 1, B1); BAR; }
    {
        LDB(B0, 1, 0); LDA(1, 0); WAIT_V(2); BAR; WAIT_L(0); MMA(0, 0, B0); BAR;
        LDB(B1, 1, 1); WAIT_V(0); BAR; WAIT_L(0); MMA(0, 1, B1); BAR;
        LDA(1, 1); BAR; WAIT_L(0); MMA(1, 0, B0); MMA(1, 1, B1); BAR; }
    if (wr == 0) BAR;
#undef P8_BOFF
#undef STAGE_A
#undef STAGE_B
#undef LDA
#undef LDB
#undef MMA
#undef WAIT_V
#undef WAIT_L
#undef BAR
#undef SCHED
    {
        int lane_e = lane, wr_e = wr, wc_e = wc;
        asm volatile("" : "+v"(lane_e), "+s"(wr_e), "+s"(wc_e));
        epi(acc, wr_e, wc_e, lane_e);
    }
}

DEV void p0_transpose(const float* W, int K, int N, bf16_t* WT, int kt, int nt, int mode, const float* kscale, LAS float* scr, int tid) {
    {
        const int n4 = (tid & 15) * 4, kr = tid >> 4, n_in = nt * 64 + n4;
#pragma unroll
        for (int i = 0; i < 2; ++i) { const int kk = kr + 32 * i; const float s = kscale ? kscale[kt * 64 + kk] : 1.f;
            f32x4 v = (f32x4){0.f, 0.f, 0.f, 0.f};
            if (n_in < N) v = *(const f32x4*)(W + (size_t)(kt * 64 + kk) * N + n_in);
            scr[kk * 65 + n4] = s * v[0]; scr[kk * 65 + n4 + 1] = s * v[1]; scr[kk * 65 + n4 + 2] = s * v[2]; scr[kk * 65 + n4 + 3] = s * v[3]; }
    }
    __syncthreads();
    const int nl = tid >> 3, kcq = tid & 7, n = nt * 64 + nl;
    if (n < N) {
        int drow = n;
        if (mode == 1) { const int type = n >> 8, j = n & 255; drow = 128 * (j >> 6) + 64 * ((j >> 5) & 1) + 16 * (((j >> 4) & 1) + 2 * type) + (j & 15); }
        if (mode == 2) { const int h = n / 96, cc = n % 96; drow = cc < 64 ? 64 * h + cc : 256 + 32 * h + (cc - 64); }
        if (mode == 3) drow = (n & ~255) | (((n >> 5) & 1) << 7) | (((n >> 6) & 3) << 5) | (n & 31);
        unsigned o[4];
#pragma unroll
        for (int j = 0; j < 4; ++j) o[j] = pk2(scr[(kcq * 8 + 2 * j) * 65 + nl], scr[(kcq * 8 + 2 * j + 1) * 65 + nl]);
        *(u32x4*)(WT + (size_t)drow * K + kt * 64 + kcq * 8) = (u32x4){o[0], o[1], o[2], o[3]};
    }
    __syncthreads();
}
constexpr int T_IN = 16 * 35, T_OUT = 16 * 16, T_UP = 16 * 16 * 8, T_DN = 16 * 4 * 16, T_QB = 4 * 6, T_KVB = 2 * 8;
constexpr int T_LAYER = T_IN + T_OUT + T_UP + T_DN + T_QB + T_KVB;
constexpr int P0_TR = NL * T_LAYER, P0_WSG = 32, P0_MODV = NL * 192, P0_ROPE = 192, P0_PAD = 48;
constexpr int P0_ITEMS = P0_TR + P0_WSG + P0_MODV + P0_ROPE + P0_PAD;

DEV void p0_expert_item(const Ctx& c, int l, int item, LAS float* scr, int tid) {
    if (item < T_UP) { const int e = item / 128, q = item % 128;
        p0_transpose(c.in(I_WUP) + ((size_t)l * 16 + e) * 1024 * 512, 1024, 512, c.ws<bf16_t>(WS_WUP) + (size_t)e * 512 * 1024, q / 8, q % 8, 1, nullptr, scr, tid); }
    else { const int r = item - T_UP, e = r / 64, q = r % 64;
        p0_transpose(c.in(I_WDN) + ((size_t)l * 16 + e) * 256 * 1024, 256, 1024, c.ws<bf16_t>(WS_WDN) + (size_t)e * 1024 * 256, q / 16, q % 16, 0, nullptr, scr, tid); }
}
DEV void phase_p0(const Ctx& c) {
    const int tid = c.tid;
    LAS float* scr = (LAS float*)c.lds;
    for (int it = c.bid; it < P0_ITEMS; it += c.nb) {
        int r = it;
        if (r < P0_TR) {
            const int l = r / T_LAYER; r -= l * T_LAYER;
            if (r < T_IN) { p0_transpose(c.in(I_WIN) + (size_t)l * 1024 * INC, 1024, INC, c.ws<bf16_t>(WS_WIN) + (size_t)l * INCP * 1024, r / 35, r % 35, 0, nullptr, scr, tid); continue; } r -= T_IN;
            if (r < T_OUT) { p0_transpose(c.in(I_WOUT) + (size_t)l * 1024 * 1024, 1024, 1024, c.ws<bf16_t>(WS_WOUT) + (size_t)l * 1024 * 1024, r / 16, r % 16, 3, nullptr, scr, tid); continue; } r -= T_OUT;
            if (r < T_UP) { if (l == 0) p0_expert_item(c, 0, r, scr, tid); continue; } r -= T_UP;
            if (r < T_DN) { if (l == 0) p0_expert_item(c, 0, T_UP + r, scr, tid); continue; } r -= T_DN;
            if (r < T_QB) { p0_transpose(c.in(I_WQB) + (size_t)l * 256 * 384, 256, 384, c.ws<bf16_t>(WS_WQB) + (size_t)l * 384 * 256, r / 6, r % 6, 2, c.in(I_QAG) + l * 256, scr, tid); continue; } r -= T_QB;
            p0_transpose(c.in(I_WKVB) + (size_t)l * 128 * 512, 128, 512, c.ws<bf16_t>(WS_WKVB) + (size_t)l * 512 * 128, r / 8, r % 8, 0, c.in(I_KVAG) + l * 128, scr, tid); continue;
        }
        r -= P0_TR;
        if (r < P0_WSG) {
            const size_t e0 = ((size_t)r * NTHREADS + tid) * 8; const float* s = c.in(I_SGUW) + e0;
            const f32x4 a = *(const f32x4*)s, b = *(const f32x4*)(s + 4);
            *(u32x4*)(c.ws<bf16_t>(WS_WSG) + e0) = (u32x4){pk2(a[0], a[1]), pk2(a[2], a[3]), pk2(b[0], b[1]), pk2(b[2], b[3])};
            continue;
        }
        r -= P0_WSG;
        if (r < P0_MODV) {
            const int l = r / 192, n0 = (r % 192) * 32;
            LAS float* sc = scr;
            LAS float* red = scr + 9 * 1024;
            __syncthreads();
            for (int i = tid; i < 9 * 1024; i += NTHREADS) { const int mb = i >> 10, k = i & 1023; sc[i] = silu_f(mb < 8 ? c.in(I_C)[mb * 1024 + k] : c.in(I_CCTX)[k]); }
            __syncthreads();
            const int kq = tid >> 3, nl = tid & 7;
            float a[9][4];
#pragma unroll
            for (int j = 0; j < 9; ++j) { a[j][0] = 0.f; a[j][1] = 0.f; a[j][2] = 0.f; a[j][3] = 0.f; }
            const float* wp = c.in(I_WMOD) + (size_t)l * 1024 * 6144 + n0 + 4 * nl;
#pragma unroll 8
            for (int k2 = 0; k2 < 16; ++k2) { const int k = kq * 16 + k2; const f32x4 w = *(const f32x4*)(wp + (size_t)k * 6144);
#pragma unroll
                for (int j = 0; j < 9; ++j) { const float s = sc[j * 1024 + k]; a[j][0] += s * w[0]; a[j][1] += s * w[1]; a[j][2] += s * w[2]; a[j][3] += s * w[3]; } }
#pragma unroll
            for (int j = 0; j < 9; ++j)
#pragma unroll
                for (int q = 0; q < 4; ++q) { float v = a[j][q]; v += xlane<8>(v); v += xlane<16>(v); v += xlane<32>(v); a[j][q] = v; }
            if ((tid & 63) < 8) {
#pragma unroll
                for (int j = 0; j < 9; ++j)
#pragma unroll
                    for (int q = 0; q < 4; ++q) red[((tid >> 6) * 9 + j) * 32 + 4 * nl + q] = a[j][q];
            }
            __syncthreads();
            for (int i = tid; i < 9 * 32; i += NTHREADS) { const int mb = i >> 5, n = i & 31;
                float v = 0.f;
#pragma unroll
                for (int w = 0; w < NW; ++w) v += red[(w * 9 + mb) * 32 + n];
                c.ws<float>(WS_MODV)[(size_t)(l * 9 + mb) * 6144 + n0 + n] = v + c.in(I_BMOD)[l * 6144 + n0 + n]; }
            __syncthreads();
            continue;
        }
        r -= P0_MODV;
        if (r < P0_ROPE) {
            const int idx = r * NTHREADS + tid;
            if (idx < 2048 * 32) { const int s = idx >> 5, i = idx & 31, f = i & 15; const float pos = (float)((i < 16) ? (s >> 6) : (s & 63));
                const float inv = powf(10000.f, -(float)f / 16.f), ang = pos * inv;
                c.ws<float>(WS_ROPEC)[idx] = cosf(ang); c.ws<float>(WS_ROPEC)[2048 * 32 + idx] = sinf(ang); }
            else { const int j = idx - 2048 * 32, s = j >> 4, i = j & 15, f = i & 7; const float pos = (float)((i < 8) ? (s >> 6) : (s & 63));
                const float inv = powf(10000.f, -(float)f / 8.f), ang = pos * inv;
                c.ws<float>(WS_ROPED)[j] = cosf(ang); c.ws<float>(WS_ROPED)[2048 * 16 + j] = sinf(ang); }
            continue;
        }
        r -= P0_ROPE;
        {
            const int e = (r * NTHREADS + tid) * 8, l = e / (96 * 1024), o = e % (96 * 1024);
            unsigned z = 0u; asm volatile("" : "+v"(z));
            *(u32x4*)(c.ws<bf16_t>(WS_WIN) + ((size_t)l * INCP + INC) * 1024 + o) = (u32x4){z, z, z, z};
        }
    }
}

constexpr int A_RW_ITEMS = NL * 9 * 1024 / NTHREADS;
constexpr int A_RC_ITEMS = NL * 9 * 20 / NW;
DEV void phase_a(const Ctx& c) {
    const int tid = c.tid, lane = tid & 63, wave = tid >> 6;
    const float* g = c.in(I_GATTN) + c.layer * 1024;
    bf16_t* H = c.ws<bf16_t>(WS_ACT);
    const int nwv = c.nb * NW, per = (NTOK + nwv - 1) / nwv, tbeg = (c.bid * NW + wave) * per, tend = min(tbeg + per, NTOK);
    int mbc = -1; f32x4 gm[4], sv[4];
#pragma unroll 1
    for (int t0 = tbeg; t0 < tend; t0 += 3) {
        f32x4 v[3][4];
#pragma unroll
        for (int u = 0; u < 3; ++u) { const int tok = min(t0 + u, tend - 1);
#pragma unroll
            for (int i = 0; i < 4; ++i) v[u][i] = c.xload4(tok, i * 256 + lane * 4); }
#pragma unroll
        for (int u = 0; u < 3; ++u) { const int tok = t0 + u;
            if (tok < tend) {
                const int mb = tok < NLAT ? (tok >> 11) : 8;
                if (mb != mbc) { mbc = mb; const float* sh = c.modv(mb, 0); const float* scl = c.modv(mb, 1);
#pragma unroll
                    for (int i = 0; i < 4; ++i) { const int e = i * 256 + lane * 4; const f32x4 gg = *(const f32x4*)(g + e), s1 = *(const f32x4*)(scl + e);
                        gm[i] = (f32x4){gg[0] * (1.f + s1[0]), gg[1] * (1.f + s1[1]), gg[2] * (1.f + s1[2]), gg[3] * (1.f + s1[3])}; sv[i] = *(const f32x4*)(sh + e); } }
                float ss = 0.f;
#pragma unroll
                for (int i = 0; i < 4; ++i) ss += v[u][i][0] * v[u][i][0] + v[u][i][1] * v[u][i][1] + v[u][i][2] * v[u][i][2] + v[u][i][3] * v[u][i][3];
                const float r = rsqrtf(wave_sum(ss) * (1.f / 1024.f) + EPS);
#pragma unroll
                for (int i = 0; i < 4; ++i) { const int e = i * 256 + lane * 4;
                    float o[4];
#pragma unroll
                    for (int j = 0; j < 4; ++j) o[j] = v[u][i][j] * r * gm[i][j] + sv[i][j];
                    *(u32x2*)(H + (size_t)tok * 1024 + e) = (u32x2){pk2(o[0], o[1]), pk2(o[2], o[3])}; }
            } }
    }
    if (c.layer == 0) {
        for (int it = c.bid; it < A_RW_ITEMS + A_RC_ITEMS; it += c.nb) {
            if (it < A_RW_ITEMS) {
                const int idx = it * NTHREADS + tid, l = idx / (9 * 1024), mb = (idx >> 10) % 9, k = idx & 1023;
                const float* mv = c.ws<float>(WS_MODV) + (size_t)(l * 9 + mb) * 6144;
                const float gm = c.in(I_GFFN)[l * 1024 + k] * (1.f + mv[4 * 1024 + k]);
                c.ws<float>(WS_GM)[idx] = gm;
                bf16_t* o = c.ws<bf16_t>(WS_RW) + (size_t)(l * 9 + mb) * 2 * 32 * 1024 + k;
                const float* wg = c.in(I_WRG) + ((size_t)l * 1024 + k) * 4; const float* we = c.in(I_WRE) + ((size_t)l * 1024 + k) * 16;
#pragma unroll
                for (int j = 0; j < 32; ++j) { const float w = j < 20 ? gm * (j < 4 ? wg[j] : we[j - 4]) : 0.f;
                    const bf16_t hi = f2bf(w); o[(size_t)j * 1024] = hi; o[(size_t)(32 + j) * 1024] = f2bf(w - bf2f(hi)); }
            } else {
                const int idx = (it - A_RW_ITEMS) * NW + wave, l = idx / 180, mb = (idx / 20) % 9, j = idx % 20;
                const float* mv = c.ws<float>(WS_MODV) + (size_t)(l * 9 + mb) * 6144 + 3 * 1024;
                float a = 0.f;
                for (int k = lane; k < 1024; k += 64) { const float w = (j < 4) ? c.in(I_WRG)[((size_t)l * 1024 + k) * 4 + j] : c.in(I_WRE)[((size_t)l * 1024 + k) * 16 + (j - 4)]; a += mv[k] * w; }
                a = wave_sum(a);
                if (lane == 0) c.ws<float>(WS_RC)[(l * 9 + mb) * 32 + j] = a + ((j < 4) ? c.in(I_BRG)[l * 4 + j] : c.in(I_BRE)[l * 16 + j - 4]);
            }
        }
    }
}

DEV void rope2(float& a, float& b, float cs, float sn) { const float x0 = a, x1 = b; a = x0 * cs - x1 * sn; b = x0 * sn + x1 * cs; }
DEV float red_q(float v) { v += xlane<16>(v); v += xlane<32>(v); return v; }
template <int MF>
DEV void b_epilogue(const Ctx& c, const f32x4 (&acc)[4][MF], int m0, int mb, int nbase, int lane) {
    const int l = c.layer;
    bf16_t* P = c.ws<bf16_t>(WS_P);
    const int q = lane >> 4, li = lane & 15;
    const bool isctx = m0 >= NLAT;
    if (nbase < 256) {
#pragma unroll
        for (int mf = 0; mf < MF; ++mf) { const int m = m0 + mb + 16 * mf + li;
#pragma unroll
            for (int nf = 0; nf < 4; ++nf) { const f32x4 a = acc[nf][mf];
                *(u32x2*)(P + (size_t)m * INC + nbase + 16 * nf + 4 * q) = (u32x2){pk2(gelu_fast(a[0]), gelu_fast(a[1])), pk2(gelu_fast(a[2]), gelu_fast(a[3]))}; } }
    } else if (nbase < 512) {
        const float* vg = c.in(I_SGUVG) + l * 256 + (nbase - 256) + 4 * q;
#pragma unroll
        for (int mf = 0; mf < MF; ++mf) { const int m = m0 + mb + 16 * mf + li;
            float v[4][4]; float ss = 0.f;
#pragma unroll
            for (int nf = 0; nf < 4; ++nf)
#pragma unroll
                for (int r = 0; r < 4; ++r) { v[nf][r] = gelu_fast(acc[nf][mf][r]); ss += v[nf][r] * v[nf][r]; }
            const float rr = rsqrtf(red_q(ss) * (1.f / 64.f) + EPS);
#pragma unroll
            for (int nf = 0; nf < 4; ++nf) { const f32x4 gg = *(const f32x4*)(vg + 16 * nf);
                *(u32x2*)(P + (size_t)m * INC + nbase + 16 * nf + 4 * q) = (u32x2){pk2(v[nf][0] * rr * gg[0], v[nf][1] * rr * gg[1]), pk2(v[nf][2] * rr * gg[2], v[nf][3] * rr * gg[3])}; } }
    } else if (nbase < OFF_CQ || (nbase >= OFF_DCQ && nbase < OFF_DKR)) {
        const bool need_ss = nbase >= OFF_DCQ;
        const int sidx = nbase < OFF_DCKV ? (nbase - OFF_DCQ) >> 6 : 4 + ((nbase - OFF_DCKV) >> 6);
#pragma unroll
        for (int mf = 0; mf < MF; ++mf) { const int m = m0 + mb + 16 * mf + li; float ss = 0.f;
#pragma unroll
            for (int nf = 0; nf < 4; ++nf) { const f32x4 a = acc[nf][mf]; ss += a[0] * a[0] + a[1] * a[1] + a[2] * a[2] + a[3] * a[3];
                *(u32x2*)(P + (size_t)m * INC + nbase + 16 * nf + 4 * q) = (u32x2){pk2(a[0], a[1]), pk2(a[2], a[3])}; }
            if (need_ss) { ss = red_q(ss); if (q == 0) c.ws<float>(WS_SSQ)[(size_t)m * 8 + sidx] = ss; } }
    } else if (nbase < OFF_CV) {
        const bool isq = nbase < OFF_CK;
        const int h = isq ? (nbase - OFF_CQ) >> 6 : (nbase - OFF_CK) >> 6;
        const float* gn = (isq ? c.in(I_GQAQG) : c.in(I_GQAKG)) + l * 64 + 4 * q;
        const float sc = isq ? C_SCALE * LOG2E : 1.f;
        const float* cosC = c.ws<float>(WS_ROPEC); const float* sinC = cosC + 2048 * 32;
#pragma unroll
        for (int mf = 0; mf < MF; ++mf) { const int m = m0 + mb + 16 * mf + li;
            int b, pos, key; bool ic; tok_info(m, b, pos, key, ic);
            float ss = 0.f;
#pragma unroll
            for (int nf = 0; nf < 4; ++nf) { const f32x4 a = acc[nf][mf]; ss += a[0] * a[0] + a[1] * a[1] + a[2] * a[2] + a[3] * a[3]; }
            const float rr = rsqrtf(red_q(ss) * (1.f / 64.f) + EPS);
            bf16_t* dst = isq ? c.ws<bf16_t>(WS_QC) + ((size_t)(b * 4 + h) * KEYS + key) * 64 : c.ws<bf16_t>(WS_KC) + ((size_t)(b * 2 + h) * KEYS + key) * 64;
#pragma unroll
            for (int nf = 0; nf < 4; ++nf) { const f32x4 gg = *(const f32x4*)(gn + 16 * nf); const f32x4 a = acc[nf][mf];
                float v0 = a[0] * rr * gg[0], v1 = a[1] * rr * gg[1], v2 = a[2] * rr * gg[2], v3 = a[3] * rr * gg[3];
                if (!isctx) { const f32x2 cs = *(const f32x2*)(cosC + pos * 32 + 8 * nf + 2 * q), sn = *(const f32x2*)(sinC + pos * 32 + 8 * nf + 2 * q);
                    rope2(v0, v1, cs[0], sn[0]); rope2(v2, v3, cs[1], sn[1]); }
                *(u32x2*)(dst + 16 * nf + 4 * q) = (u32x2){pk2(v0 * sc, v1 * sc), pk2(v2 * sc, v3 * sc)}; } }
    } else if (nbase < OFF_DCQ) {
        const int kvh = (nbase - OFF_CV) >> 6;
#pragma unroll
        for (int mf = 0; mf < MF; ++mf) { const int m = m0 + mb + 16 * mf + li;
            int b, pos, key; bool ic; tok_info(m, b, pos, key, ic);
            bf16_t* dst = c.ws<bf16_t>(WS_VCT) + ((size_t)(b * 2 + kvh) * 64 + 4 * q) * KEYS + key;
#pragma unroll
            for (int nf = 0; nf < 4; ++nf) { const f32x4 a = acc[nf][mf]; const unsigned p0 = pk2(a[0], a[1]), p1 = pk2(a[2], a[3]);
                bf16_t* d = dst + (size_t)(16 * nf) * KEYS;
                d[0] = (bf16_t)(p0 & 0xffffu); d[KEYS] = (bf16_t)(p0 >> 16); d[2 * KEYS] = (bf16_t)(p1 & 0xffffu); d[3 * KEYS] = (bf16_t)(p1 >> 16); } }
    } else if (nbase < OFF_DKR + 64) {
        const float* gn = c.in(I_MLAKG) + l * 96 + 64 + 4 * q;
        const float* cosD = c.ws<float>(WS_ROPED); const float* sinD = cosD + 2048 * 16;
#pragma unroll
        for (int mf = 0; mf < MF; ++mf) { const int m = m0 + mb + 16 * mf + li;
            int b, pos, key; bool ic; tok_info(m, b, pos, key, ic);
            float ss = 0.f;
#pragma unroll
            for (int nf = 0; nf < 2; ++nf) { const f32x4 a = acc[nf][mf]; ss += a[0] * a[0] + a[1] * a[1] + a[2] * a[2] + a[3] * a[3]; }
            const float rr = rsqrtf(red_q(ss) * (1.f / 32.f) + EPS);
#pragma unroll
            for (int nf = 0; nf < 2; ++nf) { const f32x4 gg = *(const f32x4*)(gn + 16 * nf); const f32x4 a = acc[nf][mf];
                float v0 = a[0] * rr * gg[0], v1 = a[1] * rr * gg[1], v2 = a[2] * rr * gg[2], v3 = a[3] * rr * gg[3];
                if (!isctx) { const f32x2 cs = *(const f32x2*)(cosD + pos * 16 + 8 * nf + 2 * q), sn = *(const f32x2*)(sinD + pos * 16 + 8 * nf + 2 * q);
                    rope2(v0, v1, cs[0], sn[0]); rope2(v2, v3, cs[1], sn[1]); }
                const u32x2 o = (u32x2){pk2(v0, v1), pk2(v2, v3)};
#pragma unroll
                for (int h = 0; h < 4; ++h) *(u32x2*)(c.ws<bf16_t>(WS_KD) + ((size_t)(b * 4 + h) * KEYS + key) * 96 + 64 + 16 * nf + 4 * q) = o; } }
    }
}
DEV void phase_b(const Ctx& c) {
    const int l = c.layer;
    GemmDesc g; g.A = c.ws<bf16_t>(WS_ACT); g.lda = 1024; g.rowidx = nullptr; g.nvalid = 0;
    g.B0 = c.ws<bf16_t>(WS_WIN) + (size_t)l * INCP * 1024; g.B1 = g.B0; g.ldb = 1024; g.ksplit = 1 << 30; g.K = 1024;
    constexpr int NT_N = INCP / 256, NT_M = NTOK / 256;
    auto full_tile = [&](int mt, int nt) { const int m0 = mt * 256;
        gemm_tile<4, 8>(g, m0, nt * 256, c.lds, c.tid, [&](const f32x4 (&acc)[4][8], int mb, int nbase, int lane) { b_epilogue<8>(c, acc, m0, mb, nbase, lane); }); };
    if (c.nb != 256) { for (int t = c.bid; t < NT_M * NT_N; t += c.nb) full_tile(t / NT_N, t % NT_N); }
    else if (l < NL - 1) {
        const int nmine = c.bid < 136 ? 3 : 2;
        for (int rd = 0; rd < nmine; ++rd) {
            int mt, nt, ex = -1, ch = -1;
            if (c.bid >= 136) ex = (c.bid - 136) + 120 * rd;
            else if (rd == 0) { if (c.bid < 48) ex = 240 + c.bid; else ch = c.bid - 48; }
            else ch = 88 + 136 * (rd - 1) + c.bid;
            if (ex >= 0) { const int k = ex / 72; nt = k == 0 ? 5 : (k == 1 ? 6 : (k == 2 ? 1 : 0)); mt = ex % 72; }
            else { const int k = ch / 72; nt = k < 3 ? 2 + k : 4 + k; mt = ch % 72; }
            full_tile(mt, nt);
        }
    } else {
        auto unit = [&](int u, int& mt, int& nt) {
            if (u < 256) { const int k = u >> 6; nt = k == 0 ? 5 : (k == 1 ? 6 : (k == 2 ? 1 : 0)); mt = u & 63; }
            else if (u < 576) { const int v = u - 256, k = v >> 6; nt = k < 3 ? 2 + k : 4 + k; mt = v & 63; }
            else { const int v = u - 576; nt = (v >> 3) ? 8 : 6; mt = 64 + (v & 7); } };
        for (int rd = 0; rd < 2; ++rd) { int mt, nt; unit(c.bid + 256 * rd, mt, nt); full_tile(mt, nt); }
        if (c.bid < 160) { int mt, nt; unit(512 + (c.bid >> 1), mt, nt); const int m0 = mt * 256;
            gemm_tile<2, 4>(g, m0, nt * 256 + (c.bid & 1) * 128, c.lds, c.tid, [&](const f32x4 (&acc)[4][4], int mb, int nbase, int lane) { b_epilogue<4>(c, acc, m0, mb, nbase, lane); }); }
    }
    if (l > 0) {
        for (int e = c.bid; e < T_UP + T_DN; e += c.nb) p0_expert_item(c, l, e, (LAS float*)c.lds, c.tid);
    }
}

constexpr int C_SGU_ITEMS = (NTOK / 128) * 4, C_TQ = (NTOK / 256) * 3, C_TKV = (NTOK / 256) * 4;
constexpr int SG_LD = 272;
DEV void phase_c_sgu(const Ctx& c, int item) {
    const int tid = c.tid, lane = tid & 63, wave = tid >> 6, l = c.layer;
    const int chunk = item >> 2, h = item & 3, tok0 = chunk * 128;
    const bf16_t* P = c.ws<bf16_t>(WS_P);
    LAS char* Wt = c.lds;
    LAS char* vT = c.lds + 128 * SG_LD;
    __syncthreads();
    {
        const bf16_t* Wsrc = c.ws<bf16_t>(WS_WSG) + (size_t)(l * 4 + h) * 128 * 128;
#pragma unroll
        for (int i = 0; i < 4; ++i) { const int ci = tid + NTHREADS * i, r = ci >> 4, kc = ci & 15; *(LAS u32x4*)(Wt + r * SG_LD + kc * 16) = *(const u32x4*)(Wsrc + r * 128 + kc * 8); }
        const int j = tid >> 2, qt = tid & 3;
        const bf16_t* vp = P + (size_t)(tok0 + j) * INC + OFF_AV + 64 * h + 16 * qt;
#pragma unroll
        for (int q = 0; q < 2; ++q) { const u32x4 raw = *(const u32x4*)(vp + 8 * q);
#pragma unroll
            for (int e = 0; e < 4; ++e) { LAS char* d = vT + (16 * qt + 8 * q + 2 * e) * SG_LD + j * 2;
                *(LAS bf16_t*)d = (bf16_t)(raw[e] & 0xffffu); *(LAS bf16_t*)(d + SG_LD) = (bf16_t)(raw[e] >> 16); } }
    }
    __syncthreads();
    f32x4 acc[4];
#pragma unroll
    for (int a = 0; a < 4; ++a) acc[a] = (f32x4){0.f, 0.f, 0.f, 0.f};
    const int q = lane >> 4, li = lane & 15;
#pragma unroll
    for (int ks = 0; ks < 4; ++ks) {
        bf16x8 af[4];
#pragma unroll
        for (int df = 0; df < 4; ++df) af[df] = lds_r128(vT + (16 * df + li) * SG_LD + (4 * ks + q) * 16);
        const bf16x8 bfr = lds_r128(Wt + (16 * wave + li) * SG_LD + (4 * ks + q) * 16);
#pragma unroll
        for (int df = 0; df < 4; ++df) acc[df] = __builtin_amdgcn_mfma_f32_16x16x32_bf16(af[df], bfr, acc[df], 0, 0, 0);
    }
    bf16_t* Y = c.ws<bf16_t>(WS_ACT);
    {
        const int i = 16 * wave + li, tok = tok0 + i;
        const float bs = c.in(I_SGUB)[(l * 4 + h) * 128 + i];
#pragma unroll
        for (int df = 0; df < 4; ++df) {
            const int d0 = 16 * df + 4 * q;
            const u32x2 ur = *(const u32x2*)(P + (size_t)tok * INC + OFF_AU + 64 * h + d0);
            const f32x4 a = acc[df];
            *(u32x2*)(Y + (size_t)tok * 1024 + 64 * h + d0) = (u32x2){pk2(bflo(ur[0]) * (a[0] + bs), bfhi(ur[0]) * (a[1] + bs)), pk2(bflo(ur[1]) * (a[2] + bs), bfhi(ur[1]) * (a[3] + bs))};
        }
    }
}
DEV void phase_c(const Ctx& c) {
    const int l = c.layer;
    const bf16_t* P = c.ws<bf16_t>(WS_P);
    const float* cosD = c.ws<float>(WS_ROPED); const float* sinD = cosD + 2048 * 16;
    int it = c.bid;
    const bool lastl = (l == NL - 1);
    for (; it < C_SGU_ITEMS; it += c.nb) { if (!(lastl && (it >> 2) >= NLAT / 128)) phase_c_sgu(c, it); }
    for (; it < C_SGU_ITEMS + C_TQ; it += c.nb) {
        const int t = it - C_SGU_ITEMS, mt = t / 3, nt = t % 3, m0 = mt * 256;
        if (lastl && m0 >= NLAT) continue;
        GemmDesc g; g.rowidx = nullptr; g.nvalid = 0; g.ksplit = 1 << 30; g.lda = INC;
        g.A = P + OFF_DCQ; g.K = 256; g.B0 = c.ws<bf16_t>(WS_WQB) + (size_t)l * 384 * 256; g.B1 = g.B0; g.ldb = 256;
        gemm_tile<2, 4>(g, m0, nt * 128, c.lds, c.tid, [&](const f32x4 (&acc)[4][4], int mb, int nbase, int lane) {
            const int q = lane >> 4, li = lane & 15, wn = (nbase >> 6) & 1;
            const bool isctx = m0 >= NLAT;
            const float* qg = c.in(I_MLAQG) + l * 96;
            const float sc = D_SCALE * LOG2E;
#pragma unroll
            for (int mf = 0; mf < 4; ++mf) { const int m = m0 + mb + 16 * mf + li;
                int b, pos, key; bool ic; tok_info(m, b, pos, key, ic);
                const f32x4 s4 = *(const f32x4*)(c.ws<float>(WS_SSQ) + (size_t)m * 8);
                const float r0 = rsqrtf((s4[0] + s4[1] + s4[2] + s4[3]) * (1.f / 256.f) + EPS);
                if (nt < 2) {
                    const int h = 2 * nt + wn; float ss = 0.f;
#pragma unroll
                    for (int nf = 0; nf < 4; ++nf) { const f32x4 a = acc[nf][mf] * r0; ss += a[0] * a[0] + a[1] * a[1] + a[2] * a[2] + a[3] * a[3]; }
                    const float rr = rsqrtf(red_q(ss) * (1.f / 64.f) + EPS) * r0 * sc;
                    bf16_t* dst = c.ws<bf16_t>(WS_QD) + ((size_t)(b * 4 + h) * KEYS + key) * 96 + 4 * q;
#pragma unroll
                    for (int nf = 0; nf < 4; ++nf) { const f32x4 gg = *(const f32x4*)(qg + 16 * nf + 4 * q); const f32x4 a = acc[nf][mf];
                        *(u32x2*)(dst + 16 * nf) = (u32x2){pk2(a[0] * rr * gg[0], a[1] * rr * gg[1]), pk2(a[2] * rr * gg[2], a[3] * rr * gg[3])}; }
                } else {
#pragma unroll
                    for (int hh = 0; hh < 2; ++hh) { const int h = 2 * wn + hh; float ss = 0.f;
#pragma unroll
                        for (int n2 = 0; n2 < 2; ++n2) { const f32x4 a = acc[2 * hh + n2][mf] * r0; ss += a[0] * a[0] + a[1] * a[1] + a[2] * a[2] + a[3] * a[3]; }
                        const float rr = rsqrtf(red_q(ss) * (1.f / 32.f) + EPS) * r0;
                        bf16_t* dst = c.ws<bf16_t>(WS_QD) + ((size_t)(b * 4 + h) * KEYS + key) * 96 + 64 + 4 * q;
#pragma unroll
                        for (int n2 = 0; n2 < 2; ++n2) { const f32x4 gg = *(const f32x4*)(qg + 64 + 16 * n2 + 4 * q); const f32x4 a = acc[2 * hh + n2][mf];
                            float v0 = a[0] * rr * gg[0], v1 = a[1] * rr * gg[1], v2 = a[2] * rr * gg[2], v3 = a[3] * rr * gg[3];
                            if (!isctx) { const f32x2 cs = *(const f32x2*)(cosD + pos * 16 + 8 * n2 + 2 * q), sn = *(const f32x2*)(sinD + pos * 16 + 8 * n2 + 2 * q);
                                rope2(v0, v1, cs[0], sn[0]); rope2(v2, v3, cs[1], sn[1]); }
                            *(u32x2*)(dst + 16 * n2) = (u32x2){pk2(v0 * sc, v1 * sc), pk2(v2 * sc, v3 * sc)}; } }
                }
            }
        });
    }
    for (; it < C_SGU_ITEMS + C_TQ + C_TKV; it += c.nb) {
        const int t = it - C_SGU_ITEMS - C_TQ, mt = t >> 2, h = t & 3, m0 = mt * 256;
        GemmDesc g; g.rowidx = nullptr; g.nvalid = 0; g.ksplit = 1 << 30; g.lda = INC;
        g.A = P + OFF_DCKV; g.K = 128; g.B0 = c.ws<bf16_t>(WS_WKVB) + (size_t)l * 512 * 128; g.B1 = g.B0; g.ldb = 128;
        gemm_tile<2, 4>(g, m0, h * 128, c.lds, c.tid, [&](const f32x4 (&acc)[4][4], int mb, int nbase, int lane) {
            const int q = lane >> 4, li = lane & 15, wn = (nbase >> 6) & 1;
            const float* kg = c.in(I_MLAKG) + l * 96;
#pragma unroll
            for (int mf = 0; mf < 4; ++mf) { const int m = m0 + mb + 16 * mf + li;
                int b, pos, key; bool ic; tok_info(m, b, pos, key, ic);
                const float* sp = c.ws<float>(WS_SSQ) + (size_t)m * 8;
                const float r0 = rsqrtf((sp[4] + sp[5]) * (1.f / 128.f) + EPS);
                if (wn == 0) {
                    float ss = 0.f;
#pragma unroll
                    for (int nf = 0; nf < 4; ++nf) { const f32x4 a = acc[nf][mf] * r0; ss += a[0] * a[0] + a[1] * a[1] + a[2] * a[2] + a[3] * a[3]; }
                    const float rr = rsqrtf(red_q(ss) * (1.f / 64.f) + EPS) * r0;
                    bf16_t* dst = c.ws<bf16_t>(WS_KD) + ((size_t)(b * 4 + h) * KEYS + key) * 96 + 4 * q;
#pragma unroll
                    for (int nf = 0; nf < 4; ++nf) { const f32x4 gg = *(const f32x4*)(kg + 16 * nf + 4 * q); const f32x4 a = acc[nf][mf];
                        *(u32x2*)(dst + 16 * nf) = (u32x2){pk2(a[0] * rr * gg[0], a[1] * rr * gg[1]), pk2(a[2] * rr * gg[2], a[3] * rr * gg[3])}; }
                } else {
                    bf16_t* dst = c.ws<bf16_t>(WS_VDT) + ((size_t)(b * 4 + h) * 64 + 4 * q) * KEYS + key;
#pragma unroll
                    for (int nf = 0; nf < 4; ++nf) { const f32x4 a = acc[nf][mf] * r0; const unsigned p0 = pk2(a[0], a[1]), p1 = pk2(a[2], a[3]);
                        bf16_t* d = dst + (size_t)(16 * nf) * KEYS;
                        d[0] = (bf16_t)(p0 & 0xffffu); d[KEYS] = (bf16_t)(p0 >> 16); d[2 * KEYS] = (bf16_t)(p1 & 0xffffu); d[3 * KEYS] = (bf16_t)(p1 >> 16); }
                }
            }
        });
    }
}

constexpr int AT_KN = 0, AT_KR = 8192, AT_V = 12288, AT_STAGE = 21504, AT_VLD = 136;
template <int DK>
DEV void attn_item(const bf16_t* Q, const bf16_t* K, const bf16_t* Vt, int nkeys, bf16_t* Yrow, LAS char* lds, int tid, float mref) {
    const int lane = tid & 63, wave = tid >> 6, li = lane & 15, g = lane >> 4;
    constexpr int NKS = DK / 32;
    bf16x8 qf[2][NKS];
#pragma unroll
    for (int qb = 0; qb < 2; ++qb)
#pragma unroll
        for (int ks = 0; ks < NKS; ++ks) qf[qb][ks] = *(const bf16x8*)(Q + (size_t)(32 * wave + 16 * qb + li) * DK + 32 * ks + 8 * g);
    f32x4 oacc[4][2];
#pragma unroll
    for (int db = 0; db < 4; ++db) { oacc[db][0] = (f32x4){0.f, 0.f, 0.f, 0.f}; oacc[db][1] = oacc[db][0]; }
    float lsum[2] = {0.f, 0.f};
    const int kr_ = tid >> 3, kc_ = tid & 7;
    const int rr_ = (tid >> 2) & 63, rc_ = tid & 3;
    u32x4 rk, rv, rrp;
    const int nt = nkeys / 64;
    auto gload = [&](int t) {
        const int k0 = t * 64;
        rk = *(const u32x4*)(K + (size_t)(k0 + kr_) * DK + kc_ * 8); rv = *(const u32x4*)(Vt + (size_t)kr_ * KEYS + k0 + kc_ * 8);
        if (DK == 96 && tid < 256) rrp = *(const u32x4*)(K + (size_t)(k0 + rr_) * DK + 64 + rc_ * 8);
    };
    auto lstore = [&](int st) {
        LAS char* base = lds + st * AT_STAGE;
        { const int r = kr_;
            *(LAS u32x4*)(base + AT_KN + r * 128 + ((kc_ ^ ((r >> 1) & 7)) << 4)) = rk;
            LAS char* vd = base + AT_V + r * AT_VLD + kc_ * 16;
            *(LAS u32x2*)vd = (u32x2){rv[0], rv[1]}; *(LAS u32x2*)(vd + 8) = (u32x2){rv[2], rv[3]}; }
        if (DK == 96 && tid < 256) *(LAS u32x4*)(base + AT_KR + rr_ * 64 + ((rc_ ^ ((0 - (rr_ >> 2)) & 3)) << 4)) = rrp;
    };
    __syncthreads();
    gload(0); lstore(0);
    __syncthreads();
    for (int t = 0; t < nt; ++t) {
        const int cur = t & 1;
        if (t + 1 < nt) gload(t + 1);
        LAS const char* base = lds + cur * AT_STAGE;
        f32x4 sacc[4][2];
        {
            bf16x8 kf[4][NKS];
#pragma unroll
            for (int kb = 0; kb < 4; ++kb) {
                const int row = 16 * kb + li;
#pragma unroll
                for (int ks = 0; ks < 2; ++ks) kf[kb][ks] = lds_r128(base + AT_KN + row * 128 + (((4 * ks + g) ^ ((row >> 1) & 7)) << 4));
                if (DK == 96) kf[kb][NKS - 1] = lds_r128(base + AT_KR + row * 64 + ((g ^ ((0 - (row >> 2)) & 3)) << 4));
            }
            __builtin_amdgcn_sched_barrier(0);
#pragma unroll
            for (int kb = 0; kb < 4; ++kb)
#pragma unroll
                for (int qb = 0; qb < 2; ++qb) {
                    sacc[kb][qb] = (f32x4){-mref, -mref, -mref, -mref};
#pragma unroll
                    for (int ks = 0; ks < NKS; ++ks) sacc[kb][qb] = __builtin_amdgcn_mfma_f32_16x16x32_bf16(kf[kb][ks], qf[qb][ks], sacc[kb][qb], 0, 0, 0);
                }
        }
        bf16x8 vfr[4][2];
#pragma unroll
        for (int db = 0; db < 4; ++db)
#pragma unroll
            for (int kp = 0; kp < 2; ++kp) {
                LAS const char* vp = base + AT_V + (16 * db + li) * AT_VLD + (32 * kp + 4 * g) * 2;
                const u32x2 lo = *(LAS const u32x2*)vp, hi = *(LAS const u32x2*)(vp + 32);
                vfr[db][kp] = __builtin_bit_cast(bf16x8, (u32x4){lo[0], lo[1], hi[0], hi[1]});
            }
        __builtin_amdgcn_sched_barrier(0);
        bf16x8 pf[2][2];
#pragma unroll
        for (int qb = 0; qb < 2; ++qb) {
            float ps = 0.f;
#pragma unroll
            for (int kb = 0; kb < 4; ++kb)
#pragma unroll
                for (int r = 0; r < 4; ++r) { const float p = __builtin_amdgcn_exp2f(sacc[kb][qb][r]); sacc[kb][qb][r] = p; ps += p; }
            lsum[qb] += ps;
#pragma unroll
            for (int kp = 0; kp < 2; ++kp) {
                const u32x4 w = (u32x4){pk2(sacc[2 * kp][qb][0], sacc[2 * kp][qb][1]), pk2(sacc[2 * kp][qb][2], sacc[2 * kp][qb][3]),
                                        pk2(sacc[2 * kp + 1][qb][0], sacc[2 * kp + 1][qb][1]), pk2(sacc[2 * kp + 1][qb][2], sacc[2 * kp + 1][qb][3])};
                pf[qb][kp] = __builtin_bit_cast(bf16x8, w);
            }
        }
#pragma unroll
        for (int db = 0; db < 4; ++db)
#pragma unroll
            for (int kp = 0; kp < 2; ++kp) {
#pragma unroll
                for (int qb = 0; qb < 2; ++qb) oacc[db][qb] = __builtin_amdgcn_mfma_f32_16x16x32_bf16(vfr[db][kp], pf[qb][kp], oacc[db][qb], 0, 0, 0);
            }
        if (t + 1 < nt) lstore(cur ^ 1);
        __syncthreads();
    }
#pragma unroll
    for (int qb = 0; qb < 2; ++qb) {
        float lt = lsum[qb]; lt += xlane<16>(lt); lt += xlane<32>(lt);
        const float inv = 1.f / lt;
        bf16_t* yr = Yrow + (size_t)(32 * wave + 16 * qb + li) * 1024 + 4 * g;
#pragma unroll
        for (int db = 0; db < 4; ++db) { const f32x4 o = oacc[db][qb];
            *(u32x2*)(yr + 16 * db) = (u32x2){pk2(o[0] * inv, o[1] * inv), pk2(o[2] * inv, o[3] * inv)}; }
    }
}
DEV void phase_d(const Ctx& c) {
    const int nlat = 512, nctx = (c.layer == NL - 1) ? 0 : 64;
    bf16_t* Y = c.ws<bf16_t>(WS_ACT);
    float mrefC, mrefD;
    {
        const int lane = c.tid & 63, l = c.layer;
        auto wmax = [](float v) { return wave_max(v); };
        const float gq = wmax(fabsf(c.in(I_GQAQG)[l * 64 + lane])), gk = wmax(fabsf(c.in(I_GQAKG)[l * 64 + lane]));
        mrefC = 64.f * gq * gk * C_SCALE * LOG2E - 40.f;
        const float* mq = c.in(I_MLAQG) + l * 96; const float* mk = c.in(I_MLAKG) + l * 96;
        const float qn = wmax(fabsf(mq[lane])), qr = wmax(fabsf(mq[64 + (lane & 31)])), kn = wmax(fabsf(mk[lane])), kr = wmax(fabsf(mk[64 + (lane & 31)]));
        mrefD = sqrtf((64.f * qn * qn + 32.f * qr * qr) * (64.f * kn * kn + 32.f * kr * kr)) * D_SCALE * LOG2E - 40.f;
    }
    for (int it = c.bid; it < nlat + nctx; it += c.nb) {
        int type, b, h, qpos0, nkeys, tok0;
        if (it < nlat) { type = it >> 8; const int r = it & 255; b = r >> 5; h = (r >> 3) & 3; const int qb = r & 7; qpos0 = CL + 256 * qb; nkeys = KEYS; tok0 = b * SEQ + 256 * qb; }
        else { const int u = it - nlat; type = u >> 5; const int r = u & 31; b = r >> 2; h = r & 3; qpos0 = 0; nkeys = CL; tok0 = NLAT + b * CL; }
        if (type == 0) {
            attn_item<96>(c.ws<bf16_t>(WS_QD) + ((size_t)(b * 4 + h) * KEYS + qpos0) * 96, c.ws<bf16_t>(WS_KD) + (size_t)(b * 4 + h) * KEYS * 96,
                          c.ws<bf16_t>(WS_VDT) + (size_t)(b * 4 + h) * 64 * KEYS, nkeys, Y + (size_t)tok0 * 1024 + 768 + 64 * h, c.lds, c.tid, mrefD);
        } else {
            attn_item<64>(c.ws<bf16_t>(WS_QC) + ((size_t)(b * 4 + h) * KEYS + qpos0) * 64, c.ws<bf16_t>(WS_KC) + (size_t)(b * 2 + (h >> 1)) * KEYS * 64,
                          c.ws<bf16_t>(WS_VCT) + (size_t)(b * 2 + (h >> 1)) * 64 * KEYS, nkeys, Y + (size_t)tok0 * 1024 + 512 + 64 * h, c.lds, c.tid, mrefC);
        }
    }
}

DEV void phase_e0(const Ctx& c) {
    const int tid = c.tid, lane = tid & 63, wave = tid >> 6, l = c.layer;
    bf16_t* Y = c.ws<bf16_t>(WS_ACT); const bf16_t* P = c.ws<bf16_t>(WS_P);
    const float* gg = c.in(I_GGO) + l * 1024;
    const int ntok = c.ntok_tail();
    const int ch = 4 * lane;
    const float* cw = c.in(I_CONVW) + l * 768 + ch;
    const f32x4 w0 = *(const f32x4*)cw, w1 = *(const f32x4*)(cw + 256), w2 = *(const f32x4*)(cw + 512);
    f32x4 gn[4];
#pragma unroll
    for (int g = 0; g < 4; ++g) gn[g] = *(const f32x4*)(gg + g * 256 + ch);
    const int nwv = c.nb * NW, per = (ntok + nwv - 1) / nwv, tbeg = (c.bid * NW + wave) * per, tend = min(tbeg + per, ntok);
#pragma unroll 1
    for (int t0 = tbeg; t0 < tend; t0 += 2) {
        u32x2 ya[2], yc[2], yd[2], rbb[2], c0[2], x0[2], c1[2], x1[2], c2[2], x2[2]; float mp[2], mn[2];
#pragma unroll
        for (int u = 0; u < 2; ++u) { const int tok = min(t0 + u, tend - 1);
            int b, pos, key; bool isctx; tok_info(tok, b, pos, key, isctx);
            const int seqlen = isctx ? CL : SEQ;
            const bf16_t* pr = P + (size_t)tok * INC; const bf16_t* yr = Y + (size_t)tok * 1024;
            ya[u] = *(const u32x2*)(yr + ch); yc[u] = *(const u32x2*)(yr + 512 + ch); yd[u] = *(const u32x2*)(yr + 768 + ch);
            rbb[u] = *(const u32x2*)(pr + OFF_BB + ch);
            const bool okp = pos > 0, okn = pos < seqlen - 1;
            c0[u] = *(const u32x2*)(pr - (okp ? INC : 0) + OFF_BC + ch); x0[u] = *(const u32x2*)(pr - (okp ? INC : 0) + OFF_BX + ch);
            c1[u] = *(const u32x2*)(pr + OFF_BC + ch); x1[u] = *(const u32x2*)(pr + OFF_BX + ch);
            c2[u] = *(const u32x2*)(pr + (okn ? INC : 0) + OFF_BC + ch); x2[u] = *(const u32x2*)(pr + (okn ? INC : 0) + OFF_BX + ch);
            mp[u] = okp ? 1.f : 0.f; mn[u] = okn ? 1.f : 0.f; }
#pragma unroll
        for (int u = 0; u < 2; ++u) { const int tok = t0 + u;
            if (tok < tend) {
                bf16_t* yr = Y + (size_t)tok * 1024;
                float v[4][4];
                v[0][0] = bflo(ya[u][0]); v[0][1] = bfhi(ya[u][0]); v[0][2] = bflo(ya[u][1]); v[0][3] = bfhi(ya[u][1]);
                v[2][0] = bflo(yc[u][0]); v[2][1] = bfhi(yc[u][0]); v[2][2] = bflo(yc[u][1]); v[2][3] = bfhi(yc[u][1]);
                v[3][0] = bflo(yd[u][0]); v[3][1] = bfhi(yd[u][0]); v[3][2] = bflo(yd[u][1]); v[3][3] = bfhi(yd[u][1]);
                {
                    const float zp[4] = {mp[u] * bflo(c0[u][0]) * bflo(x0[u][0]), mp[u] * bfhi(c0[u][0]) * bfhi(x0[u][0]), mp[u] * bflo(c0[u][1]) * bflo(x0[u][1]), mp[u] * bfhi(c0[u][1]) * bfhi(x0[u][1])};
                    const float zc[4] = {bflo(c1[u][0]) * bflo(x1[u][0]), bfhi(c1[u][0]) * bfhi(x1[u][0]), bflo(c1[u][1]) * bflo(x1[u][1]), bfhi(c1[u][1]) * bfhi(x1[u][1])};
                    const float zn[4] = {mn[u] * bflo(c2[u][0]) * bflo(x2[u][0]), mn[u] * bfhi(c2[u][0]) * bfhi(x2[u][0]), mn[u] * bflo(c2[u][1]) * bflo(x2[u][1]), mn[u] * bfhi(c2[u][1]) * bfhi(x2[u][1])};
                    const float bb[4] = {bflo(rbb[u][0]), bfhi(rbb[u][0]), bflo(rbb[u][1]), bfhi(rbb[u][1])};
#pragma unroll
                    for (int j = 0; j < 4; ++j) v[1][j] = bb[j] * (w0[j] * zp[j] + w1[j] * zc[j] + w2[j] * zn[j]);
                }
                float ss[4];
#pragma unroll
                for (int g = 0; g < 4; ++g) ss[g] = v[g][0] * v[g][0] + v[g][1] * v[g][1] + v[g][2] * v[g][2] + v[g][3] * v[g][3];
#pragma unroll
                for (int g = 0; g < 4; ++g) ss[g] = wave_sum(ss[g]);
#pragma unroll
                for (int g = 0; g < 4; ++g) { const float r = rsqrtf(ss[g] * (1.f / 256.f) + EPS);
                    *(u32x2*)(yr + g * 256 + ch) = (u32x2){pk2(v[g][0] * r * gn[g][0], v[g][1] * r * gn[g][1]), pk2(v[g][2] * r * gn[g][2], v[g][3] * r * gn[g][3])}; }
            } }
    }
}
DEV void e_store_row4(const Ctx& c, int m, int n, const f32x4& a) {
    const float* gate = c.modv(m < NLAT ? (m >> 11) : 8, 2);
    const f32x4 gt = *(const f32x4*)(gate + n), xv = c.xload4(m, n);
    c.xsstore4(m, n, xv[0] + gt[0] * a[0], xv[1] + gt[1] * a[1], xv[2] + gt[2] * a[2], xv[3] + gt[3] * a[3]);
}
DEV void phase_e(const Ctx& c) {
    GemmDesc g; g.A = c.ws<bf16_t>(WS_ACT); g.lda = 1024; g.rowidx = nullptr; g.nvalid = 0;
    g.B0 = c.ws<bf16_t>(WS_WOUT) + (size_t)c.layer * 1024 * 1024; g.B1 = g.B0; g.ldb = 1024; g.ksplit = 1 << 30; g.K = 1024;
    const int nfull = (NLAT / 256) * 4, nhalf = (c.layer == NL - 1) ? 0 : (NCTX / 256) * 8;
    for (int t = c.bid; t < nfull + nhalf; t += c.nb) {
        if (t < nfull) { const int m0 = (t >> 2) * 256, n0 = (t & 3) * 256;
            gemm_tile8p(g, m0, n0, c.lds, c.tid, [&](const f32x4 (&acc)[2][2][4][2], int wr, int wc, int lane) {
                const float* gate = c.modv(m0 >> 11, 2) + n0 + 64 * wc + 4 * (lane >> 4);
                f32x4 gt[2][2];
#pragma unroll
                for (int bj = 0; bj < 2; ++bj)
#pragma unroll
                    for (int n = 0; n < 2; ++n) gt[bj][n] = *(const f32x4*)(gate + 32 * bj + 16 * n);
#pragma unroll
                for (int ai = 0; ai < 2; ++ai)
#pragma unroll
                    for (int m = 0; m < 4; ++m) { const int row = m0 + 128 * ai + 64 * wr + 16 * m + (lane & 15);
#pragma unroll
                        for (int bj = 0; bj < 2; ++bj)
#pragma unroll
                            for (int n = 0; n < 2; ++n) { const int col = n0 + 64 * wc + 32 * bj + 16 * n + 4 * (lane >> 4); const f32x4 xv = c.xload4(row, col), a = acc[ai][bj][m][n], gg = gt[bj][n];
                                c.xsstore4(row, col, xv[0] + gg[0] * a[0], xv[1] + gg[1] * a[1], xv[2] + gg[2] * a[2], xv[3] + gg[3] * a[3]); } }
            }); }
        else { const int u = t - nfull, m0 = NLAT + (u >> 3) * 256;
            gemm_tile<2, 4>(g, m0, (u & 7) * 128, c.lds, c.tid, [&](const f32x4 (&acc)[4][4], int mb, int nbase, int lane) {
#pragma unroll
                for (int mf = 0; mf < 4; ++mf)
#pragma unroll
                    for (int nf = 0; nf < 4; ++nf) { const int p = nbase + 16 * nf + 4 * (lane >> 4);
                        e_store_row4(c, m0 + mb + 16 * mf + (lane & 15), (p & ~255) | (((p >> 5) & 3) << 6) | (((p >> 7) & 1) << 5) | (p & 31), acc[nf][mf]); }
            }); }
    }
}

DEV void phase_f(const Ctx& c) {
    const int tid = c.tid, lane = tid & 63, wave = tid >> 6, l = c.layer, li = lane & 15, q = lane >> 4;
    LAS float* part = (LAS float*)c.lds;
    LAS float* rs = part + 8 * 80 * 32;
    LAS int* hist = (LAS int*)(rs + 80);
    LAS int* hbase = hist + 32;
    int* cnt = c.ws<int>(WS_CNT) + l * NBUCKET * 32;
    int* ltok = c.ws<int>(WS_LTOK); float* lw = c.ws<float>(WS_LW);
    bf16_t* H = c.ws<bf16_t>(WS_ACT);
    const int ntok = c.ntok_tail(), TPB = ntok / 256, tpw = TPB / 8;
    for (int item = c.bid; item < 256; item += c.nb) {
        const int tok0 = item * TPB;
        if (tid < 32) hist[tid] = 0;
        {
            f32x4 acc[2][5];
#pragma unroll
            for (int a = 0; a < 2; ++a)
#pragma unroll
                for (int b = 0; b < 5; ++b) acc[a][b] = (f32x4){0.f, 0.f, 0.f, 0.f};
            int Bd = ((tok0 >> 11) + 1) << 11; if (tok0 >= NLAT) Bd = 1 << 30; else if (Bd > NLAT) Bd = NLAT;
            if (Bd >= tok0 + TPB) Bd = tok0 + TPB;
            const int nA = (Bd - tok0 + 15) >> 4;
            const bf16_t* xrow[5]; const bf16_t* wrow[5]; int tloc[5];
#pragma unroll
            for (int mf = 0; mf < 5; ++mf) {
                const bool segA = mf < nA;
                const int fs = segA ? tok0 + 16 * mf : Bd + 16 * (mf - nA), fe = segA ? Bd : tok0 + TPB;
                const int tokc = min(fs + li, max(fe, fs + 1) - 1);
                const int tokm = min(fs, tok0 + TPB - 1), mb = tokm < NLAT ? (tokm >> 11) : 8;
                tloc[mf] = (fs + li < fe) ? fs + li - tok0 : -1;
                xrow[mf] = c.xs(min(tokc, tok0 + TPB - 1)) + 128 * wave + 8 * q;
                wrow[mf] = c.ws<bf16_t>(WS_RW) + (size_t)(l * 9 + mb) * 2 * 32 * 1024 + (size_t)li * 1024 + 128 * wave + 8 * q; }
            if (nA * 16 >= TPB || Bd >= tok0 + TPB) {
#pragma unroll
                for (int ks = 0; ks < 4; ++ks) {
                    bf16x8 xf[5], wf[2][2];
#pragma unroll
                    for (int hl = 0; hl < 2; ++hl)
#pragma unroll
                        for (int nf = 0; nf < 2; ++nf) wf[hl][nf] = *(const bf16x8*)(wrow[0] + (size_t)(hl * 32 + nf * 16) * 1024 + 32 * ks);
#pragma unroll
                    for (int mf = 0; mf < 5; ++mf) xf[mf] = *(const bf16x8*)(xrow[mf] + 32 * ks);
#pragma unroll
                    for (int mf = 0; mf < 5; ++mf)
#pragma unroll
                        for (int hl = 0; hl < 2; ++hl)
#pragma unroll
                            for (int nf = 0; nf < 2; ++nf) acc[nf][mf] = __builtin_amdgcn_mfma_f32_16x16x32_bf16(wf[hl][nf], xf[mf], acc[nf][mf], 0, 0, 0);
                }
            } else {
#pragma unroll 1
                for (int ks = 0; ks < 4; ++ks) {
                    bf16x8 xf[5];
#pragma unroll
                    for (int mf = 0; mf < 5; ++mf) xf[mf] = *(const bf16x8*)(xrow[mf] + 32 * ks);
#pragma unroll
                    for (int mf = 0; mf < 5; ++mf)
#pragma unroll
                        for (int hl = 0; hl < 2; ++hl)
#pragma unroll
                            for (int nf = 0; nf < 2; ++nf) { const bf16x8 wf = *(const bf16x8*)(wrow[mf] + (size_t)(hl * 32 + nf * 16) * 1024 + 32 * ks);
                                acc[nf][mf] = __builtin_amdgcn_mfma_f32_16x16x32_bf16(wf, xf[mf], acc[nf][mf], 0, 0, 0); }
                }
            }
#pragma unroll
            for (int mf = 0; mf < 5; ++mf)
                if (tloc[mf] >= 0) {
#pragma unroll
                    for (int nf = 0; nf < 2; ++nf) *(LAS f32x4*)(part + ((wave * 80 + tloc[mf]) * 32 + 16 * nf + 4 * q)) = acc[nf][mf]; }
        }
        int mbc2 = -1; f32x4 g0[2], g1[2], s0[2], s1[2];
#pragma unroll 1
        for (int tl0 = 0; tl0 < tpw; tl0 += 3) {
            u32x4 r0[3], r1[3];
#pragma unroll
            for (int u = 0; u < 3; ++u) { const bf16_t* xr = c.xs(tok0 + wave * tpw + min(tl0 + u, tpw - 1)); r0[u] = *(const u32x4*)(xr + 8 * lane); r1[u] = *(const u32x4*)(xr + 512 + 8 * lane); }
#pragma unroll
            for (int u = 0; u < 3; ++u) {
                if (tl0 + u < tpw) { const int t = wave * tpw + tl0 + u, tok = tok0 + t, mb = tok < NLAT ? (tok >> 11) : 8;
                    if (mb != mbc2) { mbc2 = mb; const float* gmv = c.ws<float>(WS_GM) + (size_t)(l * 9 + mb) * 1024; const float* sh = c.modv(mb, 3);
#pragma unroll
                        for (int hf = 0; hf < 2; ++hf) { const int e = 512 * hf + 8 * lane; g0[hf] = *(const f32x4*)(gmv + e); g1[hf] = *(const f32x4*)(gmv + e + 4); s0[hf] = *(const f32x4*)(sh + e); s1[hf] = *(const f32x4*)(sh + e + 4); } }
                    float v[16];
#pragma unroll
                    for (int j = 0; j < 4; ++j) { v[2 * j] = bflo(r0[u][j]); v[2 * j + 1] = bfhi(r0[u][j]); v[8 + 2 * j] = bflo(r1[u][j]); v[8 + 2 * j + 1] = bfhi(r1[u][j]); }
                    float ss = 0.f;
#pragma unroll
                    for (int j = 0; j < 16; ++j) ss += v[j] * v[j];
                    const float rr = rsqrtf(wave_sum(ss) * (1.f / 1024.f) + EPS);
                    if (lane == 0) rs[t] = rr;
#pragma unroll
                    for (int hf = 0; hf < 2; ++hf) { const int e = 512 * hf + 8 * lane;
                        const float* vv = v + 8 * hf;
                        *(u32x4*)(H + (size_t)tok * 1024 + e) = (u32x4){pk2(vv[0] * rr * g0[hf][0] + s0[hf][0], vv[1] * rr * g0[hf][1] + s0[hf][1]), pk2(vv[2] * rr * g0[hf][2] + s0[hf][2], vv[3] * rr * g0[hf][3] + s0[hf][3]),
                                                                          pk2(vv[4] * rr * g1[hf][0] + s1[hf][0], vv[5] * rr * g1[hf][1] + s1[hf][1]), pk2(vv[6] * rr * g1[hf][2] + s1[hf][2], vv[7] * rr * g1[hf][3] + s1[hf][3])}; }
                } }
        }
        __syncthreads();
        int bucket = 0, rank = 0; float wa = 0.f, wb = 0.f;
        if (tid < TPB) {
            const int t = tid, tok = tok0 + t, mb = tok < NLAT ? (tok >> 11) : 8;
            float s[20];
#pragma unroll
            for (int j = 0; j < 20; ++j) { float a = 0.f;
#pragma unroll
                for (int w = 0; w < NW; ++w) a += part[(w * 80 + t) * 32 + j];
                s[j] = a; }
            const float* RC = c.ws<float>(WS_RC) + (l * 9 + mb) * 32;
            const float r = rs[t];
            float gl[4], el[4];
#pragma unroll
            for (int j = 0; j < 4; ++j) gl[j] = r * s[j] + RC[j];
            int gi = 0; float gmx = gl[0];
#pragma unroll
            for (int j = 1; j < 4; ++j) if (gl[j] > gmx) { gmx = gl[j]; gi = j; }
            float gs = 0.f;
#pragma unroll
            for (int j = 0; j < 4; ++j) gs += __expf(gl[j] - gmx);
            const float gw = 1.f / gs;
#pragma unroll
            for (int j = 0; j < 4; ++j) { const float sj = gi == 0 ? s[4 + j] : (gi == 1 ? s[8 + j] : (gi == 2 ? s[12 + j] : s[16 + j])); el[j] = r * sj + RC[4 + 4 * gi + j]; }
            int e1 = 0; float m1 = el[0];
#pragma unroll
            for (int j = 1; j < 4; ++j) if (el[j] > m1) { m1 = el[j]; e1 = j; }
            int e2 = -1; float m2 = -3.0e38f;
#pragma unroll
            for (int j = 0; j < 4; ++j) if (j != e1 && el[j] > m2) { m2 = el[j]; e2 = j; }
            const float p2 = __expf(m2 - m1), w1 = gw / (1.f + p2), w2 = gw * p2 / (1.f + p2);
            const int ea = e1 < e2 ? e1 : e2, eb = e1 < e2 ? e2 : e1; wa = e1 < e2 ? w1 : w2; wb = e1 < e2 ? w2 : w1;
            const int pidx = ea == 0 ? eb - 1 : (ea == 1 ? eb + 1 : 5);
            bucket = gi * 6 + pidx;
            rank = __hip_atomic_fetch_add(hist + bucket, 1, __ATOMIC_RELAXED, __HIP_MEMORY_SCOPE_WORKGROUP);
        }
        __syncthreads();
        if (tid < NBUCKET) { const int n = hist[tid]; hbase[tid] = n > 0 ? atomicAdd(&cnt[tid * 32], n) : 0; }
        __syncthreads();
        if (tid < TPB) {
            const int pos = hbase[bucket] + rank;
            ltok[bucket * NTOK + pos] = tok0 + tid;
            lw[((size_t)bucket * NTOK + pos) * 2] = wa; lw[((size_t)bucket * NTOK + pos) * 2 + 1] = wb;
        }
        __syncthreads();
    }
}

DEV void moe_find(const int* cnt, int mg, int& bucket, int& mt, int& total) {
    int acc = 0; bucket = -1; mt = 0;
    for (int b = 0; b < NBUCKET; ++b) { const int n = (cnt[b * 32] + 255) >> 8; if (bucket < 0 && mg < acc + n) { bucket = b; mt = mg - acc; } acc += n; }
    total = acc;
}
DEV void pair_of(int pidx, int& ea, int& eb) { ea = pidx < 3 ? 0 : (pidx < 5 ? 1 : 2); eb = pidx < 3 ? pidx + 1 : (pidx < 5 ? pidx - 1 : 3); }
template <int WN_, int MF>
DEV void g_tile(const Ctx& c, const int* cnt, int mg, int nt8) {
    const int l = c.layer; (void)l;
    int bucket, mt, tt; moe_find(cnt, mg, bucket, mt, tt);
    int ea, eb; pair_of(bucket % 6, ea, eb); const int grp = bucket / 6;
    const int e = grp * 4 + ((nt8 < 4) ? ea : eb);
    const int nvalid = min(256, cnt[bucket * 32] - mt * 256);
    const int* rows = c.ws<int>(WS_LTOK) + bucket * NTOK + mt * 256;
    const float* wts = c.ws<float>(WS_LW) + ((size_t)bucket * NTOK + mt * 256) * 2 + ((nt8 < 4) ? 0 : 1);
    bf16_t* HB = c.ws<bf16_t>(WS_HBUF);
    GemmDesc g; g.A = c.ws<bf16_t>(WS_ACT); g.lda = 1024; g.rowidx = rows; g.nvalid = nvalid;
    g.B0 = c.ws<bf16_t>(WS_WUP) + (size_t)e * 512 * 1024; g.B1 = g.B0; g.ldb = 1024; g.ksplit = 1 << 30; g.K = 1024;
    const int hcol0 = (nt8 >> 2) * 256 + (nt8 & 3) * 64;
    gemm_tile<WN_, MF>(g, 0, (nt8 & 3) * 128, c.lds, c.tid, [&](const f32x4 (&acc)[4][MF], int mb, int nbase, int lane) {
        const int slot = ((nbase - (nt8 & 3) * 128) >> 6);
#pragma unroll
        for (int mf = 0; mf < MF; ++mf) { const int r = mb + 16 * mf + (lane & 15); const bool ok = r < nvalid; const float w = ok ? wts[2 * r] : 0.f;
#pragma unroll
            for (int f = 0; f < 2; ++f) { const f32x4 gt = acc[f][mf], up = acc[f + 2][mf]; float o[4];
#pragma unroll
                for (int j = 0; j < 4; ++j) o[j] = ok ? silu_f(gt[j]) * up[j] * w : 0.f;
                *(u32x2*)(HB + ((size_t)mg * 256 + r) * 512 + hcol0 + 32 * slot + 16 * f + 4 * (lane >> 4)) = (u32x2){pk2(o[0], o[1]), pk2(o[2], o[3])}; } }
    });
}
template <int WN_, int MF>
DEV void h_tile(const Ctx& c, const int* cnt, int mg, int nt8) {
    const int l = c.layer;
    int bucket, mt, tt; moe_find(cnt, mg, bucket, mt, tt);
    int ea, eb; pair_of(bucket % 6, ea, eb); const int grp = bucket / 6;
    const int nvalid = min(256, cnt[bucket * 32] - mt * 256);
    const int* rows = c.ws<int>(WS_LTOK) + bucket * NTOK + mt * 256;
    GemmDesc g; g.A = c.ws<bf16_t>(WS_HBUF); g.lda = 512; g.rowidx = nullptr; g.nvalid = 0;
    g.B0 = c.ws<bf16_t>(WS_WDN) + (size_t)(grp * 4 + ea) * 1024 * 256; g.B1 = c.ws<bf16_t>(WS_WDN) + (size_t)(grp * 4 + eb) * 1024 * 256; g.ldb = 256; g.ksplit = 256; g.K = 512;
    gemm_tile<WN_, MF>(g, mg * 256, nt8 * 128, c.lds, c.tid, [&](const f32x4 (&acc)[4][MF], int mb, int nbase, int lane) {
#pragma unroll
        for (int mf = 0; mf < MF; ++mf) { const int r = mb + 16 * mf + (lane & 15);
            if (r < nvalid) { const int tok = rows[r]; const int mbi = tok < NLAT ? (tok >> 11) : 8; const float* gate = c.modv(mbi, 5);
#pragma unroll
                for (int nf = 0; nf < 4; ++nf) { const int n = nbase + 16 * nf + 4 * (lane >> 4); const f32x4 gt = *(const f32x4*)(gate + n), xv = c.xsload4(tok, n), a = acc[nf][mf];
                    const float o0 = xv[0] + gt[0] * a[0], o1 = xv[1] + gt[1] * a[1], o2 = xv[2] + gt[2] * a[2], o3 = xv[3] + gt[3] * a[3];
                    if (l == NL - 1) *(f32x4*)(c.p->out + (size_t)tok * DM + n) = (f32x4){o0, o1, o2, o3};
                    else c.xsstore4(tok, n, o0, o1, o2, o3); } } }
    });
}
DEV void phase_g(const Ctx& c) {
    const int* cnt = c.ws<int>(WS_CNT) + c.layer * NBUCKET * 32;
    int total = 0; { int b, m; moe_find(cnt, 0, b, m, total); }
    const int U = total * 4, Ufull = (U / c.nb) * c.nb, R = U - Ufull;
    for (int u = c.bid; u < Ufull; u += c.nb) g_tile<4, 8>(c, cnt, u >> 2, 2 * (u & 3));
    for (int t = c.bid; t < 2 * R; t += c.nb) { const int u = Ufull + (t >> 1); g_tile<2, 4>(c, cnt, u >> 2, 2 * (u & 3) + (t & 1)); }
}
DEV void phase_h(const Ctx& c) {
    const int* cnt = c.ws<int>(WS_CNT) + c.layer * NBUCKET * 32;
    int total = 0; { int b, m; moe_find(cnt, 0, b, m, total); }
    const int U = total * 4, Ufull = (U / c.nb) * c.nb, R = U - Ufull;
    for (int u = c.bid; u < Ufull; u += c.nb) h_tile<4, 8>(c, cnt, u >> 2, 2 * (u & 3));
    for (int t = c.bid; t < 2 * R; t += c.nb) { const int u = Ufull + (t >> 1); h_tile<2, 4>(c, cnt, u >> 2, 2 * (u & 3) + (t & 1)); }
}

constexpr int PH_P0 = 0, PH_A = 1, PH_B = 2, PH_C = 3, PH_D = 4, PH_E0 = 5, PH_E = 6, PH_F = 7, PH_G = 8, PH_H = 9, PH_PER_LAYER = 9;
DEV void run_phase(const Ctx& c, int ph) {
    switch (ph) {
        case PH_P0: phase_p0(c); break;
        case PH_A: phase_a(c); break;
        case PH_B: phase_b(c); break;
        case PH_C: phase_c(c); break;
        case PH_D: phase_d(c); break;
        case PH_E0: phase_e0(c); break;
        case PH_E: phase_e(c); break;
        case PH_F: phase_f(c); break;
        case PH_G: phase_g(c); break;
        case PH_H: phase_h(c); break;
    }
}

extern __shared__ __attribute__((aligned(16))) char smem_dyn[];

#define XB_TMO      128
#define XB_XCNT(j)  (256  + 64 * (j))
#define XB_XSUB(j)  (1280 + 64 * (j))
#define XB_XGEN(j)  (2304 + 64 * (j))
#define XB_TOP      3328
#define XB_TOPGEN   3392
#define XCD_BAR_WORDS 3456
#define XB_SPIN_CAP (1u << 22)
DEV unsigned xb_ld(unsigned* p)              { return __hip_atomic_load(p, __ATOMIC_RELAXED, __HIP_MEMORY_SCOPE_AGENT); }
DEV unsigned xb_add(unsigned* p, unsigned v) { return __hip_atomic_fetch_add(p, v, __ATOMIC_RELAXED, __HIP_MEMORY_SCOPE_AGENT); }
DEV unsigned xb_xcc_id() { return (unsigned)__builtin_amdgcn_s_getreg((3 << 11) | 20) & 0xFu; }
#define XB_SPIN(cond, bar) do { unsigned _sp = 0; while (cond) { __builtin_amdgcn_s_sleep(20); \
    if ((++_sp & 255u) == 0u) { if (xb_ld(&(bar)[XB_TMO])) break; if (_sp > XB_SPIN_CAP) { atomicAdd(&(bar)[XB_TMO], 1u); break; } } } } while (0)
struct XcdBarrier { unsigned* bar; unsigned x; volatile LAS unsigned* st; };
DEV XcdBarrier xcd_barrier_post(unsigned* bar, volatile LAS unsigned* st) {
    XcdBarrier b; b.bar = bar; b.x = xb_xcc_id(); b.st = st;
    if (threadIdx.x == 0) (void)xb_add(&bar[XB_XCNT(b.x)], 1u);
    return b;
}
DEV void xcd_barrier_complete(unsigned* bar, unsigned x, unsigned& nloc, unsigned& nx) {
    const unsigned G = gridDim.x * gridDim.y * gridDim.z;
    unsigned sum, cnt, mine, sp = 0u;
    for (;;) {
        sum = 0u; cnt = 0u; mine = 0u;
#pragma unroll
        for (unsigned j = 0; j < 16; ++j) { const unsigned c = xb_ld(&bar[XB_XCNT(j)]); sum += c; cnt += (c > 0u) ? 1u : 0u; mine = (j == x) ? c : mine; }
        if (sum == G) break;
        __builtin_amdgcn_s_sleep(1);
        if ((++sp & 255u) == 0u) { if (xb_ld(&bar[XB_TMO])) break; if (sp > XB_SPIN_CAP) { atomicAdd(&bar[XB_TMO], 1u); break; } }
    }
    nloc = mine > 0u ? mine : 1u; nx = cnt > 0u ? cnt : 1u;
}
DEV void xcd_barrier(const XcdBarrier& b) {
    asm volatile("s_waitcnt vmcnt(0)" ::: "memory");
    __syncthreads();
    if (threadIdx.x == 0) {
        unsigned* bar = b.bar;
        __builtin_amdgcn_s_waitcnt(0);
        unsigned nloc = b.st[0], nx = b.st[1];
        if (nloc == 0u) { xcd_barrier_complete(bar, b.x, nloc, nx); b.st[0] = nloc; b.st[1] = nx; }
        const unsigned old = xb_add(&bar[XB_XSUB(b.x)], 1u);
        const unsigned gen = old / nloc;
        if (old + 1u == (gen + 1u) * nloc) {
            __builtin_amdgcn_fence(__ATOMIC_RELEASE, "agent");
            asm volatile("s_waitcnt vmcnt(0)" ::: "memory");
            const unsigned og = xb_add(&bar[XB_TOP], 1u);
            const unsigned tg = og / nx;
            if (og + 1u == (tg + 1u) * nx) xb_add(&bar[XB_TOPGEN], 1u);
            else XB_SPIN(xb_ld(&bar[XB_TOPGEN]) == tg, bar);
            __builtin_amdgcn_fence(__ATOMIC_ACQUIRE, "agent");
            xb_add(&bar[XB_XGEN(b.x)], 1u);
            asm volatile("s_waitcnt vmcnt(0)" ::: "memory");
        } else {
            XB_SPIN(xb_ld(&bar[XB_XGEN(b.x)]) == gen, bar);
            __builtin_amdgcn_fence(__ATOMIC_ACQUIRE, "agent");
            asm volatile("s_waitcnt vmcnt(0)" ::: "memory");
        }
    }
    __syncthreads();
}
static_assert(XCD_BAR_WORDS * 4 <= 16384, "barrier words");


#if !MODE_SINGLE
__global__ void __launch_bounds__(NTHREADS, 2) k_phase(Params p, int layer, int ph) {
    Ctx c; c.p = (ParamsPtr)__builtin_amdgcn_kernarg_segment_ptr(); c.layer = layer; c.bid = blockIdx.x; c.nb = gridDim.x; c.tid = threadIdx.x; c.lds = (LAS char*)smem_dyn;
    run_phase(c, ph);
}


#endif
__global__ void __launch_bounds__(NTHREADS, 2) k_mega(Params p) {
    ParamsPtr pp = (ParamsPtr)__builtin_amdgcn_kernarg_segment_ptr();
    const int wave_id = __builtin_amdgcn_readfirstlane(threadIdx.x >> 6);
    Ctx c; c.p = pp; c.layer = 0; c.bid = blockIdx.x; c.nb = gridDim.x; c.tid = threadIdx.x; c.lds = (LAS char*)smem_dyn;
    volatile LAS unsigned* st = (volatile LAS unsigned*)(c.lds + LDS_BAR);
    if (threadIdx.x == 0) { st[0] = 0u; st[1] = 0u; st[2] = 0u; st[3] = 0u; }
    __syncthreads();
    XcdBarrier xb = xcd_barrier_post((unsigned*)(pp->ws + WS_BAR), st);
    unsigned long long t_prev = 0; float tacc1 = 0.f, tacc2 = 0.f;
#pragma unroll 1
    for (int step = 0; step <= 1 + NL * PH_PER_LAYER; ++step) {
        if (step) { xcd_barrier(xb); if (EXP_BAR2) xcd_barrier(xb); }
        if (PROBE_P1 >= -1) {
            const unsigned long long now = __builtin_amdgcn_s_memrealtime();
            if (step) { const int php = step > 1 ? 1 + (step - 2) % PH_PER_LAYER : 0; const float us = (float)(now - t_prev) * 0.01f;
                if (php == PROBE_P1) tacc1 += us; if (php == PROBE_P2) tacc2 += us; }
            t_prev = now;
        }
        if (step == 1 + NL * PH_PER_LAYER) break;
        { ParamsPtr q = pp; int w_ = wave_id, b_ = blockIdx.x, n_ = gridDim.x; asm volatile("" : "+s"(q), "+s"(w_), "+s"(b_), "+s"(n_));
          unsigned m_ = ~0u; asm volatile("" : "+s"(m_));
          int t_ = w_ * 64 + (int)__builtin_amdgcn_mbcnt_hi(m_, __builtin_amdgcn_mbcnt_lo(m_, 0u)); asm volatile("" : "+v"(t_)); c.p = q; c.tid = t_; c.bid = b_; c.nb = n_; }
        c.layer = step ? (step - 1) / PH_PER_LAYER : 0;
        const int ph = step ? 1 + (step - 1) % PH_PER_LAYER : 0;
        run_phase(c, ph);
        if (EXP_REP >= 0 && ph == EXP_REP && (EXP_REP != PH_E || c.layer == 0)) {
            if (EXP_REP == PH_F) { xcd_barrier(xb); if (c.bid == 0 && c.tid < NBUCKET) c.ws<int>(WS_CNT)[(c.layer * NBUCKET + c.tid) * 32] = 0; }
            xcd_barrier(xb); run_phase(c, ph); }
    }
    if (PROBE_P1 >= -1) {
        float* t2 = (float*)(pp->ws + WS_DBG);
        if (c.bid == 0 && c.tid == 0) { t2[0] = PROBE_P1 == -1 ? 100.f : tacc1; t2[1] = tacc2; }
        xcd_barrier(xb);
        const float cfill = sqrtf(t2[0]), spike = 4.f * t2[1];
        float* o = pp->out;
        for (size_t i = (size_t)c.bid * NTHREADS + c.tid; i < (size_t)NLAT * DM; i += (size_t)c.nb * NTHREADS) o[i] = (i == 0) ? spike : cfill;
    }
}

extern "C" void kernel_launch(void* const* d_in, const int* in_sizes, int n_in, void* d_out, int out_size, void* d_ws, size_t ws_size, hipStream_t stream) {
    static int grid = 0;
    if (grid == 0) {
        if (n_in != 29 || ws_size < WS_END) { fprintf(stderr, "kernel_launch: unexpected n_in %d or workspace %zu < %zu\n", n_in, ws_size, (size_t)WS_END); grid = -1; return; }
        int dev = 0, cus = 0, per_cu = 0;
        (void)hipGetDevice(&dev); (void)hipDeviceGetAttribute(&cus, hipDeviceAttributeMultiprocessorCount, dev);
#if MODE_SINGLE
        const void* kfn = (const void*)k_mega;
#else
        const void* kfn = (const void*)k_phase;
#endif
        (void)hipFuncSetAttribute(kfn, hipFuncAttributeMaxDynamicSharedMemorySize, LDS_BYTES);
        (void)hipOccupancyMaxActiveBlocksPerMultiprocessor(&per_cu, kfn, NTHREADS, LDS_BYTES);
        if (per_cu < 1) fprintf(stderr, "kernel_launch: occupancy query reports %d workgroups per CU\n", per_cu);
        grid = cus;
    }
    if (grid < 0) return;
    Params p{};
    for (int i = 0; i < 29; ++i) p.in[i] = (const float*)d_in[i];
    p.out = (float*)d_out; p.ws = (char*)d_ws;
    (void)hipMemsetAsync((char*)d_ws + WS_BAR, 0, WS_ZERO_BYTES, stream);
#if MODE_SINGLE
    void* args[] = {&p};
    hipError_t e = hipLaunchCooperativeKernel((const void*)k_mega, dim3(grid), dim3(NTHREADS), args, LDS_BYTES, stream);
    if (e != hipSuccess) fprintf(stderr, "kernel_launch: cooperative launch failed: %s (grid %d)\n", hipGetErrorString(e), grid);
#else
    hipLaunchKernelGGL(k_phase, dim3(grid), dim3(NTHREADS), LDS_BYTES, stream, p, 0, PH_P0);
    for (int l = 0; l < NL; ++l)
        for (int ph = PH_A; ph <= PH_H; ++ph) hipLaunchKernelGGL(k_phase, dim3(grid), dim3(NTHREADS), LDS_BYTES, stream, p, l, ph);
#endif
}
```

```cpp
#include <hip/hip_runtime.h>
#include <cstdio>
#include <cstdint>

#ifndef MODE_SINGLE
#define MODE_SINGLE 1
#endif
#ifndef EXP_BAR2
#define EXP_BAR2 0
#endif
#ifndef PROBE_P1
#define PROBE_P1 -2
#define PROBE_P2 -2
#endif
#ifndef EXP_REP
#define EXP_REP -1
#endif

#define DEV __device__ __forceinline__
#define LAS __attribute__((address_space(3)))
typedef unsigned short bf16_t;
typedef short bf16x8 __attribute__((ext_vector_type(8)));
typedef float f32x4 __attribute__((ext_vector_type(4)));
typedef float f32x16 __attribute__((ext_vector_type(16)));
typedef unsigned u32x4 __attribute__((ext_vector_type(4)));
typedef unsigned u32x2 __attribute__((ext_vector_type(2)));

constexpr int DM = 1024, NB = 8, SEQ = 2048, CL = 256, NL = 2;
constexpr int NLAT = NB * SEQ, NCTX = NB * CL, NTOK = NLAT + NCTX;
constexpr int KEYS = CL + SEQ;
constexpr int INC = 2208, INCP = 2304;
constexpr int OFF_AU = 0, OFF_AV = 256, OFF_BB = 512, OFF_BC = 768, OFF_BX = 1024, OFF_CQ = 1280, OFF_CK = 1536, OFF_CV = 1664,
              OFF_DCQ = 1792, OFF_DCKV = 2048, OFF_DKR = 2176;
constexpr float EPS = 1e-6f;
constexpr float LOG2E = 1.4426950408889634f;
constexpr float C_SCALE = 0.125f, D_SCALE = 0.10206207261596577f;
constexpr int NBUCKET = 24;
constexpr int MAXMT = NTOK / 256 + NBUCKET;
constexpr int NTHREADS = 512, NW = 8;
constexpr int LDS_BAR = 2 * (256 + 256) * 128, LDS_BYTES = LDS_BAR + 64;

constexpr size_t al256(size_t x) { return (x + 255) & ~(size_t)255; }
constexpr size_t WS_BAR   = 0;
constexpr size_t WS_CNT   = 16384;
constexpr size_t WS_ZERO_BYTES = 16384 + 8192;
constexpr size_t WS_MODV  = al256(WS_CNT + 8192);
constexpr size_t WS_RW    = al256(WS_MODV + (size_t)NL * 9 * 6144 * 4);
constexpr size_t WS_RC    = al256(WS_RW + (size_t)NL * 9 * 2 * 32 * 1024 * 2);
constexpr size_t WS_GM    = al256(WS_RC + (size_t)NL * 9 * 32 * 4);
constexpr size_t WS_ROPEC = al256(WS_GM + (size_t)NL * 9 * 1024 * 4);
constexpr size_t WS_ROPED = al256(WS_ROPEC + (size_t)2 * 2048 * 32 * 4);
constexpr size_t WS_WIN   = al256(WS_ROPED + (size_t)2 * 2048 * 16 * 4);
constexpr size_t WS_WOUT  = al256(WS_WIN + (size_t)NL * INCP * 1024 * 2);
constexpr size_t WS_WUP   = al256(WS_WOUT + (size_t)NL * 1024 * 1024 * 2);
constexpr size_t WS_WDN   = al256(WS_WUP + (size_t)16 * 512 * 1024 * 2);
constexpr size_t WS_WQB   = al256(WS_WDN + (size_t)16 * 1024 * 256 * 2);
constexpr size_t WS_WKVB  = al256(WS_WQB + (size_t)NL * 384 * 256 * 2);
constexpr size_t WS_WSG   = al256(WS_WKVB + (size_t)NL * 512 * 128 * 2);
constexpr size_t WS_XS    = al256(WS_WSG + (size_t)NL * 4 * 128 * 128 * 2);
constexpr size_t WS_ACT   = al256(WS_XS + (size_t)NTOK * 1024 * 2);
constexpr size_t WS_P     = al256(WS_ACT + (size_t)NTOK * 1024 * 2);
constexpr size_t WS_QRAW  = WS_P;
constexpr size_t WS_KVRAW = al256(WS_QRAW + (size_t)NTOK * 384 * 2);
constexpr size_t WS_HBUF  = WS_P;
constexpr size_t WS_QC    = al256(WS_P + (size_t)NTOK * INC * 2);
constexpr size_t WS_KC    = al256(WS_QC + (size_t)NB * 4 * KEYS * 64 * 2);
constexpr size_t WS_VCT   = al256(WS_KC + (size_t)NB * 2 * KEYS * 64 * 2);
constexpr size_t WS_QD    = al256(WS_VCT + (size_t)NB * 2 * 64 * KEYS * 2);
constexpr size_t WS_CQN   = WS_QD;
constexpr size_t WS_CKVN  = WS_QD + (size_t)NTOK * 256 * 2;
constexpr size_t WS_KD    = al256(WS_QD + (size_t)NB * 4 * KEYS * 96 * 2);
constexpr size_t WS_VDT   = al256(WS_KD + (size_t)NB * 4 * KEYS * 96 * 2);
constexpr size_t WS_LTOK  = al256(WS_VDT + (size_t)NB * 4 * 64 * KEYS * 2);
constexpr size_t WS_LW    = al256(WS_LTOK + (size_t)NBUCKET * NTOK * 4);
constexpr size_t WS_SSQ   = al256(WS_LW + (size_t)NBUCKET * NTOK * 8);
constexpr size_t WS_DBG   = al256(WS_SSQ + (size_t)NTOK * 8 * 4);
constexpr size_t WS_END   = WS_DBG + (1 << 20);
static_assert(WS_END <= ((size_t)256 << 20), "workspace");
static_assert((size_t)MAXMT * 256 * 512 * 2 <= (size_t)NTOK * INC * 2, "Hbuf overlay");
static_assert((size_t)NTOK * 384 * 2 <= (size_t)NB * 4 * KEYS * 96 * 2, "CQN/CKVN overlay");

struct Params {
    const float* in[29];
    float* out;
    char* ws;
};
enum { I_X = 0, I_C, I_CTX, I_CCTX, I_WMOD, I_BMOD, I_GATTN, I_WIN, I_SGUVG, I_SGUW, I_SGUB, I_CONVW, I_GQAQG, I_GQAKG, I_QAG, I_WQB, I_KVAG, I_WKVB,
       I_MLAQG, I_MLAKG, I_GGO, I_WOUT, I_GFFN, I_WRG, I_BRG, I_WRE, I_BRE, I_WUP, I_WDN };

DEV bf16_t f2bf(float f) { unsigned u = __float_as_uint(f); u += 0x7fffu + ((u >> 16) & 1u); return (bf16_t)(u >> 16); }
DEV float bf2f(bf16_t h) { return __uint_as_float(((unsigned)h) << 16); }
typedef __bf16 bf16x2_t __attribute__((ext_vector_type(2)));
typedef float f32x2 __attribute__((ext_vector_type(2)));
DEV unsigned pk2(float a, float b) { const f32x2 v = {a, b}; return __builtin_bit_cast(unsigned, __builtin_convertvector(v, bf16x2_t)); }
DEV float bflo(unsigned u) { return __uint_as_float(u << 16); }
DEV float bfhi(unsigned u) { return __uint_as_float(u & 0xffff0000u); }
template <int M> DEV float xlane(float v) {
    const int i = __builtin_bit_cast(int, v);
    if constexpr (M == 1) return __builtin_bit_cast(float, __builtin_amdgcn_mov_dpp(i, 0xB1, 0xF, 0xF, true));
    else if constexpr (M == 2) return __builtin_bit_cast(float, __builtin_amdgcn_mov_dpp(i, 0x4E, 0xF, 0xF, true));
    else if constexpr (M == 8) return __builtin_bit_cast(float, __builtin_amdgcn_mov_dpp(i, 0x128, 0xF, 0xF, true));
    else if constexpr (M == 4 || M == 16) return __builtin_bit_cast(float, __builtin_amdgcn_ds_swizzle(i, (M << 10) | 0x1F));
    else { static_assert(M == 32, "xlane"); const auto r = __builtin_amdgcn_permlane32_swap((unsigned)i, (unsigned)i, false, false);
        return __builtin_bit_cast(float, (int)(r[0] ^ r[1] ^ (unsigned)i)); }
}
DEV float wave_sum(float v) { v += xlane<32>(v); v += xlane<16>(v); v += xlane<8>(v); v += xlane<4>(v); v += xlane<2>(v); v += xlane<1>(v); return v; }
DEV float wave_max(float v) { v = fmaxf(v, xlane<32>(v)); v = fmaxf(v, xlane<16>(v)); v = fmaxf(v, xlane<8>(v)); v = fmaxf(v, xlane<4>(v)); v = fmaxf(v, xlane<2>(v)); return fmaxf(v, xlane<1>(v)); }
DEV float grp_sum16(float v) { v += xlane<1>(v); v += xlane<2>(v); v += xlane<4>(v); v += xlane<8>(v); return v; }
DEV float silu_f(float x) { return x / (1.f + __expf(-x)); }
DEV float gelu_fast(float x) { const float u = 1.5957691216057308f * (x + 0.044715f * x * x * x); return x * __builtin_amdgcn_rcpf(1.f + __expf(-u)); }
DEV void tok_info(int tok, int& b, int& pos, int& key, bool& isctx) {
    if (tok < NLAT) { b = tok >> 11; pos = tok & 2047; key = CL + pos; isctx = false; }
    else { const int c = tok - NLAT; b = c >> 8; pos = c & 255; key = pos; isctx = true; }
}
DEV bf16x8 lds_r128(LAS const char* p) { return *(LAS const bf16x8*)p; }

typedef const __attribute__((address_space(4))) Params* ParamsPtr;
struct Ctx {
    ParamsPtr p; int layer; int bid, nb, tid; LAS char* lds;
    DEV const float* in(int i) const { return p->in[i]; }
    template <class T> DEV T* ws(size_t off) const { return (T*)(p->ws + off); }
    DEV const float* modv(int mb, int chunk) const { return ws<float>(WS_MODV) + ((size_t)(layer * 9 + mb) * 6 + chunk) * 1024; }
    DEV const float* xin(int tok) const { return tok < NLAT ? p->in[I_X] + (size_t)tok * DM : p->in[I_CTX] + (size_t)(tok - NLAT) * DM; }
    DEV bf16_t* xs(int tok) const { return ws<bf16_t>(WS_XS) + (size_t)tok * DM; }
    DEV f32x4 xload4(int tok, int n) const {
        if (layer == 0) return *(const f32x4*)(xin(tok) + n);
        const u32x2 r = *(const u32x2*)(xs(tok) + n); return (f32x4){bflo(r[0]), bfhi(r[0]), bflo(r[1]), bfhi(r[1])};
    }
    DEV f32x4 xsload4(int tok, int n) const { const u32x2 r = *(const u32x2*)(xs(tok) + n); return (f32x4){bflo(r[0]), bfhi(r[0]), bflo(r[1]), bfhi(r[1])}; }
    DEV void xsstore4(int tok, int n, float a, float b, float c2, float d) const { *(u32x2*)(xs(tok) + n) = (u32x2){pk2(a, b), pk2(c2, d)}; }
    DEV int ntok_tail() const { return layer == NL - 1 ? NLAT : NTOK; }
};

struct GemmDesc {
    const bf16_t* A; int lda; const int* rowidx; int nvalid;
    const bf16_t* B0; const bf16_t* B1; int ldb; int ksplit; int K;
};
template <int WN_, int MF, class Epi>
DEV void gemm_tile(const GemmDesc& g, int m0, int n0, LAS char* lds, int tid, const Epi& epi) {
    constexpr int BM = (8 / WN_) * 16 * MF, BN = 64 * WN_, NPA = BM / 8, APW = (NPA + 7) / 8, BP = WN_, STAGE = (BM + BN) * 128;
    static_assert(BM % 8 == 0 && 2 * STAGE <= LDS_BAR, "tile does not fit");
    const int lane = tid & 63, wave = __builtin_amdgcn_readfirstlane(tid >> 6), wm = wave / WN_, wn = wave % WN_;
    int aoff[APW], boff[BP];
#pragma unroll
    for (int j = 0; j < APW; ++j) {
        const int pc = (j * 8 + wave < NPA) ? j * 8 + wave : wave;
        const int r = pc * 8 + (lane >> 3), kc = (lane & 7) ^ ((r >> 1) & 7);
        const int srow = g.rowidx ? g.rowidx[(r < g.nvalid) ? r : 0] : (m0 + r);
        aoff[j] = srow * g.lda + kc * 8;
    }
#pragma unroll
    for (int j = 0; j < BP; ++j) {
        const int r = (j * 8 + wave) * 8 + (lane >> 3), kc = (lane & 7) ^ ((r >> 1) & 7);
        boff[j] = (n0 + r) * g.ldb + kc * 8;
    }
    f32x4 acc[4][MF];
#pragma unroll
    for (int i = 0; i < 4; ++i)
#pragma unroll
        for (int j = 0; j < MF; ++j) acc[i][j] = (f32x4){0.f, 0.f, 0.f, 0.f};
    const int nk = g.K / 64;
    const int swz = (lane >> 1) & 7, q = lane >> 4;
    const int arow = (16 * MF * wm + (lane & 15)) * 128, brow = (64 * wn + (lane & 15)) * 128;
    LAS char* pieceA = lds + wave * 1024;
    LAS char* pieceB = lds + BM * 128 + wave * 1024;
#define GT_STAGE(KT, ST) { const int k0_ = (KT) * 64; const bf16_t* Bb_ = (k0_ < g.ksplit) ? g.B0 + k0_ : g.B1 + (k0_ - g.ksplit); \
        _Pragma("unroll") for (int j = 0; j < APW; ++j) if (NPA % 8 == 0 || j * 8 + wave < NPA) __builtin_amdgcn_global_load_lds((const void*)(g.A + aoff[j] + k0_), (LAS void*)(pieceA + (ST) * STAGE + j * 8192), 16, 0, 0); \
        _Pragma("unroll") for (int j = 0; j < BP; ++j) __builtin_amdgcn_global_load_lds((const void*)(Bb_ + boff[j]), (LAS void*)(pieceB + (ST) * STAGE + j * 8192), 16, 0, 0); }
#define GT_COMPUTE(ST) { LAS const char* As_ = lds + (ST) * STAGE; LAS const char* Bs_ = As_ + BM * 128; \
        _Pragma("unroll") for (int ks = 0; ks < 2; ++ks) { const int ch = ((4 * ks + q) ^ swz) << 4; bf16x8 bfr[4]; \
            _Pragma("unroll") for (int f = 0; f < 4; ++f) bfr[f] = lds_r128(Bs_ + brow + f * 2048 + ch); \
            _Pragma("unroll") for (int mh = 0; mh < MF; mh += 4) { bf16x8 af[4]; \
                _Pragma("unroll") for (int f = 0; f < 4; ++f) af[f] = lds_r128(As_ + arow + (mh + f) * 2048 + ch); \
                _Pragma("unroll") for (int mf = 0; mf < 4; ++mf) _Pragma("unroll") for (int nf = 0; nf < 4; ++nf) \
                    acc[nf][mh + mf] = __builtin_amdgcn_mfma_f32_16x16x32_bf16(bfr[nf], af[mf], acc[nf][mh + mf], 0, 0, 0); } } }
    __syncthreads();
    GT_STAGE(0, 0);
    asm volatile("s_waitcnt vmcnt(0)" ::: "memory");
    __syncthreads();
#pragma unroll 1
    for (int kt = 0; kt < nk; kt += 2) {
        GT_STAGE(kt + 1, 1);
        GT_COMPUTE(0);
        asm volatile("s_waitcnt vmcnt(0)" ::: "memory");
        __syncthreads();
        if (kt + 2 < nk) GT_STAGE(kt + 2, 0);
        GT_COMPUTE(1);
        asm volatile("s_waitcnt vmcnt(0)" ::: "memory");
        __syncthreads();
    }
#undef GT_STAGE
#undef GT_COMPUTE
    {
        int lane_e = lane, mb_e = 16 * MF * wm, nb_e = n0 + 64 * wn;
        asm volatile("" : "+v"(lane_e), "+v"(mb_e), "+v"(nb_e));
        epi(acc, mb_e, __builtin_amdgcn_readfirstlane(nb_e), lane_e);
    }
}

DEV int p8_lds_lo(int fr, int fq) { return (fr * 64 + fq * 16) ^ ((fr >> 3) << 5); }
DEV void p8_stage_rc(int b, int& R, int& C) { const int st = b >> 10, sb = b & 1023, swz = sb ^ (((sb >> 9) & 1) << 5); R = (st >> 1) * 16 + (swz >> 6); C = (st & 1) * 32 + ((swz & 63) >> 1); }
template <class Epi>
DEV void gemm_tile8p(const GemmDesc& g, int m0, int n0, LAS char* lds, int tid, const Epi& epi) {
    const int wid = __builtin_amdgcn_readfirstlane(tid >> 6), lane = tid & 63, wr = wid >> 2, wc = wid & 3, fr = lane & 15, fq = lane >> 4;
    int aoff[2][2], boff[2][2];
#pragma unroll
    for (int i = 0; i < 2; ++i) { int R, C; p8_stage_rc(tid * 16 + i * 8192, R, C);
#pragma unroll
        for (int h = 0; h < 2; ++h) { const int r = h * 128 + R;
            const int srow = g.rowidx ? g.rowidx[(r < g.nvalid) ? r : 0] : (m0 + r);
            aoff[h][i] = srow * g.lda + C; boff[h][i] = (n0 + r) * g.ldb + C; } }
    const int lo = p8_lds_lo(fr, fq);
    LAS char* const stg = lds + wid * 1024;
    LAS const char* const rdA = lds + wr * 8192 + lo;
    LAS const char* const rdB = lds + 65536 + wc * 4096 + lo;
    f32x4 acc[2][2][4][2];
#pragma unroll
    for (int a = 0; a < 2; ++a)
#pragma unroll
        for (int b = 0; b < 2; ++b)
#pragma unroll
            for (int m = 0; m < 4; ++m) { acc[a][b][m][0] = (f32x4){0.f, 0.f, 0.f, 0.f}; acc[a][b][m][1] = acc[a][b][m][0]; }
    bf16x8 At[4][2], B0[2][2], B1[2][2];
    const int nt = g.K / 64;
#define P8_BOFF(kt) (((kt) * 64 < g.ksplit) ? g.B0 + (kt) * 64 : g.B1 + ((kt) * 64 - g.ksplit))
#define STAGE_A(b, h, kt) { _Pragma("unroll") for (int i_ = 0; i_ < 2; ++i_) __builtin_amdgcn_global_load_lds((const void*)(g.A + aoff[h][i_] + (kt) * 64), (LAS void*)(stg + ((b) * 2 + (h)) * 16384 + i_ * 8192), 16, 0, 0); }
#define STAGE_B(b, h, kt) { const bf16_t* Bb_ = P8_BOFF(kt); _Pragma("unroll") for (int i_ = 0; i_ < 2; ++i_) __builtin_amdgcn_global_load_lds((const void*)(Bb_ + boff[h][i_]), (LAS void*)(stg + 65536 + ((b) * 2 + (h)) * 16384 + i_ * 8192), 16, 0, 0); }
#define LDA(b, h) { _Pragma("unroll") for (int m = 0; m < 4; ++m) _Pragma("unroll") for (int k = 0; k < 2; ++k) At[m][k] = lds_r128(rdA + ((b) * 2 + (h)) * 16384 + (m * 2 + k) * 1024); }
#define LDB(dst, b, h) { _Pragma("unroll") for (int n = 0; n < 2; ++n) _Pragma("unroll") for (int k = 0; k < 2; ++k) dst[n][k] = lds_r128(rdB + ((b) * 2 + (h)) * 16384 + (n * 2 + k) * 1024); }
#define MMA(ai, bj, Bx) { __builtin_amdgcn_s_setprio(1); \
        _Pragma("unroll") for (int m = 0; m < 4; ++m) _Pragma("unroll") for (int n = 0; n < 2; ++n) _Pragma("unroll") for (int k = 0; k < 2; ++k) \
            acc[ai][bj][m][n] = __builtin_amdgcn_mfma_f32_16x16x32_bf16(Bx[n][k], At[m][k], acc[ai][bj][m][n], 0, 0, 0); \
        __builtin_amdgcn_s_setprio(0); }
#define WAIT_V(n) asm volatile("s_waitcnt vmcnt(" #n ")" ::: "memory")
#define WAIT_L(n) asm volatile("s_waitcnt lgkmcnt(" #n ")" ::: "memory")
#define BAR __builtin_amdgcn_s_barrier()
#define SCHED __builtin_amdgcn_sched_barrier(0)
    __syncthreads();
    STAGE_B(0, 0, 0); STAGE_A(0, 0, 0); STAGE_B(0, 1, 0); STAGE_A(0, 1, 0);
    if (wr == 1) BAR;
    WAIT_V(4); BAR;
    STAGE_B(1, 0, 1); STAGE_A(1, 0, 1); STAGE_B(1, 1, 1);
    WAIT_V(6); BAR;
#pragma unroll 1
    for (int t = 0; t < nt - 2; t += 2) {
        LDB(B0, 0, 0); SCHED; LDA(0, 0); STAGE_A(1, 1, t + 1);
        WAIT_L(8); BAR; WAIT_L(0); MMA(0, 0, B0); BAR; SCHED;
        LDB(B1, 0, 1); STAGE_B(0, 0, t + 2);
        BAR; WAIT_L(0); MMA(0, 1, B1); BAR;
        LDA(0, 1); STAGE_A(0, 0, t + 2);
        BAR; WAIT_L(0); MMA(1, 0, B0); BAR; SCHED;
        STAGE_B(0, 1, t + 2);
        WAIT_V(6); BAR; MMA(1, 1, B1); BAR;
        LDB(B0, 1, 0); SCHED; LDA(1, 0); STAGE_A(0, 1, t + 2);
        WAIT_L(8); BAR; WAIT_L(0); MMA(0, 0, B0); BAR; SCHED;
        LDB(B1, 1, 1); STAGE_B(1, 0, t + 3);
        BAR; WAIT_L(0); MMA(0, 1, B1); BAR;
        LDA(1, 1); STAGE_A(1, 0, t + 3);
        BAR; WAIT_L(0); MMA(1, 0, B0); BAR; SCHED;
        STAGE_B(1, 1, t + 3);
        WAIT_V(6); BAR; MMA(1, 1, B1); BAR;
    }
    {
        LDB(B0, 0, 0); LDA(0, 0); STAGE_A(1, 1, nt - 1);
        BAR; WAIT_L(0); MMA(0, 0, B0); BAR;
        LDB(B1, 0, 1); BAR; WAIT_L(0); MMA(0, 1, B1); BAR;
        LDA(0, 1); WAIT_V(4); BAR; WAIT_L(0); MMA(1, 0, B0); MMA(1, 1, B1); BAR; }
    {
        LDB(B0, 1, 0); LDA(1, 0); WAIT_V(2); BAR; WAIT_L(0); MMA(0, 0, B0); BAR;
        LDB(B1, 1, 1); WAIT_V(0); BAR; WAIT_L(0); MMA(0, 1, B1); BAR;
        LDA(1, 1); BAR; WAIT_L(0); MMA(1, 0, B0); MMA(1, 1, B1); BAR; }
    if (wr == 0) BAR;
#undef P8_BOFF
#undef STAGE_A
#undef STAGE_B
#undef LDA
#undef LDB
#undef MMA
#undef WAIT_V
#undef WAIT_L
#undef BAR
#undef SCHED
    {
        int lane_e = lane, wr_e = wr, wc_e = wc;
        asm volatile("" : "+v"(lane_e), "+s"(wr_e), "+s"(wc_e));
        epi(acc, wr_e, wc_e, lane_e);
    }
}

DEV void p0_transpose(const float* W, int K, int N, bf16_t* WT, int kt, int nt, int mode, const float* kscale, LAS float* scr, int tid) {
    {
        const int n4 = (tid & 15) * 4, kr = tid >> 4, n_in = nt * 64 + n4;
#pragma unroll
        for (int i = 0; i < 2; ++i) { const int kk = kr + 32 * i; const float s = kscale ? kscale[kt * 64 + kk] : 1.f;
            f32x4 v = (f32x4){0.f, 0.f, 0.f, 0.f};
            if (n_in < N) v = *(const f32x4*)(W + (size_t)(kt * 64 + kk) * N + n_in);
            scr[kk * 65 + n4] = s * v[0]; scr[kk * 65 + n4 + 1] = s * v[1]; scr[kk * 65 + n4 + 2] = s * v[2]; scr[kk * 65 + n4 + 3] = s * v[3]; }
    }
    __syncthreads();
    const int nl = tid >> 3, kcq = tid & 7, n = nt * 64 + nl;
    if (n < N) {
        int drow = n;
        if (mode == 1) { const int type = n >> 8, j = n & 255; drow = 128 * (j >> 6) + 64 * ((j >> 5) & 1) + 16 * (((j >> 4) & 1) + 2 * type) + (j & 15); }
        if (mode == 2) { const int h = n / 96, cc = n % 96; drow = cc < 64 ? 64 * h + cc : 256 + 32 * h + (cc - 64); }
        if (mode == 3) drow = (n & ~255) | (((n >> 5) & 1) << 7) | (((n >> 6) & 3) << 5) | (n & 31);
        unsigned o[4];
#pragma unroll
        for (int j = 0; j < 4; ++j) o[j] = pk2(scr[(kcq * 8 + 2 * j) * 65 + nl], scr[(kcq * 8 + 2 * j + 1) * 65 + nl]);
        *(u32x4*)(WT + (size_t)drow * K + kt * 64 + kcq * 8) = (u32x4){o[0], o[1], o[2], o[3]};
    }
    __syncthreads();
}
constexpr int T_IN = 16 * 35, T_OUT = 16 * 16, T_UP = 16 * 16 * 8, T_DN = 16 * 4 * 16, T_QB = 4 * 6, T_KVB = 2 * 8;
constexpr int T_LAYER = T_IN + T_OUT + T_UP + T_DN + T_QB + T_KVB;
constexpr int P0_TR = NL * T_LAYER, P0_WSG = 32, P0_MODV = NL * 192, P0_ROPE = 192, P0_PAD = 48;
constexpr int P0_ITEMS = P0_TR + P0_WSG + P0_MODV + P0_ROPE + P0_PAD;

DEV void p0_expert_item(const Ctx& c, int l, int item, LAS float* scr, int tid) {
    if (item < T_UP) { const int e = item / 128, q = item % 128;
        p0_transpose(c.in(I_WUP) + ((size_t)l * 16 + e) * 1024 * 512, 1024, 512, c.ws<bf16_t>(WS_WUP) + (size_t)e * 512 * 1024, q / 8, q % 8, 1, nullptr, scr, tid); }
    else { const int r = item - T_UP, e = r / 64, q = r % 64;
        p0_transpose(c.in(I_WDN) + ((size_t)l * 16 + e) * 256 * 1024, 256, 1024, c.ws<bf16_t>(WS_WDN) + (size_t)e * 1024 * 256, q / 16, q % 16, 0, nullptr, scr, tid); }
}
DEV void phase_p0(const Ctx& c) {
    const int tid = c.tid;
    LAS float* scr = (LAS float*)c.lds;
    for (int it = c.bid; it < P0_ITEMS; it += c.nb) {
        int r = it;
        if (r < P0_TR) {
            const int l = r / T_LAYER; r -= l * T_LAYER;
            if (r < T_IN) { p0_transpose(c.in(I_WIN) + (size_t)l * 1024 * INC, 1024, INC, c.ws<bf16_t>(WS_WIN) + (size_t)l * INCP * 1024, r / 35, r % 35, 0, nullptr, scr, tid); continue; } r -= T_IN;
            if (r < T_OUT) { p0_transpose(c.in(I_WOUT) + (size_t)l * 1024 * 1024, 1024, 1024, c.ws<bf16_t>(WS_WOUT) + (size_t)l * 1024 * 1024, r / 16, r % 16, 3, nullptr, scr, tid); continue; } r -= T_OUT;
            if (r < T_UP) { if (l == 0) p0_expert_item(c, 0, r, scr, tid); continue; } r -= T_UP;
            if (r < T_DN) { if (l == 0) p0_expert_item(c, 0, T_UP + r, scr, tid); continue; } r -= T_DN;
            if (r < T_QB) { p0_transpose(c.in(I_WQB) + (size_t)l * 256 * 384, 256, 384, c.ws<bf16_t>(WS_WQB) + (size_t)l * 384 * 256, r / 6, r % 6, 2, c.in(I_QAG) + l * 256, scr, tid); continue; } r -= T_QB;
            p0_transpose(c.in(I_WKVB) + (size_t)l * 128 * 512, 128, 512, c.ws<bf16_t>(WS_WKVB) + (size_t)l * 512 * 128, r / 8, r % 8, 0, c.in(I_KVAG) + l * 128, scr, tid); continue;
        }
        r -= P0_TR;
        if (r < P0_WSG) {
            const size_t e0 = ((size_t)r * NTHREADS + tid) * 8; const float* s = c.in(I_SGUW) + e0;
            const f32x4 a = *(const f32x4*)s, b = *(const f32x4*)(s + 4);
            *(u32x4*)(c.ws<bf16_t>(WS_WSG) + e0) = (u32x4){pk2(a[0], a[1]), pk2(a[2], a[3]), pk2(b[0], b[1]), pk2(b[2], b[3])};
            continue;
        }
        r -= P0_WSG;
        if (r < P0_MODV) {
            const int l = r / 192, n0 = (r % 192) * 32;
            LAS float* sc = scr;
            LAS float* red = scr + 9 * 1024;
            __syncthreads();
            for (int i = tid; i < 9 * 1024; i += NTHREADS) { const int mb = i >> 10, k = i & 1023; sc[i] = silu_f(mb < 8 ? c.in(I_C)[mb * 1024 + k] : c.in(I_CCTX)[k]); }
            __syncthreads();
            const int kq = tid >> 3, nl = tid & 7;
            float a[9][4];
#pragma unroll
            for (int j = 0; j < 9; ++j) { a[j][0] = 0.f; a[j][1] = 0.f; a[j][2] = 0.f; a[j][3] = 0.f; }
            const float* wp = c.in(I_WMOD) + (size_t)l * 1024 * 6144 + n0 + 4 * nl;
#pragma unroll 8
            for (int k2 = 0; k2 < 16; ++k2) { const int k = kq * 16 + k2; const f32x4 w = *(const f32x4*)(wp + (size_t)k * 6144);
#pragma unroll
                for (int j = 0; j < 9; ++j) { const float s = sc[j * 1024 + k]; a[j][0] += s * w[0]; a[j][1] += s * w[1]; a[j][2] += s * w[2]; a[j][3] += s * w[3]; } }
#pragma unroll
            for (int j = 0; j < 9; ++j)
#pragma unroll
                for (int q = 0; q < 4; ++q) { float v = a[j][q]; v += xlane<8>(v); v += xlane<16>(v); v += xlane<32>(v); a[j][q] = v; }
            if ((tid & 63) < 8) {
#pragma unroll
                for (int j = 0; j < 9; ++j)
#pragma unroll
                    for (int q = 0; q < 4; ++q) red[((tid >> 6) * 9 + j) * 32 + 4 * nl + q] = a[j][q];
            }
            __syncthreads();
            for (int i = tid; i < 9 * 32; i += NTHREADS) { const int mb = i >> 5, n = i & 31;
                float v = 0.f;
#pragma unroll
                for (int w = 0; w < NW; ++w) v += red[(w * 9 + mb) * 32 + n];
                c.ws<float>(WS_MODV)[(size_t)(l * 9 + mb) * 6144 + n0 + n] = v + c.in(I_BMOD)[l * 6144 + n0 + n]; }
            __syncthreads();
            continue;
        }
        r -= P0_MODV;
        if (r < P0_ROPE) {
            const int idx = r * NTHREADS + tid;
            if (idx < 2048 * 32) { const int s = idx >> 5, i = idx & 31, f = i & 15; const float pos = (float)((i < 16) ? (s >> 6) : (s & 63));
                const float inv = powf(10000.f, -(float)f / 16.f), ang = pos * inv;
                c.ws<float>(WS_ROPEC)[idx] = cosf(ang); c.ws<float>(WS_ROPEC)[2048 * 32 + idx] = sinf(ang); }
            else { const int j = idx - 2048 * 32, s = j >> 4, i = j & 15, f = i & 7; const float pos = (float)((i < 8) ? (s >> 6) : (s & 63));
                const float inv = powf(10000.f, -(float)f / 8.f), ang = pos * inv;
                c.ws<float>(WS_ROPED)[j] = cosf(ang); c.ws<float>(WS_ROPED)[2048 * 16 + j] = sinf(ang); }
            continue;
        }
        r -= P0_ROPE;
        {
            const int e = (r * NTHREADS + tid) * 8, l = e / (96 * 1024), o = e % (96 * 1024);
            unsigned z = 0u; asm volatile("" : "+v"(z));
            *(u32x4*)(c.ws<bf16_t>(WS_WIN) + ((size_t)l * INCP + INC) * 1024 + o) = (u32x4){z, z, z, z};
        }
    }
}

constexpr int A_RW_ITEMS = NL * 9 * 1024 / NTHREADS;
constexpr int A_RC_ITEMS = NL * 9 * 20 / NW;
DEV void phase_a(const Ctx& c) {
    const int tid = c.tid, lane = tid & 63, wave = tid >> 6;
    const float* g = c.in(I_GATTN) + c.layer * 1024;
    bf16_t* H = c.ws<bf16_t>(WS_ACT);
    const int nwv = c.nb * NW, per = (NTOK + nwv - 1) / nwv, tbeg = (c.bid * NW + wave) * per, tend = min(tbeg + per, NTOK);
    int mbc = -1; f32x4 gm[4], sv[4];
#pragma unroll 1
    for (int t0 = tbeg; t0 < tend; t0 += 3) {
        f32x4 v[3][4];
#pragma unroll
        for (int u = 0; u < 3; ++u) { const int tok = min(t0 + u, tend - 1);
#pragma unroll
            for (int i = 0; i < 4; ++i) v[u][i] = c.xload4(tok, i * 256 + lane * 4); }
#pragma unroll
        for (int u = 0; u < 3; ++u) { const int tok = t0 + u;
            if (tok < tend) {
                const int mb = tok < NLAT ? (tok >> 11) : 8;
                if (mb != mbc) { mbc = mb; const float* sh = c.modv(mb, 0); const float* scl = c.modv(mb, 1);
#pragma unroll
                    for (int i = 0; i < 4; ++i) { const int e = i * 256 + lane * 4; const f32x4 gg = *(const f32x4*)(g + e), s1 = *(const f32x4*)(scl + e);
                        gm[i] = (f32x4){gg[0] * (1.f + s1[0]), gg[1] * (1.f + s1[1]), gg[2] * (1.f + s1[2]), gg[3] * (1.f + s1[3])}; sv[i] = *(const f32x4*)(sh + e); } }
                float ss = 0.f;
#pragma unroll
                for (int i = 0; i < 4; ++i) ss += v[u][i][0] * v[u][i][0] + v[u][i][1] * v[u][i][1] + v[u][i][2] * v[u][i][2] + v[u][i][3] * v[u][i][3];
                const float r = rsqrtf(wave_sum(ss) * (1.f / 1024.f) + EPS);
#pragma unroll
                for (int i = 0; i < 4; ++i) { const int e = i * 256 + lane * 4;
                    float o[4];
#pragma unroll
                    for (int j = 0; j < 4; ++j) o[j] = v[u][i][j] * r * gm[i][j] + sv[i][j];
                    *(u32x2*)(H + (size_t)tok * 1024 + e) = (u32x2){pk2(o[0], o[1]), pk2(o[2], o[3])}; }
            } }
    }
    if (c.layer == 0) {
        for (int it = c.bid; it < A_RW_ITEMS + A_RC_ITEMS; it += c.nb) {
            if (it < A_RW_ITEMS) {
                const int idx = it * NTHREADS + tid, l = idx / (9 * 1024), mb = (idx >> 10) % 9, k = idx & 1023;
                const float* mv = c.ws<float>(WS_MODV) + (size_t)(l * 9 + mb) * 6144;
                const float gm = c.in(I_GFFN)[l * 1024 + k] * (1.f + mv[4 * 1024 + k]);
                c.ws<float>(WS_GM)[idx] = gm;
                bf16_t* o = c.ws<bf16_t>(WS_RW) + (size_t)(l * 9 + mb) * 2 * 32 * 1024 + k;
                const float* wg = c.in(I_WRG) + ((size_t)l * 1024 + k) * 4; const float* we = c.in(I_WRE) + ((size_t)l * 1024 + k) * 16;
#pragma unroll
                for (int j = 0; j < 32; ++j) { const float w = j < 20 ? gm * (j < 4 ? wg[j] : we[j - 4]) : 0.f;
                    const bf16_t hi = f2bf(w); o[(size_t)j * 1024] = hi; o[(size_t)(32 + j) * 1024] = f2bf(w - bf2f(hi)); }
            } else {
                const int idx = (it - A_RW_ITEMS) * NW + wave, l = idx / 180, mb = (idx / 20) % 9, j = idx % 20;
                const float* mv = c.ws<float>(WS_MODV) + (size_t)(l * 9 + mb) * 6144 + 3 * 1024;
                float a = 0.f;
                for (int k = lane; k < 1024; k += 64) { const float w = (j < 4) ? c.in(I_WRG)[((size_t)l * 1024 + k) * 4 + j] : c.in(I_WRE)[((size_t)l * 1024 + k) * 16 + (j - 4)]; a += mv[k] * w; }
                a = wave_sum(a);
                if (lane == 0) c.ws<float>(WS_RC)[(l * 9 + mb) * 32 + j] = a + ((j < 4) ? c.in(I_BRG)[l * 4 + j] : c.in(I_BRE)[l * 16 + j - 4]);
            }
        }
    }
}

DEV void rope2(float& a, float& b, float cs, float sn) { const float x0 = a, x1 = b; a = x0 * cs - x1 * sn; b = x0 * sn + x1 * cs; }
DEV float red_q(float v) { v += xlane<16>(v); v += xlane<32>(v); return v; }
template <int MF>
DEV void b_epilogue(const Ctx& c, const f32x4 (&acc)[4][MF], int m0, int mb, int nbase, int lane) {
    const int l = c.layer;
    bf16_t* P = c.ws<bf16_t>(WS_P);
    const int q = lane >> 4, li = lane & 15;
    const bool isctx = m0 >= NLAT;
    if (nbase < 256) {
#pragma unroll
        for (int mf = 0; mf < MF; ++mf) { const int m = m0 + mb + 16 * mf + li;
#pragma unroll
            for (int nf = 0; nf < 4; ++nf) { const f32x4 a = acc[nf][mf];
                *(u32x2*)(P + (size_t)m * INC + nbase + 16 * nf + 4 * q) = (u32x2){pk2(gelu_fast(a[0]), gelu_fast(a[1])), pk2(gelu_fast(a[2]), gelu_fast(a[3]))}; } }
    } else if (nbase < 512) {
        const float* vg = c.in(I_SGUVG) + l * 256 + (nbase - 256) + 4 * q;
#pragma unroll
        for (int mf = 0; mf < MF; ++mf) { const int m = m0 + mb + 16 * mf + li;
            float v[4][4]; float ss = 0.f;
#pragma unroll
            for (int nf = 0; nf < 4; ++nf)
#pragma unroll
                for (int r = 0; r < 4; ++r) { v[nf][r] = gelu_fast(acc[nf][mf][r]); ss += v[nf][r] * v[nf][r]; }
            const float rr = rsqrtf(red_q(ss) * (1.f / 64.f) + EPS);
#pragma unroll
            for (int nf = 0; nf < 4; ++nf) { const f32x4 gg = *(const f32x4*)(vg + 16 * nf);
                *(u32x2*)(P + (size_t)m * INC + nbase + 16 * nf + 4 * q) = (u32x2){pk2(v[nf][0] * rr * gg[0], v[nf][1] * rr * gg[1]), pk2(v[nf][2] * rr * gg[2], v[nf][3] * rr * gg[3])}; } }
    } else if (nbase < OFF_CQ || (nbase >= OFF_DCQ && nbase < OFF_DKR)) {
        const bool need_ss = nbase >= OFF_DCQ;
        const int sidx = nbase < OFF_DCKV ? (nbase - OFF_DCQ) >> 6 : 4 + ((nbase - OFF_DCKV) >> 6);
#pragma unroll
        for (int mf = 0; mf < MF; ++mf) { const int m = m0 + mb + 16 * mf + li; float ss = 0.f;
#pragma unroll
            for (int nf = 0; nf < 4; ++nf) { const f32x4 a = acc[nf][mf]; ss += a[0] * a[0] + a[1] * a[1] + a[2] * a[2] + a[3] * a[3];
                *(u32x2*)(P + (size_t)m * INC + nbase + 16 * nf + 4 * q) = (u32x2){pk2(a[0], a[1]), pk2(a[2], a[3])}; }
            if (need_ss) { ss = red_q(ss); if (q == 0) c.ws<float>(WS_SSQ)[(size_t)m * 8 + sidx] = ss; } }
    } else if (nbase < OFF_CV) {
        const bool isq = nbase < OFF_CK;
        const int h = isq ? (nbase - OFF_CQ) >> 6 : (nbase - OFF_CK) >> 6;
        const float* gn = (isq ? c.in(I_GQAQG) : c.in(I_GQAKG)) + l * 64 + 4 * q;
        const float sc = isq ? C_SCALE * LOG2E : 1.f;
        const float* cosC = c.ws<float>(WS_ROPEC); const float* sinC = cosC + 2048 * 32;
#pragma unroll
        for (int mf = 0; mf < MF; ++mf) { const int m = m0 + mb + 16 * mf + li;
            int b, pos, key; bool ic; tok_info(m, b, pos, key, ic);
            float ss = 0.f;
#pragma unroll
            for (int nf = 0; nf < 4; ++nf) { const f32x4 a = acc[nf][mf]; ss += a[0] * a[0] + a[1] * a[1] + a[2] * a[2] + a[3] * a[3]; }
            const float rr = rsqrtf(red_q(ss) * (1.f / 64.f) + EPS);
            bf16_t* dst = isq ? c.ws<bf16_t>(WS_QC) + ((size_t)(b * 4 + h) * KEYS + key) * 64 : c.ws<bf16_t>(WS_KC) + ((size_t)(b * 2 + h) * KEYS + key) * 64;
#pragma unroll
            for (int nf = 0; nf < 4; ++nf) { const f32x4 gg = *(const f32x4*)(gn + 16 * nf); const f32x4 a = acc[nf][mf];
                float v0 = a[0] * rr * gg[0], v1 = a[1] * rr * gg[1], v2 = a[2] * rr * gg[2], v3 = a[3] * rr * gg[3];
                if (!isctx) { const f32x2 cs = *(const f32x2*)(cosC + pos * 32 + 8 * nf + 2 * q), sn = *(const f32x2*)(sinC + pos * 32 + 8 * nf + 2 * q);
                    rope2(v0, v1, cs[0], sn[0]); rope2(v2, v3, cs[1], sn[1]); }
                *(u32x2*)(dst + 16 * nf + 4 * q) = (u32x2){pk2(v0 * sc, v1 * sc), pk2(v2 * sc, v3 * sc)}; } }
    } else if (nbase < OFF_DCQ) {
        const int kvh = (nbase - OFF_CV) >> 6;
#pragma unroll
        for (int mf = 0; mf < MF; ++mf) { const int m = m0 + mb + 16 * mf + li;
            int b, pos, key; bool ic; tok_info(m, b, pos, key, ic);
            bf16_t* dst = c.ws<bf16_t>(WS_VCT) + ((size_t)(b * 2 + kvh) * 64 + 4 * q) * KEYS + key;
#pragma unroll
            for (int nf = 0; nf < 4; ++nf) { const f32x4 a = acc[nf][mf]; const unsigned p0 = pk2(a[0], a[1]), p1 = pk2(a[2], a[3]);
                bf16_t* d = dst + (size_t)(16 * nf) * KEYS;
                d[0] = (bf16_t)(p0 & 0xffffu); d[KEYS] = (bf16_t)(p0 >> 16); d[2 * KEYS] = (bf16_t)(p1 & 0xffffu); d[3 * KEYS] = (bf16_t)(p1 >> 16); } }
    } else if (nbase < OFF_DKR + 64) {
        const float* gn = c.in(I_MLAKG) + l * 96 + 64 + 4 * q;
        const float* cosD = c.ws<float>(WS_ROPED); const float* sinD = cosD + 2048 * 16;
#pragma unroll
        for (int mf = 0; mf < MF; ++mf) { const int m = m0 + mb + 16 * mf + li;
            int b, pos, key; bool ic; tok_info(m, b, pos, key, ic);
            float ss = 0.f;
#pragma unroll
            for (int nf = 0; nf < 2; ++nf) { const f32x4 a = acc[nf][mf]; ss += a[0] * a[0] + a[1] * a[1] + a[2] * a[2] + a[3] * a[3]; }
            const float rr = rsqrtf(red_q(ss) * (1.f / 32.f) + EPS);
#pragma unroll
            for (int nf = 0; nf < 2; ++nf) { const f32x4 gg = *(const f32x4*)(gn + 16 * nf); const f32x4 a = acc[nf][mf];
                float v0 = a[0] * rr * gg[0], v1 = a[1] * rr * gg[1], v2 = a[2] * rr * gg[2], v3 = a[3] * rr * gg[3];
                if (!isctx) { const f32x2 cs = *(const f32x2*)(cosD + pos * 16 + 8 * nf + 2 * q), sn = *(const f32x2*)(sinD + pos * 16 + 8 * nf + 2 * q);
                    rope2(v0, v1, cs[0], sn[0]); rope2(v2, v3, cs[1], sn[1]); }
                const u32x2 o = (u32x2){pk2(v0, v1), pk2(v2, v3)};
#pragma unroll
                for (int h = 0; h < 4; ++h) *(u32x2*)(c.ws<bf16_t>(WS_KD) + ((size_t)(b * 4 + h) * KEYS + key) * 96 + 64 + 16 * nf + 4 * q) = o; } }
    }
}
DEV void phase_b(const Ctx& c) {
    const int l = c.layer;
    GemmDesc g; g.A = c.ws<bf16_t>(WS_ACT); g.lda = 1024; g.rowidx = nullptr; g.nvalid = 0;
    g.B0 = c.ws<bf16_t>(WS_WIN) + (size_t)l * INCP * 1024; g.B1 = g.B0; g.ldb = 1024; g.ksplit = 1 << 30; g.K = 1024;
    constexpr int NT_N = INCP / 256, NT_M = NTOK / 256;
    auto full_tile = [&](int mt, int nt) { const int m0 = mt * 256;
        gemm_tile<4, 8>(g, m0, nt * 256, c.lds, c.tid, [&](const f32x4 (&acc)[4][8], int mb, int nbase, int lane) { b_epilogue<8>(c, acc, m0, mb, nbase, lane); }); };
    if (c.nb != 256) { for (int t = c.bid; t < NT_M * NT_N; t += c.nb) full_tile(t / NT_N, t % NT_N); }
    else if (l < NL - 1) {
        const int nmine = c.bid < 136 ? 3 : 2;
        for (int rd = 0; rd < nmine; ++rd) {
            int mt, nt, ex = -1, ch = -1;
            if (c.bid >= 136) ex = (c.bid - 136) + 120 * rd;
            else if (rd == 0) { if (c.bid < 48) ex = 240 + c.bid; else ch = c.bid - 48; }
            else ch = 88 + 136 * (rd - 1) + c.bid;
            if (ex >= 0) { const int k = ex / 72; nt = k == 0 ? 5 : (k == 1 ? 6 : (k == 2 ? 1 : 0)); mt = ex % 72; }
            else { const int k = ch / 72; nt = k < 3 ? 2 + k : 4 + k; mt = ch % 72; }
            full_tile(mt, nt);
        }
    } else {
        auto unit = [&](int u, int& mt, int& nt) {
            if (u < 256) { const int k = u >> 6; nt = k == 0 ? 5 : (k == 1 ? 6 : (k == 2 ? 1 : 0)); mt = u & 63; }
            else if (u < 576) { const int v = u - 256, k = v >> 6; nt = k < 3 ? 2 + k : 4 + k; mt = v & 63; }
            else { const int v = u - 576; nt = (v >> 3) ? 8 : 6; mt = 64 + (v & 7); } };
        for (int rd = 0; rd < 2; ++rd) { int mt, nt; unit(c.bid + 256 * rd, mt, nt); full_tile(mt, nt); }
        if (c.bid < 160) { int mt, nt; unit(512 + (c.bid >> 1), mt, nt); const int m0 = mt * 256;
            gemm_tile<2, 4>(g, m0, nt * 256 + (c.bid & 1) * 128, c.lds, c.tid, [&](const f32x4 (&acc)[4][4], int mb, int nbase, int lane) { b_epilogue<4>(c, acc, m0, mb, nbase, lane); }); }
    }
    if (l > 0) {
        for (int e = c.bid; e < T_UP + T_DN; e += c.nb) p0_expert_item(c, l, e, (LAS float*)c.lds, c.tid);
    }
}

constexpr int C_SGU_ITEMS = (NTOK / 128) * 4, C_TQ = (NTOK / 256) * 3, C_TKV = (NTOK / 256) * 4;
constexpr int SG_LD = 272;
DEV void phase_c_sgu(const Ctx& c, int item) {
    const int tid = c.tid, lane = tid & 63, wave = tid >> 6, l = c.layer;
    const int chunk = item >> 2, h = item & 3, tok0 = chunk * 128;
    const bf16_t* P = c.ws<bf16_t>(WS_P);
    LAS char* Wt = c.lds;
    LAS char* vT = c.lds + 128 * SG_LD;
    __syncthreads();
    {
        const bf16_t* Wsrc = c.ws<bf16_t>(WS_WSG) + (size_t)(l * 4 + h) * 128 * 128;
#pragma unroll
        for (int i = 0; i < 4; ++i) { const int ci = tid + NTHREADS * i, r = ci >> 4, kc = ci & 15; *(LAS u32x4*)(Wt + r * SG_LD + kc * 16) = *(const u32x4*)(Wsrc + r * 128 + kc * 8); }
        const int j = tid >> 2, qt = tid & 3;
        const bf16_t* vp = P + (size_t)(tok0 + j) * INC + OFF_AV + 64 * h + 16 * qt;
#pragma unroll
        for (int q = 0; q < 2; ++q) { const u32x4 raw = *(const u32x4*)(vp + 8 * q);
#pragma unroll
            for (int e = 0; e < 4; ++e) { LAS char* d = vT + (16 * qt + 8 * q + 2 * e) * SG_LD + j * 2;
                *(LAS bf16_t*)d = (bf16_t)(raw[e] & 0xffffu); *(LAS bf16_t*)(d + SG_LD) = (bf16_t)(raw[e] >> 16); } }
    }
    __syncthreads();
    f32x4 acc[4];
#pragma unroll
    for (int a = 0; a < 4; ++a) acc[a] = (f32x4){0.f, 0.f, 0.f, 0.f};
    const int q = lane >> 4, li = lane & 15;
#pragma unroll
    for (int ks = 0; ks < 4; ++ks) {
        bf16x8 af[4];
#pragma unroll
        for (int df = 0; df < 4; ++df) af[df] = lds_r128(vT + (16 * df + li) * SG_LD + (4 * ks + q) * 16);
        const bf16x8 bfr = lds_r128(Wt + (16 * wave + li) * SG_LD + (4 * ks + q) * 16);
#pragma unroll
        for (int df = 0; df < 4; ++df) acc[df] = __builtin_amdgcn_mfma_f32_16x16x32_bf16(af[df], bfr, acc[df], 0, 0, 0);
    }
    bf16_t* Y = c.ws<bf16_t>(WS_ACT);
    {
        const int i = 16 * wave + li, tok = tok0 + i;
        const float bs = c.in(I_SGUB)[(l * 4 + h) * 128 + i];
#pragma unroll
        for (int df = 0; df < 4; ++df) {
            const int d0 = 16 * df + 4 * q;
            const u32x2 ur = *(const u32x2*)(P + (size_t)tok * INC + OFF_AU + 64 * h + d0);
            const f32x4 a = acc[df];
            *(u32x2*)(Y + (size_t)tok * 1024 + 64 * h + d0) = (u32x2){pk2(bflo(ur[0]) * (a[0] + bs), bfhi(ur[0]) * (a[1] + bs)), pk2(bflo(ur[1]) * (a[2] + bs), bfhi(ur[1]) * (a[3] + bs))};
        }
    }
}
DEV void phase_c(const Ctx& c) {
    const int l = c.layer;
    const bf16_t* P = c.ws<bf16_t>(WS_P);
    const float* cosD = c.ws<float>(WS_ROPED); const float* sinD = cosD + 2048 * 16;
    int it = c.bid;
    const bool lastl = (l == NL - 1);
    for (; it < C_SGU_ITEMS; it += c.nb) { if (!(lastl && (it >> 2) >= NLAT / 128)) phase_c_sgu(c, it); }
    for (; it < C_SGU_ITEMS + C_TQ; it += c.nb) {
        const int t = it - C_SGU_ITEMS, mt = t / 3, nt = t % 3, m0 = mt * 256;
        if (lastl && m0 >= NLAT) continue;
        GemmDesc g; g.rowidx = nullptr; g.nvalid = 0; g.ksplit = 1 << 30; g.lda = INC;
        g.A = P + OFF_DCQ; g.K = 256; g.B0 = c.ws<bf16_t>(WS_WQB) + (size_t)l * 384 * 256; g.B1 = g.B0; g.ldb = 256;
        gemm_tile<2, 4>(g, m0, nt * 128, c.lds, c.tid, [&](const f32x4 (&acc)[4][4], int mb, int nbase, int lane) {
            const int q = lane >> 4, li = lane & 15, wn = (nbase >> 6) & 1;
            const bool isctx = m0 >= NLAT;
            const float* qg = c.in(I_MLAQG) + l * 96;
            const float sc = D_SCALE * LOG2E;
#pragma unroll
            for (int mf = 0; mf < 4; ++mf) { const int m = m0 + mb + 16 * mf + li;
                int b, pos, key; bool ic; tok_info(m, b, pos, key, ic);
                const f32x4 s4 = *(const f32x4*)(c.ws<float>(WS_SSQ) + (size_t)m * 8);
                const float r0 = rsqrtf((s4[0] + s4[1] + s4[2] + s4[3]) * (1.f / 256.f) + EPS);
                if (nt < 2) {
                    const int h = 2 * nt + wn; float ss = 0.f;
#pragma unroll
                    for (int nf = 0; nf < 4; ++nf) { const f32x4 a = acc[nf][mf] * r0; ss += a[0] * a[0] + a[1] * a[1] + a[2] * a[2] + a[3] * a[3]; }
                    const float rr = rsqrtf(red_q(ss) * (1.f / 64.f) + EPS) * r0 * sc;
                    bf16_t* dst = c.ws<bf16_t>(WS_QD) + ((size_t)(b * 4 + h) * KEYS + key) * 96 + 4 * q;
#pragma unroll
                    for (int nf = 0; nf < 4; ++nf) { const f32x4 gg = *(const f32x4*)(qg + 16 * nf + 4 * q); const f32x4 a = acc[nf][mf];
                        *(u32x2*)(dst + 16 * nf) = (u32x2){pk2(a[0] * rr * gg[0], a[1] * rr * gg[1]), pk2(a[2] * rr * gg[2], a[3] * rr * gg[3])}; }
                } else {
#pragma unroll
                    for (int hh = 0; hh < 2; ++hh) { const int h = 2 * wn + hh; float ss = 0.f;
#pragma unroll
                        for (int n2 = 0; n2 < 2; ++n2) { const f32x4 a = acc[2 * hh + n2][mf] * r0; ss += a[0] * a[0] + a[1] * a[1] + a[2] * a[2] + a[3] * a[3]; }
                        const float rr = rsqrtf(red_q(ss) * (1.f / 32.f) + EPS) * r0;
                        bf16_t* dst = c.ws<bf16_t>(WS_QD) + ((size_t)(b * 4 + h) * KEYS + key) * 96 + 64 + 4 * q;
#pragma unroll
                        for (int n2 = 0; n2 < 2; ++n2) { const f32x4 gg = *(const f32x4*)(qg + 64 + 16 * n2 + 4 * q); const f32x4 a = acc[2 * hh + n2][mf];
                            float v0 = a[0] * rr * gg[0], v1 = a[1] * rr * gg[1], v2 = a[2] * rr * gg[2], v3 = a[3] * rr * gg[3];
                            if (!isctx) { const f32x2 cs = *(const f32x2*)(cosD + pos * 16 + 8 * n2 + 2 * q), sn = *(const f32x2*)(sinD + pos * 16 + 8 * n2 + 2 * q);
                                rope2(v0, v1, cs[0], sn[0]); rope2(v2, v3, cs[1], sn[1]); }
                            *(u32x2*)(dst + 16 * n2) = (u32x2){pk2(v0 * sc, v1 * sc), pk2(v2 * sc, v3 * sc)}; } }
                }
            }
        });
    }
    for (; it < C_SGU_ITEMS + C_TQ + C_TKV; it += c.nb) {
        const int t = it - C_SGU_ITEMS - C_TQ, mt = t >> 2, h = t & 3, m0 = mt * 256;
        GemmDesc g; g.rowidx = nullptr; g.nvalid = 0; g.ksplit = 1 << 30; g.lda = INC;
        g.A = P + OFF_DCKV; g.K = 128; g.B0 = c.ws<bf16_t>(WS_WKVB) + (size_t)l * 512 * 128; g.B1 = g.B0; g.ldb = 128;
        gemm_tile<2, 4>(g, m0, h * 128, c.lds, c.tid, [&](const f32x4 (&acc)[4][4], int mb, int nbase, int lane) {
            const int q = lane >> 4, li = lane & 15, wn = (nbase >> 6) & 1;
            const float* kg = c.in(I_MLAKG) + l * 96;
#pragma unroll
            for (int mf = 0; mf < 4; ++mf) { const int m = m0 + mb + 16 * mf + li;
                int b, pos, key; bool ic; tok_info(m, b, pos, key, ic);
                const float* sp = c.ws<float>(WS_SSQ) + (size_t)m * 8;
                const float r0 = rsqrtf((sp[4] + sp[5]) * (1.f / 128.f) + EPS);
                if (wn == 0) {
                    float ss = 0.f;
#pragma unroll
                    for (int nf = 0; nf < 4; ++nf) { const f32x4 a = acc[nf][mf] * r0; ss += a[0] * a[0] + a[1] * a[1] + a[2] * a[2] + a[3] * a[3]; }
                    const float rr = rsqrtf(red_q(ss) * (1.f / 64.f) + EPS) * r0;
                    bf16_t* dst = c.ws<bf16_t>(WS_KD) + ((size_t)(b * 4 + h) * KEYS + key) * 96 + 4 * q;
#pragma unroll
                    for (int nf = 0; nf < 4; ++nf) { const f32x4 gg = *(const f32x4*)(kg + 16 * nf + 4 * q); const f32x4 a = acc[nf][mf];
                        *(u32x2*)(dst + 16 * nf) = (u32x2){pk2(a[0] * rr * gg[0], a[1] * rr * gg[1]), pk2(a[2] * rr * gg[2], a[3] * rr * gg[3])}; }
                } else {
                    bf16_t* dst = c.ws<bf16_t>(WS_VDT) + ((size_t)(b * 4 + h) * 64 + 4 * q) * KEYS + key;
#pragma unroll
                    for (int nf = 0; nf < 4; ++nf) { const f32x4 a = acc[nf][mf] * r0; const unsigned p0 = pk2(a[0], a[1]), p1 = pk2(a[2], a[3]);
                        bf16_t* d = dst + (size_t)(16 * nf) * KEYS;
                        d[0] = (bf16_t)(p0 & 0xffffu); d[KEYS] = (bf16_t)(p0 >> 16); d[2 * KEYS] = (bf16_t)(p1 & 0xffffu); d[3 * KEYS] = (bf16_t)(p1 >> 16); }
                }
            }
        });
    }
}

constexpr int AT_KN = 0, AT_KR = 8192, AT_V = 12288, AT_STAGE = 21504, AT_VLD = 136;
template <int DK>
DEV void attn_item(const bf16_t* Q, const bf16_t* K, const bf16_t* Vt, int nkeys, bf16_t* Yrow, LAS char* lds, int tid, float mref) {
    const int lane = tid & 63, wave = tid >> 6, l31 = lane & 31, h5 = lane >> 5;
    constexpr int NS = DK / 16;
    bf16x8 qf[NS];
#pragma unroll
    for (int s = 0; s < NS; ++s) qf[s] = *(const bf16x8*)(Q + (size_t)(32 * wave + l31) * DK + 16 * s + 8 * h5);
    f32x16 oacc[2];
#pragma unroll
    for (int i = 0; i < 16; ++i) { oacc[0][i] = 0.f; oacc[1][i] = 0.f; }
    float lsum = 0.f;
    const int kr_ = tid >> 3, kc_ = tid & 7;
    const int rr_ = (tid >> 2) & 63, rc_ = tid & 3;
    u32x4 rk, rv, rrp;
    const int nt = nkeys / 64;
    auto gload = [&](int t) {
        const int k0 = t * 64;
        rk = *(const u32x4*)(K + (size_t)(k0 + kr_) * DK + kc_ * 8); rv = *(const u32x4*)(Vt + (size_t)kr_ * KEYS + k0 + kc_ * 8);
        if (DK == 96 && tid < 256) rrp = *(const u32x4*)(K + (size_t)(k0 + rr_) * DK + 64 + rc_ * 8);
    };
    auto lstore = [&](int st) {
        LAS char* base = lds + st * AT_STAGE;
        { const int r = kr_;
            *(LAS u32x4*)(base + AT_KN + r * 128 + ((kc_ ^ ((r >> 1) & 7)) << 4)) = rk;
            LAS char* vd = base + AT_V + r * AT_VLD + kc_ * 16;
            *(LAS u32x2*)vd = (u32x2){rv[0], rv[1]}; *(LAS u32x2*)(vd + 8) = (u32x2){rv[2], rv[3]}; }
        if (DK == 96 && tid < 256) *(LAS u32x4*)(base + AT_KR + rr_ * 64 + ((rc_ ^ ((rr_ >> 2) & 3)) << 4)) = rrp;
    };
    __syncthreads();
    gload(0); lstore(0);
    __syncthreads();
    for (int t = 0; t < nt; ++t) {
        const int cur = t & 1;
        if (t + 1 < nt) gload(t + 1);
        LAS const char* base = lds + cur * AT_STAGE;
        f32x16 sacc[2];
        {
            bf16x8 kf[2][NS];
#pragma unroll
            for (int kt2 = 0; kt2 < 2; ++kt2) {
                const int row = 32 * kt2 + l31;
#pragma unroll
                for (int s = 0; s < 4; ++s) kf[kt2][s] = lds_r128(base + AT_KN + row * 128 + (((2 * s + h5) ^ ((row >> 1) & 7)) << 4));
                if (DK == 96) {
#pragma unroll
                    for (int s = 0; s < 2; ++s) kf[kt2][4 + s] = lds_r128(base + AT_KR + row * 64 + (((2 * s + h5) ^ ((row >> 2) & 3)) << 4));
                }
            }
            __builtin_amdgcn_sched_barrier(0);
#pragma unroll
            for (int kt2 = 0; kt2 < 2; ++kt2) {
#pragma unroll
                for (int i = 0; i < 16; ++i) sacc[kt2][i] = -mref;
#pragma unroll
                for (int s = 0; s < NS; ++s) sacc[kt2] = __builtin_amdgcn_mfma_f32_32x32x16_bf16(kf[kt2][s], qf[s], sacc[kt2], 0, 0, 0);
            }
        }
        bf16x8 vf[2][2][2];
#pragma unroll
        for (int dt = 0; dt < 2; ++dt)
#pragma unroll
            for (int kt2 = 0; kt2 < 2; ++kt2)
#pragma unroll
                for (int s2 = 0; s2 < 2; ++s2) {
                    LAS const char* vp = base + AT_V + (32 * dt + l31) * AT_VLD + (32 * kt2 + 16 * s2 + 4 * h5) * 2;
                    const u32x2 lo = *(LAS const u32x2*)vp, hi = *(LAS const u32x2*)(vp + 16);
                    vf[dt][kt2][s2] = __builtin_bit_cast(bf16x8, (u32x4){lo[0], lo[1], hi[0], hi[1]});
                }
        __builtin_amdgcn_sched_barrier(0);
        float ps = 0.f;
#pragma unroll
        for (int kt2 = 0; kt2 < 2; ++kt2)
#pragma unroll
            for (int i = 0; i < 16; ++i) { const float p = __builtin_amdgcn_exp2f(sacc[kt2][i]); sacc[kt2][i] = p; ps += p; }
        lsum += ps;
        bf16x8 pf[2][2];
#pragma unroll
        for (int kt2 = 0; kt2 < 2; ++kt2)
#pragma unroll
            for (int s2 = 0; s2 < 2; ++s2) {
                u32x4 w;
#pragma unroll
                for (int j = 0; j < 4; ++j) w[j] = pk2(sacc[kt2][8 * s2 + 2 * j], sacc[kt2][8 * s2 + 2 * j + 1]);
                pf[kt2][s2] = __builtin_bit_cast(bf16x8, w);
            }
#pragma unroll
        for (int dt = 0; dt < 2; ++dt)
#pragma unroll
            for (int kt2 = 0; kt2 < 2; ++kt2)
#pragma unroll
                for (int s2 = 0; s2 < 2; ++s2) oacc[dt] = __builtin_amdgcn_mfma_f32_32x32x16_bf16(vf[dt][kt2][s2], pf[kt2][s2], oacc[dt], 0, 0, 0);
        if (t + 1 < nt) lstore(cur ^ 1);
        __syncthreads();
    }
    const float ltot = lsum + xlane<32>(lsum), inv = 1.f / ltot;
    bf16_t* yr = Yrow + (size_t)(32 * wave + l31) * 1024;
#pragma unroll
    for (int dt = 0; dt < 2; ++dt)
#pragma unroll
        for (int g = 0; g < 4; ++g) {
            const int d0 = 32 * dt + 8 * g + 4 * h5;
            *(u32x2*)(yr + d0) = (u32x2){pk2(oacc[dt][4 * g] * inv, oacc[dt][4 * g + 1] * inv), pk2(oacc[dt][4 * g + 2] * inv, oacc[dt][4 * g + 3] * inv)};
        }
}
DEV void phase_d(const Ctx& c) {
    const int nlat = 512, nctx = (c.layer == NL - 1) ? 0 : 64;
    bf16_t* Y = c.ws<bf16_t>(WS_ACT);
    float mrefC, mrefD;
    {
        const int lane = c.tid & 63, l = c.layer;
        auto wmax = [](float v) { return wave_max(v); };
        const float gq = wmax(fabsf(c.in(I_GQAQG)[l * 64 + lane])), gk = wmax(fabsf(c.in(I_GQAKG)[l * 64 + lane]));
        mrefC = 64.f * gq * gk * C_SCALE * LOG2E - 40.f;
        const float* mq = c.in(I_MLAQG) + l * 96; const float* mk = c.in(I_MLAKG) + l * 96;
        const float qn = wmax(fabsf(mq[lane])), qr = wmax(fabsf(mq[64 + (lane & 31)])), kn = wmax(fabsf(mk[lane])), kr = wmax(fabsf(mk[64 + (lane & 31)]));
        mrefD = sqrtf((64.f * qn * qn + 32.f * qr * qr) * (64.f * kn * kn + 32.f * kr * kr)) * D_SCALE * LOG2E - 40.f;
    }
    for (int it = c.bid; it < nlat + nctx; it += c.nb) {
        int type, b, h, qpos0, nkeys, tok0;
        if (it < nlat) {
            type = it >> 8; const int r = it & 255, pr = 4 * (r & 7) + (r >> 6), qb = (r >> 3) & 7; b = pr >> 2; h = pr & 3; qpos0 = CL + 256 * qb; nkeys = KEYS; tok0 = b * SEQ + 256 * qb; }
        else { const int u = it - nlat; type = u >> 5; const int r = u & 31; b = r >> 2; h = r & 3; qpos0 = 0; nkeys = CL; tok0 = NLAT + b * CL; }
        if (type == 0) {
            attn_item<96>(c.ws<bf16_t>(WS_QD) + ((size_t)(b * 4 + h) * KEYS + qpos0) * 96, c.ws<bf16_t>(WS_KD) + (size_t)(b * 4 + h) * KEYS * 96,
                          c.ws<bf16_t>(WS_VDT) + (size_t)(b * 4 + h) * 64 * KEYS, nkeys, Y + (size_t)tok0 * 1024 + 768 + 64 * h, c.lds, c.tid, mrefD);
        } else {
            attn_item<64>(c.ws<bf16_t>(WS_QC) + ((size_t)(b * 4 + h) * KEYS + qpos0) * 64, c.ws<bf16_t>(WS_KC) + (size_t)(b * 2 + (h >> 1)) * KEYS * 64,
                          c.ws<bf16_t>(WS_VCT) + (size_t)(b * 2 + (h >> 1)) * 64 * KEYS, nkeys, Y + (size_t)tok0 * 1024 + 512 + 64 * h, c.lds, c.tid, mrefC);
        }
    }
}

DEV void phase_e0(const Ctx& c) {
    const int tid = c.tid, lane = tid & 63, wave = tid >> 6, l = c.layer;
    bf16_t* Y = c.ws<bf16_t>(WS_ACT); const bf16_t* P = c.ws<bf16_t>(WS_P);
    const float* gg = c.in(I_GGO) + l * 1024;
    const int ntok = c.ntok_tail();
    const int ch = 4 * lane;
    const float* cw = c.in(I_CONVW) + l * 768 + ch;
    const f32x4 w0 = *(const f32x4*)cw, w1 = *(const f32x4*)(cw + 256), w2 = *(const f32x4*)(cw + 512);
    f32x4 gn[4];
#pragma unroll
    for (int g = 0; g < 4; ++g) gn[g] = *(const f32x4*)(gg + g * 256 + ch);
    const int nwv = c.nb * NW, per = (ntok + nwv - 1) / nwv, tbeg = (c.bid * NW + wave) * per, tend = min(tbeg + per, ntok);
#pragma unroll 1
    for (int t0 = tbeg; t0 < tend; t0 += 2) {
        u32x2 ya[2], yc[2], yd[2], rbb[2], c0[2], x0[2], c1[2], x1[2], c2[2], x2[2]; float mp[2], mn[2];
#pragma unroll
        for (int u = 0; u < 2; ++u) { const int tok = min(t0 + u, tend - 1);
            int b, pos, key; bool isctx; tok_info(tok, b, pos, key, isctx);
            const int seqlen = isctx ? CL : SEQ;
            const bf16_t* pr = P + (size_t)tok * INC; const bf16_t* yr = Y + (size_t)tok * 1024;
            ya[u] = *(const u32x2*)(yr + ch); yc[u] = *(const u32x2*)(yr + 512 + ch); yd[u] = *(const u32x2*)(yr + 768 + ch);
            rbb[u] = *(const u32x2*)(pr + OFF_BB + ch);
            const bool okp = pos > 0, okn = pos < seqlen - 1;
            c0[u] = *(const u32x2*)(pr - (okp ? INC : 0) + OFF_BC + ch); x0[u] = *(const u32x2*)(pr - (okp ? INC : 0) + OFF_BX + ch);
            c1[u] = *(const u32x2*)(pr + OFF_BC + ch); x1[u] = *(const u32x2*)(pr + OFF_BX + ch);
            c2[u] = *(const u32x2*)(pr + (okn ? INC : 0) + OFF_BC + ch); x2[u] = *(const u32x2*)(pr + (okn ? INC : 0) + OFF_BX + ch);
            mp[u] = okp ? 1.f : 0.f; mn[u] = okn ? 1.f : 0.f; }
#pragma unroll
        for (int u = 0; u < 2; ++u) { const int tok = t0 + u;
            if (tok < tend) {
                bf16_t* yr = Y + (size_t)tok * 1024;
                float v[4][4];
                v[0][0] = bflo(ya[u][0]); v[0][1] = bfhi(ya[u][0]); v[0][2] = bflo(ya[u][1]); v[0][3] = bfhi(ya[u][1]);
                v[2][0] = bflo(yc[u][0]); v[2][1] = bfhi(yc[u][0]); v[2][2] = bflo(yc[u][1]); v[2][3] = bfhi(yc[u][1]);
                v[3][0] = bflo(yd[u][0]); v[3][1] = bfhi(yd[u][0]); v[3][2] = bflo(yd[u][1]); v[3][3] = bfhi(yd[u][1]);
                {
                    const float zp[4] = {mp[u] * bflo(c0[u][0]) * bflo(x0[u][0]), mp[u] * bfhi(c0[u][0]) * bfhi(x0[u][0]), mp[u] * bflo(c0[u][1]) * bflo(x0[u][1]), mp[u] * bfhi(c0[u][1]) * bfhi(x0[u][1])};
                    const float zc[4] = {bflo(c1[u][0]) * bflo(x1[u][0]), bfhi(c1[u][0]) * bfhi(x1[u][0]), bflo(c1[u][1]) * bflo(x1[u][1]), bfhi(c1[u][1]) * bfhi(x1[u][1])};
                    const float zn[4] = {mn[u] * bflo(c2[u][0]) * bflo(x2[u][0]), mn[u] * bfhi(c2[u][0]) * bfhi(x2[u][0]), mn[u] * bflo(c2[u][1]) * bflo(x2[u][1]), mn[u] * bfhi(c2[u][1]) * bfhi(x2[u][1])};
                    const float bb[4] = {bflo(rbb[u][0]), bfhi(rbb[u][0]), bflo(rbb[u][1]), bfhi(rbb[u][1])};
#pragma unroll
                    for (int j = 0; j < 4; ++j) v[1][j] = bb[j] * (w0[j] * zp[j] + w1[j] * zc[j] + w2[j] * zn[j]);
                }
                float ss[4];
#pragma unroll
                for (int g = 0; g < 4; ++g) ss[g] = v[g][0] * v[g][0] + v[g][1] * v[g][1] + v[g][2] * v[g][2] + v[g][3] * v[g][3];
#pragma unroll
                for (int g = 0; g < 4; ++g) ss[g] = wave_sum(ss[g]);
#pragma unroll
                for (int g = 0; g < 4; ++g) { const float r = rsqrtf(ss[g] * (1.f / 256.f) + EPS);
                    *(u32x2*)(yr + g * 256 + ch) = (u32x2){pk2(v[g][0] * r * gn[g][0], v[g][1] * r * gn[g][1]), pk2(v[g][2] * r * gn[g][2], v[g][3] * r * gn[g][3])}; }
            } }
    }
}
DEV void e_store_row4(const Ctx& c, int m, int n, const f32x4& a) {
    const float* gate = c.modv(m < NLAT ? (m >> 11) : 8, 2);
    const f32x4 gt = *(const f32x4*)(gate + n), xv = c.xload4(m, n);
    c.xsstore4(m, n, xv[0] + gt[0] * a[0], xv[1] + gt[1] * a[1], xv[2] + gt[2] * a[2], xv[3] + gt[3] * a[3]);
}
DEV void phase_e(const Ctx& c) {
    GemmDesc g; g.A = c.ws<bf16_t>(WS_ACT); g.lda = 1024; g.rowidx = nullptr; g.nvalid = 0;
    g.B0 = c.ws<bf16_t>(WS_WOUT) + (size_t)c.layer * 1024 * 1024; g.B1 = g.B0; g.ldb = 1024; g.ksplit = 1 << 30; g.K = 1024;
    const int nfull = (NLAT / 256) * 4, nhalf = (c.layer == NL - 1) ? 0 : (NCTX / 256) * 8;
    for (int t = c.bid; t < nfull + nhalf; t += c.nb) {
        if (t < nfull) { const int m0 = (t >> 2) * 256, n0 = (t & 3) * 256;
            gemm_tile8p(g, m0, n0, c.lds, c.tid, [&](const f32x4 (&acc)[2][2][4][2], int wr, int wc, int lane) {
                const float* gate = c.modv(m0 >> 11, 2) + n0 + 64 * wc + 4 * (lane >> 4);
                f32x4 gt[2][2];
#pragma unroll
                for (int bj = 0; bj < 2; ++bj)
#pragma unroll
                    for (int n = 0; n < 2; ++n) gt[bj][n] = *(const f32x4*)(gate + 32 * bj + 16 * n);
#pragma unroll
                for (int ai = 0; ai < 2; ++ai)
#pragma unroll
                    for (int m = 0; m < 4; ++m) { const int row = m0 + 128 * ai + 64 * wr + 16 * m + (lane & 15);
#pragma unroll
                        for (int bj = 0; bj < 2; ++bj)
#pragma unroll
                            for (int n = 0; n < 2; ++n) { const int col = n0 + 64 * wc + 32 * bj + 16 * n + 4 * (lane >> 4); const f32x4 xv = c.xload4(row, col), a = acc[ai][bj][m][n], gg = gt[bj][n];
                                c.xsstore4(row, col, xv[0] + gg[0] * a[0], xv[1] + gg[1] * a[1], xv[2] + gg[2] * a[2], xv[3] + gg[3] * a[3]); } }
            }); }
        else { const int u = t - nfull, m0 = NLAT + (u >> 3) * 256;
            gemm_tile<2, 4>(g, m0, (u & 7) * 128, c.lds, c.tid, [&](const f32x4 (&acc)[4][4], int mb, int nbase, int lane) {
#pragma unroll
                for (int mf = 0; mf < 4; ++mf)
#pragma unroll
                    for (int nf = 0; nf < 4; ++nf) { const int p = nbase + 16 * nf + 4 * (lane >> 4);
                        e_store_row4(c, m0 + mb + 16 * mf + (lane & 15), (p & ~255) | (((p >> 5) & 3) << 6) | (((p >> 7) & 1) << 5) | (p & 31), acc[nf][mf]); }
            }); }
    }
}

DEV void phase_f(const Ctx& c) {
    const int tid = c.tid, lane = tid & 63, wave = tid >> 6, l = c.layer, li = lane & 15, q = lane >> 4;
    LAS float* part = (LAS float*)c.lds;
    LAS float* rs = part + 8 * 80 * 32;
    LAS int* hist = (LAS int*)(rs + 80);
    LAS int* hbase = hist + 32;
    int* cnt = c.ws<int>(WS_CNT) + l * NBUCKET * 32;
    int* ltok = c.ws<int>(WS_LTOK); float* lw = c.ws<float>(WS_LW);
    bf16_t* H = c.ws<bf16_t>(WS_ACT);
    const int ntok = c.ntok_tail(), TPB = ntok / 256, tpw = TPB / 8;
    for (int item = c.bid; item < 256; item += c.nb) {
        const int tok0 = item * TPB;
        if (tid < 32) hist[tid] = 0;
        {
            f32x4 acc[2][5];
#pragma unroll
            for (int a = 0; a < 2; ++a)
#pragma unroll
                for (int b = 0; b < 5; ++b) acc[a][b] = (f32x4){0.f, 0.f, 0.f, 0.f};
            int Bd = ((tok0 >> 11) + 1) << 11; if (tok0 >= NLAT) Bd = 1 << 30; else if (Bd > NLAT) Bd = NLAT;
            if (Bd >= tok0 + TPB) Bd = tok0 + TPB;
            const int nA = (Bd - tok0 + 15) >> 4;
            const bf16_t* xrow[5]; const bf16_t* wrow[5]; int tloc[5];
#pragma unroll
            for (int mf = 0; mf < 5; ++mf) {
                const bool segA = mf < nA;
                const int fs = segA ? tok0 + 16 * mf : Bd + 16 * (mf - nA), fe = segA ? Bd : tok0 + TPB;
                const int tokc = min(fs + li, max(fe, fs + 1) - 1);
                const int tokm = min(fs, tok0 + TPB - 1), mb = tokm < NLAT ? (tokm >> 11) : 8;
                tloc[mf] = (fs + li < fe) ? fs + li - tok0 : -1;
                xrow[mf] = c.xs(min(tokc, tok0 + TPB - 1)) + 128 * wave + 8 * q;
                wrow[mf] = c.ws<bf16_t>(WS_RW) + (size_t)(l * 9 + mb) * 2 * 32 * 1024 + (size_t)li * 1024 + 128 * wave + 8 * q; }
            if (nA * 16 >= TPB || Bd >= tok0 + TPB) {
#pragma unroll
                for (int ks = 0; ks < 4; ++ks) {
                    bf16x8 xf[5], wf[2][2];
#pragma unroll
                    for (int hl = 0; hl < 2; ++hl)
#pragma unroll
                        for (int nf = 0; nf < 2; ++nf) wf[hl][nf] = *(const bf16x8*)(wrow[0] + (size_t)(hl * 32 + nf * 16) * 1024 + 32 * ks);
#pragma unroll
                    for (int mf = 0; mf < 5; ++mf) xf[mf] = *(const bf16x8*)(xrow[mf] + 32 * ks);
#pragma unroll
                    for (int mf = 0; mf < 5; ++mf)
#pragma unroll
                        for (int hl = 0; hl < 2; ++hl)
#pragma unroll
                            for (int nf = 0; nf < 2; ++nf) acc[nf][mf] = __builtin_amdgcn_mfma_f32_16x16x32_bf16(wf[hl][nf], xf[mf], acc[nf][mf], 0, 0, 0);
                }
            } else {
#pragma unroll 1
                for (int ks = 0; ks < 4; ++ks) {
                    bf16x8 xf[5];
#pragma unroll
                    for (int mf = 0; mf < 5; ++mf) xf[mf] = *(const bf16x8*)(xrow[mf] + 32 * ks);
#pragma unroll
                    for (int mf = 0; mf < 5; ++mf)
#pragma unroll
                        for (int hl = 0; hl < 2; ++hl)
#pragma unroll
                            for (int nf = 0; nf < 2; ++nf) { const bf16x8 wf = *(const bf16x8*)(wrow[mf] + (size_t)(hl * 32 + nf * 16) * 1024 + 32 * ks);
                                acc[nf][mf] = __builtin_amdgcn_mfma_f32_16x16x32_bf16(wf, xf[mf], acc[nf][mf], 0, 0, 0); }
                }
            }
#pragma unroll
            for (int mf = 0; mf < 5; ++mf)
                if (tloc[mf] >= 0) {
#pragma unroll
                    for (int nf = 0; nf < 2; ++nf) *(LAS f32x4*)(part + ((wave * 80 + tloc[mf]) * 32 + 16 * nf + 4 * q)) = acc[nf][mf]; }
        }
        int mbc2 = -1; f32x4 g0[2], g1[2], s0[2], s1[2];
#pragma unroll 1
        for (int tl0 = 0; tl0 < tpw; tl0 += 3) {
            u32x4 r0[3], r1[3];
#pragma unroll
            for (int u = 0; u < 3; ++u) { const bf16_t* xr = c.xs(tok0 + wave * tpw + min(tl0 + u, tpw - 1)); r0[u] = *(const u32x4*)(xr + 8 * lane); r1[u] = *(const u32x4*)(xr + 512 + 8 * lane); }
#pragma unroll
            for (int u = 0; u < 3; ++u) {
                if (tl0 + u < tpw) { const int t = wave * tpw + tl0 + u, tok = tok0 + t, mb = tok < NLAT ? (tok >> 11) : 8;
                    if (mb != mbc2) { mbc2 = mb; const float* gmv = c.ws<float>(WS_GM) + (size_t)(l * 9 + mb) * 1024; const float* sh = c.modv(mb, 3);
#pragma unroll
                        for (int hf = 0; hf < 2; ++hf) { const int e = 512 * hf + 8 * lane; g0[hf] = *(const f32x4*)(gmv + e); g1[hf] = *(const f32x4*)(gmv + e + 4); s0[hf] = *(const f32x4*)(sh + e); s1[hf] = *(const f32x4*)(sh + e + 4); } }
                    float v[16];
#pragma unroll
                    for (int j = 0; j < 4; ++j) { v[2 * j] = bflo(r0[u][j]); v[2 * j + 1] = bfhi(r0[u][j]); v[8 + 2 * j] = bflo(r1[u][j]); v[8 + 2 * j + 1] = bfhi(r1[u][j]); }
                    float ss = 0.f;
#pragma unroll
                    for (int j = 0; j < 16; ++j) ss += v[j] * v[j];
                    const float rr = rsqrtf(wave_sum(ss) * (1.f / 1024.f) + EPS);
                    if (lane == 0) rs[t] = rr;
#pragma unroll
                    for (int hf = 0; hf < 2; ++hf) { const int e = 512 * hf + 8 * lane;
                        const float* vv = v + 8 * hf;
                        *(u32x4*)(H + (size_t)tok * 1024 + e) = (u32x4){pk2(vv[0] * rr * g0[hf][0] + s0[hf][0], vv[1] * rr * g0[hf][1] + s0[hf][1]), pk2(vv[2] * rr * g0[hf][2] + s0[hf][2], vv[3] * rr * g0[hf][3] + s0[hf][3]),
                                                                          pk2(vv[4] * rr * g1[hf][0] + s1[hf][0], vv[5] * rr * g1[hf][1] + s1[hf][1]), pk2(vv[6] * rr * g1[hf][2] + s1[hf][2], vv[7] * rr * g1[hf][3] + s1[hf][3])}; }
                } }
        }
        __syncthreads();
        int bucket = 0, rank = 0; float wa = 0.f, wb = 0.f;
        if (tid < TPB) {
            const int t = tid, tok = tok0 + t, mb = tok < NLAT ? (tok >> 11) : 8;
            float s[20];
#pragma unroll
            for (int j = 0; j < 20; ++j) { float a = 0.f;
#pragma unroll
                for (int w = 0; w < NW; ++w) a += part[(w * 80 + t) * 32 + j];
                s[j] = a; }
            const float* RC = c.ws<float>(WS_RC) + (l * 9 + mb) * 32;
            const float r = rs[t];
            float gl[4], el[4];
#pragma unroll
            for (int j = 0; j < 4; ++j) gl[j] = r * s[j] + RC[j];
            int gi = 0; float gmx = gl[0];
#pragma unroll
            for (int j = 1; j < 4; ++j) if (gl[j] > gmx) { gmx = gl[j]; gi = j; }
            float gs = 0.f;
#pragma unroll
            for (int j = 0; j < 4; ++j) gs += __expf(gl[j] - gmx);
            const float gw = 1.f / gs;
#pragma unroll
            for (int j = 0; j < 4; ++j) { const float sj = gi == 0 ? s[4 + j] : (gi == 1 ? s[8 + j] : (gi == 2 ? s[12 + j] : s[16 + j])); el[j] = r * sj + RC[4 + 4 * gi + j]; }
            int e1 = 0; float m1 = el[0];
#pragma unroll
            for (int j = 1; j < 4; ++j) if (el[j] > m1) { m1 = el[j]; e1 = j; }
            int e2 = -1; float m2 = -3.0e38f;
#pragma unroll
            for (int j = 0; j < 4; ++j) if (j != e1 && el[j] > m2) { m2 = el[j]; e2 = j; }
            const float p2 = __expf(m2 - m1), w1 = gw / (1.f + p2), w2 = gw * p2 / (1.f + p2);
            const int ea = e1 < e2 ? e1 : e2, eb = e1 < e2 ? e2 : e1; wa = e1 < e2 ? w1 : w2; wb = e1 < e2 ? w2 : w1;
            const int pidx = ea == 0 ? eb - 1 : (ea == 1 ? eb + 1 : 5);
            bucket = gi * 6 + pidx;
            rank = __hip_atomic_fetch_add(hist + bucket, 1, __ATOMIC_RELAXED, __HIP_MEMORY_SCOPE_WORKGROUP);
        }
        __syncthreads();
        if (tid < NBUCKET) { const int n = hist[tid]; hbase[tid] = n > 0 ? atomicAdd(&cnt[tid * 32], n) : 0; }
        __syncthreads();
        if (tid < TPB) {
            const int pos = hbase[bucket] + rank;
            ltok[bucket * NTOK + pos] = tok0 + tid;
            lw[((size_t)bucket * NTOK + pos) * 2] = wa; lw[((size_t)bucket * NTOK + pos) * 2 + 1] = wb;
        }
        __syncthreads();
    }
}

DEV void moe_find(const int* cnt, int mg, int& bucket, int& mt, int& total) {
    int acc = 0; bucket = -1; mt = 0;
    for (int b = 0; b < NBUCKET; ++b) { const int n = (cnt[b * 32] + 255) >> 8; if (bucket < 0 && mg < acc + n) { bucket = b; mt = mg - acc; } acc += n; }
    total = acc;
}
DEV void pair_of(int pidx, int& ea, int& eb) { ea = pidx < 3 ? 0 : (pidx < 5 ? 1 : 2); eb = pidx < 3 ? pidx + 1 : (pidx < 5 ? pidx - 1 : 3); }
template <int WN_, int MF>
DEV void g_tile(const Ctx& c, const int* cnt, int mg, int nt8) {
    const int l = c.layer; (void)l;
    int bucket, mt, tt; moe_find(cnt, mg, bucket, mt, tt);
    int ea, eb; pair_of(bucket % 6, ea, eb); const int grp = bucket / 6;
    const int e = grp * 4 + ((nt8 < 4) ? ea : eb);
    const int nvalid = min(256, cnt[bucket * 32] - mt * 256);
    const int* rows = c.ws<int>(WS_LTOK) + bucket * NTOK + mt * 256;
    const float* wts = c.ws<float>(WS_LW) + ((size_t)bucket * NTOK + mt * 256) * 2 + ((nt8 < 4) ? 0 : 1);
    bf16_t* HB = c.ws<bf16_t>(WS_HBUF);
    GemmDesc g; g.A = c.ws<bf16_t>(WS_ACT); g.lda = 1024; g.rowidx = rows; g.nvalid = nvalid;
    g.B0 = c.ws<bf16_t>(WS_WUP) + (size_t)e * 512 * 1024; g.B1 = g.B0; g.ldb = 1024; g.ksplit = 1 << 30; g.K = 1024;
    const int hcol0 = (nt8 >> 2) * 256 + (nt8 & 3) * 64;
    gemm_tile<WN_, MF>(g, 0, (nt8 & 3) * 128, c.lds, c.tid, [&](const f32x4 (&acc)[4][MF], int mb, int nbase, int lane) {
        const int slot = ((nbase - (nt8 & 3) * 128) >> 6);
#pragma unroll
        for (int mf = 0; mf < MF; ++mf) { const int r = mb + 16 * mf + (lane & 15); const bool ok = r < nvalid; const float w = ok ? wts[2 * r] : 0.f;
#pragma unroll
            for (int f = 0; f < 2; ++f) { const f32x4 gt = acc[f][mf], up = acc[f + 2][mf]; float o[4];
#pragma unroll
                for (int j = 0; j < 4; ++j) o[j] = ok ? silu_f(gt[j]) * up[j] * w : 0.f;
                *(u32x2*)(HB + ((size_t)mg * 256 + r) * 512 + hcol0 + 32 * slot + 16 * f + 4 * (lane >> 4)) = (u32x2){pk2(o[0], o[1]), pk2(o[2], o[3])}; } }
    });
}
template <int WN_, int MF>
DEV void h_tile(const Ctx& c, const int* cnt, int mg, int nt8) {
    const int l = c.layer;
    int bucket, mt, tt; moe_find(cnt, mg, bucket, mt, tt);
    int ea, eb; pair_of(bucket % 6, ea, eb); const int grp = bucket / 6;
    const int nvalid = min(256, cnt[bucket * 32] - mt * 256);
    const int* rows = c.ws<int>(WS_LTOK) + bucket * NTOK + mt * 256;
    GemmDesc g; g.A = c.ws<bf16_t>(WS_HBUF); g.lda = 512; g.rowidx = nullptr; g.nvalid = 0;
    g.B0 = c.ws<bf16_t>(WS_WDN) + (size_t)(grp * 4 + ea) * 1024 * 256; g.B1 = c.ws<bf16_t>(WS_WDN) + (size_t)(grp * 4 + eb) * 1024 * 256; g.ldb = 256; g.ksplit = 256; g.K = 512;
    gemm_tile<WN_, MF>(g, mg * 256, nt8 * 128, c.lds, c.tid, [&](const f32x4 (&acc)[4][MF], int mb, int nbase, int lane) {
#pragma unroll
        for (int mf = 0; mf < MF; ++mf) { const int r = mb + 16 * mf + (lane & 15);
            if (r < nvalid) { const int tok = rows[r]; const int mbi = tok < NLAT ? (tok >> 11) : 8; const float* gate = c.modv(mbi, 5);
#pragma unroll
                for (int nf = 0; nf < 4; ++nf) { const int n = nbase + 16 * nf + 4 * (lane >> 4); const f32x4 gt = *(const f32x4*)(gate + n), xv = c.xsload4(tok, n), a = acc[nf][mf];
                    const float o0 = xv[0] + gt[0] * a[0], o1 = xv[1] + gt[1] * a[1], o2 = xv[2] + gt[2] * a[2], o3 = xv[3] + gt[3] * a[3];
                    if (l == NL - 1) *(f32x4*)(c.p->out + (size_t)tok * DM + n) = (f32x4){o0, o1, o2, o3};
                    else c.xsstore4(tok, n, o0, o1, o2, o3); } } }
    });
}
DEV void phase_g(const Ctx& c) {
    const int* cnt = c.ws<int>(WS_CNT) + c.layer * NBUCKET * 32;
    int total = 0; { int b, m; moe_find(cnt, 0, b, m, total); }
    const int U = total * 4, Ufull = (U / c.nb) * c.nb, R = U - Ufull;
    for (int u = c.bid; u < Ufull; u += c.nb) g_tile<4, 8>(c, cnt, u >> 2, 2 * (u & 3));
    for (int t = c.bid; t < 2 * R; t += c.nb) { const int u = Ufull + (t >> 1); g_tile<2, 4>(c, cnt, u >> 2, 2 * (u & 3) + (t & 1)); }
}
DEV void phase_h(const Ctx& c) {
    const int* cnt = c.ws<int>(WS_CNT) + c.layer * NBUCKET * 32;
    int total = 0; { int b, m; moe_find(cnt, 0, b, m, total); }
    const int U = total * 4, Ufull = (U / c.nb) * c.nb, R = U - Ufull;
    for (int u = c.bid; u < Ufull; u += c.nb) h_tile<4, 8>(c, cnt, u >> 2, 2 * (u & 3));
    for (int t = c.bid; t < 2 * R; t += c.nb) { const int u = Ufull + (t >> 1); h_tile<2, 4>(c, cnt, u >> 2, 2 * (u & 3) + (t & 1)); }
}

constexpr int PH_P0 = 0, PH_A = 1, PH_B = 2, PH_C = 3, PH_D = 4, PH_E0 = 5, PH_E = 6, PH_F = 7, PH_G = 8, PH_H = 9, PH_PER_LAYER = 9;
DEV void run_phase(const Ctx& c, int ph) {
    switch (ph) {
        case PH_P0: phase_p0(c); break;
        case PH_A: phase_a(c); break;
        case PH_B: phase_b(c); break;
        case PH_C: phase_c(c); break;
        case PH_D: phase_d(c); break;
        case PH_E0: phase_e0(c); break;
        case PH_E: phase_e(c); break;
        case PH_F: phase_f(c); break;
        case PH_G: phase_g(c); break;
        case PH_H: phase_h(c); break;
    }
}

extern __shared__ __attribute__((aligned(16))) char smem_dyn[];

#define XB_TMO      128
#define XB_XCNT(j)  (256  + 64 * (j))
#define XB_XSUB(j)  (1280 + 64 * (j))
#define XB_XGEN(j)  (2304 + 64 * (j))
#define XB_TOP      3328
#define XB_TOPGEN   3392
#define XCD_BAR_WORDS 3456
#define XB_SPIN_CAP (1u << 22)
DEV unsigned xb_ld(unsigned* p)              { return __hip_atomic_load(p, __ATOMIC_RELAXED, __HIP_MEMORY_SCOPE_AGENT); }
DEV unsigned xb_add(unsigned* p, unsigned v) { return __hip_atomic_fetch_add(p, v, __ATOMIC_RELAXED, __HIP_MEMORY_SCOPE_AGENT); }
DEV unsigned xb_xcc_id() { return (unsigned)__builtin_amdgcn_s_getreg((3 << 11) | 20) & 0xFu; }
#define XB_SPIN(cond, bar) do { unsigned _sp = 0; while (cond) { __builtin_amdgcn_s_sleep(20); \
    if ((++_sp & 255u) == 0u) { if (xb_ld(&(bar)[XB_TMO])) break; if (_sp > XB_SPIN_CAP) { atomicAdd(&(bar)[XB_TMO], 1u); break; } } } } while (0)
struct XcdBarrier { unsigned* bar; unsigned x; volatile LAS unsigned* st; };
DEV XcdBarrier xcd_barrier_post(unsigned* bar, volatile LAS unsigned* st) {
    XcdBarrier b; b.bar = bar; b.x = xb_xcc_id(); b.st = st;
    if (threadIdx.x == 0) (void)xb_add(&bar[XB_XCNT(b.x)], 1u);
    return b;
}
DEV void xcd_barrier_complete(unsigned* bar, unsigned x, unsigned& nloc, unsigned& nx) {
    const unsigned G = gridDim.x * gridDim.y * gridDim.z;
    unsigned sum, cnt, mine, sp = 0u;
    for (;;) {
        sum = 0u; cnt = 0u; mine = 0u;
#pragma unroll
        for (unsigned j = 0; j < 16; ++j) { const unsigned c = xb_ld(&bar[XB_XCNT(j)]); sum += c; cnt += (c > 0u) ? 1u : 0u; mine = (j == x) ? c : mine; }
        if (sum == G) break;
        __builtin_amdgcn_s_sleep(1);
        if ((++sp & 255u) == 0u) { if (xb_ld(&bar[XB_TMO])) break; if (sp > XB_SPIN_CAP) { atomicAdd(&bar[XB_TMO], 1u); break; } }
    }
    nloc = mine > 0u ? mine : 1u; nx = cnt > 0u ? cnt : 1u;
}
DEV void xcd_barrier(const XcdBarrier& b) {
    asm volatile("s_waitcnt vmcnt(0)" ::: "memory");
    __syncthreads();
    if (threadIdx.x == 0) {
        unsigned* bar = b.bar;
        __builtin_amdgcn_s_waitcnt(0);
        unsigned nloc = b.st[0], nx = b.st[1];
        if (nloc == 0u) { xcd_barrier_complete(bar, b.x, nloc, nx); b.st[0] = nloc; b.st[1] = nx; }
        const unsigned old = xb_add(&bar[XB_XSUB(b.x)], 1u);
        const unsigned gen = old / nloc;
        if (old + 1u == (gen + 1u) * nloc) {
            __builtin_amdgcn_fence(__ATOMIC_RELEASE, "agent");
            asm volatile("s_waitcnt vmcnt(0)" ::: "memory");
            const unsigned og = xb_add(&bar[XB_TOP], 1u);
            const unsigned tg = og / nx;
            if (og + 1u == (tg + 1u) * nx) xb_add(&bar[XB_TOPGEN], 1u);
            else XB_SPIN(xb_ld(&bar[XB_TOPGEN]) == tg, bar);
            __builtin_amdgcn_fence(__ATOMIC_ACQUIRE, "agent");
            xb_add(&bar[XB_XGEN(b.x)], 1u);
            asm volatile("s_waitcnt vmcnt(0)" ::: "memory");
        } else {
            XB_SPIN(xb_ld(&bar[XB_XGEN(b.x)]) == gen, bar);
            __builtin_amdgcn_fence(__ATOMIC_ACQUIRE, "agent");
            asm volatile("s_waitcnt vmcnt(0)" ::: "memory");
        }
    }
    __syncthreads();
}
static_assert(XCD_BAR_WORDS * 4 <= 16384, "barrier words");


#if !MODE_SINGLE
__global__ void __launch_bounds__(NTHREADS, 2) k_phase(Params p, int layer, int ph) {
    Ctx c; c.p = (ParamsPtr)__builtin_amdgcn_kernarg_segment_ptr(); c.layer = layer; c.bid = blockIdx.x; c.nb = gridDim.x; c.tid = threadIdx.x; c.lds = (LAS char*)smem_dyn;
    run_phase(c, ph);
}


#endif
__global__ void __launch_bounds__(NTHREADS, 2) k_mega(Params p) {
    ParamsPtr pp = (ParamsPtr)__builtin_amdgcn_kernarg_segment_ptr();
    const int wave_id = __builtin_amdgcn_readfirstlane(threadIdx.x >> 6);
    Ctx c; c.p = pp; c.layer = 0; c.bid = blockIdx.x; c.nb = gridDim.x; c.tid = threadIdx.x; c.lds = (LAS char*)smem_dyn;
    volatile LAS unsigned* st = (volatile LAS unsigned*)(c.lds + LDS_BAR);
    if (threadIdx.x == 0) { st[0] = 0u; st[1] = 0u; st[2] = 0u; st[3] = 0u; }
    __syncthreads();
    XcdBarrier xb = xcd_barrier_post((unsigned*)(pp->ws + WS_BAR), st);
    unsigned long long t_prev = 0; float tacc1 = 0.f, tacc2 = 0.f;
#pragma unroll 1
    for (int step = 0; step <= 1 + NL * PH_PER_LAYER; ++step) {
        if (step) { xcd_barrier(xb); if (EXP_BAR2) xcd_barrier(xb); }
        if (PROBE_P1 >= -1) {
            const unsigned long long now = __builtin_amdgcn_s_memrealtime();
            if (step) { const int php = step > 1 ? 1 + (step - 2) % PH_PER_LAYER : 0; const float us = (float)(now - t_prev) * 0.01f;
                if (php == PROBE_P1) tacc1 += us; if (php == PROBE_P2) tacc2 += us; }
            t_prev = now;
        }
        if (step == 1 + NL * PH_PER_LAYER) break;
        { ParamsPtr q = pp; int w_ = wave_id, b_ = blockIdx.x, n_ = gridDim.x; asm volatile("" : "+s"(q), "+s"(w_), "+s"(b_), "+s"(n_));
          unsigned m_ = ~0u; asm volatile("" : "+s"(m_));
          int t_ = w_ * 64 + (int)__builtin_amdgcn_mbcnt_hi(m_, __builtin_amdgcn_mbcnt_lo(m_, 0u)); asm volatile("" : "+v"(t_)); c.p = q; c.tid = t_; c.bid = b_; c.nb = n_; }
        c.layer = step ? (step - 1) / PH_PER_LAYER : 0;
        const int ph = step ? 1 + (step - 1) % PH_PER_LAYER : 0;
        run_phase(c, ph);
        if (EXP_REP >= 0 && ph == EXP_REP && (EXP_REP != PH_E || c.layer == 0)) {
            if (EXP_REP == PH_F) { xcd_barrier(xb); if (c.bid == 0 && c.tid < NBUCKET) c.ws<int>(WS_CNT)[(c.layer * NBUCKET + c.tid) * 32] = 0; }
            xcd_barrier(xb); run_phase(c, ph); }
    }
    if (PROBE_P1 >= -1) {
        float* t2 = (float*)(pp->ws + WS_DBG);
        if (c.bid == 0 && c.tid == 0) { t2[0] = PROBE_P1 == -1 ? 100.f : tacc1; t2[1] = tacc2; }
        xcd_barrier(xb);
        const float cfill = sqrtf(t2[0]), spike = 4.f * t2[1];
        float* o = pp->out;
        for (size_t i = (size_t)c.bid * NTHREADS + c.tid; i < (size_t)NLAT * DM; i += (size_t)c.nb * NTHREADS) o[i] = (i == 0) ? spike : cfill;
    }
}

extern "C" void kernel_launch(void* const* d_in, const int* in_sizes, int n_in, void* d_out, int out_size, void* d_ws, size_t ws_size, hipStream_t stream) {
    static int grid = 0;
    if (grid == 0) {
        if (n_in != 29 || ws_size < WS_END) { fprintf(stderr, "kernel_launch: unexpected n_in %d or workspace %zu < %zu\n", n_in, ws_size, (size_t)WS_END); grid = -1; return; }
        int dev = 0, cus = 0, per_cu = 0;
        (void)hipGetDevice(&dev); (void)hipDeviceGetAttribute(&cus, hipDeviceAttributeMultiprocessorCount, dev);
#if MODE_SINGLE
        const void* kfn = (const void*)k_mega;
#else
        const void* kfn = (const void*)k_phase;
#endif
        (void)hipFuncSetAttribute(kfn, hipFuncAttributeMaxDynamicSharedMemorySize, LDS_BYTES);
        (void)hipOccupancyMaxActiveBlocksPerMultiprocessor(&per_cu, kfn, NTHREADS, LDS_BYTES);
        if (per_cu < 1) fprintf(stderr, "kernel_launch: occupancy query reports %d workgroups per CU\n", per_cu);
        grid = cus;
    }
    if (grid < 0) return;
    Params p{};
    for (int i = 0; i < 29; ++i) p.in[i] = (const float*)d_in[i];
    p.out = (float*)d_out; p.ws = (char*)d_ws;
    (void)hipMemsetAsync((char*)d_ws + WS_BAR, 0, WS_ZERO_BYTES, stream);
#if MODE_SINGLE
    void* args[] = {&p};
    hipError_t e = hipLaunchCooperativeKernel((const void*)k_mega, dim3(grid), dim3(NTHREADS), args, LDS_BYTES, stream);
    if (e != hipSuccess) fprintf(stderr, "kernel_launch: cooperative launch failed: %s (grid %d)\n", hipGetErrorString(e), grid);
#else
    hipLaunchKernelGGL(k_phase, dim3(grid), dim3(NTHREADS), LDS_BYTES, stream, p, 0, PH_P0);
    for (int l = 0; l < NL; ++l)
        for (int ph = PH_A; ph <= PH_H; ++ph) hipLaunchKernelGGL(k_phase, dim3(grid), dim3(NTHREADS), LDS_BYTES, stream, p, l, ph);
#endif
}
```

```cpp
#include <hip/hip_runtime.h>
#include <cstdio>
#include <cstdint>

#ifndef MODE_SINGLE
#define MODE_SINGLE 1
#endif
#ifndef EXP_BAR2
#define EXP_BAR2 0
#endif
#ifndef PROBE_P1
#define PROBE_P1 -2
#define PROBE_P2 -2
#endif
#ifndef EXP_REP
#define EXP_REP -1
#endif

#define DEV __device__ __forceinline__
#define LAS __attribute__((address_space(3)))
typedef unsigned short bf16_t;
typedef short bf16x8 __attribute__((ext_vector_type(8)));
typedef float f32x4 __attribute__((ext_vector_type(4)));
typedef float f32x16 __attribute__((ext_vector_type(16)));
typedef unsigned u32x4 __attribute__((ext_vector_type(4)));
typedef unsigned u32x2 __attribute__((ext_vector_type(2)));

constexpr int DM = 1024, NB = 8, SEQ = 2048, CL = 256, NL = 2;
constexpr int NLAT = NB * SEQ, NCTX = NB * CL, NTOK = NLAT + NCTX;
constexpr int KEYS = CL + SEQ;
constexpr int INC = 2208, INCP = 2304;
constexpr int OFF_AU = 0, OFF_AV = 256, OFF_BB = 512, OFF_BC = 768, OFF_BX = 1024, OFF_CQ = 1280, OFF_CK = 1536, OFF_CV = 1664,
              OFF_DCQ = 1792, OFF_DCKV = 2048, OFF_DKR = 2176;
constexpr float EPS = 1e-6f;
constexpr float LOG2E = 1.4426950408889634f;
constexpr float C_SCALE = 0.125f, D_SCALE = 0.10206207261596577f;
constexpr int NBUCKET = 24;
constexpr int MAXMT = NTOK / 256 + NBUCKET;
constexpr int NTHREADS = 512, NW = 8;
constexpr int LDS_BAR = 2 * (256 + 256) * 128, LDS_BYTES = LDS_BAR + 64;

constexpr size_t al256(size_t x) { return (x + 255) & ~(size_t)255; }
constexpr size_t WS_BAR   = 0;
constexpr size_t WS_CNT   = 16384;
constexpr size_t WS_RDY   = WS_CNT + 8192;
constexpr size_t WS_ZERO_BYTES = 16384 + 8192 + 16384;
constexpr size_t WS_MODV  = al256(WS_RDY + 16384);
constexpr size_t WS_RW    = al256(WS_MODV + (size_t)NL * 9 * 6144 * 4);
constexpr size_t WS_RC    = al256(WS_RW + (size_t)NL * 9 * 2 * 32 * 1024 * 2);
constexpr size_t WS_GM    = al256(WS_RC + (size_t)NL * 9 * 32 * 4);
constexpr size_t WS_ROPEC = al256(WS_GM + (size_t)NL * 9 * 1024 * 4);
constexpr size_t WS_ROPED = al256(WS_ROPEC + (size_t)2 * 2048 * 32 * 4);
constexpr size_t WS_WIN   = al256(WS_ROPED + (size_t)2 * 2048 * 16 * 4);
constexpr size_t WS_WOUT  = al256(WS_WIN + (size_t)NL * INCP * 1024 * 2);
constexpr size_t WS_WUP   = al256(WS_WOUT + (size_t)NL * 1024 * 1024 * 2);
constexpr size_t WS_WDN   = al256(WS_WUP + (size_t)16 * 512 * 1024 * 2);
constexpr size_t WS_WQB   = al256(WS_WDN + (size_t)16 * 1024 * 256 * 2);
constexpr size_t WS_WKVB  = al256(WS_WQB + (size_t)NL * 384 * 256 * 2);
constexpr size_t WS_WSG   = al256(WS_WKVB + (size_t)NL * 512 * 128 * 2);
constexpr size_t WS_XS    = al256(WS_WSG + (size_t)NL * 4 * 128 * 128 * 2);
constexpr size_t WS_ACT   = al256(WS_XS + (size_t)NTOK * 1024 * 2);
constexpr size_t WS_P     = al256(WS_ACT + (size_t)NTOK * 1024 * 2);
constexpr size_t WS_QRAW  = WS_P;
constexpr size_t WS_KVRAW = al256(WS_QRAW + (size_t)NTOK * 384 * 2);
constexpr size_t WS_HBUF  = WS_P;
constexpr size_t WS_QC    = al256(WS_P + (size_t)NTOK * INC * 2);
constexpr size_t WS_KC    = al256(WS_QC + (size_t)NB * 4 * KEYS * 64 * 2);
constexpr size_t WS_VCT   = al256(WS_KC + (size_t)NB * 2 * KEYS * 64 * 2);
constexpr size_t WS_QD    = al256(WS_VCT + (size_t)NB * 2 * 64 * KEYS * 2);
constexpr size_t WS_CQN   = WS_QD;
constexpr size_t WS_CKVN  = WS_QD + (size_t)NTOK * 256 * 2;
constexpr size_t WS_KD    = al256(WS_QD + (size_t)NB * 4 * KEYS * 96 * 2);
constexpr size_t WS_VDT   = al256(WS_KD + (size_t)NB * 4 * KEYS * 96 * 2);
constexpr size_t WS_LTOK  = al256(WS_VDT + (size_t)NB * 4 * 64 * KEYS * 2);
constexpr size_t WS_LW    = al256(WS_LTOK + (size_t)NBUCKET * NTOK * 4);
constexpr size_t WS_SSQ   = al256(WS_LW + (size_t)NBUCKET * NTOK * 8);
constexpr size_t WS_DBG   = al256(WS_SSQ + (size_t)NTOK * 8 * 4);
constexpr size_t WS_END   = WS_DBG + (1 << 20);
static_assert(WS_END <= ((size_t)256 << 20), "workspace");
static_assert((size_t)MAXMT * 256 * 512 * 2 <= (size_t)NTOK * INC * 2, "Hbuf overlay");
static_assert((size_t)NTOK * 384 * 2 <= (size_t)NB * 4 * KEYS * 96 * 2, "CQN/CKVN overlay");

struct Params {
    const float* in[29];
    float* out;
    char* ws;
};
enum { I_X = 0, I_C, I_CTX, I_CCTX, I_WMOD, I_BMOD, I_GATTN, I_WIN, I_SGUVG, I_SGUW, I_SGUB, I_CONVW, I_GQAQG, I_GQAKG, I_QAG, I_WQB, I_KVAG, I_WKVB,
       I_MLAQG, I_MLAKG, I_GGO, I_WOUT, I_GFFN, I_WRG, I_BRG, I_WRE, I_BRE, I_WUP, I_WDN };

DEV bf16_t f2bf(float f) { unsigned u = __float_as_uint(f); u += 0x7fffu + ((u >> 16) & 1u); return (bf16_t)(u >> 16); }
DEV float bf2f(bf16_t h) { return __uint_as_float(((unsigned)h) << 16); }
typedef __bf16 bf16x2_t __attribute__((ext_vector_type(2)));
typedef float f32x2 __attribute__((ext_vector_type(2)));
DEV unsigned pk2(float a, float b) { const f32x2 v = {a, b}; return __builtin_bit_cast(unsigned, __builtin_convertvector(v, bf16x2_t)); }
DEV float bflo(unsigned u) { return __uint_as_float(u << 16); }
DEV float bfhi(unsigned u) { return __uint_as_float(u & 0xffff0000u); }
template <int M> DEV float xlane(float v) {
    const int i = __builtin_bit_cast(int, v);
    if constexpr (M == 1) return __builtin_bit_cast(float, __builtin_amdgcn_mov_dpp(i, 0xB1, 0xF, 0xF, true));
    else if constexpr (M == 2) return __builtin_bit_cast(float, __builtin_amdgcn_mov_dpp(i, 0x4E, 0xF, 0xF, true));
    else if constexpr (M == 8) return __builtin_bit_cast(float, __builtin_amdgcn_mov_dpp(i, 0x128, 0xF, 0xF, true));
    else if constexpr (M == 4 || M == 16) return __builtin_bit_cast(float, __builtin_amdgcn_ds_swizzle(i, (M << 10) | 0x1F));
    else { static_assert(M == 32, "xlane"); const auto r = __builtin_amdgcn_permlane32_swap((unsigned)i, (unsigned)i, false, false);
        return __builtin_bit_cast(float, (int)(r[0] ^ r[1] ^ (unsigned)i)); }
}
DEV float wave_sum(float v) { v += xlane<32>(v); v += xlane<16>(v); v += xlane<8>(v); v += xlane<4>(v); v += xlane<2>(v); v += xlane<1>(v); return v; }
DEV float wave_max(float v) { v = fmaxf(v, xlane<32>(v)); v = fmaxf(v, xlane<16>(v)); v = fmaxf(v, xlane<8>(v)); v = fmaxf(v, xlane<4>(v)); v = fmaxf(v, xlane<2>(v)); return fmaxf(v, xlane<1>(v)); }
DEV float grp_sum16(float v) { v += xlane<1>(v); v += xlane<2>(v); v += xlane<4>(v); v += xlane<8>(v); return v; }
DEV float silu_f(float x) { return x / (1.f + __expf(-x)); }
DEV float gelu_fast(float x) { const float u = 1.5957691216057308f * (x + 0.044715f * x * x * x); return x * __builtin_amdgcn_rcpf(1.f + __expf(-u)); }
DEV void tok_info(int tok, int& b, int& pos, int& key, bool& isctx) {
    if (tok < NLAT) { b = tok >> 11; pos = tok & 2047; key = CL + pos; isctx = false; }
    else { const int c = tok - NLAT; b = c >> 8; pos = c & 255; key = pos; isctx = true; }
}
DEV bf16x8 lds_r128(LAS const char* p) { return *(LAS const bf16x8*)p; }

typedef const __attribute__((address_space(4))) Params* ParamsPtr;
struct Ctx {
    ParamsPtr p; int layer; int bid, nb, tid; LAS char* lds;
    DEV const float* in(int i) const { return p->in[i]; }
    template <class T> DEV T* ws(size_t off) const { return (T*)(p->ws + off); }
    DEV const float* modv(int mb, int chunk) const { return ws<float>(WS_MODV) + ((size_t)(layer * 9 + mb) * 6 + chunk) * 1024; }
    DEV const float* xin(int tok) const { return tok < NLAT ? p->in[I_X] + (size_t)tok * DM : p->in[I_CTX] + (size_t)(tok - NLAT) * DM; }
    DEV bf16_t* xs(int tok) const { return ws<bf16_t>(WS_XS) + (size_t)tok * DM; }
    DEV f32x4 xload4(int tok, int n) const {
        if (layer == 0) return *(const f32x4*)(xin(tok) + n);
        const u32x2 r = *(const u32x2*)(xs(tok) + n); return (f32x4){bflo(r[0]), bfhi(r[0]), bflo(r[1]), bfhi(r[1])};
    }
    DEV f32x4 xsload4(int tok, int n) const { const u32x2 r = *(const u32x2*)(xs(tok) + n); return (f32x4){bflo(r[0]), bfhi(r[0]), bflo(r[1]), bfhi(r[1])}; }
    DEV void xsstore4(int tok, int n, float a, float b, float c2, float d) const { *(u32x2*)(xs(tok) + n) = (u32x2){pk2(a, b), pk2(c2, d)}; }
    DEV int ntok_tail() const { return layer == NL - 1 ? NLAT : NTOK; }
};

struct GemmDesc {
    const bf16_t* A; int lda; const int* rowidx; int nvalid;
    const bf16_t* B0; const bf16_t* B1; int ldb; int ksplit; int K;
};
template <int WN_, int MF, class Epi>
DEV void gemm_tile(const GemmDesc& g, int m0, int n0, LAS char* lds, int tid, const Epi& epi) {
    constexpr int BM = (8 / WN_) * 16 * MF, BN = 64 * WN_, NPA = BM / 8, APW = (NPA + 7) / 8, BP = WN_, STAGE = (BM + BN) * 128;
    static_assert(BM % 8 == 0 && 2 * STAGE <= LDS_BAR, "tile does not fit");
    const int lane = tid & 63, wave = __builtin_amdgcn_readfirstlane(tid >> 6), wm = wave / WN_, wn = wave % WN_;
    int aoff[APW], boff[BP];
#pragma unroll
    for (int j = 0; j < APW; ++j) {
        const int pc = (j * 8 + wave < NPA) ? j * 8 + wave : wave;
        const int r = pc * 8 + (lane >> 3), kc = (lane & 7) ^ ((r >> 1) & 7);
        const int srow = g.rowidx ? g.rowidx[(r < g.nvalid) ? r : 0] : (m0 + r);
        aoff[j] = srow * g.lda + kc * 8;
    }
#pragma unroll
    for (int j = 0; j < BP; ++j) {
        const int r = (j * 8 + wave) * 8 + (lane >> 3), kc = (lane & 7) ^ ((r >> 1) & 7);
        boff[j] = (n0 + r) * g.ldb + kc * 8;
    }
    f32x4 acc[4][MF];
#pragma unroll
    for (int i = 0; i < 4; ++i)
#pragma unroll
        for (int j = 0; j < MF; ++j) acc[i][j] = (f32x4){0.f, 0.f, 0.f, 0.f};
    const int nk = g.K / 64;
    const int swz = (lane >> 1) & 7, q = lane >> 4;
    const int arow = (16 * MF * wm + (lane & 15)) * 128, brow = (64 * wn + (lane & 15)) * 128;
    LAS char* pieceA = lds + wave * 1024;
    LAS char* pieceB = lds + BM * 128 + wave * 1024;
#define GT_STAGE(KT, ST) { const int k0_ = (KT) * 64; const bf16_t* Bb_ = (k0_ < g.ksplit) ? g.B0 + k0_ : g.B1 + (k0_ - g.ksplit); \
        _Pragma("unroll") for (int j = 0; j < APW; ++j) if (NPA % 8 == 0 || j * 8 + wave < NPA) __builtin_amdgcn_global_load_lds((const void*)(g.A + aoff[j] + k0_), (LAS void*)(pieceA + (ST) * STAGE + j * 8192), 16, 0, 0); \
        _Pragma("unroll") for (int j = 0; j < BP; ++j) __builtin_amdgcn_global_load_lds((const void*)(Bb_ + boff[j]), (LAS void*)(pieceB + (ST) * STAGE + j * 8192), 16, 0, 0); }
#define GT_COMPUTE(ST) { LAS const char* As_ = lds + (ST) * STAGE; LAS const char* Bs_ = As_ + BM * 128; \
        _Pragma("unroll") for (int ks = 0; ks < 2; ++ks) { const int ch = ((4 * ks + q) ^ swz) << 4; bf16x8 bfr[4]; \
            _Pragma("unroll") for (int f = 0; f < 4; ++f) bfr[f] = lds_r128(Bs_ + brow + f * 2048 + ch); \
            _Pragma("unroll") for (int mh = 0; mh < MF; mh += 4) { bf16x8 af[4]; \
                _Pragma("unroll") for (int f = 0; f < 4; ++f) af[f] = lds_r128(As_ + arow + (mh + f) * 2048 + ch); \
                _Pragma("unroll") for (int mf = 0; mf < 4; ++mf) _Pragma("unroll") for (int nf = 0; nf < 4; ++nf) \
                    acc[nf][mh + mf] = __builtin_amdgcn_mfma_f32_16x16x32_bf16(bfr[nf], af[mf], acc[nf][mh + mf], 0, 0, 0); } } }
    __syncthreads();
    GT_STAGE(0, 0);
    asm volatile("s_waitcnt vmcnt(0)" ::: "memory");
    __syncthreads();
#pragma unroll 1
    for (int kt = 0; kt < nk; kt += 2) {
        GT_STAGE(kt + 1, 1);
        GT_COMPUTE(0);
        asm volatile("s_waitcnt vmcnt(0)" ::: "memory");
        __syncthreads();
        if (kt + 2 < nk) GT_STAGE(kt + 2, 0);
        GT_COMPUTE(1);
        asm volatile("s_waitcnt vmcnt(0)" ::: "memory");
        __syncthreads();
    }
#undef GT_STAGE
#undef GT_COMPUTE
    {
        int lane_e = lane, mb_e = 16 * MF * wm, nb_e = n0 + 64 * wn;
        asm volatile("" : "+v"(lane_e), "+v"(mb_e), "+v"(nb_e));
        epi(acc, mb_e, __builtin_amdgcn_readfirstlane(nb_e), lane_e);
    }
}

DEV int p8_lds_lo(int fr, int fq) { return (fr * 64 + fq * 16) ^ ((fr >> 3) << 5); }
DEV void p8_stage_rc(int b, int& R, int& C) { const int st = b >> 10, sb = b & 1023, swz = sb ^ (((sb >> 9) & 1) << 5); R = (st >> 1) * 16 + (swz >> 6); C = (st & 1) * 32 + ((swz & 63) >> 1); }
template <class Epi>
DEV void gemm_tile8p(const GemmDesc& g, int m0, int n0, LAS char* lds, int tid, const Epi& epi) {
    const int wid = __builtin_amdgcn_readfirstlane(tid >> 6), lane = tid & 63, wr = wid >> 2, wc = wid & 3, fr = lane & 15, fq = lane >> 4;
    int aoff[2][2], boff[2][2];
#pragma unroll
    for (int i = 0; i < 2; ++i) { int R, C; p8_stage_rc(tid * 16 + i * 8192, R, C);
#pragma unroll
        for (int h = 0; h < 2; ++h) { const int r = h * 128 + R;
            const int srow = g.rowidx ? g.rowidx[(r < g.nvalid) ? r : 0] : (m0 + r);
            aoff[h][i] = srow * g.lda + C; boff[h][i] = (n0 + r) * g.ldb + C; } }
    const int lo = p8_lds_lo(fr, fq);
    LAS char* const stg = lds + wid * 1024;
    LAS const char* const rdA = lds + wr * 8192 + lo;
    LAS const char* const rdB = lds + 65536 + wc * 4096 + lo;
    f32x4 acc[2][2][4][2];
#pragma unroll
    for (int a = 0; a < 2; ++a)
#pragma unroll
        for (int b = 0; b < 2; ++b)
#pragma unroll
            for (int m = 0; m < 4; ++m) { acc[a][b][m][0] = (f32x4){0.f, 0.f, 0.f, 0.f}; acc[a][b][m][1] = acc[a][b][m][0]; }
    bf16x8 At[4][2], B0[2][2], B1[2][2];
    const int nt = g.K / 64;
#define P8_BOFF(kt) (((kt) * 64 < g.ksplit) ? g.B0 + (kt) * 64 : g.B1 + ((kt) * 64 - g.ksplit))
#define STAGE_A(b, h, kt) { _Pragma("unroll") for (int i_ = 0; i_ < 2; ++i_) __builtin_amdgcn_global_load_lds((const void*)(g.A + aoff[h][i_] + (kt) * 64), (LAS void*)(stg + ((b) * 2 + (h)) * 16384 + i_ * 8192), 16, 0, 0); }
#define STAGE_B(b, h, kt) { const bf16_t* Bb_ = P8_BOFF(kt); _Pragma("unroll") for (int i_ = 0; i_ < 2; ++i_) __builtin_amdgcn_global_load_lds((const void*)(Bb_ + boff[h][i_]), (LAS void*)(stg + 65536 + ((b) * 2 + (h)) * 16384 + i_ * 8192), 16, 0, 0); }
#define LDA(b, h) { _Pragma("unroll") for (int m = 0; m < 4; ++m) _Pragma("unroll") for (int k = 0; k < 2; ++k) At[m][k] = lds_r128(rdA + ((b) * 2 + (h)) * 16384 + (m * 2 + k) * 1024); }
#define LDB(dst, b, h) { _Pragma("unroll") for (int n = 0; n < 2; ++n) _Pragma("unroll") for (int k = 0; k < 2; ++k) dst[n][k] = lds_r128(rdB + ((b) * 2 + (h)) * 16384 + (n * 2 + k) * 1024); }
#define MMA(ai, bj, Bx) { __builtin_amdgcn_s_setprio(1); \
        _Pragma("unroll") for (int m = 0; m < 4; ++m) _Pragma("unroll") for (int n = 0; n < 2; ++n) _Pragma("unroll") for (int k = 0; k < 2; ++k) \
            acc[ai][bj][m][n] = __builtin_amdgcn_mfma_f32_16x16x32_bf16(Bx[n][k], At[m][k], acc[ai][bj][m][n], 0, 0, 0); \
        __builtin_amdgcn_s_setprio(0); }
#define WAIT_V(n) asm volatile("s_waitcnt vmcnt(" #n ")" ::: "memory")
#define WAIT_L(n) asm volatile("s_waitcnt lgkmcnt(" #n ")" ::: "memory")
#define BAR __builtin_amdgcn_s_barrier()
#define SCHED __builtin_amdgcn_sched_barrier(0)
    __syncthreads();
    STAGE_B(0, 0, 0); STAGE_A(0, 0, 0); STAGE_B(0, 1, 0); STAGE_A(0, 1, 0);
    if (wr == 1) BAR;
    WAIT_V(4); BAR;
    STAGE_B(1, 0, 1); STAGE_A(1, 0, 1); STAGE_B(1, 1, 1);
    WAIT_V(6); BAR;
#pragma unroll 1
    for (int t = 0; t < nt - 2; t += 2) {
        LDB(B0, 0, 0); SCHED; LDA(0, 0); STAGE_A(1, 1, t + 1);
        WAIT_L(8); BAR; WAIT_L(0); MMA(0, 0, B0); BAR; SCHED;
        LDB(B1, 0, 1); STAGE_B(0, 0, t + 2);
        BAR; WAIT_L(0); MMA(0, 1, B1); BAR;
        LDA(0, 1); STAGE_A(0, 0, t + 2);
        BAR; WAIT_L(0); MMA(1, 0, B0); BAR; SCHED;
        STAGE_B(0, 1, t + 2);
        WAIT_V(6); BAR; MMA(1, 1, B1); BAR;
        LDB(B0, 1, 0); SCHED; LDA(1, 0); STAGE_A(0, 1, t + 2);
        WAIT_L(8); BAR; WAIT_L(0); MMA(0, 0, B0); BAR; SCHED;
        LDB(B1, 1, 1); STAGE_B(1, 0, t + 3);
        BAR; WAIT_L(0); MMA(0, 1, B1); BAR;
        LDA(1, 1); STAGE_A(1, 0, t + 3);
        BAR; WAIT_L(0); MMA(1, 0, B0); BAR; SCHED;
        STAGE_B(1, 1, t + 3);
        WAIT_V(6); BAR; MMA(1, 1, B1); BAR;
    }
    {
        LDB(B0, 0, 0); LDA(0, 0); STAGE_A(1, 1, nt - 1);
        BAR; WAIT_L(0); MMA(0, 0, B0); BAR;
        LDB(B1, 0, 1); BAR; WAIT_L(0); MMA(0, 1, B1); BAR;
        LDA(0, 1); WAIT_V(4); BAR; WAIT_L(0); MMA(1, 0, B0); MMA(1, 1, B1); BAR; }
    {
        LDB(B0, 1, 0); LDA(1, 0); WAIT_V(2); BAR; WAIT_L(0); MMA(0, 0, B0); BAR;
        LDB(B1, 1, 1); WAIT_V(0); BAR; WAIT_L(0); MMA(0, 1, B1); BAR;
        LDA(1, 1); BAR; WAIT_L(0); MMA(1, 0, B0); MMA(1, 1, B1); BAR; }
    if (wr == 0) BAR;
#undef P8_BOFF
#undef STAGE_A
#undef STAGE_B
#undef LDA
#undef LDB
#undef MMA
#undef WAIT_V
#undef WAIT_L
#undef BAR
#undef SCHED
    {
        int lane_e = lane, wr_e = wr, wc_e = wc;
        asm volatile("" : "+v"(lane_e), "+s"(wr_e), "+s"(wc_e));
        epi(acc, wr_e, wc_e, lane_e);
    }
}

DEV void p0_transpose(const float* W, int K, int N, bf16_t* WT, int kt, int nt, int mode, const float* kscale, LAS float* scr, int tid) {
    {
        const int n4 = (tid & 15) * 4, kr = tid >> 4, n_in = nt * 64 + n4;
#pragma unroll
        for (int i = 0; i < 2; ++i) { const int kk = kr + 32 * i; const float s = kscale ? kscale[kt * 64 + kk] : 1.f;
            f32x4 v = (f32x4){0.f, 0.f, 0.f, 0.f};
            if (n_in < N) v = *(const f32x4*)(W + (size_t)(kt * 64 + kk) * N + n_in);
            scr[kk * 65 + n4] = s * v[0]; scr[kk * 65 + n4 + 1] = s * v[1]; scr[kk * 65 + n4 + 2] = s * v[2]; scr[kk * 65 + n4 + 3] = s * v[3]; }
    }
    __syncthreads();
    const int nl = tid >> 3, kcq = tid & 7, n = nt * 64 + nl;
    if (n < N) {
        int drow = n;
        if (mode == 1) { const int type = n >> 8, j = n & 255; drow = 128 * (j >> 6) + 64 * ((j >> 5) & 1) + 16 * (((j >> 4) & 1) + 2 * type) + (j & 15); }
        if (mode == 2) { const int h = n / 96, cc = n % 96; drow = cc < 64 ? 64 * h + cc : 256 + 32 * h + (cc - 64); }
        if (mode == 3) drow = (n & ~255) | (((n >> 5) & 1) << 7) | (((n >> 6) & 3) << 5) | (n & 31);
        unsigned o[4];
#pragma unroll
        for (int j = 0; j < 4; ++j) o[j] = pk2(scr[(kcq * 8 + 2 * j) * 65 + nl], scr[(kcq * 8 + 2 * j + 1) * 65 + nl]);
        *(u32x4*)(WT + (size_t)drow * K + kt * 64 + kcq * 8) = (u32x4){o[0], o[1], o[2], o[3]};
    }
    __syncthreads();
}
constexpr int T_IN = 16 * 35, T_OUT = 16 * 16, T_UP = 16 * 16 * 8, T_DN = 16 * 4 * 16, T_QB = 4 * 6, T_KVB = 2 * 8;
constexpr int T_LAYER = T_IN + T_OUT + T_UP + T_DN + T_QB + T_KVB;
constexpr int P0_TR = NL * T_LAYER, P0_WSG = 32, P0_MODV = NL * 192, P0_ROPE = 192, P0_PAD = 48;
constexpr int P0_ITEMS = P0_TR + P0_WSG + P0_MODV + P0_ROPE + P0_PAD;

DEV void p0_expert_item(const Ctx& c, int l, int item, LAS float* scr, int tid) {
    if (item < T_UP) { const int e = item / 128, q = item % 128;
        p0_transpose(c.in(I_WUP) + ((size_t)l * 16 + e) * 1024 * 512, 1024, 512, c.ws<bf16_t>(WS_WUP) + (size_t)e * 512 * 1024, q / 8, q % 8, 1, nullptr, scr, tid); }
    else { const int r = item - T_UP, e = r / 64, q = r % 64;
        p0_transpose(c.in(I_WDN) + ((size_t)l * 16 + e) * 256 * 1024, 256, 1024, c.ws<bf16_t>(WS_WDN) + (size_t)e * 1024 * 256, q / 16, q % 16, 0, nullptr, scr, tid); }
}
DEV void phase_p0(const Ctx& c) {
    const int tid = c.tid;
    LAS float* scr = (LAS float*)c.lds;
    for (int it = c.bid; it < P0_ITEMS; it += c.nb) {
        int r = it;
        if (r < P0_TR) {
            const int l = r / T_LAYER; r -= l * T_LAYER;
            if (r < T_IN) { p0_transpose(c.in(I_WIN) + (size_t)l * 1024 * INC, 1024, INC, c.ws<bf16_t>(WS_WIN) + (size_t)l * INCP * 1024, r / 35, r % 35, 0, nullptr, scr, tid); continue; } r -= T_IN;
            if (r < T_OUT) { p0_transpose(c.in(I_WOUT) + (size_t)l * 1024 * 1024, 1024, 1024, c.ws<bf16_t>(WS_WOUT) + (size_t)l * 1024 * 1024, r / 16, r % 16, 3, nullptr, scr, tid); continue; } r -= T_OUT;
            if (r < T_UP) { if (l == 0) p0_expert_item(c, 0, r, scr, tid); continue; } r -= T_UP;
            if (r < T_DN) { if (l == 0) p0_expert_item(c, 0, T_UP + r, scr, tid); continue; } r -= T_DN;
            if (r < T_QB) { p0_transpose(c.in(I_WQB) + (size_t)l * 256 * 384, 256, 384, c.ws<bf16_t>(WS_WQB) + (size_t)l * 384 * 256, r / 6, r % 6, 2, c.in(I_QAG) + l * 256, scr, tid); continue; } r -= T_QB;
            p0_transpose(c.in(I_WKVB) + (size_t)l * 128 * 512, 128, 512, c.ws<bf16_t>(WS_WKVB) + (size_t)l * 512 * 128, r / 8, r % 8, 0, c.in(I_KVAG) + l * 128, scr, tid); continue;
        }
        r -= P0_TR;
        if (r < P0_WSG) {
            const size_t e0 = ((size_t)r * NTHREADS + tid) * 8; const float* s = c.in(I_SGUW) + e0;
            const f32x4 a = *(const f32x4*)s, b = *(const f32x4*)(s + 4);
            *(u32x4*)(c.ws<bf16_t>(WS_WSG) + e0) = (u32x4){pk2(a[0], a[1]), pk2(a[2], a[3]), pk2(b[0], b[1]), pk2(b[2], b[3])};
            continue;
        }
        r -= P0_WSG;
        if (r < P0_MODV) {
            const int l = r / 192, n0 = (r % 192) * 32;
            LAS float* sc = scr;
            LAS float* red = scr + 9 * 1024;
            __syncthreads();
            for (int i = tid; i < 9 * 1024; i += NTHREADS) { const int mb = i >> 10, k = i & 1023; sc[i] = silu_f(mb < 8 ? c.in(I_C)[mb * 1024 + k] : c.in(I_CCTX)[k]); }
            __syncthreads();
            const int kq = tid >> 3, nl = tid & 7;
            float a[9][4];
#pragma unroll
            for (int j = 0; j < 9; ++j) { a[j][0] = 0.f; a[j][1] = 0.f; a[j][2] = 0.f; a[j][3] = 0.f; }
            const float* wp = c.in(I_WMOD) + (size_t)l * 1024 * 6144 + n0 + 4 * nl;
#pragma unroll 8
            for (int k2 = 0; k2 < 16; ++k2) { const int k = kq * 16 + k2; const f32x4 w = *(const f32x4*)(wp + (size_t)k * 6144);
#pragma unroll
                for (int j = 0; j < 9; ++j) { const float s = sc[j * 1024 + k]; a[j][0] += s * w[0]; a[j][1] += s * w[1]; a[j][2] += s * w[2]; a[j][3] += s * w[3]; } }
#pragma unroll
            for (int j = 0; j < 9; ++j)
#pragma unroll
                for (int q = 0; q < 4; ++q) { float v = a[j][q]; v += xlane<8>(v); v += xlane<16>(v); v += xlane<32>(v); a[j][q] = v; }
            if ((tid & 63) < 8) {
#pragma unroll
                for (int j = 0; j < 9; ++j)
#pragma unroll
                    for (int q = 0; q < 4; ++q) red[((tid >> 6) * 9 + j) * 32 + 4 * nl + q] = a[j][q];
            }
            __syncthreads();
            for (int i = tid; i < 9 * 32; i += NTHREADS) { const int mb = i >> 5, n = i & 31;
                float v = 0.f;
#pragma unroll
                for (int w = 0; w < NW; ++w) v += red[(w * 9 + mb) * 32 + n];
                c.ws<float>(WS_MODV)[(size_t)(l * 9 + mb) * 6144 + n0 + n] = v + c.in(I_BMOD)[l * 6144 + n0 + n]; }
            __syncthreads();
            continue;
        }
        r -= P0_MODV;
        if (r < P0_ROPE) {
            const int idx = r * NTHREADS + tid;
            if (idx < 2048 * 32) { const int s = idx >> 5, i = idx & 31, f = i & 15; const float pos = (float)((i < 16) ? (s >> 6) : (s & 63));
                const float inv = powf(10000.f, -(float)f / 16.f), ang = pos * inv;
                c.ws<float>(WS_ROPEC)[idx] = cosf(ang); c.ws<float>(WS_ROPEC)[2048 * 32 + idx] = sinf(ang); }
            else { const int j = idx - 2048 * 32, s = j >> 4, i = j & 15, f = i & 7; const float pos = (float)((i < 8) ? (s >> 6) : (s & 63));
                const float inv = powf(10000.f, -(float)f / 8.f), ang = pos * inv;
                c.ws<float>(WS_ROPED)[j] = cosf(ang); c.ws<float>(WS_ROPED)[2048 * 16 + j] = sinf(ang); }
            continue;
        }
        r -= P0_ROPE;
        {
            const int e = (r * NTHREADS + tid) * 8, l = e / (96 * 1024), o = e % (96 * 1024);
            unsigned z = 0u; asm volatile("" : "+v"(z));
            *(u32x4*)(c.ws<bf16_t>(WS_WIN) + ((size_t)l * INCP + INC) * 1024 + o) = (u32x4){z, z, z, z};
        }
    }
}

constexpr int A_RW_ITEMS = NL * 9 * 1024 / NTHREADS;
constexpr int A_RC_ITEMS = NL * 9 * 20 / NW;
DEV void phase_a(const Ctx& c) {
    const int tid = c.tid, lane = tid & 63, wave = tid >> 6;
    const float* g = c.in(I_GATTN) + c.layer * 1024;
    bf16_t* H = c.ws<bf16_t>(WS_ACT);
    const int nwv = c.nb * NW, per = (NTOK + nwv - 1) / nwv, tbeg = (c.bid * NW + wave) * per, tend = min(tbeg + per, NTOK);
    int mbc = -1; f32x4 gm[4], sv[4];
#pragma unroll 1
    for (int t0 = tbeg; t0 < tend; t0 += 3) {
        f32x4 v[3][4];
#pragma unroll
        for (int u = 0; u < 3; ++u) { const int tok = min(t0 + u, tend - 1);
#pragma unroll
            for (int i = 0; i < 4; ++i) v[u][i] = c.xload4(tok, i * 256 + lane * 4); }
#pragma unroll
        for (int u = 0; u < 3; ++u) { const int tok = t0 + u;
            if (tok < tend) {
                const int mb = tok < NLAT ? (tok >> 11) : 8;
                if (mb != mbc) { mbc = mb; const float* sh = c.modv(mb, 0); const float* scl = c.modv(mb, 1);
#pragma unroll
                    for (int i = 0; i < 4; ++i) { const int e = i * 256 + lane * 4; const f32x4 gg = *(const f32x4*)(g + e), s1 = *(const f32x4*)(scl + e);
                        gm[i] = (f32x4){gg[0] * (1.f + s1[0]), gg[1] * (1.f + s1[1]), gg[2] * (1.f + s1[2]), gg[3] * (1.f + s1[3])}; sv[i] = *(const f32x4*)(sh + e); } }
                float ss = 0.f;
#pragma unroll
                for (int i = 0; i < 4; ++i) ss += v[u][i][0] * v[u][i][0] + v[u][i][1] * v[u][i][1] + v[u][i][2] * v[u][i][2] + v[u][i][3] * v[u][i][3];
                const float r = rsqrtf(wave_sum(ss) * (1.f / 1024.f) + EPS);
#pragma unroll
                for (int i = 0; i < 4; ++i) { const int e = i * 256 + lane * 4;
                    float o[4];
#pragma unroll
                    for (int j = 0; j < 4; ++j) o[j] = v[u][i][j] * r * gm[i][j] + sv[i][j];
                    *(u32x2*)(H + (size_t)tok * 1024 + e) = (u32x2){pk2(o[0], o[1]), pk2(o[2], o[3])}; }
            } }
    }
    if (c.layer == 0) {
        for (int it = c.bid; it < A_RW_ITEMS + A_RC_ITEMS; it += c.nb) {
            if (it < A_RW_ITEMS) {
                const int idx = it * NTHREADS + tid, l = idx / (9 * 1024), mb = (idx >> 10) % 9, k = idx & 1023;
                const float* mv = c.ws<float>(WS_MODV) + (size_t)(l * 9 + mb) * 6144;
                const float gm = c.in(I_GFFN)[l * 1024 + k] * (1.f + mv[4 * 1024 + k]);
                c.ws<float>(WS_GM)[idx] = gm;
                bf16_t* o = c.ws<bf16_t>(WS_RW) + (size_t)(l * 9 + mb) * 2 * 32 * 1024 + k;
                const float* wg = c.in(I_WRG) + ((size_t)l * 1024 + k) * 4; const float* we = c.in(I_WRE) + ((size_t)l * 1024 + k) * 16;
#pragma unroll
                for (int j = 0; j < 32; ++j) { const float w = j < 20 ? gm * (j < 4 ? wg[j] : we[j - 4]) : 0.f;
                    const bf16_t hi = f2bf(w); o[(size_t)j * 1024] = hi; o[(size_t)(32 + j) * 1024] = f2bf(w - bf2f(hi)); }
            } else {
                const int idx = (it - A_RW_ITEMS) * NW + wave, l = idx / 180, mb = (idx / 20) % 9, j = idx % 20;
                const float* mv = c.ws<float>(WS_MODV) + (size_t)(l * 9 + mb) * 6144 + 3 * 1024;
                float a = 0.f;
                for (int k = lane; k < 1024; k += 64) { const float w = (j < 4) ? c.in(I_WRG)[((size_t)l * 1024 + k) * 4 + j] : c.in(I_WRE)[((size_t)l * 1024 + k) * 16 + (j - 4)]; a += mv[k] * w; }
                a = wave_sum(a);
                if (lane == 0) c.ws<float>(WS_RC)[(l * 9 + mb) * 32 + j] = a + ((j < 4) ? c.in(I_BRG)[l * 4 + j] : c.in(I_BRE)[l * 16 + j - 4]);
            }
        }
    }
}

DEV void rope2(float& a, float& b, float cs, float sn) { const float x0 = a, x1 = b; a = x0 * cs - x1 * sn; b = x0 * sn + x1 * cs; }
DEV float red_q(float v) { v += xlane<16>(v); v += xlane<32>(v); return v; }
template <int MF>
DEV void b_epilogue(const Ctx& c, const f32x4 (&acc)[4][MF], int m0, int mb, int nbase, int lane) {
    const int l = c.layer;
    bf16_t* P = c.ws<bf16_t>(WS_P);
    const int q = lane >> 4, li = lane & 15;
    const bool isctx = m0 >= NLAT;
    if (nbase < 256) {
#pragma unroll
        for (int mf = 0; mf < MF; ++mf) { const int m = m0 + mb + 16 * mf + li;
#pragma unroll
            for (int nf = 0; nf < 4; ++nf) { const f32x4 a = acc[nf][mf];
                *(u32x2*)(P + (size_t)m * INC + nbase + 16 * nf + 4 * q) = (u32x2){pk2(gelu_fast(a[0]), gelu_fast(a[1])), pk2(gelu_fast(a[2]), gelu_fast(a[3]))}; } }
    } else if (nbase < 512) {
        const float* vg = c.in(I_SGUVG) + l * 256 + (nbase - 256) + 4 * q;
#pragma unroll
        for (int mf = 0; mf < MF; ++mf) { const int m = m0 + mb + 16 * mf + li;
            float v[4][4]; float ss = 0.f;
#pragma unroll
            for (int nf = 0; nf < 4; ++nf)
#pragma unroll
                for (int r = 0; r < 4; ++r) { v[nf][r] = gelu_fast(acc[nf][mf][r]); ss += v[nf][r] * v[nf][r]; }
            const float rr = rsqrtf(red_q(ss) * (1.f / 64.f) + EPS);
#pragma unroll
            for (int nf = 0; nf < 4; ++nf) { const f32x4 gg = *(const f32x4*)(vg + 16 * nf);
                *(u32x2*)(P + (size_t)m * INC + nbase + 16 * nf + 4 * q) = (u32x2){pk2(v[nf][0] * rr * gg[0], v[nf][1] * rr * gg[1]), pk2(v[nf][2] * rr * gg[2], v[nf][3] * rr * gg[3])}; } }
    } else if (nbase < OFF_CQ || (nbase >= OFF_DCQ && nbase < OFF_DKR)) {
        const bool need_ss = nbase >= OFF_DCQ;
        const int sidx = nbase < OFF_DCKV ? (nbase - OFF_DCQ) >> 6 : 4 + ((nbase - OFF_DCKV) >> 6);
#pragma unroll
        for (int mf = 0; mf < MF; ++mf) { const int m = m0 + mb + 16 * mf + li; float ss = 0.f;
#pragma unroll
            for (int nf = 0; nf < 4; ++nf) { const f32x4 a = acc[nf][mf]; ss += a[0] * a[0] + a[1] * a[1] + a[2] * a[2] + a[3] * a[3];
                *(u32x2*)(P + (size_t)m * INC + nbase + 16 * nf + 4 * q) = (u32x2){pk2(a[0], a[1]), pk2(a[2], a[3])}; }
            if (need_ss) { ss = red_q(ss); if (q == 0) c.ws<float>(WS_SSQ)[(size_t)m * 8 + sidx] = ss; } }
    } else if (nbase < OFF_CV) {
        const bool isq = nbase < OFF_CK;
        const int h = isq ? (nbase - OFF_CQ) >> 6 : (nbase - OFF_CK) >> 6;
        const float* gn = (isq ? c.in(I_GQAQG) : c.in(I_GQAKG)) + l * 64 + 4 * q;
        const float sc = isq ? C_SCALE * LOG2E : 1.f;
        const float* cosC = c.ws<float>(WS_ROPEC); const float* sinC = cosC + 2048 * 32;
#pragma unroll
        for (int mf = 0; mf < MF; ++mf) { const int m = m0 + mb + 16 * mf + li;
            int b, pos, key; bool ic; tok_info(m, b, pos, key, ic);
            float ss = 0.f;
#pragma unroll
            for (int nf = 0; nf < 4; ++nf) { const f32x4 a = acc[nf][mf]; ss += a[0] * a[0] + a[1] * a[1] + a[2] * a[2] + a[3] * a[3]; }
            const float rr = rsqrtf(red_q(ss) * (1.f / 64.f) + EPS);
            bf16_t* dst = isq ? c.ws<bf16_t>(WS_QC) + ((size_t)(b * 4 + h) * KEYS + key) * 64 : c.ws<bf16_t>(WS_KC) + ((size_t)(b * 2 + h) * KEYS + key) * 64;
#pragma unroll
            for (int nf = 0; nf < 4; ++nf) { const f32x4 gg = *(const f32x4*)(gn + 16 * nf); const f32x4 a = acc[nf][mf];
                float v0 = a[0] * rr * gg[0], v1 = a[1] * rr * gg[1], v2 = a[2] * rr * gg[2], v3 = a[3] * rr * gg[3];
                if (!isctx) { const f32x2 cs = *(const f32x2*)(cosC + pos * 32 + 8 * nf + 2 * q), sn = *(const f32x2*)(sinC + pos * 32 + 8 * nf + 2 * q);
                    rope2(v0, v1, cs[0], sn[0]); rope2(v2, v3, cs[1], sn[1]); }
                *(u32x2*)(dst + 16 * nf + 4 * q) = (u32x2){pk2(v0 * sc, v1 * sc), pk2(v2 * sc, v3 * sc)}; } }
    } else if (nbase < OFF_DCQ) {
        const int kvh = (nbase - OFF_CV) >> 6;
#pragma unroll
        for (int mf = 0; mf < MF; ++mf) { const int m = m0 + mb + 16 * mf + li;
            int b, pos, key; bool ic; tok_info(m, b, pos, key, ic);
            bf16_t* dst = c.ws<bf16_t>(WS_VCT) + ((size_t)(b * 2 + kvh) * 64 + 4 * q) * KEYS + key;
#pragma unroll
            for (int nf = 0; nf < 4; ++nf) { const f32x4 a = acc[nf][mf]; const unsigned p0 = pk2(a[0], a[1]), p1 = pk2(a[2], a[3]);
                bf16_t* d = dst + (size_t)(16 * nf) * KEYS;
                d[0] = (bf16_t)(p0 & 0xffffu); d[KEYS] = (bf16_t)(p0 >> 16); d[2 * KEYS] = (bf16_t)(p1 & 0xffffu); d[3 * KEYS] = (bf16_t)(p1 >> 16); } }
    } else if (nbase < OFF_DKR + 64) {
        const float* gn = c.in(I_MLAKG) + l * 96 + 64 + 4 * q;
        const float* cosD = c.ws<float>(WS_ROPED); const float* sinD = cosD + 2048 * 16;
#pragma unroll
        for (int mf = 0; mf < MF; ++mf) { const int m = m0 + mb + 16 * mf + li;
            int b, pos, key; bool ic; tok_info(m, b, pos, key, ic);
            float ss = 0.f;
#pragma unroll
            for (int nf = 0; nf < 2; ++nf) { const f32x4 a = acc[nf][mf]; ss += a[0] * a[0] + a[1] * a[1] + a[2] * a[2] + a[3] * a[3]; }
            const float rr = rsqrtf(red_q(ss) * (1.f / 32.f) + EPS);
#pragma unroll
            for (int nf = 0; nf < 2; ++nf) { const f32x4 gg = *(const f32x4*)(gn + 16 * nf); const f32x4 a = acc[nf][mf];
                float v0 = a[0] * rr * gg[0], v1 = a[1] * rr * gg[1], v2 = a[2] * rr * gg[2], v3 = a[3] * rr * gg[3];
                if (!isctx) { const f32x2 cs = *(const f32x2*)(cosD + pos * 16 + 8 * nf + 2 * q), sn = *(const f32x2*)(sinD + pos * 16 + 8 * nf + 2 * q);
                    rope2(v0, v1, cs[0], sn[0]); rope2(v2, v3, cs[1], sn[1]); }
                const u32x2 o = (u32x2){pk2(v0, v1), pk2(v2, v3)};
#pragma unroll
                for (int h = 0; h < 4; ++h) *(u32x2*)(c.ws<bf16_t>(WS_KD) + ((size_t)(b * 4 + h) * KEYS + key) * 96 + 64 + 16 * nf + 4 * q) = o; } }
    }
}
DEV void phase_b(const Ctx& c) {
    const int l = c.layer;
    GemmDesc g; g.A = c.ws<bf16_t>(WS_ACT); g.lda = 1024; g.rowidx = nullptr; g.nvalid = 0;
    g.B0 = c.ws<bf16_t>(WS_WIN) + (size_t)l * INCP * 1024; g.B1 = g.B0; g.ldb = 1024; g.ksplit = 1 << 30; g.K = 1024;
    constexpr int NT_N = INCP / 256, NT_M = NTOK / 256;
    auto full_tile = [&](int mt, int nt) { const int m0 = mt * 256;
        gemm_tile<4, 8>(g, m0, nt * 256, c.lds, c.tid, [&](const f32x4 (&acc)[4][8], int mb, int nbase, int lane) { b_epilogue<8>(c, acc, m0, mb, nbase, lane); }); };
    if (c.nb != 256) { for (int t = c.bid; t < NT_M * NT_N; t += c.nb) full_tile(t / NT_N, t % NT_N); }
    else if (l < NL - 1) {
        const int nmine = c.bid < 136 ? 3 : 2;
        for (int rd = 0; rd < nmine; ++rd) {
            int mt, nt, ex = -1, ch = -1;
            if (c.bid >= 136) ex = (c.bid - 136) + 120 * rd;
            else if (rd == 0) { if (c.bid < 48) ex = 240 + c.bid; else ch = c.bid - 48; }
            else ch = 88 + 136 * (rd - 1) + c.bid;
            if (ex >= 0) { const int k = ex / 72; nt = k == 0 ? 5 : (k == 1 ? 6 : (k == 2 ? 1 : 0)); mt = ex % 72; }
            else { const int k = ch / 72; nt = k < 3 ? 2 + k : 4 + k; mt = ch % 72; }
            full_tile(mt, nt);
        }
    } else {
        auto unit = [&](int u, int& mt, int& nt) {
            if (u < 256) { const int k = u >> 6; nt = k == 0 ? 5 : (k == 1 ? 6 : (k == 2 ? 1 : 0)); mt = u & 63; }
            else if (u < 576) { const int v = u - 256, k = v >> 6; nt = k < 3 ? 2 + k : 4 + k; mt = v & 63; }
            else { const int v = u - 576; nt = (v >> 3) ? 8 : 6; mt = 64 + (v & 7); } };
        for (int rd = 0; rd < 2; ++rd) { int mt, nt; unit(c.bid + 256 * rd, mt, nt); full_tile(mt, nt); }
        if (c.bid < 160) { int mt, nt; unit(512 + (c.bid >> 1), mt, nt); const int m0 = mt * 256;
            gemm_tile<2, 4>(g, m0, nt * 256 + (c.bid & 1) * 128, c.lds, c.tid, [&](const f32x4 (&acc)[4][4], int mb, int nbase, int lane) { b_epilogue<4>(c, acc, m0, mb, nbase, lane); }); }
    }
    if (l > 0) {
        for (int e = c.bid; e < T_UP + T_DN; e += c.nb) p0_expert_item(c, l, e, (LAS float*)c.lds, c.tid);
    }
}

constexpr int C_SGU_ITEMS = (NTOK / 128) * 4, C_TQ = (NTOK / 256) * 3, C_TKV = (NTOK / 256) * 4;
constexpr int SG_LD = 272;
DEV void phase_c_sgu(const Ctx& c, int item) {
    const int tid = c.tid, lane = tid & 63, wave = tid >> 6, l = c.layer;
    const int chunk = item >> 2, h = item & 3, tok0 = chunk * 128;
    const bf16_t* P = c.ws<bf16_t>(WS_P);
    LAS char* Wt = c.lds;
    LAS char* vT = c.lds + 128 * SG_LD;
    __syncthreads();
    {
        const bf16_t* Wsrc = c.ws<bf16_t>(WS_WSG) + (size_t)(l * 4 + h) * 128 * 128;
#pragma unroll
        for (int i = 0; i < 4; ++i) { const int ci = tid + NTHREADS * i, r = ci >> 4, kc = ci & 15; *(LAS u32x4*)(Wt + r * SG_LD + kc * 16) = *(const u32x4*)(Wsrc + r * 128 + kc * 8); }
        const int j = tid >> 2, qt = tid & 3;
        const bf16_t* vp = P + (size_t)(tok0 + j) * INC + OFF_AV + 64 * h + 16 * qt;
#pragma unroll
        for (int q = 0; q < 2; ++q) { const u32x4 raw = *(const u32x4*)(vp + 8 * q);
#pragma unroll
            for (int e = 0; e < 4; ++e) { LAS char* d = vT + (16 * qt + 8 * q + 2 * e) * SG_LD + j * 2;
                *(LAS bf16_t*)d = (bf16_t)(raw[e] & 0xffffu); *(LAS bf16_t*)(d + SG_LD) = (bf16_t)(raw[e] >> 16); } }
    }
    __syncthreads();
    f32x4 acc[4];
#pragma unroll
    for (int a = 0; a < 4; ++a) acc[a] = (f32x4){0.f, 0.f, 0.f, 0.f};
    const int q = lane >> 4, li = lane & 15;
#pragma unroll
    for (int ks = 0; ks < 4; ++ks) {
        bf16x8 af[4];
#pragma unroll
        for (int df = 0; df < 4; ++df) af[df] = lds_r128(vT + (16 * df + li) * SG_LD + (4 * ks + q) * 16);
        const bf16x8 bfr = lds_r128(Wt + (16 * wave + li) * SG_LD + (4 * ks + q) * 16);
#pragma unroll
        for (int df = 0; df < 4; ++df) acc[df] = __builtin_amdgcn_mfma_f32_16x16x32_bf16(af[df], bfr, acc[df], 0, 0, 0);
    }
    bf16_t* Y = c.ws<bf16_t>(WS_ACT);
    {
        const int i = 16 * wave + li, tok = tok0 + i;
        const float bs = c.in(I_SGUB)[(l * 4 + h) * 128 + i];
#pragma unroll
        for (int df = 0; df < 4; ++df) {
            const int d0 = 16 * df + 4 * q;
            const u32x2 ur = *(const u32x2*)(P + (size_t)tok * INC + OFF_AU + 64 * h + d0);
            const f32x4 a = acc[df];
            *(u32x2*)(Y + (size_t)tok * 1024 + 64 * h + d0) = (u32x2){pk2(bflo(ur[0]) * (a[0] + bs), bfhi(ur[0]) * (a[1] + bs)), pk2(bflo(ur[1]) * (a[2] + bs), bfhi(ur[1]) * (a[3] + bs))};
        }
    }
}
DEV void phase_c(const Ctx& c) {
    const int l = c.layer;
    const bf16_t* P = c.ws<bf16_t>(WS_P);
    const float* cosD = c.ws<float>(WS_ROPED); const float* sinD = cosD + 2048 * 16;
    int it = c.bid;
    const bool lastl = (l == NL - 1);
    for (; it < C_SGU_ITEMS; it += c.nb) { if (!(lastl && (it >> 2) >= NLAT / 128)) phase_c_sgu(c, it); }
    for (; it < C_SGU_ITEMS + C_TQ; it += c.nb) {
        const int t = it - C_SGU_ITEMS, mt = t / 3, nt = t % 3, m0 = mt * 256;
        if (lastl && m0 >= NLAT) continue;
        GemmDesc g; g.rowidx = nullptr; g.nvalid = 0; g.ksplit = 1 << 30; g.lda = INC;
        g.A = P + OFF_DCQ; g.K = 256; g.B0 = c.ws<bf16_t>(WS_WQB) + (size_t)l * 384 * 256; g.B1 = g.B0; g.ldb = 256;
        gemm_tile<2, 4>(g, m0, nt * 128, c.lds, c.tid, [&](const f32x4 (&acc)[4][4], int mb, int nbase, int lane) {
            const int q = lane >> 4, li = lane & 15, wn = (nbase >> 6) & 1;
            const bool isctx = m0 >= NLAT;
            const float* qg = c.in(I_MLAQG) + l * 96;
            const float sc = D_SCALE * LOG2E;
#pragma unroll
            for (int mf = 0; mf < 4; ++mf) { const int m = m0 + mb + 16 * mf + li;
                int b, pos, key; bool ic; tok_info(m, b, pos, key, ic);
                const f32x4 s4 = *(const f32x4*)(c.ws<float>(WS_SSQ) + (size_t)m * 8);
                const float r0 = rsqrtf((s4[0] + s4[1] + s4[2] + s4[3]) * (1.f / 256.f) + EPS);
                if (nt < 2) {
                    const int h = 2 * nt + wn; float ss = 0.f;
#pragma unroll
                    for (int nf = 0; nf < 4; ++nf) { const f32x4 a = acc[nf][mf] * r0; ss += a[0] * a[0] + a[1] * a[1] + a[2] * a[2] + a[3] * a[3]; }
                    const float rr = rsqrtf(red_q(ss) * (1.f / 64.f) + EPS) * r0 * sc;
                    bf16_t* dst = c.ws<bf16_t>(WS_QD) + ((size_t)(b * 4 + h) * KEYS + key) * 96 + 4 * q;
#pragma unroll
                    for (int nf = 0; nf < 4; ++nf) { const f32x4 gg = *(const f32x4*)(qg + 16 * nf + 4 * q); const f32x4 a = acc[nf][mf];
                        *(u32x2*)(dst + 16 * nf) = (u32x2){pk2(a[0] * rr * gg[0], a[1] * rr * gg[1]), pk2(a[2] * rr * gg[2], a[3] * rr * gg[3])}; }
                } else {
#pragma unroll
                    for (int hh = 0; hh < 2; ++hh) { const int h = 2 * wn + hh; float ss = 0.f;
#pragma unroll
                        for (int n2 = 0; n2 < 2; ++n2) { const f32x4 a = acc[2 * hh + n2][mf] * r0; ss += a[0] * a[0] + a[1] * a[1] + a[2] * a[2] + a[3] * a[3]; }
                        const float rr = rsqrtf(red_q(ss) * (1.f / 32.f) + EPS) * r0;
                        bf16_t* dst = c.ws<bf16_t>(WS_QD) + ((size_t)(b * 4 + h) * KEYS + key) * 96 + 64 + 4 * q;
#pragma unroll
                        for (int n2 = 0; n2 < 2; ++n2) { const f32x4 gg = *(const f32x4*)(qg + 64 + 16 * n2 + 4 * q); const f32x4 a = acc[2 * hh + n2][mf];
                            float v0 = a[0] * rr * gg[0], v1 = a[1] * rr * gg[1], v2 = a[2] * rr * gg[2], v3 = a[3] * rr * gg[3];
                            if (!isctx) { const f32x2 cs = *(const f32x2*)(cosD + pos * 16 + 8 * n2 + 2 * q), sn = *(const f32x2*)(sinD + pos * 16 + 8 * n2 + 2 * q);
                                rope2(v0, v1, cs[0], sn[0]); rope2(v2, v3, cs[1], sn[1]); }
                            *(u32x2*)(dst + 16 * n2) = (u32x2){pk2(v0 * sc, v1 * sc), pk2(v2 * sc, v3 * sc)}; } }
                }
            }
        });
    }
    for (; it < C_SGU_ITEMS + C_TQ + C_TKV; it += c.nb) {
        const int t = it - C_SGU_ITEMS - C_TQ, mt = t >> 2, h = t & 3, m0 = mt * 256;
        GemmDesc g; g.rowidx = nullptr; g.nvalid = 0; g.ksplit = 1 << 30; g.lda = INC;
        g.A = P + OFF_DCKV; g.K = 128; g.B0 = c.ws<bf16_t>(WS_WKVB) + (size_t)l * 512 * 128; g.B1 = g.B0; g.ldb = 128;
        gemm_tile<2, 4>(g, m0, h * 128, c.lds, c.tid, [&](const f32x4 (&acc)[4][4], int mb, int nbase, int lane) {
            const int q = lane >> 4, li = lane & 15, wn = (nbase >> 6) & 1;
            const float* kg = c.in(I_MLAKG) + l * 96;
#pragma unroll
            for (int mf = 0; mf < 4; ++mf) { const int m = m0 + mb + 16 * mf + li;
                int b, pos, key; bool ic; tok_info(m, b, pos, key, ic);
                const float* sp = c.ws<float>(WS_SSQ) + (size_t)m * 8;
                const float r0 = rsqrtf((sp[4] + sp[5]) * (1.f / 128.f) + EPS);
                if (wn == 0) {
                    float ss = 0.f;
#pragma unroll
                    for (int nf = 0; nf < 4; ++nf) { const f32x4 a = acc[nf][mf] * r0; ss += a[0] * a[0] + a[1] * a[1] + a[2] * a[2] + a[3] * a[3]; }
                    const float rr = rsqrtf(red_q(ss) * (1.f / 64.f) + EPS) * r0;
                    bf16_t* dst = c.ws<bf16_t>(WS_KD) + ((size_t)(b * 4 + h) * KEYS + key) * 96 + 4 * q;
#pragma unroll
                    for (int nf = 0; nf < 4; ++nf) { const f32x4 gg = *(const f32x4*)(kg + 16 * nf + 4 * q); const f32x4 a = acc[nf][mf];
                        *(u32x2*)(dst + 16 * nf) = (u32x2){pk2(a[0] * rr * gg[0], a[1] * rr * gg[1]), pk2(a[2] * rr * gg[2], a[3] * rr * gg[3])}; }
                } else {
                    bf16_t* dst = c.ws<bf16_t>(WS_VDT) + ((size_t)(b * 4 + h) * 64 + 4 * q) * KEYS + key;
#pragma unroll
                    for (int nf = 0; nf < 4; ++nf) { const f32x4 a = acc[nf][mf] * r0; const unsigned p0 = pk2(a[0], a[1]), p1 = pk2(a[2], a[3]);
                        bf16_t* d = dst + (size_t)(16 * nf) * KEYS;
                        d[0] = (bf16_t)(p0 & 0xffffu); d[KEYS] = (bf16_t)(p0 >> 16); d[2 * KEYS] = (bf16_t)(p1 & 0xffffu); d[3 * KEYS] = (bf16_t)(p1 >> 16); }
                }
            }
        });
    }
}

constexpr int AT_KN = 0, AT_KR = 8192, AT_V = 12288, AT_STAGE = 21504, AT_VLD = 136;
template <int DK>
DEV void attn_item(const bf16_t* Q, const bf16_t* K, const bf16_t* Vt, int nkeys, bf16_t* Yrow, LAS char* lds, int tid, float mref) {
    const int lane = tid & 63, wave = tid >> 6, l31 = lane & 31, h5 = lane >> 5;
    constexpr int NS = DK / 16;
    bf16x8 qf[NS];
#pragma unroll
    for (int s = 0; s < NS; ++s) qf[s] = *(const bf16x8*)(Q + (size_t)(32 * wave + l31) * DK + 16 * s + 8 * h5);
    f32x16 oacc[2];
#pragma unroll
    for (int i = 0; i < 16; ++i) { oacc[0][i] = 0.f; oacc[1][i] = 0.f; }
    float lsum = 0.f;
    const int kr_ = tid >> 3, kc_ = tid & 7;
    const int rr_ = (tid >> 2) & 63, rc_ = tid & 3;
    u32x4 rk, rv, rrp;
    const int nt = nkeys / 64;
    auto gload = [&](int t) {
        const int k0 = t * 64;
        rk = *(const u32x4*)(K + (size_t)(k0 + kr_) * DK + kc_ * 8); rv = *(const u32x4*)(Vt + (size_t)kr_ * KEYS + k0 + kc_ * 8);
        if (DK == 96 && tid < 256) rrp = *(const u32x4*)(K + (size_t)(k0 + rr_) * DK + 64 + rc_ * 8);
    };
    auto lstore = [&](int st) {
        LAS char* base = lds + st * AT_STAGE;
        { const int r = kr_;
            *(LAS u32x4*)(base + AT_KN + r * 128 + ((kc_ ^ ((r >> 1) & 7)) << 4)) = rk;
            LAS char* vd = base + AT_V + r * AT_VLD + kc_ * 16;
            *(LAS u32x2*)vd = (u32x2){rv[0], rv[1]}; *(LAS u32x2*)(vd + 8) = (u32x2){rv[2], rv[3]}; }
        if (DK == 96 && tid < 256) *(LAS u32x4*)(base + AT_KR + rr_ * 64 + ((rc_ ^ ((rr_ >> 2) & 3)) << 4)) = rrp;
    };
    __syncthreads();
    gload(0); lstore(0);
    __syncthreads();
    for (int t = 0; t < nt; ++t) {
        const int cur = t & 1;
        if (t + 1 < nt) gload(t + 1);
        LAS const char* base = lds + cur * AT_STAGE;
        f32x16 sacc[2];
        {
            bf16x8 kf[2][NS];
#pragma unroll
            for (int kt2 = 0; kt2 < 2; ++kt2) {
                const int row = 32 * kt2 + l31;
#pragma unroll
                for (int s = 0; s < 4; ++s) kf[kt2][s] = lds_r128(base + AT_KN + row * 128 + (((2 * s + h5) ^ ((row >> 1) & 7)) << 4));
                if (DK == 96) {
#pragma unroll
                    for (int s = 0; s < 2; ++s) kf[kt2][4 + s] = lds_r128(base + AT_KR + row * 64 + (((2 * s + h5) ^ ((row >> 2) & 3)) << 4));
                }
            }
            __builtin_amdgcn_sched_barrier(0);
#pragma unroll
            for (int kt2 = 0; kt2 < 2; ++kt2) {
#pragma unroll
                for (int i = 0; i < 16; ++i) sacc[kt2][i] = -mref;
#pragma unroll
                for (int s = 0; s < NS; ++s) sacc[kt2] = __builtin_amdgcn_mfma_f32_32x32x16_bf16(kf[kt2][s], qf[s], sacc[kt2], 0, 0, 0);
            }
        }
        bf16x8 vf[2][2][2];
#pragma unroll
        for (int dt = 0; dt < 2; ++dt)
#pragma unroll
            for (int kt2 = 0; kt2 < 2; ++kt2)
#pragma unroll
                for (int s2 = 0; s2 < 2; ++s2) {
                    LAS const char* vp = base + AT_V + (32 * dt + l31) * AT_VLD + (32 * kt2 + 16 * s2 + 4 * h5) * 2;
                    const u32x2 lo = *(LAS const u32x2*)vp, hi = *(LAS const u32x2*)(vp + 16);
                    vf[dt][kt2][s2] = __builtin_bit_cast(bf16x8, (u32x4){lo[0], lo[1], hi[0], hi[1]});
                }
        __builtin_amdgcn_sched_barrier(0);
        float ps = 0.f;
#pragma unroll
        for (int kt2 = 0; kt2 < 2; ++kt2)
#pragma unroll
            for (int i = 0; i < 16; ++i) { const float p = __builtin_amdgcn_exp2f(sacc[kt2][i]); sacc[kt2][i] = p; ps += p; }
        lsum += ps;
        bf16x8 pf[2][2];
#pragma unroll
        for (int kt2 = 0; kt2 < 2; ++kt2)
#pragma unroll
            for (int s2 = 0; s2 < 2; ++s2) {
                u32x4 w;
#pragma unroll
                for (int j = 0; j < 4; ++j) w[j] = pk2(sacc[kt2][8 * s2 + 2 * j], sacc[kt2][8 * s2 + 2 * j + 1]);
                pf[kt2][s2] = __builtin_bit_cast(bf16x8, w);
            }
#pragma unroll
        for (int dt = 0; dt < 2; ++dt)
#pragma unroll
            for (int kt2 = 0; kt2 < 2; ++kt2)
#pragma unroll
                for (int s2 = 0; s2 < 2; ++s2) oacc[dt] = __builtin_amdgcn_mfma_f32_32x32x16_bf16(vf[dt][kt2][s2], pf[kt2][s2], oacc[dt], 0, 0, 0);
        if (t + 1 < nt) lstore(cur ^ 1);
        __syncthreads();
    }
    const float ltot = lsum + xlane<32>(lsum), inv = 1.f / ltot;
    bf16_t* yr = Yrow + (size_t)(32 * wave + l31) * 1024;
#pragma unroll
    for (int dt = 0; dt < 2; ++dt)
#pragma unroll
        for (int g = 0; g < 4; ++g) {
            const int d0 = 32 * dt + 8 * g + 4 * h5;
            *(u32x2*)(yr + d0) = (u32x2){pk2(oacc[dt][4 * g] * inv, oacc[dt][4 * g + 1] * inv), pk2(oacc[dt][4 * g + 2] * inv, oacc[dt][4 * g + 3] * inv)};
        }
}
DEV void phase_d(const Ctx& c) {
    const int nlat = 512, nctx = (c.layer == NL - 1) ? 0 : 64;
    bf16_t* Y = c.ws<bf16_t>(WS_ACT);
    float mrefC, mrefD;
    {
        const int lane = c.tid & 63, l = c.layer;
        auto wmax = [](float v) { return wave_max(v); };
        const float gq = wmax(fabsf(c.in(I_GQAQG)[l * 64 + lane])), gk = wmax(fabsf(c.in(I_GQAKG)[l * 64 + lane]));
        mrefC = 64.f * gq * gk * C_SCALE * LOG2E - 40.f;
        const float* mq = c.in(I_MLAQG) + l * 96; const float* mk = c.in(I_MLAKG) + l * 96;
        const float qn = wmax(fabsf(mq[lane])), qr = wmax(fabsf(mq[64 + (lane & 31)])), kn = wmax(fabsf(mk[lane])), kr = wmax(fabsf(mk[64 + (lane & 31)]));
        mrefD = sqrtf((64.f * qn * qn + 32.f * qr * qr) * (64.f * kn * kn + 32.f * kr * kr)) * D_SCALE * LOG2E - 40.f;
    }
    for (int it = c.bid; it < nlat + nctx; it += c.nb) {
        int type, b, h, qpos0, nkeys, tok0;
        if (it < nlat) {
            type = it >> 8; const int r = it & 255, pr = 4 * (r & 7) + (r >> 6), qb = (r >> 3) & 7; b = pr >> 2; h = pr & 3; qpos0 = CL + 256 * qb; nkeys = KEYS; tok0 = b * SEQ + 256 * qb; }
        else { const int u = it - nlat; type = u >> 5; const int r = u & 31; b = r >> 2; h = r & 3; qpos0 = 0; nkeys = CL; tok0 = NLAT + b * CL; }
        if (type == 0) {
            attn_item<96>(c.ws<bf16_t>(WS_QD) + ((size_t)(b * 4 + h) * KEYS + qpos0) * 96, c.ws<bf16_t>(WS_KD) + (size_t)(b * 4 + h) * KEYS * 96,
                          c.ws<bf16_t>(WS_VDT) + (size_t)(b * 4 + h) * 64 * KEYS, nkeys, Y + (size_t)tok0 * 1024 + 768 + 64 * h, c.lds, c.tid, mrefD);
        } else {
            attn_item<64>(c.ws<bf16_t>(WS_QC) + ((size_t)(b * 4 + h) * KEYS + qpos0) * 64, c.ws<bf16_t>(WS_KC) + (size_t)(b * 2 + (h >> 1)) * KEYS * 64,
                          c.ws<bf16_t>(WS_VCT) + (size_t)(b * 2 + (h >> 1)) * 64 * KEYS, nkeys, Y + (size_t)tok0 * 1024 + 512 + 64 * h, c.lds, c.tid, mrefC);
        }
    }
}

DEV void phase_e0(const Ctx& c) {
    const int tid = c.tid, lane = tid & 63, wave = tid >> 6, l = c.layer;
    bf16_t* Y = c.ws<bf16_t>(WS_ACT); const bf16_t* P = c.ws<bf16_t>(WS_P);
    const float* gg = c.in(I_GGO) + l * 1024;
    const int ntok = c.ntok_tail();
    const int ch = 4 * lane;
    const float* cw = c.in(I_CONVW) + l * 768 + ch;
    const f32x4 w0 = *(const f32x4*)cw, w1 = *(const f32x4*)(cw + 256), w2 = *(const f32x4*)(cw + 512);
    f32x4 gn[4];
#pragma unroll
    for (int g = 0; g < 4; ++g) gn[g] = *(const f32x4*)(gg + g * 256 + ch);
    const int nwv = c.nb * NW, per = (ntok + nwv - 1) / nwv, tbeg = (c.bid * NW + wave) * per, tend = min(tbeg + per, ntok);
#pragma unroll 1
    for (int t0 = tbeg; t0 < tend; t0 += 2) {
        u32x2 ya[2], yc[2], yd[2], rbb[2], c0[2], x0[2], c1[2], x1[2], c2[2], x2[2]; float mp[2], mn[2];
#pragma unroll
        for (int u = 0; u < 2; ++u) { const int tok = min(t0 + u, tend - 1);
            int b, pos, key; bool isctx; tok_info(tok, b, pos, key, isctx);
            const int seqlen = isctx ? CL : SEQ;
            const bf16_t* pr = P + (size_t)tok * INC; const bf16_t* yr = Y + (size_t)tok * 1024;
            ya[u] = *(const u32x2*)(yr + ch); yc[u] = *(const u32x2*)(yr + 512 + ch); yd[u] = *(const u32x2*)(yr + 768 + ch);
            rbb[u] = *(const u32x2*)(pr + OFF_BB + ch);
            const bool okp = pos > 0, okn = pos < seqlen - 1;
            c0[u] = *(const u32x2*)(pr - (okp ? INC : 0) + OFF_BC + ch); x0[u] = *(const u32x2*)(pr - (okp ? INC : 0) + OFF_BX + ch);
            c1[u] = *(const u32x2*)(pr + OFF_BC + ch); x1[u] = *(const u32x2*)(pr + OFF_BX + ch);
            c2[u] = *(const u32x2*)(pr + (okn ? INC : 0) + OFF_BC + ch); x2[u] = *(const u32x2*)(pr + (okn ? INC : 0) + OFF_BX + ch);
            mp[u] = okp ? 1.f : 0.f; mn[u] = okn ? 1.f : 0.f; }
#pragma unroll
        for (int u = 0; u < 2; ++u) { const int tok = t0 + u;
            if (tok < tend) {
                bf16_t* yr = Y + (size_t)tok * 1024;
                float v[4][4];
                v[0][0] = bflo(ya[u][0]); v[0][1] = bfhi(ya[u][0]); v[0][2] = bflo(ya[u][1]); v[0][3] = bfhi(ya[u][1]);
                v[2][0] = bflo(yc[u][0]); v[2][1] = bfhi(yc[u][0]); v[2][2] = bflo(yc[u][1]); v[2][3] = bfhi(yc[u][1]);
                v[3][0] = bflo(yd[u][0]); v[3][1] = bfhi(yd[u][0]); v[3][2] = bflo(yd[u][1]); v[3][3] = bfhi(yd[u][1]);
                {
                    const float zp[4] = {mp[u] * bflo(c0[u][0]) * bflo(x0[u][0]), mp[u] * bfhi(c0[u][0]) * bfhi(x0[u][0]), mp[u] * bflo(c0[u][1]) * bflo(x0[u][1]), mp[u] * bfhi(c0[u][1]) * bfhi(x0[u][1])};
                    const float zc[4] = {bflo(c1[u][0]) * bflo(x1[u][0]), bfhi(c1[u][0]) * bfhi(x1[u][0]), bflo(c1[u][1]) * bflo(x1[u][1]), bfhi(c1[u][1]) * bfhi(x1[u][1])};
                    const float zn[4] = {mn[u] * bflo(c2[u][0]) * bflo(x2[u][0]), mn[u] * bfhi(c2[u][0]) * bfhi(x2[u][0]), mn[u] * bflo(c2[u][1]) * bflo(x2[u][1]), mn[u] * bfhi(c2[u][1]) * bfhi(x2[u][1])};
                    const float bb[4] = {bflo(rbb[u][0]), bfhi(rbb[u][0]), bflo(rbb[u][1]), bfhi(rbb[u][1])};
#pragma unroll
                    for (int j = 0; j < 4; ++j) v[1][j] = bb[j] * (w0[j] * zp[j] + w1[j] * zc[j] + w2[j] * zn[j]);
                }
                float ss[4];
#pragma unroll
                for (int g = 0; g < 4; ++g) ss[g] = v[g][0] * v[g][0] + v[g][1] * v[g][1] + v[g][2] * v[g][2] + v[g][3] * v[g][3];
#pragma unroll
                for (int g = 0; g < 4; ++g) ss[g] = wave_sum(ss[g]);
#pragma unroll
                for (int g = 0; g < 4; ++g) { const float r = rsqrtf(ss[g] * (1.f / 256.f) + EPS);
                    *(u32x2*)(yr + g * 256 + ch) = (u32x2){pk2(v[g][0] * r * gn[g][0], v[g][1] * r * gn[g][1]), pk2(v[g][2] * r * gn[g][2], v[g][3] * r * gn[g][3])}; }
            } }
    }
}
DEV void e_store_row4(const Ctx& c, int m, int n, const f32x4& a) {
    const float* gate = c.modv(m < NLAT ? (m >> 11) : 8, 2);
    const f32x4 gt = *(const f32x4*)(gate + n), xv = c.xload4(m, n);
    c.xsstore4(m, n, xv[0] + gt[0] * a[0], xv[1] + gt[1] * a[1], xv[2] + gt[2] * a[2], xv[3] + gt[3] * a[3]);
}
DEV void phase_e(const Ctx& c) {
    GemmDesc g; g.A = c.ws<bf16_t>(WS_ACT); g.lda = 1024; g.rowidx = nullptr; g.nvalid = 0;
    g.B0 = c.ws<bf16_t>(WS_WOUT) + (size_t)c.layer * 1024 * 1024; g.B1 = g.B0; g.ldb = 1024; g.ksplit = 1 << 30; g.K = 1024;
    const int nfull = (NLAT / 256) * 4, nhalf = (c.layer == NL - 1) ? 0 : (NCTX / 256) * 8;
    for (int t = c.bid; t < nfull + nhalf; t += c.nb) {
        if (t < nfull) { const int m0 = (t >> 2) * 256, n0 = (t & 3) * 256;
            gemm_tile8p(g, m0, n0, c.lds, c.tid, [&](const f32x4 (&acc)[2][2][4][2], int wr, int wc, int lane) {
                const float* gate = c.modv(m0 >> 11, 2) + n0 + 64 * wc + 4 * (lane >> 4);
                f32x4 gt[2][2];
#pragma unroll
                for (int bj = 0; bj < 2; ++bj)
#pragma unroll
                    for (int n = 0; n < 2; ++n) gt[bj][n] = *(const f32x4*)(gate + 32 * bj + 16 * n);
#pragma unroll
                for (int ai = 0; ai < 2; ++ai)
#pragma unroll
                    for (int m = 0; m < 4; ++m) { const int row = m0 + 128 * ai + 64 * wr + 16 * m + (lane & 15);
#pragma unroll
                        for (int bj = 0; bj < 2; ++bj)
#pragma unroll
                            for (int n = 0; n < 2; ++n) { const int col = n0 + 64 * wc + 32 * bj + 16 * n + 4 * (lane >> 4); const f32x4 xv = c.xload4(row, col), a = acc[ai][bj][m][n], gg = gt[bj][n];
                                c.xsstore4(row, col, xv[0] + gg[0] * a[0], xv[1] + gg[1] * a[1], xv[2] + gg[2] * a[2], xv[3] + gg[3] * a[3]); } }
            }); }
        else { const int u = t - nfull, m0 = NLAT + (u >> 3) * 256;
            gemm_tile<2, 4>(g, m0, (u & 7) * 128, c.lds, c.tid, [&](const f32x4 (&acc)[4][4], int mb, int nbase, int lane) {
#pragma unroll
                for (int mf = 0; mf < 4; ++mf)
#pragma unroll
                    for (int nf = 0; nf < 4; ++nf) { const int p = nbase + 16 * nf + 4 * (lane >> 4);
                        e_store_row4(c, m0 + mb + 16 * mf + (lane & 15), (p & ~255) | (((p >> 5) & 3) << 6) | (((p >> 7) & 1) << 5) | (p & 31), acc[nf][mf]); }
            }); }
    }
}

DEV void phase_f(const Ctx& c) {
    const int tid = c.tid, lane = tid & 63, wave = tid >> 6, l = c.layer, li = lane & 15, q = lane >> 4;
    LAS float* part = (LAS float*)c.lds;
    LAS float* rs = part + 8 * 80 * 32;
    LAS int* hist = (LAS int*)(rs + 80);
    LAS int* hbase = hist + 32;
    int* cnt = c.ws<int>(WS_CNT) + l * NBUCKET * 32;
    int* ltok = c.ws<int>(WS_LTOK); float* lw = c.ws<float>(WS_LW);
    bf16_t* H = c.ws<bf16_t>(WS_ACT);
    const int ntok = c.ntok_tail(), TPB = ntok / 256, tpw = TPB / 8;
    for (int item = c.bid; item < 256; item += c.nb) {
        const int tok0 = item * TPB;
        if (tid < 32) hist[tid] = 0;
        {
            f32x4 acc[2][5];
#pragma unroll
            for (int a = 0; a < 2; ++a)
#pragma unroll
                for (int b = 0; b < 5; ++b) acc[a][b] = (f32x4){0.f, 0.f, 0.f, 0.f};
            int Bd = ((tok0 >> 11) + 1) << 11; if (tok0 >= NLAT) Bd = 1 << 30; else if (Bd > NLAT) Bd = NLAT;
            if (Bd >= tok0 + TPB) Bd = tok0 + TPB;
            const int nA = (Bd - tok0 + 15) >> 4;
            const bf16_t* xrow[5]; const bf16_t* wrow[5]; int tloc[5];
#pragma unroll
            for (int mf = 0; mf < 5; ++mf) {
                const bool segA = mf < nA;
                const int fs = segA ? tok0 + 16 * mf : Bd + 16 * (mf - nA), fe = segA ? Bd : tok0 + TPB;
                const int tokc = min(fs + li, max(fe, fs + 1) - 1);
                const int tokm = min(fs, tok0 + TPB - 1), mb = tokm < NLAT ? (tokm >> 11) : 8;
                tloc[mf] = (fs + li < fe) ? fs + li - tok0 : -1;
                xrow[mf] = c.xs(min(tokc, tok0 + TPB - 1)) + 128 * wave + 8 * q;
                wrow[mf] = c.ws<bf16_t>(WS_RW) + (size_t)(l * 9 + mb) * 2 * 32 * 1024 + (size_t)li * 1024 + 128 * wave + 8 * q; }
            if (nA * 16 >= TPB || Bd >= tok0 + TPB) {
#pragma unroll
                for (int ks = 0; ks < 4; ++ks) {
                    bf16x8 xf[5], wf[2][2];
#pragma unroll
                    for (int hl = 0; hl < 2; ++hl)
#pragma unroll
                        for (int nf = 0; nf < 2; ++nf) wf[hl][nf] = *(const bf16x8*)(wrow[0] + (size_t)(hl * 32 + nf * 16) * 1024 + 32 * ks);
#pragma unroll
                    for (int mf = 0; mf < 5; ++mf) xf[mf] = *(const bf16x8*)(xrow[mf] + 32 * ks);
#pragma unroll
                    for (int mf = 0; mf < 5; ++mf)
#pragma unroll
                        for (int hl = 0; hl < 2; ++hl)
#pragma unroll
                            for (int nf = 0; nf < 2; ++nf) acc[nf][mf] = __builtin_amdgcn_mfma_f32_16x16x32_bf16(wf[hl][nf], xf[mf], acc[nf][mf], 0, 0, 0);
                }
            } else {
#pragma unroll 1
                for (int ks = 0; ks < 4; ++ks) {
                    bf16x8 xf[5];
#pragma unroll
                    for (int mf = 0; mf < 5; ++mf) xf[mf] = *(const bf16x8*)(xrow[mf] + 32 * ks);
#pragma unroll
                    for (int mf = 0; mf < 5; ++mf)
#pragma unroll
                        for (int hl = 0; hl < 2; ++hl)
#pragma unroll
                            for (int nf = 0; nf < 2; ++nf) { const bf16x8 wf = *(const bf16x8*)(wrow[mf] + (size_t)(hl * 32 + nf * 16) * 1024 + 32 * ks);
                                acc[nf][mf] = __builtin_amdgcn_mfma_f32_16x16x32_bf16(wf, xf[mf], acc[nf][mf], 0, 0, 0); }
                }
            }
#pragma unroll
            for (int mf = 0; mf < 5; ++mf)
                if (tloc[mf] >= 0) {
#pragma unroll
                    for (int nf = 0; nf < 2; ++nf) *(LAS f32x4*)(part + ((wave * 80 + tloc[mf]) * 32 + 16 * nf + 4 * q)) = acc[nf][mf]; }
        }
        int mbc2 = -1; f32x4 g0[2], g1[2], s0[2], s1[2];
#pragma unroll 1
        for (int tl0 = 0; tl0 < tpw; tl0 += 3) {
            u32x4 r0[3], r1[3];
#pragma unroll
            for (int u = 0; u < 3; ++u) { const bf16_t* xr = c.xs(tok0 + wave * tpw + min(tl0 + u, tpw - 1)); r0[u] = *(const u32x4*)(xr + 8 * lane); r1[u] = *(const u32x4*)(xr + 512 + 8 * lane); }
#pragma unroll
            for (int u = 0; u < 3; ++u) {
                if (tl0 + u < tpw) { const int t = wave * tpw + tl0 + u, tok = tok0 + t, mb = tok < NLAT ? (tok >> 11) : 8;
                    if (mb != mbc2) { mbc2 = mb; const float* gmv = c.ws<float>(WS_GM) + (size_t)(l * 9 + mb) * 1024; const float* sh = c.modv(mb, 3);
#pragma unroll
                        for (int hf = 0; hf < 2; ++hf) { const int e = 512 * hf + 8 * lane; g0[hf] = *(const f32x4*)(gmv + e); g1[hf] = *(const f32x4*)(gmv + e + 4); s0[hf] = *(const f32x4*)(sh + e); s1[hf] = *(const f32x4*)(sh + e + 4); } }
                    float v[16];
#pragma unroll
                    for (int j = 0; j < 4; ++j) { v[2 * j] = bflo(r0[u][j]); v[2 * j + 1] = bfhi(r0[u][j]); v[8 + 2 * j] = bflo(r1[u][j]); v[8 + 2 * j + 1] = bfhi(r1[u][j]); }
                    float ss = 0.f;
#pragma unroll
                    for (int j = 0; j < 16; ++j) ss += v[j] * v[j];
                    const float rr = rsqrtf(wave_sum(ss) * (1.f / 1024.f) + EPS);
                    if (lane == 0) rs[t] = rr;
#pragma unroll
                    for (int hf = 0; hf < 2; ++hf) { const int e = 512 * hf + 8 * lane;
                        const float* vv = v + 8 * hf;
                        *(u32x4*)(H + (size_t)tok * 1024 + e) = (u32x4){pk2(vv[0] * rr * g0[hf][0] + s0[hf][0], vv[1] * rr * g0[hf][1] + s0[hf][1]), pk2(vv[2] * rr * g0[hf][2] + s0[hf][2], vv[3] * rr * g0[hf][3] + s0[hf][3]),
                                                                          pk2(vv[4] * rr * g1[hf][0] + s1[hf][0], vv[5] * rr * g1[hf][1] + s1[hf][1]), pk2(vv[6] * rr * g1[hf][2] + s1[hf][2], vv[7] * rr * g1[hf][3] + s1[hf][3])}; }
                } }
        }
        __syncthreads();
        int bucket = 0, rank = 0; float wa = 0.f, wb = 0.f;
        if (tid < TPB) {
            const int t = tid, tok = tok0 + t, mb = tok < NLAT ? (tok >> 11) : 8;
            float s[20];
#pragma unroll
            for (int j = 0; j < 20; ++j) { float a = 0.f;
#pragma unroll
                for (int w = 0; w < NW; ++w) a += part[(w * 80 + t) * 32 + j];
                s[j] = a; }
            const float* RC = c.ws<float>(WS_RC) + (l * 9 + mb) * 32;
            const float r = rs[t];
            float gl[4], el[4];
#pragma unroll
            for (int j = 0; j < 4; ++j) gl[j] = r * s[j] + RC[j];
            int gi = 0; float gmx = gl[0];
#pragma unroll
            for (int j = 1; j < 4; ++j) if (gl[j] > gmx) { gmx = gl[j]; gi = j; }
            float gs = 0.f;
#pragma unroll
            for (int j = 0; j < 4; ++j) gs += __expf(gl[j] - gmx);
            const float gw = 1.f / gs;
#pragma unroll
            for (int j = 0; j < 4; ++j) { const float sj = gi == 0 ? s[4 + j] : (gi == 1 ? s[8 + j] : (gi == 2 ? s[12 + j] : s[16 + j])); el[j] = r * sj + RC[4 + 4 * gi + j]; }
            int e1 = 0; float m1 = el[0];
#pragma unroll
            for (int j = 1; j < 4; ++j) if (el[j] > m1) { m1 = el[j]; e1 = j; }
            int e2 = -1; float m2 = -3.0e38f;
#pragma unroll
            for (int j = 0; j < 4; ++j) if (j != e1 && el[j] > m2) { m2 = el[j]; e2 = j; }
            const float p2 = __expf(m2 - m1), w1 = gw / (1.f + p2), w2 = gw * p2 / (1.f + p2);
            const int ea = e1 < e2 ? e1 : e2, eb = e1 < e2 ? e2 : e1; wa = e1 < e2 ? w1 : w2; wb = e1 < e2 ? w2 : w1;
            const int pidx = ea == 0 ? eb - 1 : (ea == 1 ? eb + 1 : 5);
            bucket = gi * 6 + pidx;
            rank = __hip_atomic_fetch_add(hist + bucket, 1, __ATOMIC_RELAXED, __HIP_MEMORY_SCOPE_WORKGROUP);
        }
        __syncthreads();
        if (tid < NBUCKET) { const int n = hist[tid]; hbase[tid] = n > 0 ? atomicAdd(&cnt[tid * 32], n) : 0; }
        __syncthreads();
        if (tid < TPB) {
            const int pos = hbase[bucket] + rank;
            ltok[bucket * NTOK + pos] = tok0 + tid;
            lw[((size_t)bucket * NTOK + pos) * 2] = wa; lw[((size_t)bucket * NTOK + pos) * 2 + 1] = wb;
        }
        __syncthreads();
    }
}

#define GAS __attribute__((address_space(1)))
#define XB_TMO      128
#define XB_XCNT(j)  (256  + 64 * (j))
#define XB_XSUB(j)  (1280 + 64 * (j))
#define XB_XGEN(j)  (2304 + 64 * (j))
#define XB_TOP      3328
#define XB_TOPGEN   3392
#define XCD_BAR_WORDS 3456
#define XB_SPIN_CAP (1u << 22)
DEV unsigned xb_ld(unsigned* p)              { return __hip_atomic_load(p, __ATOMIC_RELAXED, __HIP_MEMORY_SCOPE_AGENT); }
DEV unsigned xb_add(unsigned* p, unsigned v) { return __hip_atomic_fetch_add(p, v, __ATOMIC_RELAXED, __HIP_MEMORY_SCOPE_AGENT); }
DEV unsigned xb_xcc_id() { return (unsigned)__builtin_amdgcn_s_getreg((3 << 11) | 20) & 0xFu; }
#define XB_SPIN(cond, bar) do { unsigned _sp = 0; while (cond) { __builtin_amdgcn_s_sleep(20); \
    if ((++_sp & 255u) == 0u) { if (xb_ld(&(bar)[XB_TMO])) break; if (_sp > XB_SPIN_CAP) { atomicAdd(&(bar)[XB_TMO], 1u); break; } } } } while (0)
DEV void moe_find(const int* cnt, int mg, int& bucket, int& mt, int& total) {
    int acc = 0; bucket = -1; mt = 0;
    for (int b = 0; b < NBUCKET; ++b) { const int n = (cnt[b * 32] + 255) >> 8; if (bucket < 0 && mg < acc + n) { bucket = b; mt = mg - acc; } acc += n; }
    total = acc;
}
DEV void pair_of(int pidx, int& ea, int& eb) { ea = pidx < 3 ? 0 : (pidx < 5 ? 1 : 2); eb = pidx < 3 ? pidx + 1 : (pidx < 5 ? pidx - 1 : 3); }
template <int WN_, int MF>
DEV void g_tile(const Ctx& c, const int* cnt, int mg, int nt8) {
    const int l = c.layer; (void)l;
    int bucket, mt, tt; moe_find(cnt, mg, bucket, mt, tt);
    int ea, eb; pair_of(bucket % 6, ea, eb); const int grp = bucket / 6;
    const int e = grp * 4 + ((nt8 < 4) ? ea : eb);
    const int nvalid = min(256, cnt[bucket * 32] - mt * 256);
    const int* rows = c.ws<int>(WS_LTOK) + bucket * NTOK + mt * 256;
    const float* wts = c.ws<float>(WS_LW) + ((size_t)bucket * NTOK + mt * 256) * 2 + ((nt8 < 4) ? 0 : 1);
    bf16_t* HB = c.ws<bf16_t>(WS_HBUF);
    GemmDesc g; g.A = c.ws<bf16_t>(WS_ACT); g.lda = 1024; g.rowidx = rows; g.nvalid = nvalid;
    g.B0 = c.ws<bf16_t>(WS_WUP) + (size_t)e * 512 * 1024; g.B1 = g.B0; g.ldb = 1024; g.ksplit = 1 << 30; g.K = 1024;
    const int hcol0 = (nt8 >> 2) * 256 + (nt8 & 3) * 64;
    gemm_tile<WN_, MF>(g, 0, (nt8 & 3) * 128, c.lds, c.tid, [&](const f32x4 (&acc)[4][MF], int mb, int nbase, int lane) {
        const int slot = ((nbase - (nt8 & 3) * 128) >> 6);
#pragma unroll
        for (int mf = 0; mf < MF; ++mf) { const int r = mb + 16 * mf + (lane & 15); const bool ok = r < nvalid; const float w = ok ? wts[2 * r] : 0.f;
#pragma unroll
            for (int f = 0; f < 2; ++f) { const f32x4 gt = acc[f][mf], up = acc[f + 2][mf]; float o[4];
#pragma unroll
                for (int j = 0; j < 4; ++j) o[j] = ok ? silu_f(gt[j]) * up[j] * w : 0.f;
                __hip_atomic_store((GAS unsigned long long*)(HB + ((size_t)mg * 256 + r) * 512 + hcol0 + 32 * slot + 16 * f + 4 * (lane >> 4)),
                                   (unsigned long long)pk2(o[0], o[1]) | ((unsigned long long)pk2(o[2], o[3]) << 32), __ATOMIC_RELAXED, __HIP_MEMORY_SCOPE_AGENT); } }
    });
    asm volatile("s_waitcnt vmcnt(0)" ::: "memory");
    __syncthreads();
    if (c.tid == 0) (void)xb_add(c.ws<unsigned>(WS_RDY) + (c.layer * 128 + mg) * 16, WN_ == 4 ? 2u : 1u);
}
template <int WN_, int MF>
DEV void h_tile(const Ctx& c, const int* cnt, int mg, int nt8) {
    const int l = c.layer;
    int bucket, mt, tt; moe_find(cnt, mg, bucket, mt, tt);
    int ea, eb; pair_of(bucket % 6, ea, eb); const int grp = bucket / 6;
    const int nvalid = min(256, cnt[bucket * 32] - mt * 256);
    const int* rows = c.ws<int>(WS_LTOK) + bucket * NTOK + mt * 256;
    GemmDesc g; g.A = c.ws<bf16_t>(WS_HBUF); g.lda = 512; g.rowidx = nullptr; g.nvalid = 0;
    g.B0 = c.ws<bf16_t>(WS_WDN) + (size_t)(grp * 4 + ea) * 1024 * 256; g.B1 = c.ws<bf16_t>(WS_WDN) + (size_t)(grp * 4 + eb) * 1024 * 256; g.ldb = 256; g.ksplit = 256; g.K = 512;
    if (c.tid < 64) {
        unsigned* rdy = c.ws<unsigned>(WS_RDY) + (c.layer * 128 + mg) * 16; unsigned* bar = c.ws<unsigned>(WS_BAR);
        { unsigned sp_ = 0; while (xb_ld(rdy) < 8u) { __builtin_amdgcn_s_sleep(2); if ((++sp_ & 1023u) == 0u) { if (xb_ld(&bar[XB_TMO])) break; if (sp_ > (1u << 24)) { atomicAdd(&bar[XB_TMO], 1u); break; } } } }
        __builtin_amdgcn_fence(__ATOMIC_ACQUIRE, "agent");
    }
    gemm_tile<WN_, MF>(g, mg * 256, nt8 * 128, c.lds, c.tid, [&](const f32x4 (&acc)[4][MF], int mb, int nbase, int lane) {
#pragma unroll
        for (int mf = 0; mf < MF; ++mf) { const int r = mb + 16 * mf + (lane & 15);
            if (r < nvalid) { const int tok = rows[r]; const int mbi = tok < NLAT ? (tok >> 11) : 8; const float* gate = c.modv(mbi, 5);
#pragma unroll
                for (int nf = 0; nf < 4; ++nf) { const int n = nbase + 16 * nf + 4 * (lane >> 4); const f32x4 gt = *(const f32x4*)(gate + n), xv = c.xsload4(tok, n), a = acc[nf][mf];
                    const float o0 = xv[0] + gt[0] * a[0], o1 = xv[1] + gt[1] * a[1], o2 = xv[2] + gt[2] * a[2], o3 = xv[3] + gt[3] * a[3];
                    if (l == NL - 1) *(f32x4*)(c.p->out + (size_t)tok * DM + n) = (f32x4){o0, o1, o2, o3};
                    else c.xsstore4(tok, n, o0, o1, o2, o3); } } }
    });
}
DEV void phase_g(const Ctx& c) {
    const int* cnt = c.ws<int>(WS_CNT) + c.layer * NBUCKET * 32;
    int total = 0; { int b, m; moe_find(cnt, 0, b, m, total); }
    const int U = total * 4, Ufull = (U / c.nb) * c.nb, R = U - Ufull;
    for (int u = c.bid; u < Ufull; u += c.nb) g_tile<4, 8>(c, cnt, u >> 2, 2 * (u & 3));
    for (int t = c.bid; t < 2 * R; t += c.nb) { const int u = Ufull + (t >> 1); g_tile<2, 4>(c, cnt, u >> 2, 2 * (u & 3) + (t & 1)); }
}
DEV void phase_h(const Ctx& c) {
    const int* cnt = c.ws<int>(WS_CNT) + c.layer * NBUCKET * 32;
    int total = 0; { int b, m; moe_find(cnt, 0, b, m, total); }
    const int U = __builtin_amdgcn_readfirstlane(total * 4), R = U - (U / c.nb) * c.nb;
    int base = 0;
#pragma unroll 1
    for (int s = 0; base < U; ++s) {
        const int thr = s == 0 ? min(2 * R, c.nb) : (s == 1 ? max(0, 2 * R - c.nb) : 0), nw = c.nb - thr, rem = U - base, k = c.bid - thr;
        if (k >= 0) {
            if (rem < nw && 2 * rem <= nw) { if (k < 2 * rem) { const int j = base + (k >> 1); h_tile<2, 4>(c, cnt, j >> 2, 2 * (j & 3) + (k & 1)); } }
            else if (k < rem) { const int j = base + k; h_tile<4, 8>(c, cnt, j >> 2, 2 * (j & 3)); }
        }
        base += nw;
    }
}

constexpr int PH_P0 = 0, PH_A = 1, PH_B = 2, PH_C = 3, PH_D = 4, PH_E0 = 5, PH_E = 6, PH_F = 7, PH_G = 8, PH_PER_LAYER = 8;
DEV void run_phase(const Ctx& c, int ph) {
    switch (ph) {
        case PH_P0: phase_p0(c); break;
        case PH_A: phase_a(c); break;
        case PH_B: phase_b(c); break;
        case PH_C: phase_c(c); break;
        case PH_D: phase_d(c); break;
        case PH_E0: phase_e0(c); break;
        case PH_E: phase_e(c); break;
        case PH_F: phase_f(c); break;
        case PH_G: phase_g(c); phase_h(c); break;
    }
}

extern __shared__ __attribute__((aligned(16))) char smem_dyn[];

struct XcdBarrier { unsigned* bar; unsigned x; volatile LAS unsigned* st; };
DEV XcdBarrier xcd_barrier_post(unsigned* bar, volatile LAS unsigned* st) {
    XcdBarrier b; b.bar = bar; b.x = xb_xcc_id(); b.st = st;
    if (threadIdx.x == 0) (void)xb_add(&bar[XB_XCNT(b.x)], 1u);
    return b;
}
DEV void xcd_barrier_complete(unsigned* bar, unsigned x, unsigned& nloc, unsigned& nx) {
    const unsigned G = gridDim.x * gridDim.y * gridDim.z;
    unsigned sum, cnt, mine, sp = 0u;
    for (;;) {
        sum = 0u; cnt = 0u; mine = 0u;
#pragma unroll
        for (unsigned j = 0; j < 16; ++j) { const unsigned c = xb_ld(&bar[XB_XCNT(j)]); sum += c; cnt += (c > 0u) ? 1u : 0u; mine = (j == x) ? c : mine; }
        if (sum == G) break;
        __builtin_amdgcn_s_sleep(1);
        if ((++sp & 255u) == 0u) { if (xb_ld(&bar[XB_TMO])) break; if (sp > XB_SPIN_CAP) { atomicAdd(&bar[XB_TMO], 1u); break; } }
    }
    nloc = mine > 0u ? mine : 1u; nx = cnt > 0u ? cnt : 1u;
}
DEV void xcd_barrier(const XcdBarrier& b) {
    asm volatile("s_waitcnt vmcnt(0)" ::: "memory");
    __syncthreads();
    if (threadIdx.x == 0) {
        unsigned* bar = b.bar;
        __builtin_amdgcn_s_waitcnt(0);
        unsigned nloc = b.st[0], nx = b.st[1];
        if (nloc == 0u) { xcd_barrier_complete(bar, b.x, nloc, nx); b.st[0] = nloc; b.st[1] = nx; }
        const unsigned old = xb_add(&bar[XB_XSUB(b.x)], 1u);
        const unsigned gen = old / nloc;
        if (old + 1u == (gen + 1u) * nloc) {
            __builtin_amdgcn_fence(__ATOMIC_RELEASE, "agent");
            asm volatile("s_waitcnt vmcnt(0)" ::: "memory");
            const unsigned og = xb_add(&bar[XB_TOP], 1u);
            const unsigned tg = og / nx;
            if (og + 1u == (tg + 1u) * nx) xb_add(&bar[XB_TOPGEN], 1u);
            else XB_SPIN(xb_ld(&bar[XB_TOPGEN]) == tg, bar);
            __builtin_amdgcn_fence(__ATOMIC_ACQUIRE, "agent");
            xb_add(&bar[XB_XGEN(b.x)], 1u);
            asm volatile("s_waitcnt vmcnt(0)" ::: "memory");
        } else {
            XB_SPIN(xb_ld(&bar[XB_XGEN(b.x)]) == gen, bar);
            __builtin_amdgcn_fence(__ATOMIC_ACQUIRE, "agent");
            asm volatile("s_waitcnt vmcnt(0)" ::: "memory");
        }
    }
    __syncthreads();
}
static_assert(XCD_BAR_WORDS * 4 <= 16384, "barrier words");


#if !MODE_SINGLE
__global__ void __launch_bounds__(NTHREADS, 2) k_phase(Params p, int layer, int ph) {
    Ctx c; c.p = (ParamsPtr)__builtin_amdgcn_kernarg_segment_ptr(); c.layer = layer; c.bid = blockIdx.x; c.nb = gridDim.x; c.tid = threadIdx.x; c.lds = (LAS char*)smem_dyn;
    run_phase(c, ph);
}


#endif
__global__ void __launch_bounds__(NTHREADS, 2) k_mega(Params p) {
    ParamsPtr pp = (ParamsPtr)__builtin_amdgcn_kernarg_segment_ptr();
    const int wave_id = __builtin_amdgcn_readfirstlane(threadIdx.x >> 6);
    Ctx c; c.p = pp; c.layer = 0; c.bid = blockIdx.x; c.nb = gridDim.x; c.tid = threadIdx.x; c.lds = (LAS char*)smem_dyn;
    volatile LAS unsigned* st = (volatile LAS unsigned*)(c.lds + LDS_BAR);
    if (threadIdx.x == 0) { st[0] = 0u; st[1] = 0u; st[2] = 0u; st[3] = 0u; }
    __syncthreads();
    XcdBarrier xb = xcd_barrier_post((unsigned*)(pp->ws + WS_BAR), st);
    unsigned long long t_prev = 0; float tacc1 = 0.f, tacc2 = 0.f;
#pragma unroll 1
    for (int step = 0; step <= 1 + NL * PH_PER_LAYER; ++step) {
        if (step) { xcd_barrier(xb); if (EXP_BAR2) xcd_barrier(xb); }
        if (PROBE_P1 >= -1) {
            const unsigned long long now = __builtin_amdgcn_s_memrealtime();
            if (step) { const int php = step > 1 ? 1 + (step - 2) % PH_PER_LAYER : 0; const float us = (float)(now - t_prev) * 0.01f;
                if (php == PROBE_P1) tacc1 += us; if (php == PROBE_P2) tacc2 += us; }
            t_prev = now;
        }
        if (step == 1 + NL * PH_PER_LAYER) break;
        { ParamsPtr q = pp; int w_ = wave_id, b_ = blockIdx.x, n_ = gridDim.x; asm volatile("" : "+s"(q), "+s"(w_), "+s"(b_), "+s"(n_));
          unsigned m_ = ~0u; asm volatile("" : "+s"(m_));
          int t_ = w_ * 64 + (int)__builtin_amdgcn_mbcnt_hi(m_, __builtin_amdgcn_mbcnt_lo(m_, 0u)); asm volatile("" : "+v"(t_)); c.p = q; c.tid = t_; c.bid = b_; c.nb = n_; }
        c.layer = step ? (step - 1) / PH_PER_LAYER : 0;
        const int ph = step ? 1 + (step - 1) % PH_PER_LAYER : 0;
        run_phase(c, ph);
        if (EXP_REP >= 0 && ph == EXP_REP && (EXP_REP != PH_E || c.layer == 0)) {
            if (EXP_REP == PH_F) { xcd_barrier(xb); if (c.bid == 0 && c.tid < NBUCKET) c.ws<int>(WS_CNT)[(c.layer * NBUCKET + c.tid) * 32] = 0; }
            xcd_barrier(xb); run_phase(c, ph); }
    }
    if (PROBE_P1 >= -1) {
        float* t2 = (float*)(pp->ws + WS_DBG);
        if (c.bid == 0 && c.tid == 0) { t2[0] = PROBE_P1 == -1 ? 100.f : tacc1; t2[1] = tacc2; }
        xcd_barrier(xb);
        const float cfill = sqrtf(t2[0]), spike = 4.f * t2[1];
        float* o = pp->out;
        for (size_t i = (size_t)c.bid * NTHREADS + c.tid; i < (size_t)NLAT * DM; i += (size_t)c.nb * NTHREADS) o[i] = (i == 0) ? spike : cfill;
    }
}

extern "C" void kernel_launch(void* const* d_in, const int* in_sizes, int n_in, void* d_out, int out_size, void* d_ws, size_t ws_size, hipStream_t stream) {
    static int grid = 0;
    if (grid == 0) {
        if (n_in != 29 || ws_size < WS_END) { fprintf(stderr, "kernel_launch: unexpected n_in %d or workspace %zu < %zu\n", n_in, ws_size, (size_t)WS_END); grid = -1; return; }
        int dev = 0, cus = 0, per_cu = 0;
        (void)hipGetDevice(&dev); (void)hipDeviceGetAttribute(&cus, hipDeviceAttributeMultiprocessorCount, dev);
#if MODE_SINGLE
        const void* kfn = (const void*)k_mega;
#else
        const void* kfn = (const void*)k_phase;
#endif
        (void)hipFuncSetAttribute(kfn, hipFuncAttributeMaxDynamicSharedMemorySize, LDS_BYTES);
        (void)hipOccupancyMaxActiveBlocksPerMultiprocessor(&per_cu, kfn, NTHREADS, LDS_BYTES);
        if (per_cu < 1) fprintf(stderr, "kernel_launch: occupancy query reports %d workgroups per CU\n", per_cu);
        grid = cus;
    }
    if (grid < 0) return;
    Params p{};
    for (int i = 0; i < 29; ++i) p.in[i] = (const float*)d_in[i];
    p.out = (float*)d_out; p.ws = (char*)d_ws;
    (void)hipMemsetAsync((char*)d_ws + WS_BAR, 0, WS_ZERO_BYTES, stream);
#if MODE_SINGLE
    void* args[] = {&p};
    hipError_t e = hipLaunchCooperativeKernel((const void*)k_mega, dim3(grid), dim3(NTHREADS), args, LDS_BYTES, stream);
    if (e != hipSuccess) fprintf(stderr, "kernel_launch: cooperative launch failed: %s (grid %d)\n", hipGetErrorString(e), grid);
#else
    hipLaunchKernelGGL(k_phase, dim3(grid), dim3(NTHREADS), LDS_BYTES, stream, p, 0, PH_P0);
    for (int l = 0; l < NL; ++l)
        for (int ph = PH_A; ph <= PH_G; ++ph) hipLaunchKernelGGL(k_phase, dim3(grid), dim3(NTHREADS), LDS_BYTES, stream, p, l, ph);
#endif
}
```

```cpp
#include <hip/hip_runtime.h>
#include <cstdio>
#include <cstdint>

#ifndef MODE_SINGLE
#define MODE_SINGLE 1
#endif
#ifndef EXP_BAR2
#define EXP_BAR2 0
#endif
#ifndef PROBE_P1
#define PROBE_P1 -2
#define PROBE_P2 -2
#endif
#ifndef EXP_REP
#define EXP_REP -1
#endif

#define DEV __device__ __forceinline__
#define LAS __attribute__((address_space(3)))
typedef unsigned short bf16_t;
typedef short bf16x8 __attribute__((ext_vector_type(8)));
typedef float f32x4 __attribute__((ext_vector_type(4)));
typedef float f32x16 __attribute__((ext_vector_type(16)));
typedef unsigned u32x4 __attribute__((ext_vector_type(4)));
typedef unsigned u32x2 __attribute__((ext_vector_type(2)));

constexpr int DM = 1024, NB = 8, SEQ = 2048, CL = 256, NL = 2;
constexpr int NLAT = NB * SEQ, NCTX = NB * CL, NTOK = NLAT + NCTX;
constexpr int KEYS = CL + SEQ;
constexpr int INC = 2208, INCP = 2304;
constexpr int OFF_AU = 0, OFF_AV = 256, OFF_BB = 512, OFF_BC = 768, OFF_BX = 1024, OFF_CQ = 1280, OFF_CK = 1536, OFF_CV = 1664,
              OFF_DCQ = 1792, OFF_DCKV = 2048, OFF_DKR = 2176;
constexpr float EPS = 1e-6f;
constexpr float LOG2E = 1.4426950408889634f;
constexpr float C_SCALE = 0.125f, D_SCALE = 0.10206207261596577f;
constexpr int NBUCKET = 24;
constexpr int MAXMT = NTOK / 256 + NBUCKET;
constexpr int NTHREADS = 512, NW = 8;
constexpr int LDS_BAR = 2 * (256 + 256) * 128, LDS_BYTES = LDS_BAR + 64;

constexpr size_t al256(size_t x) { return (x + 255) & ~(size_t)255; }
constexpr size_t WS_BAR   = 0;
constexpr size_t WS_CNT   = 16384;
constexpr size_t WS_RDY   = WS_CNT + 8192;
constexpr size_t WS_RDYE  = WS_RDY + 16384;
constexpr size_t WS_ZERO_BYTES = 16384 + 8192 + 16384 + 16384;
constexpr size_t WS_MODV  = al256(WS_RDYE + 16384);
constexpr size_t WS_RW    = al256(WS_MODV + (size_t)NL * 9 * 6144 * 4);
constexpr size_t WS_RC    = al256(WS_RW + (size_t)NL * 9 * 2 * 32 * 1024 * 2);
constexpr size_t WS_GM    = al256(WS_RC + (size_t)NL * 9 * 32 * 4);
constexpr size_t WS_ROPEC = al256(WS_GM + (size_t)NL * 9 * 1024 * 4);
constexpr size_t WS_ROPED = al256(WS_ROPEC + (size_t)2 * 2048 * 32 * 4);
constexpr size_t WS_WIN   = al256(WS_ROPED + (size_t)2 * 2048 * 16 * 4);
constexpr size_t WS_WOUT  = al256(WS_WIN + (size_t)NL * INCP * 1024 * 2);
constexpr size_t WS_WUP   = al256(WS_WOUT + (size_t)NL * 1024 * 1024 * 2);
constexpr size_t WS_WDN   = al256(WS_WUP + (size_t)16 * 512 * 1024 * 2);
constexpr size_t WS_WQB   = al256(WS_WDN + (size_t)16 * 1024 * 256 * 2);
constexpr size_t WS_WKVB  = al256(WS_WQB + (size_t)NL * 384 * 256 * 2);
constexpr size_t WS_WSG   = al256(WS_WKVB + (size_t)NL * 512 * 128 * 2);
constexpr size_t WS_XS    = al256(WS_WSG + (size_t)NL * 4 * 128 * 128 * 2);
constexpr size_t WS_ACT   = al256(WS_XS + (size_t)NTOK * 1024 * 2);
constexpr size_t WS_P     = al256(WS_ACT + (size_t)NTOK * 1024 * 2);
constexpr size_t WS_QRAW  = WS_P;
constexpr size_t WS_KVRAW = al256(WS_QRAW + (size_t)NTOK * 384 * 2);
constexpr size_t WS_HBUF  = WS_P;
constexpr size_t WS_QC    = al256(WS_P + (size_t)NTOK * INC * 2);
constexpr size_t WS_KC    = al256(WS_QC + (size_t)NB * 4 * KEYS * 64 * 2);
constexpr size_t WS_VCT   = al256(WS_KC + (size_t)NB * 2 * KEYS * 64 * 2);
constexpr size_t WS_QD    = al256(WS_VCT + (size_t)NB * 2 * 64 * KEYS * 2);
constexpr size_t WS_CQN   = WS_QD;
constexpr size_t WS_CKVN  = WS_QD + (size_t)NTOK * 256 * 2;
constexpr size_t WS_KD    = al256(WS_QD + (size_t)NB * 4 * KEYS * 96 * 2);
constexpr size_t WS_VDT   = al256(WS_KD + (size_t)NB * 4 * KEYS * 96 * 2);
constexpr size_t WS_LTOK  = al256(WS_VDT + (size_t)NB * 4 * 64 * KEYS * 2);
constexpr size_t WS_LW    = al256(WS_LTOK + (size_t)NBUCKET * NTOK * 4);
constexpr size_t WS_SSQ   = al256(WS_LW + (size_t)NBUCKET * NTOK * 8);
constexpr size_t WS_DBG   = al256(WS_SSQ + (size_t)NTOK * 8 * 4);
constexpr size_t WS_END   = WS_DBG + (1 << 20);
static_assert(WS_END <= ((size_t)256 << 20), "workspace");
static_assert((size_t)MAXMT * 256 * 512 * 2 <= (size_t)NTOK * INC * 2, "Hbuf overlay");
static_assert((size_t)NTOK * 384 * 2 <= (size_t)NB * 4 * KEYS * 96 * 2, "CQN/CKVN overlay");

struct Params {
    const float* in[29];
    float* out;
    char* ws;
};
enum { I_X = 0, I_C, I_CTX, I_CCTX, I_WMOD, I_BMOD, I_GATTN, I_WIN, I_SGUVG, I_SGUW, I_SGUB, I_CONVW, I_GQAQG, I_GQAKG, I_QAG, I_WQB, I_KVAG, I_WKVB,
       I_MLAQG, I_MLAKG, I_GGO, I_WOUT, I_GFFN, I_WRG, I_BRG, I_WRE, I_BRE, I_WUP, I_WDN };

DEV bf16_t f2bf(float f) { unsigned u = __float_as_uint(f); u += 0x7fffu + ((u >> 16) & 1u); return (bf16_t)(u >> 16); }
DEV float bf2f(bf16_t h) { return __uint_as_float(((unsigned)h) << 16); }
typedef __bf16 bf16x2_t __attribute__((ext_vector_type(2)));
typedef float f32x2 __attribute__((ext_vector_type(2)));
DEV unsigned pk2(float a, float b) { const f32x2 v = {a, b}; return __builtin_bit_cast(unsigned, __builtin_convertvector(v, bf16x2_t)); }
DEV float bflo(unsigned u) { return __uint_as_float(u << 16); }
DEV float bfhi(unsigned u) { return __uint_as_float(u & 0xffff0000u); }
template <int M> DEV float xlane(float v) {
    const int i = __builtin_bit_cast(int, v);
    if constexpr (M == 1) return __builtin_bit_cast(float, __builtin_amdgcn_mov_dpp(i, 0xB1, 0xF, 0xF, true));
    else if constexpr (M == 2) return __builtin_bit_cast(float, __builtin_amdgcn_mov_dpp(i, 0x4E, 0xF, 0xF, true));
    else if constexpr (M == 8) return __builtin_bit_cast(float, __builtin_amdgcn_mov_dpp(i, 0x128, 0xF, 0xF, true));
    else if constexpr (M == 4 || M == 16) return __builtin_bit_cast(float, __builtin_amdgcn_ds_swizzle(i, (M << 10) | 0x1F));
    else { static_assert(M == 32, "xlane"); const auto r = __builtin_amdgcn_permlane32_swap((unsigned)i, (unsigned)i, false, false);
        return __builtin_bit_cast(float, (int)(r[0] ^ r[1] ^ (unsigned)i)); }
}
DEV float wave_sum(float v) { v += xlane<32>(v); v += xlane<16>(v); v += xlane<8>(v); v += xlane<4>(v); v += xlane<2>(v); v += xlane<1>(v); return v; }
DEV float wave_max(float v) { v = fmaxf(v, xlane<32>(v)); v = fmaxf(v, xlane<16>(v)); v = fmaxf(v, xlane<8>(v)); v = fmaxf(v, xlane<4>(v)); v = fmaxf(v, xlane<2>(v)); return fmaxf(v, xlane<1>(v)); }
DEV float grp_sum16(float v) { v += xlane<1>(v); v += xlane<2>(v); v += xlane<4>(v); v += xlane<8>(v); return v; }
DEV float silu_f(float x) { return x / (1.f + __expf(-x)); }
DEV float gelu_fast(float x) { const float u = 1.5957691216057308f * (x + 0.044715f * x * x * x); return x * __builtin_amdgcn_rcpf(1.f + __expf(-u)); }
DEV void tok_info(int tok, int& b, int& pos, int& key, bool& isctx) {
    if (tok < NLAT) { b = tok >> 11; pos = tok & 2047; key = CL + pos; isctx = false; }
    else { const int c = tok - NLAT; b = c >> 8; pos = c & 255; key = pos; isctx = true; }
}
DEV bf16x8 lds_r128(LAS const char* p) { return *(LAS const bf16x8*)p; }

typedef const __attribute__((address_space(4))) Params* ParamsPtr;
struct Ctx {
    ParamsPtr p; int layer; int bid, nb, tid; LAS char* lds;
    DEV const float* in(int i) const { return p->in[i]; }
    template <class T> DEV T* ws(size_t off) const { return (T*)(p->ws + off); }
    DEV const float* modv(int mb, int chunk) const { return ws<float>(WS_MODV) + ((size_t)(layer * 9 + mb) * 6 + chunk) * 1024; }
    DEV const float* xin(int tok) const { return tok < NLAT ? p->in[I_X] + (size_t)tok * DM : p->in[I_CTX] + (size_t)(tok - NLAT) * DM; }
    DEV bf16_t* xs(int tok) const { return ws<bf16_t>(WS_XS) + (size_t)tok * DM; }
    DEV f32x4 xload4(int tok, int n) const {
        if (layer == 0) return *(const f32x4*)(xin(tok) + n);
        const u32x2 r = *(const u32x2*)(xs(tok) + n); return (f32x4){bflo(r[0]), bfhi(r[0]), bflo(r[1]), bfhi(r[1])};
    }
    DEV f32x4 xsload4(int tok, int n) const { const u32x2 r = *(const u32x2*)(xs(tok) + n); return (f32x4){bflo(r[0]), bfhi(r[0]), bflo(r[1]), bfhi(r[1])}; }
    DEV void xsstore4(int tok, int n, float a, float b, float c2, float d) const { *(u32x2*)(xs(tok) + n) = (u32x2){pk2(a, b), pk2(c2, d)}; }
    DEV void xsstore4_wt(int tok, int n, float a, float b, float c2, float d) const { __hip_atomic_store((__attribute__((address_space(1))) unsigned long long*)(xs(tok) + n), (unsigned long long)pk2(a, b) | ((unsigned long long)pk2(c2, d) << 32), __ATOMIC_RELAXED, __HIP_MEMORY_SCOPE_AGENT); }
    DEV int ntok_tail() const { return layer == NL - 1 ? NLAT : NTOK; }
};

#define GAS __attribute__((address_space(1)))
#define XB_TMO      128
#define XB_XCNT(j)  (256  + 64 * (j))
#define XB_XSUB(j)  (1280 + 64 * (j))
#define XB_XGEN(j)  (2304 + 64 * (j))
#define XB_TOP      3328
#define XB_TOPGEN   3392
#define XCD_BAR_WORDS 3456
#define XB_SPIN_CAP (1u << 22)
DEV unsigned xb_ld(unsigned* p)              { return __hip_atomic_load(p, __ATOMIC_RELAXED, __HIP_MEMORY_SCOPE_AGENT); }
DEV unsigned xb_add(unsigned* p, unsigned v) { return __hip_atomic_fetch_add(p, v, __ATOMIC_RELAXED, __HIP_MEMORY_SCOPE_AGENT); }
DEV unsigned xb_xcc_id() { return (unsigned)__builtin_amdgcn_s_getreg((3 << 11) | 20) & 0xFu; }
#define XB_SPIN(cond, bar) do { unsigned _sp = 0; while (cond) { __builtin_amdgcn_s_sleep(20); \
    if ((++_sp & 255u) == 0u) { if (xb_ld(&(bar)[XB_TMO])) break; if (_sp > XB_SPIN_CAP) { atomicAdd(&(bar)[XB_TMO], 1u); break; } } } } while (0)
DEV void st8_wt(void* p, unsigned lo, unsigned hi) { __hip_atomic_store((GAS unsigned long long*)p, (unsigned long long)lo | ((unsigned long long)hi << 32), __ATOMIC_RELAXED, __HIP_MEMORY_SCOPE_AGENT); }
DEV void publish_add(const Ctx& c, unsigned* w, unsigned v) { asm volatile("s_waitcnt vmcnt(0)" ::: "memory"); __syncthreads(); if (c.tid == 0) (void)xb_add(w, v); }
DEV void publish_rel(const Ctx& c, unsigned* w, unsigned v) {
    asm volatile("s_waitcnt vmcnt(0)" ::: "memory"); __syncthreads();
    if (c.tid == 0) { __builtin_amdgcn_fence(__ATOMIC_RELEASE, "agent"); asm volatile("s_waitcnt vmcnt(0)" ::: "memory"); (void)xb_add(w, v); }
}
DEV void wait_ready(const Ctx& c, unsigned* w0, unsigned want) {
    if (c.tid < 64) { unsigned* bar = c.ws<unsigned>(WS_BAR); unsigned sp_ = 0;
        while (xb_ld(w0) < want) { __builtin_amdgcn_s_sleep(2); if ((++sp_ & 1023u) == 0u) { if (xb_ld(&bar[XB_TMO])) break; if (sp_ > (1u << 24)) { atomicAdd(&bar[XB_TMO], 1u); break; } } }
        __builtin_amdgcn_fence(__ATOMIC_ACQUIRE, "agent"); }
}
struct GemmDesc {
    const bf16_t* A; int lda; const int* rowidx; int nvalid;
    const bf16_t* B0; const bf16_t* B1; int ldb; int ksplit; int K;
};
template <int WN_, int MF, class Epi>
DEV void gemm_tile(const GemmDesc& g, int m0, int n0, LAS char* lds, int tid, const Epi& epi) {
    constexpr int BM = (8 / WN_) * 16 * MF, BN = 64 * WN_, NPA = BM / 8, APW = (NPA + 7) / 8, BP = WN_, STAGE = (BM + BN) * 128;
    static_assert(BM % 8 == 0 && 2 * STAGE <= LDS_BAR, "tile does not fit");
    const int lane = tid & 63, wave = __builtin_amdgcn_readfirstlane(tid >> 6), wm = wave / WN_, wn = wave % WN_;
    int aoff[APW], boff[BP];
#pragma unroll
    for (int j = 0; j < APW; ++j) {
        const int pc = (j * 8 + wave < NPA) ? j * 8 + wave : wave;
        const int r = pc * 8 + (lane >> 3), kc = (lane & 7) ^ ((r >> 1) & 7);
        const int srow = g.rowidx ? g.rowidx[(r < g.nvalid) ? r : 0] : (m0 + r);
        aoff[j] = srow * g.lda + kc * 8;
    }
#pragma unroll
    for (int j = 0; j < BP; ++j) {
        const int r = (j * 8 + wave) * 8 + (lane >> 3), kc = (lane & 7) ^ ((r >> 1) & 7);
        boff[j] = (n0 + r) * g.ldb + kc * 8;
    }
    f32x4 acc[4][MF];
#pragma unroll
    for (int i = 0; i < 4; ++i)
#pragma unroll
        for (int j = 0; j < MF; ++j) acc[i][j] = (f32x4){0.f, 0.f, 0.f, 0.f};
    const int nk = g.K / 64;
    const int swz = (lane >> 1) & 7, q = lane >> 4;
    const int arow = (16 * MF * wm + (lane & 15)) * 128, brow = (64 * wn + (lane & 15)) * 128;
    LAS char* pieceA = lds + wave * 1024;
    LAS char* pieceB = lds + BM * 128 + wave * 1024;
#define GT_STAGE(KT, ST) { const int k0_ = (KT) * 64; const bf16_t* Bb_ = (k0_ < g.ksplit) ? g.B0 + k0_ : g.B1 + (k0_ - g.ksplit); \
        _Pragma("unroll") for (int j = 0; j < APW; ++j) if (NPA % 8 == 0 || j * 8 + wave < NPA) __builtin_amdgcn_global_load_lds((const void*)(g.A + aoff[j] + k0_), (LAS void*)(pieceA + (ST) * STAGE + j * 8192), 16, 0, 0); \
        _Pragma("unroll") for (int j = 0; j < BP; ++j) __builtin_amdgcn_global_load_lds((const void*)(Bb_ + boff[j]), (LAS void*)(pieceB + (ST) * STAGE + j * 8192), 16, 0, 0); }
#define GT_COMPUTE(ST) { LAS const char* As_ = lds + (ST) * STAGE; LAS const char* Bs_ = As_ + BM * 128; \
        _Pragma("unroll") for (int ks = 0; ks < 2; ++ks) { const int ch = ((4 * ks + q) ^ swz) << 4; bf16x8 bfr[4]; \
            _Pragma("unroll") for (int f = 0; f < 4; ++f) bfr[f] = lds_r128(Bs_ + brow + f * 2048 + ch); \
            _Pragma("unroll") for (int mh = 0; mh < MF; mh += 4) { bf16x8 af[4]; \
                _Pragma("unroll") for (int f = 0; f < 4; ++f) af[f] = lds_r128(As_ + arow + (mh + f) * 2048 + ch); \
                _Pragma("unroll") for (int mf = 0; mf < 4; ++mf) _Pragma("unroll") for (int nf = 0; nf < 4; ++nf) \
                    acc[nf][mh + mf] = __builtin_amdgcn_mfma_f32_16x16x32_bf16(bfr[nf], af[mf], acc[nf][mh + mf], 0, 0, 0); } } }
    __syncthreads();
    GT_STAGE(0, 0);
    asm volatile("s_waitcnt vmcnt(0)" ::: "memory");
    __syncthreads();
#pragma unroll 1
    for (int kt = 0; kt < nk; kt += 2) {
        GT_STAGE(kt + 1, 1);
        GT_COMPUTE(0);
        asm volatile("s_waitcnt vmcnt(0)" ::: "memory");
        __syncthreads();
        if (kt + 2 < nk) GT_STAGE(kt + 2, 0);
        GT_COMPUTE(1);
        asm volatile("s_waitcnt vmcnt(0)" ::: "memory");
        __syncthreads();
    }
#undef GT_STAGE
#undef GT_COMPUTE
    {
        int lane_e = lane, mb_e = 16 * MF * wm, nb_e = n0 + 64 * wn;
        asm volatile("" : "+v"(lane_e), "+v"(mb_e), "+v"(nb_e));
        epi(acc, mb_e, __builtin_amdgcn_readfirstlane(nb_e), lane_e);
    }
}

DEV int p8_lds_lo(int fr, int fq) { return (fr * 64 + fq * 16) ^ ((fr >> 3) << 5); }
DEV void p8_stage_rc(int b, int& R, int& C) { const int st = b >> 10, sb = b & 1023, swz = sb ^ (((sb >> 9) & 1) << 5); R = (st >> 1) * 16 + (swz >> 6); C = (st & 1) * 32 + ((swz & 63) >> 1); }
template <class Epi>
DEV void gemm_tile8p(const GemmDesc& g, int m0, int n0, LAS char* lds, int tid, const Epi& epi) {
    const int wid = __builtin_amdgcn_readfirstlane(tid >> 6), lane = tid & 63, wr = wid >> 2, wc = wid & 3, fr = lane & 15, fq = lane >> 4;
    int aoff[2][2], boff[2][2];
#pragma unroll
    for (int i = 0; i < 2; ++i) { int R, C; p8_stage_rc(tid * 16 + i * 8192, R, C);
#pragma unroll
        for (int h = 0; h < 2; ++h) { const int r = h * 128 + R;
            const int srow = g.rowidx ? g.rowidx[(r < g.nvalid) ? r : 0] : (m0 + r);
            aoff[h][i] = srow * g.lda + C; boff[h][i] = (n0 + r) * g.ldb + C; } }
    const int lo = p8_lds_lo(fr, fq);
    LAS char* const stg = lds + wid * 1024;
    LAS const char* const rdA = lds + wr * 8192 + lo;
    LAS const char* const rdB = lds + 65536 + wc * 4096 + lo;
    f32x4 acc[2][2][4][2];
#pragma unroll
    for (int a = 0; a < 2; ++a)
#pragma unroll
        for (int b = 0; b < 2; ++b)
#pragma unroll
            for (int m = 0; m < 4; ++m) { acc[a][b][m][0] = (f32x4){0.f, 0.f, 0.f, 0.f}; acc[a][b][m][1] = acc[a][b][m][0]; }
    bf16x8 At[4][2], B0[2][2], B1[2][2];
    const int nt = g.K / 64;
#define P8_BOFF(kt) (((kt) * 64 < g.ksplit) ? g.B0 + (kt) * 64 : g.B1 + ((kt) * 64 - g.ksplit))
#define STAGE_A(b, h, kt) { _Pragma("unroll") for (int i_ = 0; i_ < 2; ++i_) __builtin_amdgcn_global_load_lds((const void*)(g.A + aoff[h][i_] + (kt) * 64), (LAS void*)(stg + ((b) * 2 + (h)) * 16384 + i_ * 8192), 16, 0, 0); }
#define STAGE_B(b, h, kt) { const bf16_t* Bb_ = P8_BOFF(kt); _Pragma("unroll") for (int i_ = 0; i_ < 2; ++i_) __builtin_amdgcn_global_load_lds((const void*)(Bb_ + boff[h][i_]), (LAS void*)(stg + 65536 + ((b) * 2 + (h)) * 16384 + i_ * 8192), 16, 0, 0); }
#define LDA(b, h) { _Pragma("unroll") for (int m = 0; m < 4; ++m) _Pragma("unroll") for (int k = 0; k < 2; ++k) At[m][k] = lds_r128(rdA + ((b) * 2 + (h)) * 16384 + (m * 2 + k) * 1024); }
#define LDB(dst, b, h) { _Pragma("unroll") for (int n = 0; n < 2; ++n) _Pragma("unroll") for (int k = 0; k < 2; ++k) dst[n][k] = lds_r128(rdB + ((b) * 2 + (h)) * 16384 + (n * 2 + k) * 1024); }
#define MMA(ai, bj, Bx) { __builtin_amdgcn_s_setprio(1); \
        _Pragma("unroll") for (int m = 0; m < 4; ++m) _Pragma("unroll") for (int n = 0; n < 2; ++n) _Pragma("unroll") for (int k = 0; k < 2; ++k) \
            acc[ai][bj][m][n] = __builtin_amdgcn_mfma_f32_16x16x32_bf16(Bx[n][k], At[m][k], acc[ai][bj][m][n], 0, 0, 0); \
        __builtin_amdgcn_s_setprio(0); }
#define WAIT_V(n) asm volatile("s_waitcnt vmcnt(" #n ")" ::: "memory")
#define WAIT_L(n) asm volatile("s_waitcnt lgkmcnt(" #n ")" ::: "memory")
#define BAR __builtin_amdgcn_s_barrier()
#define SCHED __builtin_amdgcn_sched_barrier(0)
    __syncthreads();
    STAGE_B(0, 0, 0); STAGE_A(0, 0, 0); STAGE_B(0, 1, 0); STAGE_A(0, 1, 0);
    if (wr == 1) BAR;
    WAIT_V(4); BAR;
    STAGE_B(1, 0, 1); STAGE_A(1, 0, 1); STAGE_B(1, 1, 1);
    WAIT_V(6); BAR;
#pragma unroll 1
    for (int t = 0; t < nt - 2; t += 2) {
        LDB(B0, 0, 0); SCHED; LDA(0, 0); STAGE_A(1, 1, t + 1);
        WAIT_L(8); BAR; WAIT_L(0); MMA(0, 0, B0); BAR; SCHED;
        LDB(B1, 0, 1); STAGE_B(0, 0, t + 2);
        BAR; WAIT_L(0); MMA(0, 1, B1); BAR;
        LDA(0, 1); STAGE_A(0, 0, t + 2);
        BAR; WAIT_L(0); MMA(1, 0, B0); BAR; SCHED;
        STAGE_B(0, 1, t + 2);
        WAIT_V(6); BAR; MMA(1, 1, B1); BAR;
        LDB(B0, 1, 0); SCHED; LDA(1, 0); STAGE_A(0, 1, t + 2);
        WAIT_L(8); BAR; WAIT_L(0); MMA(0, 0, B0); BAR; SCHED;
        LDB(B1, 1, 1); STAGE_B(1, 0, t + 3);
        BAR; WAIT_L(0); MMA(0, 1, B1); BAR;
        LDA(1, 1); STAGE_A(1, 0, t + 3);
        BAR; WAIT_L(0); MMA(1, 0, B0); BAR; SCHED;
        STAGE_B(1, 1, t + 3);
        WAIT_V(6); BAR; MMA(1, 1, B1); BAR;
    }
    {
        LDB(B0, 0, 0); LDA(0, 0); STAGE_A(1, 1, nt - 1);
        BAR; WAIT_L(0); MMA(0, 0, B0); BAR;
        LDB(B1, 0, 1); BAR; WAIT_L(0); MMA(0, 1, B1); BAR;
        LDA(0, 1); WAIT_V(4); BAR; WAIT_L(0); MMA(1, 0, B0); MMA(1, 1, B1); BAR; }
    {
        LDB(B0, 1, 0); LDA(1, 0); WAIT_V(2); BAR; WAIT_L(0); MMA(0, 0, B0); BAR;
        LDB(B1, 1, 1); WAIT_V(0); BAR; WAIT_L(0); MMA(0, 1, B1); BAR;
        LDA(1, 1); BAR; WAIT_L(0); MMA(1, 0, B0); MMA(1, 1, B1); BAR; }
    if (wr == 0) BAR;
#undef P8_BOFF
#undef STAGE_A
#undef STAGE_B
#undef LDA
#undef LDB
#undef MMA
#undef WAIT_V
#undef WAIT_L
#undef BAR
#undef SCHED
    {
        int lane_e = lane, wr_e = wr, wc_e = wc;
        asm volatile("" : "+v"(lane_e), "+s"(wr_e), "+s"(wc_e));
        epi(acc, wr_e, wc_e, lane_e);
    }
}

DEV void p0_transpose(const float* W, int K, int N, bf16_t* WT, int kt, int nt, int mode, const float* kscale, LAS float* scr, int tid) {
    {
        const int n4 = (tid & 15) * 4, kr = tid >> 4, n_in = nt * 64 + n4;
#pragma unroll
        for (int i = 0; i < 2; ++i) { const int kk = kr + 32 * i; const float s = kscale ? kscale[kt * 64 + kk] : 1.f;
            f32x4 v = (f32x4){0.f, 0.f, 0.f, 0.f};
            if (n_in < N) v = *(const f32x4*)(W + (size_t)(kt * 64 + kk) * N + n_in);
            scr[kk * 65 + n4] = s * v[0]; scr[kk * 65 + n4 + 1] = s * v[1]; scr[kk * 65 + n4 + 2] = s * v[2]; scr[kk * 65 + n4 + 3] = s * v[3]; }
    }
    __syncthreads();
    const int nl = tid >> 3, kcq = tid & 7, n = nt * 64 + nl;
    if (n < N) {
        int drow = n;
        if (mode == 1) { const int type = n >> 8, j = n & 255; drow = 128 * (j >> 6) + 64 * ((j >> 5) & 1) + 16 * (((j >> 4) & 1) + 2 * type) + (j & 15); }
        if (mode == 2) { const int h = n / 96, cc = n % 96; drow = cc < 64 ? 64 * h + cc : 256 + 32 * h + (cc - 64); }
        if (mode == 3) drow = (n & ~255) | (((n >> 5) & 1) << 7) | (((n >> 6) & 3) << 5) | (n & 31);
        unsigned o[4];
#pragma unroll
        for (int j = 0; j < 4; ++j) o[j] = pk2(scr[(kcq * 8 + 2 * j) * 65 + nl], scr[(kcq * 8 + 2 * j + 1) * 65 + nl]);
        *(u32x4*)(WT + (size_t)drow * K + kt * 64 + kcq * 8) = (u32x4){o[0], o[1], o[2], o[3]};
    }
    __syncthreads();
}
constexpr int T_IN = 16 * 35, T_OUT = 16 * 16, T_UP = 16 * 16 * 8, T_DN = 16 * 4 * 16, T_QB = 4 * 6, T_KVB = 2 * 8;
constexpr int T_LAYER = T_IN + T_OUT + T_UP + T_DN + T_QB + T_KVB;
constexpr int P0_TR = NL * T_LAYER, P0_WSG = 32, P0_MODV = NL * 192, P0_ROPE = 192, P0_PAD = 48;
constexpr int P0_ITEMS = P0_TR + P0_WSG + P0_MODV + P0_ROPE + P0_PAD;

DEV void p0_expert_item(const Ctx& c, int l, int item, LAS float* scr, int tid) {
    if (item < T_UP) { const int e = item / 128, q = item % 128;
        p0_transpose(c.in(I_WUP) + ((size_t)l * 16 + e) * 1024 * 512, 1024, 512, c.ws<bf16_t>(WS_WUP) + (size_t)e * 512 * 1024, q / 8, q % 8, 1, nullptr, scr, tid); }
    else { const int r = item - T_UP, e = r / 64, q = r % 64;
        p0_transpose(c.in(I_WDN) + ((size_t)l * 16 + e) * 256 * 1024, 256, 1024, c.ws<bf16_t>(WS_WDN) + (size_t)e * 1024 * 256, q / 16, q % 16, 0, nullptr, scr, tid); }
}
DEV void phase_p0(const Ctx& c) {
    const int tid = c.tid;
    LAS float* scr = (LAS float*)c.lds;
    for (int it = c.bid; it < P0_ITEMS; it += c.nb) {
        int r = it;
        if (r < P0_TR) {
            const int l = r / T_LAYER; r -= l * T_LAYER;
            if (r < T_IN) { p0_transpose(c.in(I_WIN) + (size_t)l * 1024 * INC, 1024, INC, c.ws<bf16_t>(WS_WIN) + (size_t)l * INCP * 1024, r / 35, r % 35, 0, nullptr, scr, tid); continue; } r -= T_IN;
            if (r < T_OUT) { p0_transpose(c.in(I_WOUT) + (size_t)l * 1024 * 1024, 1024, 1024, c.ws<bf16_t>(WS_WOUT) + (size_t)l * 1024 * 1024, r / 16, r % 16, 3, nullptr, scr, tid); continue; } r -= T_OUT;
            if (r < T_UP) { if (l == 0) p0_expert_item(c, 0, r, scr, tid); continue; } r -= T_UP;
            if (r < T_DN) { if (l == 0) p0_expert_item(c, 0, T_UP + r, scr, tid); continue; } r -= T_DN;
            if (r < T_QB) { p0_transpose(c.in(I_WQB) + (size_t)l * 256 * 384, 256, 384, c.ws<bf16_t>(WS_WQB) + (size_t)l * 384 * 256, r / 6, r % 6, 2, c.in(I_QAG) + l * 256, scr, tid); continue; } r -= T_QB;
            p0_transpose(c.in(I_WKVB) + (size_t)l * 128 * 512, 128, 512, c.ws<bf16_t>(WS_WKVB) + (size_t)l * 512 * 128, r / 8, r % 8, 0, c.in(I_KVAG) + l * 128, scr, tid); continue;
        }
        r -= P0_TR;
        if (r < P0_WSG) {
            const size_t e0 = ((size_t)r * NTHREADS + tid) * 8; const float* s = c.in(I_SGUW) + e0;
            const f32x4 a = *(const f32x4*)s, b = *(const f32x4*)(s + 4);
            *(u32x4*)(c.ws<bf16_t>(WS_WSG) + e0) = (u32x4){pk2(a[0], a[1]), pk2(a[2], a[3]), pk2(b[0], b[1]), pk2(b[2], b[3])};
            continue;
        }
        r -= P0_WSG;
        if (r < P0_MODV) {
            const int l = r / 192, n0 = (r % 192) * 32;
            LAS float* sc = scr;
            LAS float* red = scr + 9 * 1024;
            __syncthreads();
            for (int i = tid; i < 9 * 1024; i += NTHREADS) { const int mb = i >> 10, k = i & 1023; sc[i] = silu_f(mb < 8 ? c.in(I_C)[mb * 1024 + k] : c.in(I_CCTX)[k]); }
            __syncthreads();
            const int kq = tid >> 3, nl = tid & 7;
            float a[9][4];
#pragma unroll
            for (int j = 0; j < 9; ++j) { a[j][0] = 0.f; a[j][1] = 0.f; a[j][2] = 0.f; a[j][3] = 0.f; }
            const float* wp = c.in(I_WMOD) + (size_t)l * 1024 * 6144 + n0 + 4 * nl;
#pragma unroll 8
            for (int k2 = 0; k2 < 16; ++k2) { const int k = kq * 16 + k2; const f32x4 w = *(const f32x4*)(wp + (size_t)k * 6144);
#pragma unroll
                for (int j = 0; j < 9; ++j) { const float s = sc[j * 1024 + k]; a[j][0] += s * w[0]; a[j][1] += s * w[1]; a[j][2] += s * w[2]; a[j][3] += s * w[3]; } }
#pragma unroll
            for (int j = 0; j < 9; ++j)
#pragma unroll
                for (int q = 0; q < 4; ++q) { float v = a[j][q]; v += xlane<8>(v); v += xlane<16>(v); v += xlane<32>(v); a[j][q] = v; }
            if ((tid & 63) < 8) {
#pragma unroll
                for (int j = 0; j < 9; ++j)
#pragma unroll
                    for (int q = 0; q < 4; ++q) red[((tid >> 6) * 9 + j) * 32 + 4 * nl + q] = a[j][q];
            }
            __syncthreads();
            for (int i = tid; i < 9 * 32; i += NTHREADS) { const int mb = i >> 5, n = i & 31;
                float v = 0.f;
#pragma unroll
                for (int w = 0; w < NW; ++w) v += red[(w * 9 + mb) * 32 + n];
                c.ws<float>(WS_MODV)[(size_t)(l * 9 + mb) * 6144 + n0 + n] = v + c.in(I_BMOD)[l * 6144 + n0 + n]; }
            __syncthreads();
            continue;
        }
        r -= P0_MODV;
        if (r < P0_ROPE) {
            const int idx = r * NTHREADS + tid;
            if (idx < 2048 * 32) { const int s = idx >> 5, i = idx & 31, f = i & 15; const float pos = (float)((i < 16) ? (s >> 6) : (s & 63));
                const float inv = powf(10000.f, -(float)f / 16.f), ang = pos * inv;
                c.ws<float>(WS_ROPEC)[idx] = cosf(ang); c.ws<float>(WS_ROPEC)[2048 * 32 + idx] = sinf(ang); }
            else { const int j = idx - 2048 * 32, s = j >> 4, i = j & 15, f = i & 7; const float pos = (float)((i < 8) ? (s >> 6) : (s & 63));
                const float inv = powf(10000.f, -(float)f / 8.f), ang = pos * inv;
                c.ws<float>(WS_ROPED)[j] = cosf(ang); c.ws<float>(WS_ROPED)[2048 * 16 + j] = sinf(ang); }
            continue;
        }
        r -= P0_ROPE;
        {
            const int e = (r * NTHREADS + tid) * 8, l = e / (96 * 1024), o = e % (96 * 1024);
            unsigned z = 0u; asm volatile("" : "+v"(z));
            *(u32x4*)(c.ws<bf16_t>(WS_WIN) + ((size_t)l * INCP + INC) * 1024 + o) = (u32x4){z, z, z, z};
        }
    }
}

constexpr int A_RW_ITEMS = NL * 9 * 1024 / NTHREADS;
constexpr int A_RC_ITEMS = NL * 9 * 20 / NW;
DEV void phase_a(const Ctx& c) {
    const int tid = c.tid, lane = tid & 63, wave = tid >> 6;
    const float* g = c.in(I_GATTN) + c.layer * 1024;
    bf16_t* H = c.ws<bf16_t>(WS_ACT);
    const int nwv = c.nb * NW, per = (NTOK + nwv - 1) / nwv, tbeg = (c.bid * NW + wave) * per, tend = min(tbeg + per, NTOK);
    int mbc = -1; f32x4 gm[4], sv[4];
#pragma unroll 1
    for (int t0 = tbeg; t0 < tend; t0 += 3) {
        f32x4 v[3][4];
#pragma unroll
        for (int u = 0; u < 3; ++u) { const int tok = min(t0 + u, tend - 1);
#pragma unroll
            for (int i = 0; i < 4; ++i) v[u][i] = c.xload4(tok, i * 256 + lane * 4); }
#pragma unroll
        for (int u = 0; u < 3; ++u) { const int tok = t0 + u;
            if (tok < tend) {
                const int mb = tok < NLAT ? (tok >> 11) : 8;
                if (mb != mbc) { mbc = mb; const float* sh = c.modv(mb, 0); const float* scl = c.modv(mb, 1);
#pragma unroll
                    for (int i = 0; i < 4; ++i) { const int e = i * 256 + lane * 4; const f32x4 gg = *(const f32x4*)(g + e), s1 = *(const f32x4*)(scl + e);
                        gm[i] = (f32x4){gg[0] * (1.f + s1[0]), gg[1] * (1.f + s1[1]), gg[2] * (1.f + s1[2]), gg[3] * (1.f + s1[3])}; sv[i] = *(const f32x4*)(sh + e); } }
                float ss = 0.f;
#pragma unroll
                for (int i = 0; i < 4; ++i) ss += v[u][i][0] * v[u][i][0] + v[u][i][1] * v[u][i][1] + v[u][i][2] * v[u][i][2] + v[u][i][3] * v[u][i][3];
                const float r = rsqrtf(wave_sum(ss) * (1.f / 1024.f) + EPS);
#pragma unroll
                for (int i = 0; i < 4; ++i) { const int e = i * 256 + lane * 4;
                    float o[4];
#pragma unroll
                    for (int j = 0; j < 4; ++j) o[j] = v[u][i][j] * r * gm[i][j] + sv[i][j];
                    *(u32x2*)(H + (size_t)tok * 1024 + e) = (u32x2){pk2(o[0], o[1]), pk2(o[2], o[3])}; }
            } }
    }
    if (c.layer == 0) {
        for (int it = c.bid; it < A_RW_ITEMS + A_RC_ITEMS; it += c.nb) {
            if (it < A_RW_ITEMS) {
                const int idx = it * NTHREADS + tid, l = idx / (9 * 1024), mb = (idx >> 10) % 9, k = idx & 1023;
                const float* mv = c.ws<float>(WS_MODV) + (size_t)(l * 9 + mb) * 6144;
                const float gm = c.in(I_GFFN)[l * 1024 + k] * (1.f + mv[4 * 1024 + k]);
                c.ws<float>(WS_GM)[idx] = gm;
                bf16_t* o = c.ws<bf16_t>(WS_RW) + (size_t)(l * 9 + mb) * 2 * 32 * 1024 + k;
                const float* wg = c.in(I_WRG) + ((size_t)l * 1024 + k) * 4; const float* we = c.in(I_WRE) + ((size_t)l * 1024 + k) * 16;
#pragma unroll
                for (int j = 0; j < 32; ++j) { const float w = j < 20 ? gm * (j < 4 ? wg[j] : we[j - 4]) : 0.f;
                    const bf16_t hi = f2bf(w); o[(size_t)j * 1024] = hi; o[(size_t)(32 + j) * 1024] = f2bf(w - bf2f(hi)); }
            } else {
                const int idx = (it - A_RW_ITEMS) * NW + wave, l = idx / 180, mb = (idx / 20) % 9, j = idx % 20;
                const float* mv = c.ws<float>(WS_MODV) + (size_t)(l * 9 + mb) * 6144 + 3 * 1024;
                float a = 0.f;
                for (int k = lane; k < 1024; k += 64) { const float w = (j < 4) ? c.in(I_WRG)[((size_t)l * 1024 + k) * 4 + j] : c.in(I_WRE)[((size_t)l * 1024 + k) * 16 + (j - 4)]; a += mv[k] * w; }
                a = wave_sum(a);
                if (lane == 0) c.ws<float>(WS_RC)[(l * 9 + mb) * 32 + j] = a + ((j < 4) ? c.in(I_BRG)[l * 4 + j] : c.in(I_BRE)[l * 16 + j - 4]);
            }
        }
    }
}

DEV void rope2(float& a, float& b, float cs, float sn) { const float x0 = a, x1 = b; a = x0 * cs - x1 * sn; b = x0 * sn + x1 * cs; }
DEV float red_q(float v) { v += xlane<16>(v); v += xlane<32>(v); return v; }
template <int MF>
DEV void b_epilogue(const Ctx& c, const f32x4 (&acc)[4][MF], int m0, int mb, int nbase, int lane) {
    const int l = c.layer;
    bf16_t* P = c.ws<bf16_t>(WS_P);
    const int q = lane >> 4, li = lane & 15;
    const bool isctx = m0 >= NLAT;
    if (nbase < 256) {
#pragma unroll
        for (int mf = 0; mf < MF; ++mf) { const int m = m0 + mb + 16 * mf + li;
#pragma unroll
            for (int nf = 0; nf < 4; ++nf) { const f32x4 a = acc[nf][mf];
                *(u32x2*)(P + (size_t)m * INC + nbase + 16 * nf + 4 * q) = (u32x2){pk2(gelu_fast(a[0]), gelu_fast(a[1])), pk2(gelu_fast(a[2]), gelu_fast(a[3]))}; } }
    } else if (nbase < 512) {
        const float* vg = c.in(I_SGUVG) + l * 256 + (nbase - 256) + 4 * q;
#pragma unroll
        for (int mf = 0; mf < MF; ++mf) { const int m = m0 + mb + 16 * mf + li;
            float v[4][4]; float ss = 0.f;
#pragma unroll
            for (int nf = 0; nf < 4; ++nf)
#pragma unroll
                for (int r = 0; r < 4; ++r) { v[nf][r] = gelu_fast(acc[nf][mf][r]); ss += v[nf][r] * v[nf][r]; }
            const float rr = rsqrtf(red_q(ss) * (1.f / 64.f) + EPS);
#pragma unroll
            for (int nf = 0; nf < 4; ++nf) { const f32x4 gg = *(const f32x4*)(vg + 16 * nf);
                *(u32x2*)(P + (size_t)m * INC + nbase + 16 * nf + 4 * q) = (u32x2){pk2(v[nf][0] * rr * gg[0], v[nf][1] * rr * gg[1]), pk2(v[nf][2] * rr * gg[2], v[nf][3] * rr * gg[3])}; } }
    } else if (nbase < OFF_CQ || (nbase >= OFF_DCQ && nbase < OFF_DKR)) {
        const bool need_ss = nbase >= OFF_DCQ;
        const int sidx = nbase < OFF_DCKV ? (nbase - OFF_DCQ) >> 6 : 4 + ((nbase - OFF_DCKV) >> 6);
#pragma unroll
        for (int mf = 0; mf < MF; ++mf) { const int m = m0 + mb + 16 * mf + li; float ss = 0.f;
#pragma unroll
            for (int nf = 0; nf < 4; ++nf) { const f32x4 a = acc[nf][mf]; ss += a[0] * a[0] + a[1] * a[1] + a[2] * a[2] + a[3] * a[3];
                *(u32x2*)(P + (size_t)m * INC + nbase + 16 * nf + 4 * q) = (u32x2){pk2(a[0], a[1]), pk2(a[2], a[3])}; }
            if (need_ss) { ss = red_q(ss); if (q == 0) c.ws<float>(WS_SSQ)[(size_t)m * 8 + sidx] = ss; } }
    } else if (nbase < OFF_CV) {
        const bool isq = nbase < OFF_CK;
        const int h = isq ? (nbase - OFF_CQ) >> 6 : (nbase - OFF_CK) >> 6;
        const float* gn = (isq ? c.in(I_GQAQG) : c.in(I_GQAKG)) + l * 64 + 4 * q;
        const float sc = isq ? C_SCALE * LOG2E : 1.f;
        const float* cosC = c.ws<float>(WS_ROPEC); const float* sinC = cosC + 2048 * 32;
#pragma unroll
        for (int mf = 0; mf < MF; ++mf) { const int m = m0 + mb + 16 * mf + li;
            int b, pos, key; bool ic; tok_info(m, b, pos, key, ic);
            float ss = 0.f;
#pragma unroll
            for (int nf = 0; nf < 4; ++nf) { const f32x4 a = acc[nf][mf]; ss += a[0] * a[0] + a[1] * a[1] + a[2] * a[2] + a[3] * a[3]; }
            const float rr = rsqrtf(red_q(ss) * (1.f / 64.f) + EPS);
            bf16_t* dst = isq ? c.ws<bf16_t>(WS_QC) + ((size_t)(b * 4 + h) * KEYS + key) * 64 : c.ws<bf16_t>(WS_KC) + ((size_t)(b * 2 + h) * KEYS + key) * 64;
#pragma unroll
            for (int nf = 0; nf < 4; ++nf) { const f32x4 gg = *(const f32x4*)(gn + 16 * nf); const f32x4 a = acc[nf][mf];
                float v0 = a[0] * rr * gg[0], v1 = a[1] * rr * gg[1], v2 = a[2] * rr * gg[2], v3 = a[3] * rr * gg[3];
                if (!isctx) { const f32x2 cs = *(const f32x2*)(cosC + pos * 32 + 8 * nf + 2 * q), sn = *(const f32x2*)(sinC + pos * 32 + 8 * nf + 2 * q);
                    rope2(v0, v1, cs[0], sn[0]); rope2(v2, v3, cs[1], sn[1]); }
                *(u32x2*)(dst + 16 * nf + 4 * q) = (u32x2){pk2(v0 * sc, v1 * sc), pk2(v2 * sc, v3 * sc)}; } }
    } else if (nbase < OFF_DCQ) {
        const int kvh = (nbase - OFF_CV) >> 6;
#pragma unroll
        for (int mf = 0; mf < MF; ++mf) { const int m = m0 + mb + 16 * mf + li;
            int b, pos, key; bool ic; tok_info(m, b, pos, key, ic);
            bf16_t* dst = c.ws<bf16_t>(WS_VCT) + ((size_t)(b * 2 + kvh) * 64 + 4 * q) * KEYS + key;
#pragma unroll
            for (int nf = 0; nf < 4; ++nf) { const f32x4 a = acc[nf][mf]; const unsigned p0 = pk2(a[0], a[1]), p1 = pk2(a[2], a[3]);
                bf16_t* d = dst + (size_t)(16 * nf) * KEYS;
                d[0] = (bf16_t)(p0 & 0xffffu); d[KEYS] = (bf16_t)(p0 >> 16); d[2 * KEYS] = (bf16_t)(p1 & 0xffffu); d[3 * KEYS] = (bf16_t)(p1 >> 16); } }
    } else if (nbase < OFF_DKR + 64) {
        const float* gn = c.in(I_MLAKG) + l * 96 + 64 + 4 * q;
        const float* cosD = c.ws<float>(WS_ROPED); const float* sinD = cosD + 2048 * 16;
#pragma unroll
        for (int mf = 0; mf < MF; ++mf) { const int m = m0 + mb + 16 * mf + li;
            int b, pos, key; bool ic; tok_info(m, b, pos, key, ic);
            float ss = 0.f;
#pragma unroll
            for (int nf = 0; nf < 2; ++nf) { const f32x4 a = acc[nf][mf]; ss += a[0] * a[0] + a[1] * a[1] + a[2] * a[2] + a[3] * a[3]; }
            const float rr = rsqrtf(red_q(ss) * (1.f / 32.f) + EPS);
#pragma unroll
            for (int nf = 0; nf < 2; ++nf) { const f32x4 gg = *(const f32x4*)(gn + 16 * nf); const f32x4 a = acc[nf][mf];
                float v0 = a[0] * rr * gg[0], v1 = a[1] * rr * gg[1], v2 = a[2] * rr * gg[2], v3 = a[3] * rr * gg[3];
                if (!isctx) { const f32x2 cs = *(const f32x2*)(cosD + pos * 16 + 8 * nf + 2 * q), sn = *(const f32x2*)(sinD + pos * 16 + 8 * nf + 2 * q);
                    rope2(v0, v1, cs[0], sn[0]); rope2(v2, v3, cs[1], sn[1]); }
                const u32x2 o = (u32x2){pk2(v0, v1), pk2(v2, v3)};
#pragma unroll
                for (int h = 0; h < 4; ++h) *(u32x2*)(c.ws<bf16_t>(WS_KD) + ((size_t)(b * 4 + h) * KEYS + key) * 96 + 64 + 16 * nf + 4 * q) = o; } }
    }
}
DEV void phase_b(const Ctx& c) {
    const int l = c.layer;
    GemmDesc g; g.A = c.ws<bf16_t>(WS_ACT); g.lda = 1024; g.rowidx = nullptr; g.nvalid = 0;
    g.B0 = c.ws<bf16_t>(WS_WIN) + (size_t)l * INCP * 1024; g.B1 = g.B0; g.ldb = 1024; g.ksplit = 1 << 30; g.K = 1024;
    constexpr int NT_N = INCP / 256, NT_M = NTOK / 256;
    auto full_tile = [&](int mt, int nt) { const int m0 = mt * 256;
        gemm_tile<4, 8>(g, m0, nt * 256, c.lds, c.tid, [&](const f32x4 (&acc)[4][8], int mb, int nbase, int lane) { b_epilogue<8>(c, acc, m0, mb, nbase, lane); }); };
    if (c.nb != 256) { for (int t = c.bid; t < NT_M * NT_N; t += c.nb) full_tile(t / NT_N, t % NT_N); }
    else if (l < NL - 1) {
        const int nmine = c.bid < 136 ? 3 : 2;
        for (int rd = 0; rd < nmine; ++rd) {
            int mt, nt, ex = -1, ch = -1;
            if (c.bid >= 136) ex = (c.bid - 136) + 120 * rd;
            else if (rd == 0) { if (c.bid < 48) ex = 240 + c.bid; else ch = c.bid - 48; }
            else ch = 88 + 136 * (rd - 1) + c.bid;
            if (ex >= 0) { const int k = ex / 72; nt = k == 0 ? 5 : (k == 1 ? 6 : (k == 2 ? 1 : 0)); mt = ex % 72; }
            else { const int k = ch / 72; nt = k < 3 ? 2 + k : 4 + k; mt = ch % 72; }
            full_tile(mt, nt);
        }
    } else {
        auto unit = [&](int u, int& mt, int& nt) {
            if (u < 256) { const int k = u >> 6; nt = k == 0 ? 5 : (k == 1 ? 6 : (k == 2 ? 1 : 0)); mt = u & 63; }
            else if (u < 576) { const int v = u - 256, k = v >> 6; nt = k < 3 ? 2 + k : 4 + k; mt = v & 63; }
            else { const int v = u - 576; nt = (v >> 3) ? 8 : 6; mt = 64 + (v & 7); } };
        for (int rd = 0; rd < 2; ++rd) { int mt, nt; unit(c.bid + 256 * rd, mt, nt); full_tile(mt, nt); }
        if (c.bid < 160) { int mt, nt; unit(512 + (c.bid >> 1), mt, nt); const int m0 = mt * 256;
            gemm_tile<2, 4>(g, m0, nt * 256 + (c.bid & 1) * 128, c.lds, c.tid, [&](const f32x4 (&acc)[4][4], int mb, int nbase, int lane) { b_epilogue<4>(c, acc, m0, mb, nbase, lane); }); }
    }
    if (l > 0) {
        for (int e = c.bid; e < T_UP + T_DN; e += c.nb) p0_expert_item(c, l, e, (LAS float*)c.lds, c.tid);
    }
}

constexpr int C_SGU_ITEMS = (NTOK / 128) * 4, C_TQ = (NTOK / 256) * 3, C_TKV = (NTOK / 256) * 4;
constexpr int SG_LD = 272;
DEV void phase_c_sgu(const Ctx& c, int item) {
    const int tid = c.tid, lane = tid & 63, wave = tid >> 6, l = c.layer;
    const int chunk = item >> 2, h = item & 3, tok0 = chunk * 128;
    const bf16_t* P = c.ws<bf16_t>(WS_P);
    LAS char* Wt = c.lds;
    LAS char* vT = c.lds + 128 * SG_LD;
    __syncthreads();
    {
        const bf16_t* Wsrc = c.ws<bf16_t>(WS_WSG) + (size_t)(l * 4 + h) * 128 * 128;
#pragma unroll
        for (int i = 0; i < 4; ++i) { const int ci = tid + NTHREADS * i, r = ci >> 4, kc = ci & 15; *(LAS u32x4*)(Wt + r * SG_LD + kc * 16) = *(const u32x4*)(Wsrc + r * 128 + kc * 8); }
        const int j = tid >> 2, qt = tid & 3;
        const bf16_t* vp = P + (size_t)(tok0 + j) * INC + OFF_AV + 64 * h + 16 * qt;
#pragma unroll
        for (int q = 0; q < 2; ++q) { const u32x4 raw = *(const u32x4*)(vp + 8 * q);
#pragma unroll
            for (int e = 0; e < 4; ++e) { LAS char* d = vT + (16 * qt + 8 * q + 2 * e) * SG_LD + j * 2;
                *(LAS bf16_t*)d = (bf16_t)(raw[e] & 0xffffu); *(LAS bf16_t*)(d + SG_LD) = (bf16_t)(raw[e] >> 16); } }
    }
    __syncthreads();
    f32x4 acc[4];
#pragma unroll
    for (int a = 0; a < 4; ++a) acc[a] = (f32x4){0.f, 0.f, 0.f, 0.f};
    const int q = lane >> 4, li = lane & 15;
#pragma unroll
    for (int ks = 0; ks < 4; ++ks) {
        bf16x8 af[4];
#pragma unroll
        for (int df = 0; df < 4; ++df) af[df] = lds_r128(vT + (16 * df + li) * SG_LD + (4 * ks + q) * 16);
        const bf16x8 bfr = lds_r128(Wt + (16 * wave + li) * SG_LD + (4 * ks + q) * 16);
#pragma unroll
        for (int df = 0; df < 4; ++df) acc[df] = __builtin_amdgcn_mfma_f32_16x16x32_bf16(af[df], bfr, acc[df], 0, 0, 0);
    }
    bf16_t* Y = c.ws<bf16_t>(WS_ACT);
    {
        const int i = 16 * wave + li, tok = tok0 + i;
        const float bs = c.in(I_SGUB)[(l * 4 + h) * 128 + i];
#pragma unroll
        for (int df = 0; df < 4; ++df) {
            const int d0 = 16 * df + 4 * q;
            const u32x2 ur = *(const u32x2*)(P + (size_t)tok * INC + OFF_AU + 64 * h + d0);
            const f32x4 a = acc[df];
            *(u32x2*)(Y + (size_t)tok * 1024 + 64 * h + d0) = (u32x2){pk2(bflo(ur[0]) * (a[0] + bs), bfhi(ur[0]) * (a[1] + bs)), pk2(bflo(ur[1]) * (a[2] + bs), bfhi(ur[1]) * (a[3] + bs))};
        }
    }
}
DEV void phase_c(const Ctx& c) {
    const int l = c.layer;
    const bf16_t* P = c.ws<bf16_t>(WS_P);
    const float* cosD = c.ws<float>(WS_ROPED); const float* sinD = cosD + 2048 * 16;
    int it = c.bid;
    const bool lastl = (l == NL - 1);
    for (; it < C_SGU_ITEMS; it += c.nb) { if (!(lastl && (it >> 2) >= NLAT / 128)) phase_c_sgu(c, it); }
    for (; it < C_SGU_ITEMS + C_TQ; it += c.nb) {
        const int t = it - C_SGU_ITEMS, mt = t / 3, nt = t % 3, m0 = mt * 256;
        if (lastl && m0 >= NLAT) continue;
        GemmDesc g; g.rowidx = nullptr; g.nvalid = 0; g.ksplit = 1 << 30; g.lda = INC;
        g.A = P + OFF_DCQ; g.K = 256; g.B0 = c.ws<bf16_t>(WS_WQB) + (size_t)l * 384 * 256; g.B1 = g.B0; g.ldb = 256;
        gemm_tile<2, 4>(g, m0, nt * 128, c.lds, c.tid, [&](const f32x4 (&acc)[4][4], int mb, int nbase, int lane) {
            const int q = lane >> 4, li = lane & 15, wn = (nbase >> 6) & 1;
            const bool isctx = m0 >= NLAT;
            const float* qg = c.in(I_MLAQG) + l * 96;
            const float sc = D_SCALE * LOG2E;
#pragma unroll
            for (int mf = 0; mf < 4; ++mf) { const int m = m0 + mb + 16 * mf + li;
                int b, pos, key; bool ic; tok_info(m, b, pos, key, ic);
                const f32x4 s4 = *(const f32x4*)(c.ws<float>(WS_SSQ) + (size_t)m * 8);
                const float r0 = rsqrtf((s4[0] + s4[1] + s4[2] + s4[3]) * (1.f / 256.f) + EPS);
                if (nt < 2) {
                    const int h = 2 * nt + wn; float ss = 0.f;
#pragma unroll
                    for (int nf = 0; nf < 4; ++nf) { const f32x4 a = acc[nf][mf] * r0; ss += a[0] * a[0] + a[1] * a[1] + a[2] * a[2] + a[3] * a[3]; }
                    const float rr = rsqrtf(red_q(ss) * (1.f / 64.f) + EPS) * r0 * sc;
                    bf16_t* dst = c.ws<bf16_t>(WS_QD) + ((size_t)(b * 4 + h) * KEYS + key) * 96 + 4 * q;
#pragma unroll
                    for (int nf = 0; nf < 4; ++nf) { const f32x4 gg = *(const f32x4*)(qg + 16 * nf + 4 * q); const f32x4 a = acc[nf][mf];
                        *(u32x2*)(dst + 16 * nf) = (u32x2){pk2(a[0] * rr * gg[0], a[1] * rr * gg[1]), pk2(a[2] * rr * gg[2], a[3] * rr * gg[3])}; }
                } else {
#pragma unroll
                    for (int hh = 0; hh < 2; ++hh) { const int h = 2 * wn + hh; float ss = 0.f;
#pragma unroll
                        for (int n2 = 0; n2 < 2; ++n2) { const f32x4 a = acc[2 * hh + n2][mf] * r0; ss += a[0] * a[0] + a[1] * a[1] + a[2] * a[2] + a[3] * a[3]; }
                        const float rr = rsqrtf(red_q(ss) * (1.f / 32.f) + EPS) * r0;
                        bf16_t* dst = c.ws<bf16_t>(WS_QD) + ((size_t)(b * 4 + h) * KEYS + key) * 96 + 64 + 4 * q;
#pragma unroll
                        for (int n2 = 0; n2 < 2; ++n2) { const f32x4 gg = *(const f32x4*)(qg + 64 + 16 * n2 + 4 * q); const f32x4 a = acc[2 * hh + n2][mf];
                            float v0 = a[0] * rr * gg[0], v1 = a[1] * rr * gg[1], v2 = a[2] * rr * gg[2], v3 = a[3] * rr * gg[3];
                            if (!isctx) { const f32x2 cs = *(const f32x2*)(cosD + pos * 16 + 8 * n2 + 2 * q), sn = *(const f32x2*)(sinD + pos * 16 + 8 * n2 + 2 * q);
                                rope2(v0, v1, cs[0], sn[0]); rope2(v2, v3, cs[1], sn[1]); }
                            *(u32x2*)(dst + 16 * n2) = (u32x2){pk2(v0 * sc, v1 * sc), pk2(v2 * sc, v3 * sc)}; } }
                }
            }
        });
    }
    for (; it < C_SGU_ITEMS + C_TQ + C_TKV; it += c.nb) {
        const int t = it - C_SGU_ITEMS - C_TQ, mt = t >> 2, h = t & 3, m0 = mt * 256;
        GemmDesc g; g.rowidx = nullptr; g.nvalid = 0; g.ksplit = 1 << 30; g.lda = INC;
        g.A = P + OFF_DCKV; g.K = 128; g.B0 = c.ws<bf16_t>(WS_WKVB) + (size_t)l * 512 * 128; g.B1 = g.B0; g.ldb = 128;
        gemm_tile<2, 4>(g, m0, h * 128, c.lds, c.tid, [&](const f32x4 (&acc)[4][4], int mb, int nbase, int lane) {
            const int q = lane >> 4, li = lane & 15, wn = (nbase >> 6) & 1;
            const float* kg = c.in(I_MLAKG) + l * 96;
#pragma unroll
            for (int mf = 0; mf < 4; ++mf) { const int m = m0 + mb + 16 * mf + li;
                int b, pos, key; bool ic; tok_info(m, b, pos, key, ic);
                const float* sp = c.ws<float>(WS_SSQ) + (size_t)m * 8;
                const float r0 = rsqrtf((sp[4] + sp[5]) * (1.f / 128.f) + EPS);
                if (wn == 0) {
                    float ss = 0.f;
#pragma unroll
                    for (int nf = 0; nf < 4; ++nf) { const f32x4 a = acc[nf][mf] * r0; ss += a[0] * a[0] + a[1] * a[1] + a[2] * a[2] + a[3] * a[3]; }
                    const float rr = rsqrtf(red_q(ss) * (1.f / 64.f) + EPS) * r0;
                    bf16_t* dst = c.ws<bf16_t>(WS_KD) + ((size_t)(b * 4 + h) * KEYS + key) * 96 + 4 * q;
#pragma unroll
                    for (int nf = 0; nf < 4; ++nf) { const f32x4 gg = *(const f32x4*)(kg + 16 * nf + 4 * q); const f32x4 a = acc[nf][mf];
                        *(u32x2*)(dst + 16 * nf) = (u32x2){pk2(a[0] * rr * gg[0], a[1] * rr * gg[1]), pk2(a[2] * rr * gg[2], a[3] * rr * gg[3])}; }
                } else {
                    bf16_t* dst = c.ws<bf16_t>(WS_VDT) + ((size_t)(b * 4 + h) * 64 + 4 * q) * KEYS + key;
#pragma unroll
                    for (int nf = 0; nf < 4; ++nf) { const f32x4 a = acc[nf][mf] * r0; const unsigned p0 = pk2(a[0], a[1]), p1 = pk2(a[2], a[3]);
                        bf16_t* d = dst + (size_t)(16 * nf) * KEYS;
                        d[0] = (bf16_t)(p0 & 0xffffu); d[KEYS] = (bf16_t)(p0 >> 16); d[2 * KEYS] = (bf16_t)(p1 & 0xffffu); d[3 * KEYS] = (bf16_t)(p1 >> 16); }
                }
            }
        });
    }
}

constexpr int AT_KN = 0, AT_KR = 8192, AT_V = 12288, AT_STAGE = 21504, AT_VLD = 136;
template <int DK>
DEV void attn_item(const bf16_t* Q, const bf16_t* K, const bf16_t* Vt, int nkeys, bf16_t* Yrow, LAS char* lds, int tid, float mref) {
    const int lane = tid & 63, wave = tid >> 6, l31 = lane & 31, h5 = lane >> 5;
    constexpr int NS = DK / 16;
    bf16x8 qf[NS];
#pragma unroll
    for (int s = 0; s < NS; ++s) qf[s] = *(const bf16x8*)(Q + (size_t)(32 * wave + l31) * DK + 16 * s + 8 * h5);
    f32x16 oacc[2];
#pragma unroll
    for (int i = 0; i < 16; ++i) { oacc[0][i] = 0.f; oacc[1][i] = 0.f; }
    float lsum = 0.f;
    const int kr_ = tid >> 3, kc_ = tid & 7;
    const int rr_ = (tid >> 2) & 63, rc_ = tid & 3;
    u32x4 rk, rv, rrp;
    const int nt = nkeys / 64;
    auto gload = [&](int t) {
        const int k0 = t * 64;
        rk = *(const u32x4*)(K + (size_t)(k0 + kr_) * DK + kc_ * 8); rv = *(const u32x4*)(Vt + (size_t)kr_ * KEYS + k0 + kc_ * 8);
        if (DK == 96 && tid < 256) rrp = *(const u32x4*)(K + (size_t)(k0 + rr_) * DK + 64 + rc_ * 8);
    };
    auto lstore = [&](int st) {
        LAS char* base = lds + st * AT_STAGE;
        { const int r = kr_;
            *(LAS u32x4*)(base + AT_KN + r * 128 + ((kc_ ^ ((r >> 1) & 7)) << 4)) = rk;
            LAS char* vd = base + AT_V + r * AT_VLD + kc_ * 16;
            *(LAS u32x2*)vd = (u32x2){rv[0], rv[1]}; *(LAS u32x2*)(vd + 8) = (u32x2){rv[2], rv[3]}; }
        if (DK == 96 && tid < 256) *(LAS u32x4*)(base + AT_KR + rr_ * 64 + ((rc_ ^ ((rr_ >> 2) & 3)) << 4)) = rrp;
    };
    __syncthreads();
    gload(0); lstore(0);
    __syncthreads();
    for (int t = 0; t < nt; ++t) {
        const int cur = t & 1;
        if (t + 1 < nt) gload(t + 1);
        LAS const char* base = lds + cur * AT_STAGE;
        f32x16 sacc[2];
        {
            bf16x8 kf[2][NS];
#pragma unroll
            for (int kt2 = 0; kt2 < 2; ++kt2) {
                const int row = 32 * kt2 + l31;
#pragma unroll
                for (int s = 0; s < 4; ++s) kf[kt2][s] = lds_r128(base + AT_KN + row * 128 + (((2 * s + h5) ^ ((row >> 1) & 7)) << 4));
                if (DK == 96) {
#pragma unroll
                    for (int s = 0; s < 2; ++s) kf[kt2][4 + s] = lds_r128(base + AT_KR + row * 64 + (((2 * s + h5) ^ ((row >> 2) & 3)) << 4));
                }
            }
            __builtin_amdgcn_sched_barrier(0);
#pragma unroll
            for (int kt2 = 0; kt2 < 2; ++kt2) {
#pragma unroll
                for (int i = 0; i < 16; ++i) sacc[kt2][i] = -mref;
#pragma unroll
                for (int s = 0; s < NS; ++s) sacc[kt2] = __builtin_amdgcn_mfma_f32_32x32x16_bf16(kf[kt2][s], qf[s], sacc[kt2], 0, 0, 0);
            }
        }
        bf16x8 vf[2][2][2];
#pragma unroll
        for (int dt = 0; dt < 2; ++dt)
#pragma unroll
            for (int kt2 = 0; kt2 < 2; ++kt2)
#pragma unroll
                for (int s2 = 0; s2 < 2; ++s2) {
                    LAS const char* vp = base + AT_V + (32 * dt + l31) * AT_VLD + (32 * kt2 + 16 * s2 + 4 * h5) * 2;
                    const u32x2 lo = *(LAS const u32x2*)vp, hi = *(LAS const u32x2*)(vp + 16);
                    vf[dt][kt2][s2] = __builtin_bit_cast(bf16x8, (u32x4){lo[0], lo[1], hi[0], hi[1]});
                }
        __builtin_amdgcn_sched_barrier(0);
        float ps = 0.f;
#pragma unroll
        for (int kt2 = 0; kt2 < 2; ++kt2)
#pragma unroll
            for (int i = 0; i < 16; ++i) { const float p = __builtin_amdgcn_exp2f(sacc[kt2][i]); sacc[kt2][i] = p; ps += p; }
        lsum += ps;
        bf16x8 pf[2][2];
#pragma unroll
        for (int kt2 = 0; kt2 < 2; ++kt2)
#pragma unroll
            for (int s2 = 0; s2 < 2; ++s2) {
                u32x4 w;
#pragma unroll
                for (int j = 0; j < 4; ++j) w[j] = pk2(sacc[kt2][8 * s2 + 2 * j], sacc[kt2][8 * s2 + 2 * j + 1]);
                pf[kt2][s2] = __builtin_bit_cast(bf16x8, w);
            }
#pragma unroll
        for (int dt = 0; dt < 2; ++dt)
#pragma unroll
            for (int kt2 = 0; kt2 < 2; ++kt2)
#pragma unroll
                for (int s2 = 0; s2 < 2; ++s2) oacc[dt] = __builtin_amdgcn_mfma_f32_32x32x16_bf16(vf[dt][kt2][s2], pf[kt2][s2], oacc[dt], 0, 0, 0);
        if (t + 1 < nt) lstore(cur ^ 1);
        __syncthreads();
    }
    const float ltot = lsum + xlane<32>(lsum), inv = 1.f / ltot;
    bf16_t* yr = Yrow + (size_t)(32 * wave + l31) * 1024;
#pragma unroll
    for (int dt = 0; dt < 2; ++dt)
#pragma unroll
        for (int g = 0; g < 4; ++g) {
            const int d0 = 32 * dt + 8 * g + 4 * h5;
            *(u32x2*)(yr + d0) = (u32x2){pk2(oacc[dt][4 * g] * inv, oacc[dt][4 * g + 1] * inv), pk2(oacc[dt][4 * g + 2] * inv, oacc[dt][4 * g + 3] * inv)};
        }
}
DEV void phase_d(const Ctx& c) {
    const int nlat = 512, nctx = (c.layer == NL - 1) ? 0 : 64;
    bf16_t* Y = c.ws<bf16_t>(WS_ACT);
    float mrefC, mrefD;
    {
        const int lane = c.tid & 63, l = c.layer;
        auto wmax = [](float v) { return wave_max(v); };
        const float gq = wmax(fabsf(c.in(I_GQAQG)[l * 64 + lane])), gk = wmax(fabsf(c.in(I_GQAKG)[l * 64 + lane]));
        mrefC = 64.f * gq * gk * C_SCALE * LOG2E - 40.f;
        const float* mq = c.in(I_MLAQG) + l * 96; const float* mk = c.in(I_MLAKG) + l * 96;
        const float qn = wmax(fabsf(mq[lane])), qr = wmax(fabsf(mq[64 + (lane & 31)])), kn = wmax(fabsf(mk[lane])), kr = wmax(fabsf(mk[64 + (lane & 31)]));
        mrefD = sqrtf((64.f * qn * qn + 32.f * qr * qr) * (64.f * kn * kn + 32.f * kr * kr)) * D_SCALE * LOG2E - 40.f;
    }
    for (int it = c.bid; it < nlat + nctx; it += c.nb) {
        int type, b, h, qpos0, nkeys, tok0;
        if (it < nlat) {
            type = it >> 8; const int r = it & 255, pr = 4 * (r & 7) + (r >> 6), qb = (r >> 3) & 7; b = pr >> 2; h = pr & 3; qpos0 = CL + 256 * qb; nkeys = KEYS; tok0 = b * SEQ + 256 * qb; }
        else { const int u = it - nlat; type = u >> 5; const int r = u & 31; b = r >> 2; h = r & 3; qpos0 = 0; nkeys = CL; tok0 = NLAT + b * CL; }
        if (type == 0) {
            attn_item<96>(c.ws<bf16_t>(WS_QD) + ((size_t)(b * 4 + h) * KEYS + qpos0) * 96, c.ws<bf16_t>(WS_KD) + (size_t)(b * 4 + h) * KEYS * 96,
                          c.ws<bf16_t>(WS_VDT) + (size_t)(b * 4 + h) * 64 * KEYS, nkeys, Y + (size_t)tok0 * 1024 + 768 + 64 * h, c.lds, c.tid, mrefD);
        } else {
            attn_item<64>(c.ws<bf16_t>(WS_QC) + ((size_t)(b * 4 + h) * KEYS + qpos0) * 64, c.ws<bf16_t>(WS_KC) + (size_t)(b * 2 + (h >> 1)) * KEYS * 64,
                          c.ws<bf16_t>(WS_VCT) + (size_t)(b * 2 + (h >> 1)) * 64 * KEYS, nkeys, Y + (size_t)tok0 * 1024 + 512 + 64 * h, c.lds, c.tid, mrefC);
        }
    }
}

DEV void phase_e0(const Ctx& c) {
    const int tid = c.tid, lane = tid & 63, wave = tid >> 6, l = c.layer;
    bf16_t* Y = c.ws<bf16_t>(WS_ACT); const bf16_t* P = c.ws<bf16_t>(WS_P);
    const float* gg = c.in(I_GGO) + l * 1024;
    const int ntok = c.ntok_tail();
    const int ch = 4 * lane;
    const float* cw = c.in(I_CONVW) + l * 768 + ch;
    const f32x4 w0 = *(const f32x4*)cw, w1 = *(const f32x4*)(cw + 256), w2 = *(const f32x4*)(cw + 512);
    f32x4 gn[4];
#pragma unroll
    for (int g = 0; g < 4; ++g) gn[g] = *(const f32x4*)(gg + g * 256 + ch);
    const int nwv = c.nb * NW, per = (ntok + nwv - 1) / nwv, tbeg = (c.bid * NW + wave) * per, tend = min(tbeg + per, ntok);
#pragma unroll 1
    for (int t0 = tbeg; t0 < tend; t0 += 2) {
        u32x2 ya[2], yc[2], yd[2], rbb[2], c0[2], x0[2], c1[2], x1[2], c2[2], x2[2]; float mp[2], mn[2];
#pragma unroll
        for (int u = 0; u < 2; ++u) { const int tok = min(t0 + u, tend - 1);
            int b, pos, key; bool isctx; tok_info(tok, b, pos, key, isctx);
            const int seqlen = isctx ? CL : SEQ;
            const bf16_t* pr = P + (size_t)tok * INC; const bf16_t* yr = Y + (size_t)tok * 1024;
            ya[u] = *(const u32x2*)(yr + ch); yc[u] = *(const u32x2*)(yr + 512 + ch); yd[u] = *(const u32x2*)(yr + 768 + ch);
            rbb[u] = *(const u32x2*)(pr + OFF_BB + ch);
            const bool okp = pos > 0, okn = pos < seqlen - 1;
            c0[u] = *(const u32x2*)(pr - (okp ? INC : 0) + OFF_BC + ch); x0[u] = *(const u32x2*)(pr - (okp ? INC : 0) + OFF_BX + ch);
            c1[u] = *(const u32x2*)(pr + OFF_BC + ch); x1[u] = *(const u32x2*)(pr + OFF_BX + ch);
            c2[u] = *(const u32x2*)(pr + (okn ? INC : 0) + OFF_BC + ch); x2[u] = *(const u32x2*)(pr + (okn ? INC : 0) + OFF_BX + ch);
            mp[u] = okp ? 1.f : 0.f; mn[u] = okn ? 1.f : 0.f; }
#pragma unroll
        for (int u = 0; u < 2; ++u) { const int tok = t0 + u;
            if (tok < tend) {
                bf16_t* yr = Y + (size_t)tok * 1024;
                float v[4][4];
                v[0][0] = bflo(ya[u][0]); v[0][1] = bfhi(ya[u][0]); v[0][2] = bflo(ya[u][1]); v[0][3] = bfhi(ya[u][1]);
                v[2][0] = bflo(yc[u][0]); v[2][1] = bfhi(yc[u][0]); v[2][2] = bflo(yc[u][1]); v[2][3] = bfhi(yc[u][1]);
                v[3][0] = bflo(yd[u][0]); v[3][1] = bfhi(yd[u][0]); v[3][2] = bflo(yd[u][1]); v[3][3] = bfhi(yd[u][1]);
                {
                    const float zp[4] = {mp[u] * bflo(c0[u][0]) * bflo(x0[u][0]), mp[u] * bfhi(c0[u][0]) * bfhi(x0[u][0]), mp[u] * bflo(c0[u][1]) * bflo(x0[u][1]), mp[u] * bfhi(c0[u][1]) * bfhi(x0[u][1])};
                    const float zc[4] = {bflo(c1[u][0]) * bflo(x1[u][0]), bfhi(c1[u][0]) * bfhi(x1[u][0]), bflo(c1[u][1]) * bflo(x1[u][1]), bfhi(c1[u][1]) * bfhi(x1[u][1])};
                    const float zn[4] = {mn[u] * bflo(c2[u][0]) * bflo(x2[u][0]), mn[u] * bfhi(c2[u][0]) * bfhi(x2[u][0]), mn[u] * bflo(c2[u][1]) * bflo(x2[u][1]), mn[u] * bfhi(c2[u][1]) * bfhi(x2[u][1])};
                    const float bb[4] = {bflo(rbb[u][0]), bfhi(rbb[u][0]), bflo(rbb[u][1]), bfhi(rbb[u][1])};
#pragma unroll
                    for (int j = 0; j < 4; ++j) v[1][j] = bb[j] * (w0[j] * zp[j] + w1[j] * zc[j] + w2[j] * zn[j]);
                }
                float ss[4];
#pragma unroll
                for (int g = 0; g < 4; ++g) ss[g] = v[g][0] * v[g][0] + v[g][1] * v[g][1] + v[g][2] * v[g][2] + v[g][3] * v[g][3];
#pragma unroll
                for (int g = 0; g < 4; ++g) ss[g] = wave_sum(ss[g]);
#pragma unroll
                for (int g = 0; g < 4; ++g) { const float r = rsqrtf(ss[g] * (1.f / 256.f) + EPS);
                    *(u32x2*)(yr + g * 256 + ch) = (u32x2){pk2(v[g][0] * r * gn[g][0], v[g][1] * r * gn[g][1]), pk2(v[g][2] * r * gn[g][2], v[g][3] * r * gn[g][3])}; }
            } }
    }
}
DEV void e_store_row4(const Ctx& c, int m, int n, const f32x4& a) {
    const float* gate = c.modv(m < NLAT ? (m >> 11) : 8, 2);
    const f32x4 gt = *(const f32x4*)(gate + n), xv = c.xload4(m, n);
    c.xsstore4(m, n, xv[0] + gt[0] * a[0], xv[1] + gt[1] * a[1], xv[2] + gt[2] * a[2], xv[3] + gt[3] * a[3]);
}
DEV void phase_e(const Ctx& c) {
    GemmDesc g; g.A = c.ws<bf16_t>(WS_ACT); g.lda = 1024; g.rowidx = nullptr; g.nvalid = 0;
    g.B0 = c.ws<bf16_t>(WS_WOUT) + (size_t)c.layer * 1024 * 1024; g.B1 = g.B0; g.ldb = 1024; g.ksplit = 1 << 30; g.K = 1024;
    const int nfull = (NLAT / 256) * 4, nhalf = (c.layer == NL - 1) ? 0 : (NCTX / 256) * 8;
    for (int t = c.bid; t < nfull + nhalf; t += c.nb) {
        if (t < nfull) { const int m0 = (t >> 2) * 256, n0 = (t & 3) * 256;
            gemm_tile8p(g, m0, n0, c.lds, c.tid, [&](const f32x4 (&acc)[2][2][4][2], int wr, int wc, int lane) {
                const float* gate = c.modv(m0 >> 11, 2) + n0 + 64 * wc + 4 * (lane >> 4);
                f32x4 gt[2][2];
#pragma unroll
                for (int bj = 0; bj < 2; ++bj)
#pragma unroll
                    for (int n = 0; n < 2; ++n) gt[bj][n] = *(const f32x4*)(gate + 32 * bj + 16 * n);
#pragma unroll
                for (int ai = 0; ai < 2; ++ai)
#pragma unroll
                    for (int m = 0; m < 4; ++m) { const int row = m0 + 128 * ai + 64 * wr + 16 * m + (lane & 15);
#pragma unroll
                        for (int bj = 0; bj < 2; ++bj)
#pragma unroll
                            for (int n = 0; n < 2; ++n) { const int col = n0 + 64 * wc + 32 * bj + 16 * n + 4 * (lane >> 4); const f32x4 xv = c.xload4(row, col), a = acc[ai][bj][m][n], gg = gt[bj][n];
                                c.xsstore4(row, col, xv[0] + gg[0] * a[0], xv[1] + gg[1] * a[1], xv[2] + gg[2] * a[2], xv[3] + gg[3] * a[3]); } }
            });
            publish_rel(c, c.ws<unsigned>(WS_RDYE) + (c.layer * 128 + (t >> 2)) * 16, 2u); }
        else { const int u = t - nfull, m0 = NLAT + (u >> 3) * 256;
            gemm_tile<2, 4>(g, m0, (u & 7) * 128, c.lds, c.tid, [&](const f32x4 (&acc)[4][4], int mb, int nbase, int lane) {
#pragma unroll
                for (int mf = 0; mf < 4; ++mf)
#pragma unroll
                    for (int nf = 0; nf < 4; ++nf) { const int p = nbase + 16 * nf + 4 * (lane >> 4);
                        e_store_row4(c, m0 + mb + 16 * mf + (lane & 15), (p & ~255) | (((p >> 5) & 3) << 6) | (((p >> 7) & 1) << 5) | (p & 31), acc[nf][mf]); }
            });
            publish_rel(c, c.ws<unsigned>(WS_RDYE) + (c.layer * 128 + NLAT / 256 + (u >> 3)) * 16, 1u); }
    }
}

DEV void phase_f_item(const Ctx& c, int nseg, int sbase, int sstride) {
    const int tid = c.tid, lane = tid & 63, wave = tid >> 6, l = c.layer, li = lane & 15, q = lane >> 4;
    LAS float* part = (LAS float*)c.lds;
    LAS float* rs = part + 8 * 96 * 32;
    LAS int* hist = (LAS int*)(rs + 96);
    LAS int* hbase = hist + 32;
    int* cnt = c.ws<int>(WS_CNT) + l * NBUCKET * 32;
    int* ltok = c.ws<int>(WS_LTOK); float* lw = c.ws<float>(WS_LW);
    bf16_t* H = c.ws<bf16_t>(WS_ACT);
    __syncthreads();
    if (tid < 32) hist[tid] = 0;
#pragma unroll 1
    for (int sg = 0; sg < nseg; ++sg) wait_ready(c, c.ws<unsigned>(WS_RDYE) + (l * 128 + ((sbase + sstride * sg) >> 3)) * 16, 8u);
    __syncthreads();
#pragma unroll 1
    for (int sg = 0; sg < nseg; ++sg) {
        const int tokb = 32 * (sbase + sstride * sg), mb = tokb < NLAT ? (tokb >> 11) : 8;
        f32x4 acc[2][2];
#pragma unroll
        for (int a = 0; a < 2; ++a)
#pragma unroll
            for (int b = 0; b < 2; ++b) acc[a][b] = (f32x4){0.f, 0.f, 0.f, 0.f};
        const bf16_t* xrow = c.xs(tokb + li) + 128 * wave + 8 * q;
        const bf16_t* wrow = c.ws<bf16_t>(WS_RW) + (size_t)(l * 9 + mb) * 2 * 32 * 1024 + (size_t)li * 1024 + 128 * wave + 8 * q;
#pragma unroll
        for (int ks = 0; ks < 4; ++ks) {
            bf16x8 xf[2], wf[2][2];
#pragma unroll
            for (int hl = 0; hl < 2; ++hl)
#pragma unroll
                for (int nf = 0; nf < 2; ++nf) wf[hl][nf] = *(const bf16x8*)(wrow + (size_t)(hl * 32 + nf * 16) * 1024 + 32 * ks);
#pragma unroll
            for (int mf = 0; mf < 2; ++mf) xf[mf] = *(const bf16x8*)(xrow + (size_t)mf * 16 * DM + 32 * ks);
#pragma unroll
            for (int mf = 0; mf < 2; ++mf)
#pragma unroll
                for (int hl = 0; hl < 2; ++hl)
#pragma unroll
                    for (int nf = 0; nf < 2; ++nf) acc[nf][mf] = __builtin_amdgcn_mfma_f32_16x16x32_bf16(wf[hl][nf], xf[mf], acc[nf][mf], 0, 0, 0);
        }
#pragma unroll
        for (int mf = 0; mf < 2; ++mf)
#pragma unroll
            for (int nf = 0; nf < 2; ++nf) *(LAS f32x4*)(part + ((wave * 96 + 32 * sg + 16 * mf + li) * 32 + 16 * nf + 4 * q)) = acc[nf][mf];
    }
#pragma unroll 1
    for (int sg = 0; sg < nseg; ++sg) {
        const int tokb = 32 * (sbase + sstride * sg), mb = tokb < NLAT ? (tokb >> 11) : 8;
        u32x4 r0[4], r1[4];
#pragma unroll
        for (int u = 0; u < 4; ++u) { const bf16_t* xr = c.xs(tokb + 4 * wave + u); r0[u] = *(const u32x4*)(xr + 8 * lane); r1[u] = *(const u32x4*)(xr + 512 + 8 * lane); }
        f32x4 g0[2], g1[2], s0[2], s1[2];
        { const float* gmv = c.ws<float>(WS_GM) + (size_t)(l * 9 + mb) * 1024; const float* sh = c.modv(mb, 3);
#pragma unroll
          for (int hf = 0; hf < 2; ++hf) { const int e = 512 * hf + 8 * lane; g0[hf] = *(const f32x4*)(gmv + e); g1[hf] = *(const f32x4*)(gmv + e + 4); s0[hf] = *(const f32x4*)(sh + e); s1[hf] = *(const f32x4*)(sh + e + 4); } }
#pragma unroll
        for (int u = 0; u < 4; ++u) { const int t = 32 * sg + 4 * wave + u, tok = tokb + 4 * wave + u;
            float v[16];
#pragma unroll
            for (int j = 0; j < 4; ++j) { v[2 * j] = bflo(r0[u][j]); v[2 * j + 1] = bfhi(r0[u][j]); v[8 + 2 * j] = bflo(r1[u][j]); v[8 + 2 * j + 1] = bfhi(r1[u][j]); }
            float ss = 0.f;
#pragma unroll
            for (int j = 0; j < 16; ++j) ss += v[j] * v[j];
            const float rr = rsqrtf(wave_sum(ss) * (1.f / 1024.f) + EPS);
            if (lane == 0) rs[t] = rr;
#pragma unroll
            for (int hf = 0; hf < 2; ++hf) { const int e = 512 * hf + 8 * lane;
                const float* vv = v + 8 * hf;
                *(u32x4*)(H + (size_t)tok * 1024 + e) = (u32x4){pk2(vv[0] * rr * g0[hf][0] + s0[hf][0], vv[1] * rr * g0[hf][1] + s0[hf][1]), pk2(vv[2] * rr * g0[hf][2] + s0[hf][2], vv[3] * rr * g0[hf][3] + s0[hf][3]),
                                                                  pk2(vv[4] * rr * g1[hf][0] + s1[hf][0], vv[5] * rr * g1[hf][1] + s1[hf][1]), pk2(vv[6] * rr * g1[hf][2] + s1[hf][2], vv[7] * rr * g1[hf][3] + s1[hf][3])}; }
        }
    }
    __syncthreads();
    int bucket = 0, rank = 0, mytok = 0; float wa = 0.f, wb = 0.f;
    if (tid < 32 * nseg) {
        const int t = tid, tok = 32 * (sbase + sstride * (t >> 5)) + (t & 31), mb = tok < NLAT ? (tok >> 11) : 8;
        mytok = tok;
        float s[20];
#pragma unroll
        for (int j = 0; j < 20; ++j) { float a = 0.f;
#pragma unroll
            for (int w = 0; w < NW; ++w) a += part[(w * 96 + t) * 32 + j];
            s[j] = a; }
            const float* RC = c.ws<float>(WS_RC) + (l * 9 + mb) * 32;
        const float r = rs[t];
        float gl[4], el[4];
#pragma unroll
        for (int j = 0; j < 4; ++j) gl[j] = r * s[j] + RC[j];
        int gi = 0; float gmx = gl[0];
#pragma unroll
        for (int j = 1; j < 4; ++j) if (gl[j] > gmx) { gmx = gl[j]; gi = j; }
        float gs = 0.f;
#pragma unroll
        for (int j = 0; j < 4; ++j) gs += __expf(gl[j] - gmx);
        const float gw = 1.f / gs;
#pragma unroll
        for (int j = 0; j < 4; ++j) { const float sj = gi == 0 ? s[4 + j] : (gi == 1 ? s[8 + j] : (gi == 2 ? s[12 + j] : s[16 + j])); el[j] = r * sj + RC[4 + 4 * gi + j]; }
        int e1 = 0; float m1 = el[0];
#pragma unroll
        for (int j = 1; j < 4; ++j) if (el[j] > m1) { m1 = el[j]; e1 = j; }
        int e2 = -1; float m2 = -3.0e38f;
#pragma unroll
        for (int j = 0; j < 4; ++j) if (j != e1 && el[j] > m2) { m2 = el[j]; e2 = j; }
        const float p2 = __expf(m2 - m1), w1 = gw / (1.f + p2), w2 = gw * p2 / (1.f + p2);
        const int ea = e1 < e2 ? e1 : e2, eb = e1 < e2 ? e2 : e1; wa = e1 < e2 ? w1 : w2; wb = e1 < e2 ? w2 : w1;
        const int pidx = ea == 0 ? eb - 1 : (ea == 1 ? eb + 1 : 5);
        bucket = gi * 6 + pidx;
        rank = __hip_atomic_fetch_add(hist + bucket, 1, __ATOMIC_RELAXED, __HIP_MEMORY_SCOPE_WORKGROUP);
    }
    __syncthreads();
    if (tid < NBUCKET) { const int n = hist[tid]; hbase[tid] = n > 0 ? atomicAdd(&cnt[tid * 32], n) : 0; }
    __syncthreads();
    if (tid < 32 * nseg) {
        const int pos = hbase[bucket] + rank;
        ltok[bucket * NTOK + pos] = mytok;
        lw[((size_t)bucket * NTOK + pos) * 2] = wa; lw[((size_t)bucket * NTOK + pos) * 2 + 1] = wb;
    }
}
DEV void phase_f(const Ctx& c) {
    if (c.nb == 256) {
        if (c.layer == NL - 1) phase_f_item(c, 2, 2 * c.bid, 1);
        else if (c.bid < 64) phase_f_item(c, 1, NLAT / 32 + c.bid, 0);
        else { const int k = c.bid - 64; phase_f_item(c, k < 128 ? 3 : 2, k, 192); }
    } else {
        for (int sgi = c.bid; sgi < c.ntok_tail() / 32; sgi += c.nb) phase_f_item(c, 1, sgi, 0);
    }
}

DEV void moe_find(const int* cnt, int mg, int& bucket, int& mt, int& total) {
    int acc = 0; bucket = -1; mt = 0;
    for (int b = 0; b < NBUCKET; ++b) { const int n = (cnt[b * 32] + 255) >> 8; if (bucket < 0 && mg < acc + n) { bucket = b; mt = mg - acc; } acc += n; }
    total = acc;
}
DEV void pair_of(int pidx, int& ea, int& eb) { ea = pidx < 3 ? 0 : (pidx < 5 ? 1 : 2); eb = pidx < 3 ? pidx + 1 : (pidx < 5 ? pidx - 1 : 3); }
template <int WN_, int MF>
DEV void g_tile(const Ctx& c, const int* cnt, int mg, int nt8) {
    const int l = c.layer; (void)l;
    int bucket, mt, tt; moe_find(cnt, mg, bucket, mt, tt);
    int ea, eb; pair_of(bucket % 6, ea, eb); const int grp = bucket / 6;
    const int e = grp * 4 + ((nt8 < 4) ? ea : eb);
    const int nvalid = min(256, cnt[bucket * 32] - mt * 256);
    const int* rows = c.ws<int>(WS_LTOK) + bucket * NTOK + mt * 256;
    const float* wts = c.ws<float>(WS_LW) + ((size_t)bucket * NTOK + mt * 256) * 2 + ((nt8 < 4) ? 0 : 1);
    bf16_t* HB = c.ws<bf16_t>(WS_HBUF);
    GemmDesc g; g.A = c.ws<bf16_t>(WS_ACT); g.lda = 1024; g.rowidx = rows; g.nvalid = nvalid;
    g.B0 = c.ws<bf16_t>(WS_WUP) + (size_t)e * 512 * 1024; g.B1 = g.B0; g.ldb = 1024; g.ksplit = 1 << 30; g.K = 1024;
    const int hcol0 = (nt8 >> 2) * 256 + (nt8 & 3) * 64;
    gemm_tile<WN_, MF>(g, 0, (nt8 & 3) * 128, c.lds, c.tid, [&](const f32x4 (&acc)[4][MF], int mb, int nbase, int lane) {
        const int slot = ((nbase - (nt8 & 3) * 128) >> 6);
#pragma unroll
        for (int mf = 0; mf < MF; ++mf) { const int r = mb + 16 * mf + (lane & 15); const bool ok = r < nvalid; const float w = ok ? wts[2 * r] : 0.f;
#pragma unroll
            for (int f = 0; f < 2; ++f) { const f32x4 gt = acc[f][mf], up = acc[f + 2][mf]; float o[4];
#pragma unroll
                for (int j = 0; j < 4; ++j) o[j] = ok ? silu_f(gt[j]) * up[j] * w : 0.f;
                __hip_atomic_store((GAS unsigned long long*)(HB + ((size_t)mg * 256 + r) * 512 + hcol0 + 32 * slot + 16 * f + 4 * (lane >> 4)),
                                   (unsigned long long)pk2(o[0], o[1]) | ((unsigned long long)pk2(o[2], o[3]) << 32), __ATOMIC_RELAXED, __HIP_MEMORY_SCOPE_AGENT); } }
    });
    asm volatile("s_waitcnt vmcnt(0)" ::: "memory");
    __syncthreads();
    if (c.tid == 0) (void)xb_add(c.ws<unsigned>(WS_RDY) + (c.layer * 128 + mg) * 16, WN_ == 4 ? 2u : 1u);
}
template <int WN_, int MF>
DEV void h_tile(const Ctx& c, const int* cnt, int mg, int nt8) {
    const int l = c.layer;
    int bucket, mt, tt; moe_find(cnt, mg, bucket, mt, tt);
    int ea, eb; pair_of(bucket % 6, ea, eb); const int grp = bucket / 6;
    const int nvalid = min(256, cnt[bucket * 32] - mt * 256);
    const int* rows = c.ws<int>(WS_LTOK) + bucket * NTOK + mt * 256;
    GemmDesc g; g.A = c.ws<bf16_t>(WS_HBUF); g.lda = 512; g.rowidx = nullptr; g.nvalid = 0;
    g.B0 = c.ws<bf16_t>(WS_WDN) + (size_t)(grp * 4 + ea) * 1024 * 256; g.B1 = c.ws<bf16_t>(WS_WDN) + (size_t)(grp * 4 + eb) * 1024 * 256; g.ldb = 256; g.ksplit = 256; g.K = 512;
    if (c.tid < 64) {
        unsigned* rdy = c.ws<unsigned>(WS_RDY) + (c.layer * 128 + mg) * 16; unsigned* bar = c.ws<unsigned>(WS_BAR);
        { unsigned sp_ = 0; while (xb_ld(rdy) < 8u) { __builtin_amdgcn_s_sleep(2); if ((++sp_ & 1023u) == 0u) { if (xb_ld(&bar[XB_TMO])) break; if (sp_ > (1u << 24)) { atomicAdd(&bar[XB_TMO], 1u); break; } } } }
        __builtin_amdgcn_fence(__ATOMIC_ACQUIRE, "agent");
    }
    gemm_tile<WN_, MF>(g, mg * 256, nt8 * 128, c.lds, c.tid, [&](const f32x4 (&acc)[4][MF], int mb, int nbase, int lane) {
#pragma unroll
        for (int mf = 0; mf < MF; ++mf) { const int r = mb + 16 * mf + (lane & 15);
            if (r < nvalid) { const int tok = rows[r]; const int mbi = tok < NLAT ? (tok >> 11) : 8; const float* gate = c.modv(mbi, 5);
#pragma unroll
                for (int nf = 0; nf < 4; ++nf) { const int n = nbase + 16 * nf + 4 * (lane >> 4); const f32x4 gt = *(const f32x4*)(gate + n), xv = c.xsload4(tok, n), a = acc[nf][mf];
                    const float o0 = xv[0] + gt[0] * a[0], o1 = xv[1] + gt[1] * a[1], o2 = xv[2] + gt[2] * a[2], o3 = xv[3] + gt[3] * a[3];
                    if (l == NL - 1) *(f32x4*)(c.p->out + (size_t)tok * DM + n) = (f32x4){o0, o1, o2, o3};
                    else c.xsstore4(tok, n, o0, o1, o2, o3); } } }
    });
}
DEV void phase_g(const Ctx& c) {
    const int* cnt = c.ws<int>(WS_CNT) + c.layer * NBUCKET * 32;
    int total = 0; { int b, m; moe_find(cnt, 0, b, m, total); }
    const int U = total * 4, Ufull = (U / c.nb) * c.nb, R = U - Ufull;
    for (int u = c.bid; u < Ufull; u += c.nb) g_tile<4, 8>(c, cnt, u >> 2, 2 * (u & 3));
    for (int t = c.bid; t < 2 * R; t += c.nb) { const int u = Ufull + (t >> 1); g_tile<2, 4>(c, cnt, u >> 2, 2 * (u & 3) + (t & 1)); }
}
DEV void phase_h(const Ctx& c) {
    const int* cnt = c.ws<int>(WS_CNT) + c.layer * NBUCKET * 32;
    int total = 0; { int b, m; moe_find(cnt, 0, b, m, total); }
    const int U = __builtin_amdgcn_readfirstlane(total * 4), R = U - (U / c.nb) * c.nb;
    int base = 0;
#pragma unroll 1
    for (int s = 0; base < U; ++s) {
        const int thr = s == 0 ? min(2 * R, c.nb) : (s == 1 ? max(0, 2 * R - c.nb) : 0), nw = c.nb - thr, rem = U - base, k = c.bid - thr;
        if (k >= 0) {
            if (rem < nw && 2 * rem <= nw) { if (k < 2 * rem) { const int j = base + (k >> 1); h_tile<2, 4>(c, cnt, j >> 2, 2 * (j & 3) + (k & 1)); } }
            else if (k < rem) { const int j = base + k; h_tile<4, 8>(c, cnt, j >> 2, 2 * (j & 3)); }
        }
        base += nw;
    }
}

constexpr int PH_P0 = 0, PH_A = 1, PH_B = 2, PH_C = 3, PH_D = 4, PH_E0 = 5, PH_E = 6, PH_G = 7, PH_PER_LAYER = 7;
DEV void run_phase(const Ctx& c, int ph) {
    switch (ph) {
        case PH_P0: phase_p0(c); break;
        case PH_A: phase_a(c); break;
        case PH_B: phase_b(c); break;
        case PH_C: phase_c(c); break;
        case PH_D: phase_d(c); break;
        case PH_E0: phase_e0(c); break;
        case PH_E: phase_e(c); phase_f(c); break;
        case PH_G: phase_g(c); phase_h(c); break;
    }
}

extern __shared__ __attribute__((aligned(16))) char smem_dyn[];

struct XcdBarrier { unsigned* bar; unsigned x; volatile LAS unsigned* st; };
DEV XcdBarrier xcd_barrier_post(unsigned* bar, volatile LAS unsigned* st) {
    XcdBarrier b; b.bar = bar; b.x = xb_xcc_id(); b.st = st;
    if (threadIdx.x == 0) (void)xb_add(&bar[XB_XCNT(b.x)], 1u);
    return b;
}
DEV void xcd_barrier_complete(unsigned* bar, unsigned x, unsigned& nloc, unsigned& nx) {
    const unsigned G = gridDim.x * gridDim.y * gridDim.z;
    unsigned sum, cnt, mine, sp = 0u;
    for (;;) {
        sum = 0u; cnt = 0u; mine = 0u;
#pragma unroll
        for (unsigned j = 0; j < 16; ++j) { const unsigned c = xb_ld(&bar[XB_XCNT(j)]); sum += c; cnt += (c > 0u) ? 1u : 0u; mine = (j == x) ? c : mine; }
        if (sum == G) break;
        __builtin_amdgcn_s_sleep(1);
        if ((++sp & 255u) == 0u) { if (xb_ld(&bar[XB_TMO])) break; if (sp > XB_SPIN_CAP) { atomicAdd(&bar[XB_TMO], 1u); break; } }
    }
    nloc = mine > 0u ? mine : 1u; nx = cnt > 0u ? cnt : 1u;
}
DEV void xcd_barrier(const XcdBarrier& b) {
    asm volatile("s_waitcnt vmcnt(0)" ::: "memory");
    __syncthreads();
    if (threadIdx.x == 0) {
        unsigned* bar = b.bar;
        __builtin_amdgcn_s_waitcnt(0);
        unsigned nloc = b.st[0], nx = b.st[1];
        if (nloc == 0u) { xcd_barrier_complete(bar, b.x, nloc, nx); b.st[0] = nloc; b.st[1] = nx; }
        const unsigned old = xb_add(&bar[XB_XSUB(b.x)], 1u);
        const unsigned gen = old / nloc;
        if (old + 1u == (gen + 1u) * nloc) {
            __builtin_amdgcn_fence(__ATOMIC_RELEASE, "agent");
            asm volatile("s_waitcnt vmcnt(0)" ::: "memory");
            const unsigned og = xb_add(&bar[XB_TOP], 1u);
            const unsigned tg = og / nx;
            if (og + 1u == (tg + 1u) * nx) xb_add(&bar[XB_TOPGEN], 1u);
            else XB_SPIN(xb_ld(&bar[XB_TOPGEN]) == tg, bar);
            __builtin_amdgcn_fence(__ATOMIC_ACQUIRE, "agent");
            xb_add(&bar[XB_XGEN(b.x)], 1u);
            asm volatile("s_waitcnt vmcnt(0)" ::: "memory");
        } else {
            XB_SPIN(xb_ld(&bar[XB_XGEN(b.x)]) == gen, bar);
            __builtin_amdgcn_fence(__ATOMIC_ACQUIRE, "agent");
            asm volatile("s_waitcnt vmcnt(0)" ::: "memory");
        }
    }
    __syncthreads();
}
static_assert(XCD_BAR_WORDS * 4 <= 16384, "barrier words");


#if !MODE_SINGLE
__global__ void __launch_bounds__(NTHREADS, 2) k_phase(Params p, int layer, int ph) {
    Ctx c; c.p = (ParamsPtr)__builtin_amdgcn_kernarg_segment_ptr(); c.layer = layer; c.bid = blockIdx.x; c.nb = gridDim.x; c.tid = threadIdx.x; c.lds = (LAS char*)smem_dyn;
    run_phase(c, ph);
}


#endif
__global__ void __launch_bounds__(NTHREADS, 2) k_mega(Params p) {
    ParamsPtr pp = (ParamsPtr)__builtin_amdgcn_kernarg_segment_ptr();
    const int wave_id = __builtin_amdgcn_readfirstlane(threadIdx.x >> 6);
    Ctx c; c.p = pp; c.layer = 0; c.bid = blockIdx.x; c.nb = gridDim.x; c.tid = threadIdx.x; c.lds = (LAS char*)smem_dyn;
    volatile LAS unsigned* st = (volatile LAS unsigned*)(c.lds + LDS_BAR);
    if (threadIdx.x == 0) { st[0] = 0u; st[1] = 0u; st[2] = 0u; st[3] = 0u; }
    __syncthreads();
    XcdBarrier xb = xcd_barrier_post((unsigned*)(pp->ws + WS_BAR), st);
    unsigned long long t_prev = 0; float tacc1 = 0.f, tacc2 = 0.f;
#pragma unroll 1
    for (int step = 0; step <= 1 + NL * PH_PER_LAYER; ++step) {
        if (step) { xcd_barrier(xb); if (EXP_BAR2) xcd_barrier(xb); }
        if (PROBE_P1 >= -1) {
            const unsigned long long now = __builtin_amdgcn_s_memrealtime();
            if (step) { const int php = step > 1 ? 1 + (step - 2) % PH_PER_LAYER : 0; const float us = (float)(now - t_prev) * 0.01f;
                if (php == PROBE_P1) tacc1 += us; if (php == PROBE_P2) tacc2 += us; }
            t_prev = now;
        }
        if (step == 1 + NL * PH_PER_LAYER) break;
        { ParamsPtr q = pp; int w_ = wave_id, b_ = blockIdx.x, n_ = gridDim.x; asm volatile("" : "+s"(q), "+s"(w_), "+s"(b_), "+s"(n_));
          unsigned m_ = ~0u; asm volatile("" : "+s"(m_));
          int t_ = w_ * 64 + (int)__builtin_amdgcn_mbcnt_hi(m_, __builtin_amdgcn_mbcnt_lo(m_, 0u)); asm volatile("" : "+v"(t_)); c.p = q; c.tid = t_; c.bid = b_; c.nb = n_; }
        c.layer = step ? (step - 1) / PH_PER_LAYER : 0;
        const int ph = step ? 1 + (step - 1) % PH_PER_LAYER : 0;
        run_phase(c, ph);
        if (EXP_REP >= 0 && ph == EXP_REP && (EXP_REP != PH_E || c.layer == 0)) {
            xcd_barrier(xb); run_phase(c, ph); }
    }
    if (PROBE_P1 >= -1) {
        float* t2 = (float*)(pp->ws + WS_DBG);
        if (c.bid == 0 && c.tid == 0) { t2[0] = PROBE_P1 == -1 ? 100.f : tacc1; t2[1] = tacc2; }
        xcd_barrier(xb);
        const float cfill = sqrtf(t2[0]), spike = 4.f * t2[1];
        float* o = pp->out;
        for (size_t i = (size_t)c.bid * NTHREADS + c.tid; i < (size_t)NLAT * DM; i += (size_t)c.nb * NTHREADS) o[i] = (i == 0) ? spike : cfill;
    }
}

extern "C" void kernel_launch(void* const* d_in, const int* in_sizes, int n_in, void* d_out, int out_size, void* d_ws, size_t ws_size, hipStream_t stream) {
    static int grid = 0;
    if (grid == 0) {
        if (n_in != 29 || ws_size < WS_END) { fprintf(stderr, "kernel_launch: unexpected n_in %d or workspace %zu < %zu\n", n_in, ws_size, (size_t)WS_END); grid = -1; return; }
        int dev = 0, cus = 0, per_cu = 0;
        (void)hipGetDevice(&dev); (void)hipDeviceGetAttribute(&cus, hipDeviceAttributeMultiprocessorCount, dev);
#if MODE_SINGLE
        const void* kfn = (const void*)k_mega;
#else
        const void* kfn = (const void*)k_phase;
#endif
        (void)hipFuncSetAttribute(kfn, hipFuncAttributeMaxDynamicSharedMemorySize, LDS_BYTES);
        (void)hipOccupancyMaxActiveBlocksPerMultiprocessor(&per_cu, kfn, NTHREADS, LDS_BYTES);
        if (per_cu < 1) fprintf(stderr, "kernel_launch: occupancy query reports %d workgroups per CU\n", per_cu);
        grid = cus;
    }
    if (grid < 0) return;
    Params p{};
    for (int i = 0; i < 29; ++i) p.in[i] = (const float*)d_in[i];
    p.out = (float*)d_out; p.ws = (char*)d_ws;
    (void)hipMemsetAsync((char*)d_ws + WS_BAR, 0, WS_ZERO_BYTES, stream);
#if MODE_SINGLE
    void* args[] = {&p};
    hipError_t e = hipLaunchCooperativeKernel((const void*)k_mega, dim3(grid), dim3(NTHREADS), args, LDS_BYTES, stream);
    if (e != hipSuccess) fprintf(stderr, "kernel_launch: cooperative launch failed: %s (grid %d)\n", hipGetErrorString(e), grid);
#else
    hipLaunchKernelGGL(k_phase, dim3(grid), dim3(NTHREADS), LDS_BYTES, stream, p, 0, PH_P0);
    for (int l = 0; l < NL; ++l)
        for (int ph = PH_A; ph <= PH_G; ++ph) hipLaunchKernelGGL(k_phase, dim3(grid), dim3(NTHREADS), LDS_BYTES, stream, p, l, ph);
#endif
}
```

```cpp
#include <hip/hip_runtime.h>
#include <cstdio>
#include <cstdint>

#ifndef MODE_SINGLE
#define MODE_SINGLE 1
#endif
#ifndef EXP_BAR2
#define EXP_BAR2 0
#endif
#ifndef PROBE_P1
#define PROBE_P1 -2
#define PROBE_P2 -2
#endif
#ifndef EXP_REP
#define EXP_REP -1
#endif

#define DEV __device__ __forceinline__
#define LAS __attribute__((address_space(3)))
typedef unsigned short bf16_t;
typedef short bf16x8 __attribute__((ext_vector_type(8)));
typedef float f32x4 __attribute__((ext_vector_type(4)));
typedef float f32x16 __attribute__((ext_vector_type(16)));
typedef unsigned u32x4 __attribute__((ext_vector_type(4)));
typedef unsigned u32x2 __attribute__((ext_vector_type(2)));

constexpr int DM = 1024, NB = 8, SEQ = 2048, CL = 256, NL = 2;
constexpr int NLAT = NB * SEQ, NCTX = NB * CL, NTOK = NLAT + NCTX;
constexpr int KEYS = CL + SEQ;
constexpr int INC = 2208, INCP = 2304;
constexpr int OFF_AU = 0, OFF_AV = 256, OFF_BB = 512, OFF_BC = 768, OFF_BX = 1024, OFF_CQ = 1280, OFF_CK = 1536, OFF_CV = 1664,
              OFF_DCQ = 1792, OFF_DCKV = 2048, OFF_DKR = 2176;
constexpr float EPS = 1e-6f;
constexpr float LOG2E = 1.4426950408889634f;
constexpr float C_SCALE = 0.125f, D_SCALE = 0.10206207261596577f;
constexpr int NBUCKET = 24;
constexpr int MAXMT = NTOK / 256 + NBUCKET;
constexpr int NTHREADS = 512, NW = 8;
constexpr int LDS_BAR = 2 * (256 + 256) * 128, LDS_BYTES = LDS_BAR + 64;

constexpr size_t al256(size_t x) { return (x + 255) & ~(size_t)255; }
constexpr size_t WS_BAR   = 0;
constexpr size_t WS_CNT   = 16384;
constexpr size_t WS_RDY   = WS_CNT + 8192;
constexpr size_t WS_RDYE  = WS_RDY + 16384;
constexpr size_t WS_ZERO_BYTES = 16384 + 8192 + 16384 + 16384;
constexpr size_t WS_MODV  = al256(WS_RDYE + 16384);
constexpr size_t WS_RW    = al256(WS_MODV + (size_t)NL * 9 * 6144 * 4);
constexpr size_t WS_RC    = al256(WS_RW + (size_t)NL * 9 * 2 * 32 * 1024 * 2);
constexpr size_t WS_GM    = al256(WS_RC + (size_t)NL * 9 * 32 * 4);
constexpr size_t WS_ROPEC = al256(WS_GM + (size_t)NL * 9 * 1024 * 4);
constexpr size_t WS_ROPED = al256(WS_ROPEC + (size_t)2 * 2048 * 32 * 4);
constexpr size_t WS_WIN   = al256(WS_ROPED + (size_t)2 * 2048 * 16 * 4);
constexpr size_t WS_WOUT  = al256(WS_WIN + (size_t)NL * INCP * 1024 * 2);
constexpr size_t WS_WUP   = al256(WS_WOUT + (size_t)NL * 1024 * 1024 * 2);
constexpr size_t WS_WDN   = al256(WS_WUP + (size_t)16 * 512 * 1024 * 2);
constexpr size_t WS_WQB   = al256(WS_WDN + (size_t)16 * 1024 * 256 * 2);
constexpr size_t WS_WKVB  = al256(WS_WQB + (size_t)NL * 384 * 256 * 2);
constexpr size_t WS_WSG   = al256(WS_WKVB + (size_t)NL * 512 * 128 * 2);
constexpr size_t WS_XS    = al256(WS_WSG + (size_t)NL * 4 * 128 * 128 * 2);
constexpr size_t WS_ACT   = al256(WS_XS + (size_t)NTOK * 1024 * 2);
constexpr size_t WS_P     = al256(WS_ACT + (size_t)NTOK * 1024 * 2);
constexpr size_t WS_QRAW  = WS_P;
constexpr size_t WS_KVRAW = al256(WS_QRAW + (size_t)NTOK * 384 * 2);
constexpr size_t WS_HBUF  = WS_P;
constexpr size_t WS_QC    = al256(WS_P + (size_t)NTOK * INC * 2);
constexpr size_t WS_KC    = al256(WS_QC + (size_t)NB * 4 * KEYS * 64 * 2);
constexpr size_t WS_VCT   = al256(WS_KC + (size_t)NB * 2 * KEYS * 64 * 2);
constexpr size_t WS_QD    = al256(WS_VCT + (size_t)NB * 2 * 64 * KEYS * 2);
constexpr size_t WS_CQN   = WS_QD;
constexpr size_t WS_CKVN  = WS_QD + (size_t)NTOK * 256 * 2;
constexpr size_t WS_KD    = al256(WS_QD + (size_t)NB * 4 * KEYS * 96 * 2);
constexpr size_t WS_VDT   = al256(WS_KD + (size_t)NB * 4 * KEYS * 96 * 2);
constexpr size_t WS_LTOK  = al256(WS_VDT + (size_t)NB * 4 * 64 * KEYS * 2);
constexpr size_t WS_LW    = al256(WS_LTOK + (size_t)NBUCKET * NTOK * 4);
constexpr size_t WS_SSQ   = al256(WS_LW + (size_t)NBUCKET * NTOK * 8);
constexpr size_t WS_DBG   = al256(WS_SSQ + (size_t)NTOK * 8 * 4);
constexpr size_t WS_END   = WS_DBG + (1 << 20);
static_assert(WS_END <= ((size_t)256 << 20), "workspace");
static_assert((size_t)MAXMT * 256 * 512 * 2 <= (size_t)NTOK * INC * 2, "Hbuf overlay");
static_assert((size_t)NTOK * 384 * 2 <= (size_t)NB * 4 * KEYS * 96 * 2, "CQN/CKVN overlay");

struct Params {
    const float* in[29];
    float* out;
    char* ws;
};
enum { I_X = 0, I_C, I_CTX, I_CCTX, I_WMOD, I_BMOD, I_GATTN, I_WIN, I_SGUVG, I_SGUW, I_SGUB, I_CONVW, I_GQAQG, I_GQAKG, I_QAG, I_WQB, I_KVAG, I_WKVB,
       I_MLAQG, I_MLAKG, I_GGO, I_WOUT, I_GFFN, I_WRG, I_BRG, I_WRE, I_BRE, I_WUP, I_WDN };

DEV bf16_t f2bf(float f) { unsigned u = __float_as_uint(f); u += 0x7fffu + ((u >> 16) & 1u); return (bf16_t)(u >> 16); }
DEV float bf2f(bf16_t h) { return __uint_as_float(((unsigned)h) << 16); }
typedef __bf16 bf16x2_t __attribute__((ext_vector_type(2)));
typedef float f32x2 __attribute__((ext_vector_type(2)));
DEV unsigned pk2(float a, float b) { const f32x2 v = {a, b}; return __builtin_bit_cast(unsigned, __builtin_convertvector(v, bf16x2_t)); }
DEV float bflo(unsigned u) { return __uint_as_float(u << 16); }
DEV float bfhi(unsigned u) { return __uint_as_float(u & 0xffff0000u); }
template <int M> DEV float xlane(float v) {
    const int i = __builtin_bit_cast(int, v);
    if constexpr (M == 1) return __builtin_bit_cast(float, __builtin_amdgcn_mov_dpp(i, 0xB1, 0xF, 0xF, true));
    else if constexpr (M == 2) return __builtin_bit_cast(float, __builtin_amdgcn_mov_dpp(i, 0x4E, 0xF, 0xF, true));
    else if constexpr (M == 8) return __builtin_bit_cast(float, __builtin_amdgcn_mov_dpp(i, 0x128, 0xF, 0xF, true));
    else if constexpr (M == 4 || M == 16) return __builtin_bit_cast(float, __builtin_amdgcn_ds_swizzle(i, (M << 10) | 0x1F));
    else { static_assert(M == 32, "xlane"); const auto r = __builtin_amdgcn_permlane32_swap((unsigned)i, (unsigned)i, false, false);
        return __builtin_bit_cast(float, (int)(r[0] ^ r[1] ^ (unsigned)i)); }
}
DEV float wave_sum(float v) { v += xlane<32>(v); v += xlane<16>(v); v += xlane<8>(v); v += xlane<4>(v); v += xlane<2>(v); v += xlane<1>(v); return v; }
DEV float wave_max(float v) { v = fmaxf(v, xlane<32>(v)); v = fmaxf(v, xlane<16>(v)); v = fmaxf(v, xlane<8>(v)); v = fmaxf(v, xlane<4>(v)); v = fmaxf(v, xlane<2>(v)); return fmaxf(v, xlane<1>(v)); }
DEV float grp_sum16(float v) { v += xlane<1>(v); v += xlane<2>(v); v += xlane<4>(v); v += xlane<8>(v); return v; }
DEV float silu_f(float x) { return x / (1.f + __expf(-x)); }
DEV float gelu_fast(float x) { const float u = 1.5957691216057308f * (x + 0.044715f * x * x * x); return x * __builtin_amdgcn_rcpf(1.f + __expf(-u)); }
DEV void tok_info(int tok, int& b, int& pos, int& key, bool& isctx) {
    if (tok < NLAT) { b = tok >> 11; pos = tok & 2047; key = CL + pos; isctx = false; }
    else { const int c = tok - NLAT; b = c >> 8; pos = c & 255; key = pos; isctx = true; }
}
DEV bf16x8 lds_r128(LAS const char* p) { return *(LAS const bf16x8*)p; }

typedef const __attribute__((address_space(4))) Params* ParamsPtr;
struct Ctx {
    ParamsPtr p; int layer; int bid, nb, tid; LAS char* lds;
    DEV const float* in(int i) const { return p->in[i]; }
    template <class T> DEV T* ws(size_t off) const { return (T*)(p->ws + off); }
    DEV const float* modv(int mb, int chunk) const { return ws<float>(WS_MODV) + ((size_t)(layer * 9 + mb) * 6 + chunk) * 1024; }
    DEV const float* xin(int tok) const { return tok < NLAT ? p->in[I_X] + (size_t)tok * DM : p->in[I_CTX] + (size_t)(tok - NLAT) * DM; }
    DEV bf16_t* xs(int tok) const { return ws<bf16_t>(WS_XS) + (size_t)tok * DM; }
    DEV f32x4 xload4(int tok, int n) const {
        if (layer == 0) return *(const f32x4*)(xin(tok) + n);
        const u32x2 r = *(const u32x2*)(xs(tok) + n); return (f32x4){bflo(r[0]), bfhi(r[0]), bflo(r[1]), bfhi(r[1])};
    }
    DEV f32x4 xsload4(int tok, int n) const { const u32x2 r = *(const u32x2*)(xs(tok) + n); return (f32x4){bflo(r[0]), bfhi(r[0]), bflo(r[1]), bfhi(r[1])}; }
    DEV void xsstore4(int tok, int n, float a, float b, float c2, float d) const { *(u32x2*)(xs(tok) + n) = (u32x2){pk2(a, b), pk2(c2, d)}; }
    DEV void xsstore4_wt(int tok, int n, float a, float b, float c2, float d) const { __hip_atomic_store((__attribute__((address_space(1))) unsigned long long*)(xs(tok) + n), (unsigned long long)pk2(a, b) | ((unsigned long long)pk2(c2, d) << 32), __ATOMIC_RELAXED, __HIP_MEMORY_SCOPE_AGENT); }
    DEV int ntok_tail() const { return layer == NL - 1 ? NLAT : NTOK; }
};

#define GAS __attribute__((address_space(1)))
#define XB_TMO      128
#define XB_XCNT(j)  (256  + 64 * (j))
#define XB_XSUB(j)  (1280 + 64 * (j))
#define XB_XGEN(j)  (2304 + 64 * (j))
#define XB_TOP      3328
#define XB_TOPGEN   3392
#define XCD_BAR_WORDS 3456
#define XB_SPIN_CAP (1u << 22)
DEV unsigned xb_ld(unsigned* p)              { return __hip_atomic_load(p, __ATOMIC_RELAXED, __HIP_MEMORY_SCOPE_AGENT); }
DEV unsigned xb_add(unsigned* p, unsigned v) { return __hip_atomic_fetch_add(p, v, __ATOMIC_RELAXED, __HIP_MEMORY_SCOPE_AGENT); }
DEV unsigned xb_xcc_id() { return (unsigned)__builtin_amdgcn_s_getreg((3 << 11) | 20) & 0xFu; }
#define XB_SPIN(cond, bar) do { unsigned _sp = 0; while (cond) { __builtin_amdgcn_s_sleep(20); \
    if ((++_sp & 255u) == 0u) { if (xb_ld(&(bar)[XB_TMO])) break; if (_sp > XB_SPIN_CAP) { atomicAdd(&(bar)[XB_TMO], 1u); break; } } } } while (0)
DEV void st8_wt(void* p, unsigned lo, unsigned hi) { __hip_atomic_store((GAS unsigned long long*)p, (unsigned long long)lo | ((unsigned long long)hi << 32), __ATOMIC_RELAXED, __HIP_MEMORY_SCOPE_AGENT); }
DEV void publish_add(const Ctx& c, unsigned* w, unsigned v) { asm volatile("s_waitcnt vmcnt(0)" ::: "memory"); __syncthreads(); if (c.tid == 0) (void)xb_add(w, v); }
DEV void publish_rel(const Ctx& c, unsigned* w, unsigned v) {
    asm volatile("s_waitcnt vmcnt(0)" ::: "memory"); __syncthreads();
    if (c.tid == 0) { __builtin_amdgcn_fence(__ATOMIC_RELEASE, "agent"); asm volatile("s_waitcnt vmcnt(0)" ::: "memory"); (void)xb_add(w, v); }
}
DEV void wait_ready(const Ctx& c, unsigned* w0, unsigned want) {
    if (c.tid < 64) { unsigned* bar = c.ws<unsigned>(WS_BAR); unsigned sp_ = 0;
        while (xb_ld(w0) < want) { __builtin_amdgcn_s_sleep(2); if ((++sp_ & 1023u) == 0u) { if (xb_ld(&bar[XB_TMO])) break; if (sp_ > (1u << 24)) { atomicAdd(&bar[XB_TMO], 1u); break; } } }
        __builtin_amdgcn_fence(__ATOMIC_ACQUIRE, "agent"); }
}
struct GemmDesc {
    const bf16_t* A; int lda; const int* rowidx; int nvalid;
    const bf16_t* B0; const bf16_t* B1; int ldb; int ksplit; int K;
};
template <int WN_, int MF, class Epi>
DEV void gemm_tile(const GemmDesc& g, int m0, int n0, LAS char* lds, int tid, const Epi& epi) {
    constexpr int BM = (8 / WN_) * 16 * MF, BN = 64 * WN_, NPA = BM / 8, APW = (NPA + 7) / 8, BP = WN_, STAGE = (BM + BN) * 128;
    static_assert(BM % 8 == 0 && 2 * STAGE <= LDS_BAR, "tile does not fit");
    const int lane = tid & 63, wave = __builtin_amdgcn_readfirstlane(tid >> 6), wm = wave / WN_, wn = wave % WN_;
    int aoff[APW], boff[BP];
#pragma unroll
    for (int j = 0; j < APW; ++j) {
        const int pc = (j * 8 + wave < NPA) ? j * 8 + wave : wave;
        const int r = pc * 8 + (lane >> 3), kc = (lane & 7) ^ ((r >> 1) & 7);
        const int srow = g.rowidx ? g.rowidx[(r < g.nvalid) ? r : 0] : (m0 + r);
        aoff[j] = srow * g.lda + kc * 8;
    }
#pragma unroll
    for (int j = 0; j < BP; ++j) {
        const int r = (j * 8 + wave) * 8 + (lane >> 3), kc = (lane & 7) ^ ((r >> 1) & 7);
        boff[j] = (n0 + r) * g.ldb + kc * 8;
    }
    f32x4 acc[4][MF];
#pragma unroll
    for (int i = 0; i < 4; ++i)
#pragma unroll
        for (int j = 0; j < MF; ++j) acc[i][j] = (f32x4){0.f, 0.f, 0.f, 0.f};
    const int nk = g.K / 64;
    const int swz = (lane >> 1) & 7, q = lane >> 4;
    const int arow = (16 * MF * wm + (lane & 15)) * 128, brow = (64 * wn + (lane & 15)) * 128;
    LAS char* pieceA = lds + wave * 1024;
    LAS char* pieceB = lds + BM * 128 + wave * 1024;
#define GT_STAGE(KT, ST) { const int k0_ = (KT) * 64; const bf16_t* Bb_ = (k0_ < g.ksplit) ? g.B0 + k0_ : g.B1 + (k0_ - g.ksplit); \
        _Pragma("unroll") for (int j = 0; j < APW; ++j) if (NPA % 8 == 0 || j * 8 + wave < NPA) __builtin_amdgcn_global_load_lds((const void*)(g.A + aoff[j] + k0_), (LAS void*)(pieceA + (ST) * STAGE + j * 8192), 16, 0, 0); \
        _Pragma("unroll") for (int j = 0; j < BP; ++j) __builtin_amdgcn_global_load_lds((const void*)(Bb_ + boff[j]), (LAS void*)(pieceB + (ST) * STAGE + j * 8192), 16, 0, 0); }
#define GT_COMPUTE(ST) { LAS const char* As_ = lds + (ST) * STAGE; LAS const char* Bs_ = As_ + BM * 128; \
        _Pragma("unroll") for (int ks = 0; ks < 2; ++ks) { const int ch = ((4 * ks + q) ^ swz) << 4; bf16x8 bfr[4]; \
            _Pragma("unroll") for (int f = 0; f < 4; ++f) bfr[f] = lds_r128(Bs_ + brow + f * 2048 + ch); \
            _Pragma("unroll") for (int mh = 0; mh < MF; mh += 4) { bf16x8 af[4]; \
                _Pragma("unroll") for (int f = 0; f < 4; ++f) af[f] = lds_r128(As_ + arow + (mh + f) * 2048 + ch); \
                _Pragma("unroll") for (int mf = 0; mf < 4; ++mf) _Pragma("unroll") for (int nf = 0; nf < 4; ++nf) \
                    acc[nf][mh + mf] = __builtin_amdgcn_mfma_f32_16x16x32_bf16(bfr[nf], af[mf], acc[nf][mh + mf], 0, 0, 0); } } }
    __syncthreads();
    GT_STAGE(0, 0);
    asm volatile("s_waitcnt vmcnt(0)" ::: "memory");
    __syncthreads();
#pragma unroll 1
    for (int kt = 0; kt < nk; kt += 2) {
        GT_STAGE(kt + 1, 1);
        GT_COMPUTE(0);
        asm volatile("s_waitcnt vmcnt(0)" ::: "memory");
        __syncthreads();
        if (kt + 2 < nk) GT_STAGE(kt + 2, 0);
        GT_COMPUTE(1);
        asm volatile("s_waitcnt vmcnt(0)" ::: "memory");
        __syncthreads();
    }
#undef GT_STAGE
#undef GT_COMPUTE
    {
        int lane_e = lane, mb_e = 16 * MF * wm, nb_e = n0 + 64 * wn;
        asm volatile("" : "+v"(lane_e), "+v"(mb_e), "+v"(nb_e));
        epi(acc, mb_e, __builtin_amdgcn_readfirstlane(nb_e), lane_e);
    }
}

DEV int p8_lds_lo(int fr, int fq) { return (fr * 64 + fq * 16) ^ ((fr >> 3) << 5); }
DEV void p8_stage_rc(int b, int& R, int& C) { const int st = b >> 10, sb = b & 1023, swz = sb ^ (((sb >> 9) & 1) << 5); R = (st >> 1) * 16 + (swz >> 6); C = (st & 1) * 32 + ((swz & 63) >> 1); }
template <class Epi>
DEV void gemm_tile8p(const GemmDesc& g, int m0, int n0, LAS char* lds, int tid, const Epi& epi) {
    const int wid = __builtin_amdgcn_readfirstlane(tid >> 6), lane = tid & 63, wr = wid >> 2, wc = wid & 3, fr = lane & 15, fq = lane >> 4;
    int aoff[2][2], boff[2][2];
#pragma unroll
    for (int i = 0; i < 2; ++i) { int R, C; p8_stage_rc(tid * 16 + i * 8192, R, C);
#pragma unroll
        for (int h = 0; h < 2; ++h) { const int r = h * 128 + R;
            const int srow = g.rowidx ? g.rowidx[(r < g.nvalid) ? r : 0] : (m0 + r);
            aoff[h][i] = srow * g.lda + C; boff[h][i] = (n0 + r) * g.ldb + C; } }
    const int lo = p8_lds_lo(fr, fq);
    LAS char* const stg = lds + wid * 1024;
    LAS const char* const rdA = lds + wr * 8192 + lo;
    LAS const char* const rdB = lds + 65536 + wc * 4096 + lo;
    f32x4 acc[2][2][4][2];
#pragma unroll
    for (int a = 0; a < 2; ++a)
#pragma unroll
        for (int b = 0; b < 2; ++b)
#pragma unroll
            for (int m = 0; m < 4; ++m) { acc[a][b][m][0] = (f32x4){0.f, 0.f, 0.f, 0.f}; acc[a][b][m][1] = acc[a][b][m][0]; }
    bf16x8 At[4][2], B0[2][2], B1[2][2];
    const int nt = g.K / 64;
#define P8_BOFF(kt) (((kt) * 64 < g.ksplit) ? g.B0 + (kt) * 64 : g.B1 + ((kt) * 64 - g.ksplit))
#define STAGE_A(b, h, kt) { _Pragma("unroll") for (int i_ = 0; i_ < 2; ++i_) __builtin_amdgcn_global_load_lds((const void*)(g.A + aoff[h][i_] + (kt) * 64), (LAS void*)(stg + ((b) * 2 + (h)) * 16384 + i_ * 8192), 16, 0, 0); }
#define STAGE_B(b, h, kt) { const bf16_t* Bb_ = P8_BOFF(kt); _Pragma("unroll") for (int i_ = 0; i_ < 2; ++i_) __builtin_amdgcn_global_load_lds((const void*)(Bb_ + boff[h][i_]), (LAS void*)(stg + 65536 + ((b) * 2 + (h)) * 16384 + i_ * 8192), 16, 0, 0); }
#define LDA(b, h) { _Pragma("unroll") for (int m = 0; m < 4; ++m) _Pragma("unroll") for (int k = 0; k < 2; ++k) At[m][k] = lds_r128(rdA + ((b) * 2 + (h)) * 16384 + (m * 2 + k) * 1024); }
#define LDB(dst, b, h) { _Pragma("unroll") for (int n = 0; n < 2; ++n) _Pragma("unroll") for (int k = 0; k < 2; ++k) dst[n][k] = lds_r128(rdB + ((b) * 2 + (h)) * 16384 + (n * 2 + k) * 1024); }
#define MMA(ai, bj, Bx) { __builtin_amdgcn_s_setprio(1); \
        _Pragma("unroll") for (int m = 0; m < 4; ++m) _Pragma("unroll") for (int n = 0; n < 2; ++n) _Pragma("unroll") for (int k = 0; k < 2; ++k) \
            acc[ai][bj][m][n] = __builtin_amdgcn_mfma_f32_16x16x32_bf16(Bx[n][k], At[m][k], acc[ai][bj][m][n], 0, 0, 0); \
        __builtin_amdgcn_s_setprio(0); }
#define WAIT_V(n) asm volatile("s_waitcnt vmcnt(" #n ")" ::: "memory")
#define WAIT_L(n) asm volatile("s_waitcnt lgkmcnt(" #n ")" ::: "memory")
#define BAR __builtin_amdgcn_s_barrier()
#define SCHED __builtin_amdgcn_sched_barrier(0)
    __syncthreads();
    STAGE_B(0, 0, 0); STAGE_A(0, 0, 0); STAGE_B(0, 1, 0); STAGE_A(0, 1, 0);
    if (wr == 1) BAR;
    WAIT_V(4); BAR;
    STAGE_B(1, 0, 1); STAGE_A(1, 0, 1); STAGE_B(1, 1, 1);
    WAIT_V(6); BAR;
#pragma unroll 1
    for (int t = 0; t < nt - 2; t += 2) {
        LDB(B0, 0, 0); SCHED; LDA(0, 0); STAGE_A(1, 1, t + 1);
        WAIT_L(8); BAR; WAIT_L(0); MMA(0, 0, B0); BAR; SCHED;
        LDB(B1, 0, 1); STAGE_B(0, 0, t + 2);
        BAR; WAIT_L(0); MMA(0, 1, B1); BAR;
        LDA(0, 1); STAGE_A(0, 0, t + 2);
        BAR; WAIT_L(0); MMA(1, 0, B0); BAR; SCHED;
        STAGE_B(0, 1, t + 2);
        WAIT_V(6); BAR; MMA(1, 1, B1); BAR;
        LDB(B0, 1, 0); SCHED; LDA(1, 0); STAGE_A(0, 1, t + 2);
        WAIT_L(8); BAR; WAIT_L(0); MMA(0, 0, B0); BAR; SCHED;
        LDB(B1, 1, 1); STAGE_B(1, 0, t + 3);
        BAR; WAIT_L(0); MMA(0, 1, B1); BAR;
        LDA(1, 1); STAGE_A(1, 0, t + 3);
        BAR; WAIT_L(0); MMA(1, 0, B0); BAR; SCHED;
        STAGE_B(1, 1, t + 3);
        WAIT_V(6); BAR; MMA(1, 1, B1); BAR;
    }
    {
        LDB(B0, 0, 0); LDA(0, 0); STAGE_A(1, 1, nt - 1);
        BAR; WAIT_L(0); MMA(0, 0, B0); BAR;
        LDB(B1, 0, 1); BAR; WAIT_L(0); MMA(0, 1, B1); BAR;
        LDA(0, 1); WAIT_V(4); BAR; WAIT_L(0); MMA(1, 0, B0); MMA(1, 1, B1); BAR; }
    {
        LDB(B0, 1, 0); LDA(1, 0); WAIT_V(2); BAR; WAIT_L(0); MMA(0, 0, B0); BAR;
        LDB(B1, 1, 1); WAIT_V(0); BAR; WAIT_L(0); MMA(0, 1, B1); BAR;
        LDA(1, 1); BAR; WAIT_L(0); MMA(1, 0, B0); MMA(1, 1, B1); BAR; }
    if (wr == 0) BAR;
#undef P8_BOFF
#undef STAGE_A
#undef STAGE_B
#undef LDA
#undef LDB
#undef MMA
#undef WAIT_V
#undef WAIT_L
#undef BAR
#undef SCHED
    {
        int lane_e = lane, wr_e = wr, wc_e = wc;
        asm volatile("" : "+v"(lane_e), "+s"(wr_e), "+s"(wc_e));
        epi(acc, wr_e, wc_e, lane_e);
    }
}

DEV void p0_transpose(const float* W, int K, int N, bf16_t* WT, int kt, int nt, int mode, const float* kscale, LAS float* scr, int tid) {
    {
        const int n4 = (tid & 15) * 4, kr = tid >> 4, n_in = nt * 64 + n4;
#pragma unroll
        for (int i = 0; i < 2; ++i) { const int kk = kr + 32 * i; const float s = kscale ? kscale[kt * 64 + kk] : 1.f;
            f32x4 v = (f32x4){0.f, 0.f, 0.f, 0.f};
            if (n_in < N) v = *(const f32x4*)(W + (size_t)(kt * 64 + kk) * N + n_in);
            scr[kk * 65 + n4] = s * v[0]; scr[kk * 65 + n4 + 1] = s * v[1]; scr[kk * 65 + n4 + 2] = s * v[2]; scr[kk * 65 + n4 + 3] = s * v[3]; }
    }
    __syncthreads();
    const int nl = tid >> 3, kcq = tid & 7, n = nt * 64 + nl;
    if (n < N) {
        int drow = n;
        if (mode == 1) { const int type = n >> 8, j = n & 255; drow = 128 * (j >> 6) + 64 * ((j >> 5) & 1) + 16 * (((j >> 4) & 1) + 2 * type) + (j & 15); }
        if (mode == 2) { const int h = n / 96, cc = n % 96; drow = cc < 64 ? 64 * h + cc : 256 + 32 * h + (cc - 64); }
        if (mode == 3) drow = (n & ~255) | (((n >> 5) & 1) << 7) | (((n >> 6) & 3) << 5) | (n & 31);
        unsigned o[4];
#pragma unroll
        for (int j = 0; j < 4; ++j) o[j] = pk2(scr[(kcq * 8 + 2 * j) * 65 + nl], scr[(kcq * 8 + 2 * j + 1) * 65 + nl]);
        *(u32x4*)(WT + (size_t)drow * K + kt * 64 + kcq * 8) = (u32x4){o[0], o[1], o[2], o[3]};
    }
    __syncthreads();
}
constexpr int T_IN = 16 * 35, T_OUT = 16 * 16, T_UP = 16 * 16 * 8, T_DN = 16 * 4 * 16, T_QB = 4 * 6, T_KVB = 2 * 8;
constexpr int T_LAYER = T_IN + T_OUT + T_UP + T_DN + T_QB + T_KVB;
constexpr int P0_TR = NL * T_LAYER, P0_WSG = 32, P0_MODV = NL * 192, P0_ROPE = 192, P0_PAD = 48;
constexpr int P0_ITEMS = P0_TR + P0_WSG + P0_MODV + P0_ROPE + P0_PAD;

DEV void p0_expert_item(const Ctx& c, int l, int item, LAS float* scr, int tid) {
    if (item < T_UP) { const int e = item / 128, q = item % 128;
        p0_transpose(c.in(I_WUP) + ((size_t)l * 16 + e) * 1024 * 512, 1024, 512, c.ws<bf16_t>(WS_WUP) + (size_t)e * 512 * 1024, q / 8, q % 8, 1, nullptr, scr, tid); }
    else { const int r = item - T_UP, e = r / 64, q = r % 64;
        p0_transpose(c.in(I_WDN) + ((size_t)l * 16 + e) * 256 * 1024, 256, 1024, c.ws<bf16_t>(WS_WDN) + (size_t)e * 1024 * 256, q / 16, q % 16, 0, nullptr, scr, tid); }
}
DEV void phase_p0(const Ctx& c) {
    const int tid = c.tid;
    LAS float* scr = (LAS float*)c.lds;
    for (int it = c.bid; it < P0_ITEMS; it += c.nb) {
        int r = it;
        if (r < P0_TR) {
            const int l = r / T_LAYER; r -= l * T_LAYER;
            if (r < T_IN) { p0_transpose(c.in(I_WIN) + (size_t)l * 1024 * INC, 1024, INC, c.ws<bf16_t>(WS_WIN) + (size_t)l * INCP * 1024, r / 35, r % 35, 0, nullptr, scr, tid); continue; } r -= T_IN;
            if (r < T_OUT) { p0_transpose(c.in(I_WOUT) + (size_t)l * 1024 * 1024, 1024, 1024, c.ws<bf16_t>(WS_WOUT) + (size_t)l * 1024 * 1024, r / 16, r % 16, 3, nullptr, scr, tid); continue; } r -= T_OUT;
            if (r < T_UP) { if (l == 0 && c.nb != 256) p0_expert_item(c, 0, r, scr, tid); continue; } r -= T_UP;
            if (r < T_DN) { if (l == 0 && c.nb != 256) p0_expert_item(c, 0, T_UP + r, scr, tid); continue; } r -= T_DN;
            if (r < T_QB) { p0_transpose(c.in(I_WQB) + (size_t)l * 256 * 384, 256, 384, c.ws<bf16_t>(WS_WQB) + (size_t)l * 384 * 256, r / 6, r % 6, 2, c.in(I_QAG) + l * 256, scr, tid); continue; } r -= T_QB;
            p0_transpose(c.in(I_WKVB) + (size_t)l * 128 * 512, 128, 512, c.ws<bf16_t>(WS_WKVB) + (size_t)l * 512 * 128, r / 8, r % 8, 0, c.in(I_KVAG) + l * 128, scr, tid); continue;
        }
        r -= P0_TR;
        if (r < P0_WSG) {
            const size_t e0 = ((size_t)r * NTHREADS + tid) * 8; const float* s = c.in(I_SGUW) + e0;
            const f32x4 a = *(const f32x4*)s, b = *(const f32x4*)(s + 4);
            *(u32x4*)(c.ws<bf16_t>(WS_WSG) + e0) = (u32x4){pk2(a[0], a[1]), pk2(a[2], a[3]), pk2(b[0], b[1]), pk2(b[2], b[3])};
            continue;
        }
        r -= P0_WSG;
        if (r < P0_MODV) {
            const int l = r / 192, n0 = (r % 192) * 32;
            LAS float* sc = scr;
            LAS float* red = scr + 9 * 1024;
            __syncthreads();
            for (int i = tid; i < 9 * 1024; i += NTHREADS) { const int mb = i >> 10, k = i & 1023; sc[i] = silu_f(mb < 8 ? c.in(I_C)[mb * 1024 + k] : c.in(I_CCTX)[k]); }
            __syncthreads();
            const int kq = tid >> 3, nl = tid & 7;
            float a[9][4];
#pragma unroll
            for (int j = 0; j < 9; ++j) { a[j][0] = 0.f; a[j][1] = 0.f; a[j][2] = 0.f; a[j][3] = 0.f; }
            const float* wp = c.in(I_WMOD) + (size_t)l * 1024 * 6144 + n0 + 4 * nl;
#pragma unroll 8
            for (int k2 = 0; k2 < 16; ++k2) { const int k = kq * 16 + k2; const f32x4 w = *(const f32x4*)(wp + (size_t)k * 6144);
#pragma unroll
                for (int j = 0; j < 9; ++j) { const float s = sc[j * 1024 + k]; a[j][0] += s * w[0]; a[j][1] += s * w[1]; a[j][2] += s * w[2]; a[j][3] += s * w[3]; } }
#pragma unroll
            for (int j = 0; j < 9; ++j)
#pragma unroll
                for (int q = 0; q < 4; ++q) { float v = a[j][q]; v += xlane<8>(v); v += xlane<16>(v); v += xlane<32>(v); a[j][q] = v; }
            if ((tid & 63) < 8) {
#pragma unroll
                for (int j = 0; j < 9; ++j)
#pragma unroll
                    for (int q = 0; q < 4; ++q) red[((tid >> 6) * 9 + j) * 32 + 4 * nl + q] = a[j][q];
            }
            __syncthreads();
            for (int i = tid; i < 9 * 32; i += NTHREADS) { const int mb = i >> 5, n = i & 31;
                float v = 0.f;
#pragma unroll
                for (int w = 0; w < NW; ++w) v += red[(w * 9 + mb) * 32 + n];
                c.ws<float>(WS_MODV)[(size_t)(l * 9 + mb) * 6144 + n0 + n] = v + c.in(I_BMOD)[l * 6144 + n0 + n]; }
            __syncthreads();
            continue;
        }
        r -= P0_MODV;
        if (r < P0_ROPE) {
            const int idx = r * NTHREADS + tid;
            if (idx < 2048 * 32) { const int s = idx >> 5, i = idx & 31, f = i & 15; const float pos = (float)((i < 16) ? (s >> 6) : (s & 63));
                const float inv = powf(10000.f, -(float)f / 16.f), ang = pos * inv;
                c.ws<float>(WS_ROPEC)[idx] = cosf(ang); c.ws<float>(WS_ROPEC)[2048 * 32 + idx] = sinf(ang); }
            else { const int j = idx - 2048 * 32, s = j >> 4, i = j & 15, f = i & 7; const float pos = (float)((i < 8) ? (s >> 6) : (s & 63));
                const float inv = powf(10000.f, -(float)f / 8.f), ang = pos * inv;
                c.ws<float>(WS_ROPED)[j] = cosf(ang); c.ws<float>(WS_ROPED)[2048 * 16 + j] = sinf(ang); }
            continue;
        }
        r -= P0_ROPE;
        {
            const int e = (r * NTHREADS + tid) * 8, l = e / (96 * 1024), o = e % (96 * 1024);
            unsigned z = 0u; asm volatile("" : "+v"(z));
            *(u32x4*)(c.ws<bf16_t>(WS_WIN) + ((size_t)l * INCP + INC) * 1024 + o) = (u32x4){z, z, z, z};
        }
    }
}

constexpr int A_RW_ITEMS = NL * 9 * 1024 / NTHREADS;
constexpr int A_RC_ITEMS = NL * 9 * 20 / NW;
DEV void phase_a(const Ctx& c) {
    const int tid = c.tid, lane = tid & 63, wave = tid >> 6;
    const float* g = c.in(I_GATTN) + c.layer * 1024;
    bf16_t* H = c.ws<bf16_t>(WS_ACT);
    const int nwv = c.nb * NW, per = (NTOK + nwv - 1) / nwv, tbeg = (c.bid * NW + wave) * per, tend = min(tbeg + per, NTOK);
    int mbc = -1; f32x4 gm[4], sv[4];
#pragma unroll 1
    for (int t0 = tbeg; t0 < tend; t0 += 3) {
        f32x4 v[3][4];
#pragma unroll
        for (int u = 0; u < 3; ++u) { const int tok = min(t0 + u, tend - 1);
#pragma unroll
            for (int i = 0; i < 4; ++i) v[u][i] = c.xload4(tok, i * 256 + lane * 4); }
#pragma unroll
        for (int u = 0; u < 3; ++u) { const int tok = t0 + u;
            if (tok < tend) {
                const int mb = tok < NLAT ? (tok >> 11) : 8;
                if (mb != mbc) { mbc = mb; const float* sh = c.modv(mb, 0); const float* scl = c.modv(mb, 1);
#pragma unroll
                    for (int i = 0; i < 4; ++i) { const int e = i * 256 + lane * 4; const f32x4 gg = *(const f32x4*)(g + e), s1 = *(const f32x4*)(scl + e);
                        gm[i] = (f32x4){gg[0] * (1.f + s1[0]), gg[1] * (1.f + s1[1]), gg[2] * (1.f + s1[2]), gg[3] * (1.f + s1[3])}; sv[i] = *(const f32x4*)(sh + e); } }
                float ss = 0.f;
#pragma unroll
                for (int i = 0; i < 4; ++i) ss += v[u][i][0] * v[u][i][0] + v[u][i][1] * v[u][i][1] + v[u][i][2] * v[u][i][2] + v[u][i][3] * v[u][i][3];
                const float r = rsqrtf(wave_sum(ss) * (1.f / 1024.f) + EPS);
#pragma unroll
                for (int i = 0; i < 4; ++i) { const int e = i * 256 + lane * 4;
                    float o[4];
#pragma unroll
                    for (int j = 0; j < 4; ++j) o[j] = v[u][i][j] * r * gm[i][j] + sv[i][j];
                    *(u32x2*)(H + (size_t)tok * 1024 + e) = (u32x2){pk2(o[0], o[1]), pk2(o[2], o[3])}; }
            } }
    }
    if (c.layer == 0) {
        for (int it = c.bid; it < A_RW_ITEMS + A_RC_ITEMS; it += c.nb) {
            if (it < A_RW_ITEMS) {
                const int idx = it * NTHREADS + tid, l = idx / (9 * 1024), mb = (idx >> 10) % 9, k = idx & 1023;
                const float* mv = c.ws<float>(WS_MODV) + (size_t)(l * 9 + mb) * 6144;
                const float gm = c.in(I_GFFN)[l * 1024 + k] * (1.f + mv[4 * 1024 + k]);
                c.ws<float>(WS_GM)[idx] = gm;
                bf16_t* o = c.ws<bf16_t>(WS_RW) + (size_t)(l * 9 + mb) * 2 * 32 * 1024 + k;
                const float* wg = c.in(I_WRG) + ((size_t)l * 1024 + k) * 4; const float* we = c.in(I_WRE) + ((size_t)l * 1024 + k) * 16;
#pragma unroll
                for (int j = 0; j < 32; ++j) { const float w = j < 20 ? gm * (j < 4 ? wg[j] : we[j - 4]) : 0.f;
                    const bf16_t hi = f2bf(w); o[(size_t)j * 1024] = hi; o[(size_t)(32 + j) * 1024] = f2bf(w - bf2f(hi)); }
            } else {
                const int idx = (it - A_RW_ITEMS) * NW + wave, l = idx / 180, mb = (idx / 20) % 9, j = idx % 20;
                const float* mv = c.ws<float>(WS_MODV) + (size_t)(l * 9 + mb) * 6144 + 3 * 1024;
                float a = 0.f;
                for (int k = lane; k < 1024; k += 64) { const float w = (j < 4) ? c.in(I_WRG)[((size_t)l * 1024 + k) * 4 + j] : c.in(I_WRE)[((size_t)l * 1024 + k) * 16 + (j - 4)]; a += mv[k] * w; }
                a = wave_sum(a);
                if (lane == 0) c.ws<float>(WS_RC)[(l * 9 + mb) * 32 + j] = a + ((j < 4) ? c.in(I_BRG)[l * 4 + j] : c.in(I_BRE)[l * 16 + j - 4]);
            }
        }
    }
}

DEV void rope2(float& a, float& b, float cs, float sn) { const float x0 = a, x1 = b; a = x0 * cs - x1 * sn; b = x0 * sn + x1 * cs; }
DEV float red_q(float v) { v += xlane<16>(v); v += xlane<32>(v); return v; }
template <int MF>
DEV void b_epilogue(const Ctx& c, const f32x4 (&acc)[4][MF], int m0, int mb, int nbase, int lane) {
    const int l = c.layer;
    bf16_t* P = c.ws<bf16_t>(WS_P);
    const int q = lane >> 4, li = lane & 15;
    const bool isctx = m0 >= NLAT;
    if (nbase < 256) {
#pragma unroll
        for (int mf = 0; mf < MF; ++mf) { const int m = m0 + mb + 16 * mf + li;
#pragma unroll
            for (int nf = 0; nf < 4; ++nf) { const f32x4 a = acc[nf][mf];
                *(u32x2*)(P + (size_t)m * INC + nbase + 16 * nf + 4 * q) = (u32x2){pk2(gelu_fast(a[0]), gelu_fast(a[1])), pk2(gelu_fast(a[2]), gelu_fast(a[3]))}; } }
    } else if (nbase < 512) {
        const float* vg = c.in(I_SGUVG) + l * 256 + (nbase - 256) + 4 * q;
#pragma unroll
        for (int mf = 0; mf < MF; ++mf) { const int m = m0 + mb + 16 * mf + li;
            float v[4][4]; float ss = 0.f;
#pragma unroll
            for (int nf = 0; nf < 4; ++nf)
#pragma unroll
                for (int r = 0; r < 4; ++r) { v[nf][r] = gelu_fast(acc[nf][mf][r]); ss += v[nf][r] * v[nf][r]; }
            const float rr = rsqrtf(red_q(ss) * (1.f / 64.f) + EPS);
#pragma unroll
            for (int nf = 0; nf < 4; ++nf) { const f32x4 gg = *(const f32x4*)(vg + 16 * nf);
                *(u32x2*)(P + (size_t)m * INC + nbase + 16 * nf + 4 * q) = (u32x2){pk2(v[nf][0] * rr * gg[0], v[nf][1] * rr * gg[1]), pk2(v[nf][2] * rr * gg[2], v[nf][3] * rr * gg[3])}; } }
    } else if (nbase < OFF_CQ || (nbase >= OFF_DCQ && nbase < OFF_DKR)) {
        const bool need_ss = nbase >= OFF_DCQ;
        const int sidx = nbase < OFF_DCKV ? (nbase - OFF_DCQ) >> 6 : 4 + ((nbase - OFF_DCKV) >> 6);
#pragma unroll
        for (int mf = 0; mf < MF; ++mf) { const int m = m0 + mb + 16 * mf + li; float ss = 0.f;
#pragma unroll
            for (int nf = 0; nf < 4; ++nf) { const f32x4 a = acc[nf][mf]; ss += a[0] * a[0] + a[1] * a[1] + a[2] * a[2] + a[3] * a[3];
                *(u32x2*)(P + (size_t)m * INC + nbase + 16 * nf + 4 * q) = (u32x2){pk2(a[0], a[1]), pk2(a[2], a[3])}; }
            if (need_ss) { ss = red_q(ss); if (q == 0) c.ws<float>(WS_SSQ)[(size_t)m * 8 + sidx] = ss; } }
    } else if (nbase < OFF_CV) {
        const bool isq = nbase < OFF_CK;
        const int h = isq ? (nbase - OFF_CQ) >> 6 : (nbase - OFF_CK) >> 6;
        const float* gn = (isq ? c.in(I_GQAQG) : c.in(I_GQAKG)) + l * 64 + 4 * q;
        const float sc = isq ? C_SCALE * LOG2E : 1.f;
        const float* cosC = c.ws<float>(WS_ROPEC); const float* sinC = cosC + 2048 * 32;
#pragma unroll
        for (int mf = 0; mf < MF; ++mf) { const int m = m0 + mb + 16 * mf + li;
            int b, pos, key; bool ic; tok_info(m, b, pos, key, ic);
            float ss = 0.f;
#pragma unroll
            for (int nf = 0; nf < 4; ++nf) { const f32x4 a = acc[nf][mf]; ss += a[0] * a[0] + a[1] * a[1] + a[2] * a[2] + a[3] * a[3]; }
            const float rr = rsqrtf(red_q(ss) * (1.f / 64.f) + EPS);
            bf16_t* dst = isq ? c.ws<bf16_t>(WS_QC) + ((size_t)(b * 4 + h) * KEYS + key) * 64 : c.ws<bf16_t>(WS_KC) + ((size_t)(b * 2 + h) * KEYS + key) * 64;
#pragma unroll
            for (int nf = 0; nf < 4; ++nf) { const f32x4 gg = *(const f32x4*)(gn + 16 * nf); const f32x4 a = acc[nf][mf];
                float v0 = a[0] * rr * gg[0], v1 = a[1] * rr * gg[1], v2 = a[2] * rr * gg[2], v3 = a[3] * rr * gg[3];
                if (!isctx) { const f32x2 cs = *(const f32x2*)(cosC + pos * 32 + 8 * nf + 2 * q), sn = *(const f32x2*)(sinC + pos * 32 + 8 * nf + 2 * q);
                    rope2(v0, v1, cs[0], sn[0]); rope2(v2, v3, cs[1], sn[1]); }
                *(u32x2*)(dst + 16 * nf + 4 * q) = (u32x2){pk2(v0 * sc, v1 * sc), pk2(v2 * sc, v3 * sc)}; } }
    } else if (nbase < OFF_DCQ) {
        const int kvh = (nbase - OFF_CV) >> 6;
#pragma unroll
        for (int mf = 0; mf < MF; ++mf) { const int m = m0 + mb + 16 * mf + li;
            int b, pos, key; bool ic; tok_info(m, b, pos, key, ic);
            bf16_t* dst = c.ws<bf16_t>(WS_VCT) + ((size_t)(b * 2 + kvh) * 64 + 4 * q) * KEYS + key;
#pragma unroll
            for (int nf = 0; nf < 4; ++nf) { const f32x4 a = acc[nf][mf]; const unsigned p0 = pk2(a[0], a[1]), p1 = pk2(a[2], a[3]);
                bf16_t* d = dst + (size_t)(16 * nf) * KEYS;
                d[0] = (bf16_t)(p0 & 0xffffu); d[KEYS] = (bf16_t)(p0 >> 16); d[2 * KEYS] = (bf16_t)(p1 & 0xffffu); d[3 * KEYS] = (bf16_t)(p1 >> 16); } }
    } else if (nbase < OFF_DKR + 64) {
        const float* gn = c.in(I_MLAKG) + l * 96 + 64 + 4 * q;
        const float* cosD = c.ws<float>(WS_ROPED); const float* sinD = cosD + 2048 * 16;
#pragma unroll
        for (int mf = 0; mf < MF; ++mf) { const int m = m0 + mb + 16 * mf + li;
            int b, pos, key; bool ic; tok_info(m, b, pos, key, ic);
            float ss = 0.f;
#pragma unroll
            for (int nf = 0; nf < 2; ++nf) { const f32x4 a = acc[nf][mf]; ss += a[0] * a[0] + a[1] * a[1] + a[2] * a[2] + a[3] * a[3]; }
            const float rr = rsqrtf(red_q(ss) * (1.f / 32.f) + EPS);
#pragma unroll
            for (int nf = 0; nf < 2; ++nf) { const f32x4 gg = *(const f32x4*)(gn + 16 * nf); const f32x4 a = acc[nf][mf];
                float v0 = a[0] * rr * gg[0], v1 = a[1] * rr * gg[1], v2 = a[2] * rr * gg[2], v3 = a[3] * rr * gg[3];
                if (!isctx) { const f32x2 cs = *(const f32x2*)(cosD + pos * 16 + 8 * nf + 2 * q), sn = *(const f32x2*)(sinD + pos * 16 + 8 * nf + 2 * q);
                    rope2(v0, v1, cs[0], sn[0]); rope2(v2, v3, cs[1], sn[1]); }
                const u32x2 o = (u32x2){pk2(v0, v1), pk2(v2, v3)};
#pragma unroll
                for (int h = 0; h < 4; ++h) *(u32x2*)(c.ws<bf16_t>(WS_KD) + ((size_t)(b * 4 + h) * KEYS + key) * 96 + 64 + 16 * nf + 4 * q) = o; } }
    }
}
DEV void phase_b(const Ctx& c) {
    const int l = c.layer;
    GemmDesc g; g.A = c.ws<bf16_t>(WS_ACT); g.lda = 1024; g.rowidx = nullptr; g.nvalid = 0;
    g.B0 = c.ws<bf16_t>(WS_WIN) + (size_t)l * INCP * 1024; g.B1 = g.B0; g.ldb = 1024; g.ksplit = 1 << 30; g.K = 1024;
    constexpr int NT_N = INCP / 256, NT_M = NTOK / 256;
    auto full_tile = [&](int mt, int nt) { const int m0 = mt * 256;
        gemm_tile<4, 8>(g, m0, nt * 256, c.lds, c.tid, [&](const f32x4 (&acc)[4][8], int mb, int nbase, int lane) { b_epilogue<8>(c, acc, m0, mb, nbase, lane); }); };
    if (c.nb != 256) { for (int t = c.bid; t < NT_M * NT_N; t += c.nb) full_tile(t / NT_N, t % NT_N); }
    else if (l < NL - 1) {
        const int nmine = c.bid < 136 ? 3 : 2;
        for (int rd = 0; rd < nmine; ++rd) {
            int mt, nt, ex = -1, ch = -1;
            if (c.bid >= 136) ex = (c.bid - 136) + 120 * rd;
            else if (rd == 0) { if (c.bid < 48) ex = 240 + c.bid; else ch = c.bid - 48; }
            else ch = 88 + 136 * (rd - 1) + c.bid;
            if (ex >= 0) { const int k = ex / 72; nt = k == 0 ? 5 : (k == 1 ? 6 : (k == 2 ? 1 : 0)); mt = ex % 72; }
            else { const int k = ch / 72; nt = k < 3 ? 2 + k : 4 + k; mt = ch % 72; }
            full_tile(mt, nt);
        }
    } else {
        auto unit = [&](int u, int& mt, int& nt) {
            if (u < 256) { const int k = u >> 6; nt = k == 0 ? 5 : (k == 1 ? 6 : (k == 2 ? 1 : 0)); mt = u & 63; }
            else if (u < 576) { const int v = u - 256, k = v >> 6; nt = k < 3 ? 2 + k : 4 + k; mt = v & 63; }
            else { const int v = u - 576; nt = (v >> 3) ? 8 : 6; mt = 64 + (v & 7); } };
        for (int rd = 0; rd < 2; ++rd) { int mt, nt; unit(c.bid + 256 * rd, mt, nt); full_tile(mt, nt); }
        if (c.bid < 160) { int mt, nt; unit(512 + (c.bid >> 1), mt, nt); const int m0 = mt * 256;
            gemm_tile<2, 4>(g, m0, nt * 256 + (c.bid & 1) * 128, c.lds, c.tid, [&](const f32x4 (&acc)[4][4], int mb, int nbase, int lane) { b_epilogue<4>(c, acc, m0, mb, nbase, lane); }); }
    }
    if (l > 0 && c.nb != 256) {
        for (int e = c.bid; e < T_UP + T_DN; e += c.nb) p0_expert_item(c, l, e, (LAS float*)c.lds, c.tid);
    }
}

constexpr int C_SGU_ITEMS = (NTOK / 128) * 4, C_TQ = (NTOK / 256) * 3, C_TKV = (NTOK / 256) * 4;
constexpr int SG_LD = 272;
DEV void phase_c_sgu(const Ctx& c, int item) {
    const int tid = c.tid, lane = tid & 63, wave = tid >> 6, l = c.layer;
    const int chunk = item >> 2, h = item & 3, tok0 = chunk * 128;
    const bf16_t* P = c.ws<bf16_t>(WS_P);
    LAS char* Wt = c.lds;
    LAS char* vT = c.lds + 128 * SG_LD;
    __syncthreads();
    {
        const bf16_t* Wsrc = c.ws<bf16_t>(WS_WSG) + (size_t)(l * 4 + h) * 128 * 128;
#pragma unroll
        for (int i = 0; i < 4; ++i) { const int ci = tid + NTHREADS * i, r = ci >> 4, kc = ci & 15; *(LAS u32x4*)(Wt + r * SG_LD + kc * 16) = *(const u32x4*)(Wsrc + r * 128 + kc * 8); }
        const int j = tid >> 2, qt = tid & 3;
        const bf16_t* vp = P + (size_t)(tok0 + j) * INC + OFF_AV + 64 * h + 16 * qt;
#pragma unroll
        for (int q = 0; q < 2; ++q) { const u32x4 raw = *(const u32x4*)(vp + 8 * q);
#pragma unroll
            for (int e = 0; e < 4; ++e) { LAS char* d = vT + (16 * qt + 8 * q + 2 * e) * SG_LD + j * 2;
                *(LAS bf16_t*)d = (bf16_t)(raw[e] & 0xffffu); *(LAS bf16_t*)(d + SG_LD) = (bf16_t)(raw[e] >> 16); } }
    }
    __syncthreads();
    f32x4 acc[4];
#pragma unroll
    for (int a = 0; a < 4; ++a) acc[a] = (f32x4){0.f, 0.f, 0.f, 0.f};
    const int q = lane >> 4, li = lane & 15;
#pragma unroll
    for (int ks = 0; ks < 4; ++ks) {
        bf16x8 af[4];
#pragma unroll
        for (int df = 0; df < 4; ++df) af[df] = lds_r128(vT + (16 * df + li) * SG_LD + (4 * ks + q) * 16);
        const bf16x8 bfr = lds_r128(Wt + (16 * wave + li) * SG_LD + (4 * ks + q) * 16);
#pragma unroll
        for (int df = 0; df < 4; ++df) acc[df] = __builtin_amdgcn_mfma_f32_16x16x32_bf16(af[df], bfr, acc[df], 0, 0, 0);
    }
    bf16_t* Y = c.ws<bf16_t>(WS_ACT);
    {
        const int i = 16 * wave + li, tok = tok0 + i;
        const float bs = c.in(I_SGUB)[(l * 4 + h) * 128 + i];
#pragma unroll
        for (int df = 0; df < 4; ++df) {
            const int d0 = 16 * df + 4 * q;
            const u32x2 ur = *(const u32x2*)(P + (size_t)tok * INC + OFF_AU + 64 * h + d0);
            const f32x4 a = acc[df];
            *(u32x2*)(Y + (size_t)tok * 1024 + 64 * h + d0) = (u32x2){pk2(bflo(ur[0]) * (a[0] + bs), bfhi(ur[0]) * (a[1] + bs)), pk2(bflo(ur[1]) * (a[2] + bs), bfhi(ur[1]) * (a[3] + bs))};
        }
    }
}
DEV void phase_c(const Ctx& c) {
    const int l = c.layer;
    const bf16_t* P = c.ws<bf16_t>(WS_P);
    const float* cosD = c.ws<float>(WS_ROPED); const float* sinD = cosD + 2048 * 16;
    int it = c.bid;
    const bool lastl = (l == NL - 1);
    for (; it < C_SGU_ITEMS; it += c.nb) { if (!(lastl && (it >> 2) >= NLAT / 128)) phase_c_sgu(c, it); }
    for (; it < C_SGU_ITEMS + C_TQ; it += c.nb) {
        const int t = it - C_SGU_ITEMS, mt = t / 3, nt = t % 3, m0 = mt * 256;
        if (lastl && m0 >= NLAT) continue;
        GemmDesc g; g.rowidx = nullptr; g.nvalid = 0; g.ksplit = 1 << 30; g.lda = INC;
        g.A = P + OFF_DCQ; g.K = 256; g.B0 = c.ws<bf16_t>(WS_WQB) + (size_t)l * 384 * 256; g.B1 = g.B0; g.ldb = 256;
        gemm_tile<2, 4>(g, m0, nt * 128, c.lds, c.tid, [&](const f32x4 (&acc)[4][4], int mb, int nbase, int lane) {
            const int q = lane >> 4, li = lane & 15, wn = (nbase >> 6) & 1;
            const bool isctx = m0 >= NLAT;
            const float* qg = c.in(I_MLAQG) + l * 96;
            const float sc = D_SCALE * LOG2E;
#pragma unroll
            for (int mf = 0; mf < 4; ++mf) { const int m = m0 + mb + 16 * mf + li;
                int b, pos, key; bool ic; tok_info(m, b, pos, key, ic);
                const f32x4 s4 = *(const f32x4*)(c.ws<float>(WS_SSQ) + (size_t)m * 8);
                const float r0 = rsqrtf((s4[0] + s4[1] + s4[2] + s4[3]) * (1.f / 256.f) + EPS);
                if (nt < 2) {
                    const int h = 2 * nt + wn; float ss = 0.f;
#pragma unroll
                    for (int nf = 0; nf < 4; ++nf) { const f32x4 a = acc[nf][mf] * r0; ss += a[0] * a[0] + a[1] * a[1] + a[2] * a[2] + a[3] * a[3]; }
                    const float rr = rsqrtf(red_q(ss) * (1.f / 64.f) + EPS) * r0 * sc;
                    bf16_t* dst = c.ws<bf16_t>(WS_QD) + ((size_t)(b * 4 + h) * KEYS + key) * 96 + 4 * q;
#pragma unroll
                    for (int nf = 0; nf < 4; ++nf) { const f32x4 gg = *(const f32x4*)(qg + 16 * nf + 4 * q); const f32x4 a = acc[nf][mf];
                        *(u32x2*)(dst + 16 * nf) = (u32x2){pk2(a[0] * rr * gg[0], a[1] * rr * gg[1]), pk2(a[2] * rr * gg[2], a[3] * rr * gg[3])}; }
                } else {
#pragma unroll
                    for (int hh = 0; hh < 2; ++hh) { const int h = 2 * wn + hh; float ss = 0.f;
#pragma unroll
                        for (int n2 = 0; n2 < 2; ++n2) { const f32x4 a = acc[2 * hh + n2][mf] * r0; ss += a[0] * a[0] + a[1] * a[1] + a[2] * a[2] + a[3] * a[3]; }
                        const float rr = rsqrtf(red_q(ss) * (1.f / 32.f) + EPS) * r0;
                        bf16_t* dst = c.ws<bf16_t>(WS_QD) + ((size_t)(b * 4 + h) * KEYS + key) * 96 + 64 + 4 * q;
#pragma unroll
                        for (int n2 = 0; n2 < 2; ++n2) { const f32x4 gg = *(const f32x4*)(qg + 64 + 16 * n2 + 4 * q); const f32x4 a = acc[2 * hh + n2][mf];
                            float v0 = a[0] * rr * gg[0], v1 = a[1] * rr * gg[1], v2 = a[2] * rr * gg[2], v3 = a[3] * rr * gg[3];
                            if (!isctx) { const f32x2 cs = *(const f32x2*)(cosD + pos * 16 + 8 * n2 + 2 * q), sn = *(const f32x2*)(sinD + pos * 16 + 8 * n2 + 2 * q);
                                rope2(v0, v1, cs[0], sn[0]); rope2(v2, v3, cs[1], sn[1]); }
                            *(u32x2*)(dst + 16 * n2) = (u32x2){pk2(v0 * sc, v1 * sc), pk2(v2 * sc, v3 * sc)}; } }
                }
            }
        });
    }
    for (; it < C_SGU_ITEMS + C_TQ + C_TKV; it += c.nb) {
        const int t = it - C_SGU_ITEMS - C_TQ, mt = t >> 2, h = t & 3, m0 = mt * 256;
        GemmDesc g; g.rowidx = nullptr; g.nvalid = 0; g.ksplit = 1 << 30; g.lda = INC;
        g.A = P + OFF_DCKV; g.K = 128; g.B0 = c.ws<bf16_t>(WS_WKVB) + (size_t)l * 512 * 128; g.B1 = g.B0; g.ldb = 128;
        gemm_tile<2, 4>(g, m0, h * 128, c.lds, c.tid, [&](const f32x4 (&acc)[4][4], int mb, int nbase, int lane) {
            const int q = lane >> 4, li = lane & 15, wn = (nbase >> 6) & 1;
            const float* kg = c.in(I_MLAKG) + l * 96;
#pragma unroll
            for (int mf = 0; mf < 4; ++mf) { const int m = m0 + mb + 16 * mf + li;
                int b, pos, key; bool ic; tok_info(m, b, pos, key, ic);
                const float* sp = c.ws<float>(WS_SSQ) + (size_t)m * 8;
                const float r0 = rsqrtf((sp[4] + sp[5]) * (1.f / 128.f) + EPS);
                if (wn == 0) {
                    float ss = 0.f;
#pragma unroll
                    for (int nf = 0; nf < 4; ++nf) { const f32x4 a = acc[nf][mf] * r0; ss += a[0] * a[0] + a[1] * a[1] + a[2] * a[2] + a[3] * a[3]; }
                    const float rr = rsqrtf(red_q(ss) * (1.f / 64.f) + EPS) * r0;
                    bf16_t* dst = c.ws<bf16_t>(WS_KD) + ((size_t)(b * 4 + h) * KEYS + key) * 96 + 4 * q;
#pragma unroll
                    for (int nf = 0; nf < 4; ++nf) { const f32x4 gg = *(const f32x4*)(kg + 16 * nf + 4 * q); const f32x4 a = acc[nf][mf];
                        *(u32x2*)(dst + 16 * nf) = (u32x2){pk2(a[0] * rr * gg[0], a[1] * rr * gg[1]), pk2(a[2] * rr * gg[2], a[3] * rr * gg[3])}; }
                } else {
                    bf16_t* dst = c.ws<bf16_t>(WS_VDT) + ((size_t)(b * 4 + h) * 64 + 4 * q) * KEYS + key;
#pragma unroll
                    for (int nf = 0; nf < 4; ++nf) { const f32x4 a = acc[nf][mf] * r0; const unsigned p0 = pk2(a[0], a[1]), p1 = pk2(a[2], a[3]);
                        bf16_t* d = dst + (size_t)(16 * nf) * KEYS;
                        d[0] = (bf16_t)(p0 & 0xffffu); d[KEYS] = (bf16_t)(p0 >> 16); d[2 * KEYS] = (bf16_t)(p1 & 0xffffu); d[3 * KEYS] = (bf16_t)(p1 >> 16); }
                }
            }
        });
    }
}

constexpr int AT_KN = 0, AT_KR = 8192, AT_V = 12288, AT_STAGE = 21504, AT_VLD = 136;
constexpr int AT_CV = 2 * AT_STAGE;
template <int DK, bool CV>
DEV void attn_item(const Ctx& c, const bf16_t* Q, const bf16_t* K, const bf16_t* Vt, int nkeys, bf16_t* Yrow, LAS char* lds, int tid, float mref) {
    const int lane = tid & 63, wave = tid >> 6, l31 = lane & 31, h5 = lane >> 5;
    f32x4 cv0 = (f32x4){0.f, 0.f, 0.f, 0.f}, cv1 = cv0;
    auto cv_decode = [&](int j, const float*& W, bf16_t*& WT, int& Kd, int& Nd, int& kt, int& ntl, int& mode) {
        const int item = c.bid + 256 * j, l = c.layer;
        if (item < T_UP) { const int e = item / 128, q = item % 128; W = c.in(I_WUP) + ((size_t)l * 16 + e) * 1024 * 512; Kd = 1024; Nd = 512; WT = c.ws<bf16_t>(WS_WUP) + (size_t)e * 512 * 1024; kt = q / 8; ntl = q % 8; mode = 1; }
        else { const int r = item - T_UP, e = r / 64, q = r % 64; W = c.in(I_WDN) + ((size_t)l * 16 + e) * 256 * 1024; Kd = 256; Nd = 1024; WT = c.ws<bf16_t>(WS_WDN) + (size_t)e * 1024 * 256; kt = q / 16; ntl = q % 16; mode = 0; }
    };
    auto cv_load = [&](int j) { const float* W; bf16_t* WT; int Kd, Nd, kt, ntl, mode; cv_decode(j, W, WT, Kd, Nd, kt, ntl, mode);
        const float* src = W + (size_t)(kt * 64 + (tid >> 4)) * Nd + ntl * 64 + (tid & 15) * 4;
        cv0 = *(const f32x4*)src; cv1 = *(const f32x4*)(src + (size_t)32 * Nd); };
    auto cv_lds = [&]() { LAS float* scr = (LAS float*)(lds + AT_CV); const int n4 = (tid & 15) * 4, kr = tid >> 4;
#pragma unroll
        for (int e = 0; e < 4; ++e) { scr[kr * 65 + n4 + e] = cv0[e]; scr[(kr + 32) * 65 + n4 + e] = cv1[e]; } };
    auto cv_store = [&](int j) { const float* W; bf16_t* WT; int Kd, Nd, kt, ntl, mode; cv_decode(j, W, WT, Kd, Nd, kt, ntl, mode);
        LAS const float* scr = (LAS const float*)(lds + AT_CV);
        const int nl = tid >> 3, kcq = tid & 7, n = ntl * 64 + nl;
        int drow = n;
        if (mode == 1) { const int type = n >> 8, jj = n & 255; drow = 128 * (jj >> 6) + 64 * ((jj >> 5) & 1) + 16 * (((jj >> 4) & 1) + 2 * type) + (jj & 15); }
        unsigned o[4];
#pragma unroll
        for (int e = 0; e < 4; ++e) o[e] = pk2(scr[(kcq * 8 + 2 * e) * 65 + nl], scr[(kcq * 8 + 2 * e + 1) * 65 + nl]);
        *(u32x4*)(WT + (size_t)drow * Kd + kt * 64 + kcq * 8) = (u32x4){o[0], o[1], o[2], o[3]}; };
    constexpr int NS = DK / 16;
    bf16x8 qf[NS];
#pragma unroll
    for (int s = 0; s < NS; ++s) qf[s] = *(const bf16x8*)(Q + (size_t)(32 * wave + l31) * DK + 16 * s + 8 * h5);
    f32x16 oacc[2];
#pragma unroll
    for (int i = 0; i < 16; ++i) { oacc[0][i] = 0.f; oacc[1][i] = 0.f; }
    float lsum = 0.f;
    const int kr_ = tid >> 3, kc_ = tid & 7;
    const int rr_ = (tid >> 2) & 63, rc_ = tid & 3;
    u32x4 rk, rv, rrp;
    const int nt = nkeys / 64;
    auto gload = [&](int t) {
        const int k0 = t * 64;
        rk = *(const u32x4*)(K + (size_t)(k0 + kr_) * DK + kc_ * 8); rv = *(const u32x4*)(Vt + (size_t)kr_ * KEYS + k0 + kc_ * 8);
        if (DK == 96 && tid < 256) rrp = *(const u32x4*)(K + (size_t)(k0 + rr_) * DK + 64 + rc_ * 8);
    };
    auto lstore = [&](int st) {
        LAS char* base = lds + st * AT_STAGE;
        { const int r = kr_;
            *(LAS u32x4*)(base + AT_KN + r * 128 + ((kc_ ^ ((r >> 1) & 7)) << 4)) = rk;
            LAS char* vd = base + AT_V + r * AT_VLD + kc_ * 16;
            *(LAS u32x2*)vd = (u32x2){rv[0], rv[1]}; *(LAS u32x2*)(vd + 8) = (u32x2){rv[2], rv[3]}; }
        if (DK == 96 && tid < 256) *(LAS u32x4*)(base + AT_KR + rr_ * 64 + ((rc_ ^ ((rr_ >> 2) & 3)) << 4)) = rrp;
    };
    __syncthreads();
    gload(0); lstore(0);
    __syncthreads();
    int cvj = 0, cvp = 0;
    for (int t = 0; t < nt; ++t) {
        const int cur = t & 1;
        if (t + 1 < nt) gload(t + 1);
        if (CV && cvj < 12) { if (cvp == 0) cv_load(cvj); else if (cvp == 2) cv_store(cvj); }
        LAS const char* base = lds + cur * AT_STAGE;
        f32x16 sacc[2];
        {
            bf16x8 kf[2][NS];
#pragma unroll
            for (int kt2 = 0; kt2 < 2; ++kt2) {
                const int row = 32 * kt2 + l31;
#pragma unroll
                for (int s = 0; s < 4; ++s) kf[kt2][s] = lds_r128(base + AT_KN + row * 128 + (((2 * s + h5) ^ ((row >> 1) & 7)) << 4));
                if (DK == 96) {
#pragma unroll
                    for (int s = 0; s < 2; ++s) kf[kt2][4 + s] = lds_r128(base + AT_KR + row * 64 + (((2 * s + h5) ^ ((row >> 2) & 3)) << 4));
                }
            }
            __builtin_amdgcn_sched_barrier(0);
#pragma unroll
            for (int kt2 = 0; kt2 < 2; ++kt2) {
#pragma unroll
                for (int i = 0; i < 16; ++i) sacc[kt2][i] = -mref;
#pragma unroll
                for (int s = 0; s < NS; ++s) sacc[kt2] = __builtin_amdgcn_mfma_f32_32x32x16_bf16(kf[kt2][s], qf[s], sacc[kt2], 0, 0, 0);
            }
        }
        bf16x8 vf[2][2][2];
#pragma unroll
        for (int dt = 0; dt < 2; ++dt)
#pragma unroll
            for (int kt2 = 0; kt2 < 2; ++kt2)
#pragma unroll
                for (int s2 = 0; s2 < 2; ++s2) {
                    LAS const char* vp = base + AT_V + (32 * dt + l31) * AT_VLD + (32 * kt2 + 16 * s2 + 4 * h5) * 2;
                    const u32x2 lo = *(LAS const u32x2*)vp, hi = *(LAS const u32x2*)(vp + 16);
                    vf[dt][kt2][s2] = __builtin_bit_cast(bf16x8, (u32x4){lo[0], lo[1], hi[0], hi[1]});
                }
        __builtin_amdgcn_sched_barrier(0);
        float ps = 0.f;
#pragma unroll
        for (int kt2 = 0; kt2 < 2; ++kt2)
#pragma unroll
            for (int i = 0; i < 16; ++i) { const float p = __builtin_amdgcn_exp2f(sacc[kt2][i]); sacc[kt2][i] = p; ps += p; }
        lsum += ps;
        bf16x8 pf[2][2];
#pragma unroll
        for (int kt2 = 0; kt2 < 2; ++kt2)
#pragma unroll
            for (int s2 = 0; s2 < 2; ++s2) {
                u32x4 w;
#pragma unroll
                for (int j = 0; j < 4; ++j) w[j] = pk2(sacc[kt2][8 * s2 + 2 * j], sacc[kt2][8 * s2 + 2 * j + 1]);
                pf[kt2][s2] = __builtin_bit_cast(bf16x8, w);
            }
#pragma unroll
        for (int dt = 0; dt < 2; ++dt)
#pragma unroll
            for (int kt2 = 0; kt2 < 2; ++kt2)
#pragma unroll
                for (int s2 = 0; s2 < 2; ++s2) oacc[dt] = __builtin_amdgcn_mfma_f32_32x32x16_bf16(vf[dt][kt2][s2], pf[kt2][s2], oacc[dt], 0, 0, 0);
        if (CV && cvj < 12) { if (cvp == 1) cv_lds(); if (++cvp == 3) { cvp = 0; ++cvj; } }
        if (t + 1 < nt) lstore(cur ^ 1);
        __syncthreads();
    }
    const float ltot = lsum + xlane<32>(lsum), inv = 1.f / ltot;
    bf16_t* yr = Yrow + (size_t)(32 * wave + l31) * 1024;
#pragma unroll
    for (int dt = 0; dt < 2; ++dt)
#pragma unroll
        for (int g = 0; g < 4; ++g) {
            const int d0 = 32 * dt + 8 * g + 4 * h5;
            *(u32x2*)(yr + d0) = (u32x2){pk2(oacc[dt][4 * g] * inv, oacc[dt][4 * g + 1] * inv), pk2(oacc[dt][4 * g + 2] * inv, oacc[dt][4 * g + 3] * inv)};
        }
}
DEV void phase_d(const Ctx& c) {
    const int nlat = 512, nctx = (c.layer == NL - 1) ? 0 : 64;
    bf16_t* Y = c.ws<bf16_t>(WS_ACT);
    float mrefC, mrefD;
    {
        const int lane = c.tid & 63, l = c.layer;
        auto wmax = [](float v) { return wave_max(v); };
        const float gq = wmax(fabsf(c.in(I_GQAQG)[l * 64 + lane])), gk = wmax(fabsf(c.in(I_GQAKG)[l * 64 + lane]));
        mrefC = 64.f * gq * gk * C_SCALE * LOG2E - 40.f;
        const float* mq = c.in(I_MLAQG) + l * 96; const float* mk = c.in(I_MLAKG) + l * 96;
        const float qn = wmax(fabsf(mq[lane])), qr = wmax(fabsf(mq[64 + (lane & 31)])), kn = wmax(fabsf(mk[lane])), kr = wmax(fabsf(mk[64 + (lane & 31)]));
        mrefD = sqrtf((64.f * qn * qn + 32.f * qr * qr) * (64.f * kn * kn + 32.f * kr * kr)) * D_SCALE * LOG2E - 40.f;
    }
    for (int it = c.bid; it < nlat + nctx; it += c.nb) {
        int type, b, h, qpos0, nkeys, tok0;
        if (it < nlat) {
            type = it >> 8; const int r = it & 255, pr = 4 * (r & 7) + (r >> 6), qb = (r >> 3) & 7; b = pr >> 2; h = pr & 3; qpos0 = CL + 256 * qb; nkeys = KEYS; tok0 = b * SEQ + 256 * qb; }
        else { const int u = it - nlat; type = u >> 5; const int r = u & 31; b = r >> 2; h = r & 3; qpos0 = 0; nkeys = CL; tok0 = NLAT + b * CL; }
        if (type == 0) {
            const bf16_t* Qp = c.ws<bf16_t>(WS_QD) + ((size_t)(b * 4 + h) * KEYS + qpos0) * 96; const bf16_t* Kp = c.ws<bf16_t>(WS_KD) + (size_t)(b * 4 + h) * KEYS * 96;
            const bf16_t* Vp = c.ws<bf16_t>(WS_VDT) + (size_t)(b * 4 + h) * 64 * KEYS; bf16_t* Yp = Y + (size_t)tok0 * 1024 + 768 + 64 * h;
            if (it < 256 && c.nb == 256) attn_item<96, true>(c, Qp, Kp, Vp, nkeys, Yp, c.lds, c.tid, mrefD);
            else attn_item<96, false>(c, Qp, Kp, Vp, nkeys, Yp, c.lds, c.tid, mrefD);
        } else {
            attn_item<64, false>(c, c.ws<bf16_t>(WS_QC) + ((size_t)(b * 4 + h) * KEYS + qpos0) * 64, c.ws<bf16_t>(WS_KC) + (size_t)(b * 2 + (h >> 1)) * KEYS * 64,
                          c.ws<bf16_t>(WS_VCT) + (size_t)(b * 2 + (h >> 1)) * 64 * KEYS, nkeys, Y + (size_t)tok0 * 1024 + 512 + 64 * h, c.lds, c.tid, mrefC);
        }
    }
}

DEV void phase_e0(const Ctx& c) {
    const int tid = c.tid, lane = tid & 63, wave = tid >> 6, l = c.layer;
    bf16_t* Y = c.ws<bf16_t>(WS_ACT); const bf16_t* P = c.ws<bf16_t>(WS_P);
    const float* gg = c.in(I_GGO) + l * 1024;
    const int ntok = c.ntok_tail();
    const int ch = 4 * lane;
    const float* cw = c.in(I_CONVW) + l * 768 + ch;
    const f32x4 w0 = *(const f32x4*)cw, w1 = *(const f32x4*)(cw + 256), w2 = *(const f32x4*)(cw + 512);
    f32x4 gn[4];
#pragma unroll
    for (int g = 0; g < 4; ++g) gn[g] = *(const f32x4*)(gg + g * 256 + ch);
    const int nwv = c.nb * NW, per = (ntok + nwv - 1) / nwv, tbeg = (c.bid * NW + wave) * per, tend = min(tbeg + per, ntok);
#pragma unroll 1
    for (int t0 = tbeg; t0 < tend; t0 += 2) {
        u32x2 ya[2], yc[2], yd[2], rbb[2], c0[2], x0[2], c1[2], x1[2], c2[2], x2[2]; float mp[2], mn[2];
#pragma unroll
        for (int u = 0; u < 2; ++u) { const int tok = min(t0 + u, tend - 1);
            int b, pos, key; bool isctx; tok_info(tok, b, pos, key, isctx);
            const int seqlen = isctx ? CL : SEQ;
            const bf16_t* pr = P + (size_t)tok * INC; const bf16_t* yr = Y + (size_t)tok * 1024;
            ya[u] = *(const u32x2*)(yr + ch); yc[u] = *(const u32x2*)(yr + 512 + ch); yd[u] = *(const u32x2*)(yr + 768 + ch);
            rbb[u] = *(const u32x2*)(pr + OFF_BB + ch);
            const bool okp = pos > 0, okn = pos < seqlen - 1;
            c0[u] = *(const u32x2*)(pr - (okp ? INC : 0) + OFF_BC + ch); x0[u] = *(const u32x2*)(pr - (okp ? INC : 0) + OFF_BX + ch);
            c1[u] = *(const u32x2*)(pr + OFF_BC + ch); x1[u] = *(const u32x2*)(pr + OFF_BX + ch);
            c2[u] = *(const u32x2*)(pr + (okn ? INC : 0) + OFF_BC + ch); x2[u] = *(const u32x2*)(pr + (okn ? INC : 0) + OFF_BX + ch);
            mp[u] = okp ? 1.f : 0.f; mn[u] = okn ? 1.f : 0.f; }
#pragma unroll
        for (int u = 0; u < 2; ++u) { const int tok = t0 + u;
            if (tok < tend) {
                bf16_t* yr = Y + (size_t)tok * 1024;
                float v[4][4];
                v[0][0] = bflo(ya[u][0]); v[0][1] = bfhi(ya[u][0]); v[0][2] = bflo(ya[u][1]); v[0][3] = bfhi(ya[u][1]);
                v[2][0] = bflo(yc[u][0]); v[2][1] = bfhi(yc[u][0]); v[2][2] = bflo(yc[u][1]); v[2][3] = bfhi(yc[u][1]);
                v[3][0] = bflo(yd[u][0]); v[3][1] = bfhi(yd[u][0]); v[3][2] = bflo(yd[u][1]); v[3][3] = bfhi(yd[u][1]);
                {
                    const float zp[4] = {mp[u] * bflo(c0[u][0]) * bflo(x0[u][0]), mp[u] * bfhi(c0[u][0]) * bfhi(x0[u][0]), mp[u] * bflo(c0[u][1]) * bflo(x0[u][1]), mp[u] * bfhi(c0[u][1]) * bfhi(x0[u][1])};
                    const float zc[4] = {bflo(c1[u][0]) * bflo(x1[u][0]), bfhi(c1[u][0]) * bfhi(x1[u][0]), bflo(c1[u][1]) * bflo(x1[u][1]), bfhi(c1[u][1]) * bfhi(x1[u][1])};
                    const float zn[4] = {mn[u] * bflo(c2[u][0]) * bflo(x2[u][0]), mn[u] * bfhi(c2[u][0]) * bfhi(x2[u][0]), mn[u] * bflo(c2[u][1]) * bflo(x2[u][1]), mn[u] * bfhi(c2[u][1]) * bfhi(x2[u][1])};
                    const float bb[4] = {bflo(rbb[u][0]), bfhi(rbb[u][0]), bflo(rbb[u][1]), bfhi(rbb[u][1])};
#pragma unroll
                    for (int j = 0; j < 4; ++j) v[1][j] = bb[j] * (w0[j] * zp[j] + w1[j] * zc[j] + w2[j] * zn[j]);
                }
                float ss[4];
#pragma unroll
                for (int g = 0; g < 4; ++g) ss[g] = v[g][0] * v[g][0] + v[g][1] * v[g][1] + v[g][2] * v[g][2] + v[g][3] * v[g][3];
#pragma unroll
                for (int g = 0; g < 4; ++g) ss[g] = wave_sum(ss[g]);
#pragma unroll
                for (int g = 0; g < 4; ++g) { const float r = rsqrtf(ss[g] * (1.f / 256.f) + EPS);
                    *(u32x2*)(yr + g * 256 + ch) = (u32x2){pk2(v[g][0] * r * gn[g][0], v[g][1] * r * gn[g][1]), pk2(v[g][2] * r * gn[g][2], v[g][3] * r * gn[g][3])}; }
            } }
    }
}
DEV void e_store_row4(const Ctx& c, int m, int n, const f32x4& a) {
    const float* gate = c.modv(m < NLAT ? (m >> 11) : 8, 2);
    const f32x4 gt = *(const f32x4*)(gate + n), xv = c.xload4(m, n);
    c.xsstore4(m, n, xv[0] + gt[0] * a[0], xv[1] + gt[1] * a[1], xv[2] + gt[2] * a[2], xv[3] + gt[3] * a[3]);
}
DEV void phase_e(const Ctx& c) {
    GemmDesc g; g.A = c.ws<bf16_t>(WS_ACT); g.lda = 1024; g.rowidx = nullptr; g.nvalid = 0;
    g.B0 = c.ws<bf16_t>(WS_WOUT) + (size_t)c.layer * 1024 * 1024; g.B1 = g.B0; g.ldb = 1024; g.ksplit = 1 << 30; g.K = 1024;
    const int nfull = (NLAT / 256) * 4, nhalf = (c.layer == NL - 1) ? 0 : (NCTX / 256) * 8;
    for (int t = c.bid; t < nfull + nhalf; t += c.nb) {
        if (t < nfull) { const int m0 = (t >> 2) * 256, n0 = (t & 3) * 256;
            gemm_tile8p(g, m0, n0, c.lds, c.tid, [&](const f32x4 (&acc)[2][2][4][2], int wr, int wc, int lane) {
                const float* gate = c.modv(m0 >> 11, 2) + n0 + 64 * wc + 4 * (lane >> 4);
                f32x4 gt[2][2];
#pragma unroll
                for (int bj = 0; bj < 2; ++bj)
#pragma unroll
                    for (int n = 0; n < 2; ++n) gt[bj][n] = *(const f32x4*)(gate + 32 * bj + 16 * n);
#pragma unroll
                for (int ai = 0; ai < 2; ++ai)
#pragma unroll
                    for (int m = 0; m < 4; ++m) { const int row = m0 + 128 * ai + 64 * wr + 16 * m + (lane & 15);
#pragma unroll
                        for (int bj = 0; bj < 2; ++bj)
#pragma unroll
                            for (int n = 0; n < 2; ++n) { const int col = n0 + 64 * wc + 32 * bj + 16 * n + 4 * (lane >> 4); const f32x4 xv = c.xload4(row, col), a = acc[ai][bj][m][n], gg = gt[bj][n];
                                c.xsstore4(row, col, xv[0] + gg[0] * a[0], xv[1] + gg[1] * a[1], xv[2] + gg[2] * a[2], xv[3] + gg[3] * a[3]); } }
            });
            publish_rel(c, c.ws<unsigned>(WS_RDYE) + (c.layer * 128 + (t >> 2)) * 16, 2u); }
        else { const int u = t - nfull, m0 = NLAT + (u >> 3) * 256;
            gemm_tile<2, 4>(g, m0, (u & 7) * 128, c.lds, c.tid, [&](const f32x4 (&acc)[4][4], int mb, int nbase, int lane) {
#pragma unroll
                for (int mf = 0; mf < 4; ++mf)
#pragma unroll
                    for (int nf = 0; nf < 4; ++nf) { const int p = nbase + 16 * nf + 4 * (lane >> 4);
                        e_store_row4(c, m0 + mb + 16 * mf + (lane & 15), (p & ~255) | (((p >> 5) & 3) << 6) | (((p >> 7) & 1) << 5) | (p & 31), acc[nf][mf]); }
            });
            publish_rel(c, c.ws<unsigned>(WS_RDYE) + (c.layer * 128 + NLAT / 256 + (u >> 3)) * 16, 1u); }
    }
}

DEV void phase_f_item(const Ctx& c, int nseg, int sbase, int sstride) {
    const int tid = c.tid, lane = tid & 63, wave = tid >> 6, l = c.layer, li = lane & 15, q = lane >> 4;
    LAS float* part = (LAS float*)c.lds;
    LAS float* rs = part + 8 * 96 * 32;
    LAS int* hist = (LAS int*)(rs + 96);
    LAS int* hbase = hist + 32;
    int* cnt = c.ws<int>(WS_CNT) + l * NBUCKET * 32;
    int* ltok = c.ws<int>(WS_LTOK); float* lw = c.ws<float>(WS_LW);
    bf16_t* H = c.ws<bf16_t>(WS_ACT);
    __syncthreads();
    if (tid < 32) hist[tid] = 0;
#pragma unroll 1
    for (int sg = 0; sg < nseg; ++sg) wait_ready(c, c.ws<unsigned>(WS_RDYE) + (l * 128 + ((sbase + sstride * sg) >> 3)) * 16, 8u);
    __syncthreads();
#pragma unroll 1
    for (int sg = 0; sg < nseg; ++sg) {
        const int tokb = 32 * (sbase + sstride * sg), mb = tokb < NLAT ? (tokb >> 11) : 8;
        f32x4 acc[2][2];
#pragma unroll
        for (int a = 0; a < 2; ++a)
#pragma unroll
            for (int b = 0; b < 2; ++b) acc[a][b] = (f32x4){0.f, 0.f, 0.f, 0.f};
        const bf16_t* xrow = c.xs(tokb + li) + 128 * wave + 8 * q;
        const bf16_t* wrow = c.ws<bf16_t>(WS_RW) + (size_t)(l * 9 + mb) * 2 * 32 * 1024 + (size_t)li * 1024 + 128 * wave + 8 * q;
#pragma unroll
        for (int ks = 0; ks < 4; ++ks) {
            bf16x8 xf[2], wf[2][2];
#pragma unroll
            for (int hl = 0; hl < 2; ++hl)
#pragma unroll
                for (int nf = 0; nf < 2; ++nf) wf[hl][nf] = *(const bf16x8*)(wrow + (size_t)(hl * 32 + nf * 16) * 1024 + 32 * ks);
#pragma unroll
            for (int mf = 0; mf < 2; ++mf) xf[mf] = *(const bf16x8*)(xrow + (size_t)mf * 16 * DM + 32 * ks);
#pragma unroll
            for (int mf = 0; mf < 2; ++mf)
#pragma unroll
                for (int hl = 0; hl < 2; ++hl)
#pragma unroll
                    for (int nf = 0; nf < 2; ++nf) acc[nf][mf] = __builtin_amdgcn_mfma_f32_16x16x32_bf16(wf[hl][nf], xf[mf], acc[nf][mf], 0, 0, 0);
        }
#pragma unroll
        for (int mf = 0; mf < 2; ++mf)
#pragma unroll
            for (int nf = 0; nf < 2; ++nf) *(LAS f32x4*)(part + ((wave * 96 + 32 * sg + 16 * mf + li) * 32 + 16 * nf + 4 * q)) = acc[nf][mf];
    }
#pragma unroll 1
    for (int sg = 0; sg < nseg; ++sg) {
        const int tokb = 32 * (sbase + sstride * sg), mb = tokb < NLAT ? (tokb >> 11) : 8;
        u32x4 r0[4], r1[4];
#pragma unroll
        for (int u = 0; u < 4; ++u) { const bf16_t* xr = c.xs(tokb + 4 * wave + u); r0[u] = *(const u32x4*)(xr + 8 * lane); r1[u] = *(const u32x4*)(xr + 512 + 8 * lane); }
        f32x4 g0[2], g1[2], s0[2], s1[2];
        { const float* gmv = c.ws<float>(WS_GM) + (size_t)(l * 9 + mb) * 1024; const float* sh = c.modv(mb, 3);
#pragma unroll
          for (int hf = 0; hf < 2; ++hf) { const int e = 512 * hf + 8 * lane; g0[hf] = *(const f32x4*)(gmv + e); g1[hf] = *(const f32x4*)(gmv + e + 4); s0[hf] = *(const f32x4*)(sh + e); s1[hf] = *(const f32x4*)(sh + e + 4); } }
#pragma unroll
        for (int u = 0; u < 4; ++u) { const int t = 32 * sg + 4 * wave + u, tok = tokb + 4 * wave + u;
            float v[16];
#pragma unroll
            for (int j = 0; j < 4; ++j) { v[2 * j] = bflo(r0[u][j]); v[2 * j + 1] = bfhi(r0[u][j]); v[8 + 2 * j] = bflo(r1[u][j]); v[8 + 2 * j + 1] = bfhi(r1[u][j]); }
            float ss = 0.f;
#pragma unroll
            for (int j = 0; j < 16; ++j) ss += v[j] * v[j];
            const float rr = rsqrtf(wave_sum(ss) * (1.f / 1024.f) + EPS);
            if (lane == 0) rs[t] = rr;
#pragma unroll
            for (int hf = 0; hf < 2; ++hf) { const int e = 512 * hf + 8 * lane;
                const float* vv = v + 8 * hf;
                *(u32x4*)(H + (size_t)tok * 1024 + e) = (u32x4){pk2(vv[0] * rr * g0[hf][0] + s0[hf][0], vv[1] * rr * g0[hf][1] + s0[hf][1]), pk2(vv[2] * rr * g0[hf][2] + s0[hf][2], vv[3] * rr * g0[hf][3] + s0[hf][3]),
                                                                  pk2(vv[4] * rr * g1[hf][0] + s1[hf][0], vv[5] * rr * g1[hf][1] + s1[hf][1]), pk2(vv[6] * rr * g1[hf][2] + s1[hf][2], vv[7] * rr * g1[hf][3] + s1[hf][3])}; }
        }
    }
    __syncthreads();
    int bucket = 0, rank = 0, mytok = 0; float wa = 0.f, wb = 0.f;
    if (tid < 32 * nseg) {
        const int t = tid, tok = 32 * (sbase + sstride * (t >> 5)) + (t & 31), mb = tok < NLAT ? (tok >> 11) : 8;
        mytok = tok;
        float s[20];
#pragma unroll
        for (int j = 0; j < 20; ++j) { float a = 0.f;
#pragma unroll
            for (int w = 0; w < NW; ++w) a += part[(w * 96 + t) * 32 + j];
            s[j] = a; }
            const float* RC = c.ws<float>(WS_RC) + (l * 9 + mb) * 32;
        const float r = rs[t];
        float gl[4], el[4];
#pragma unroll
        for (int j = 0; j < 4; ++j) gl[j] = r * s[j] + RC[j];
        int gi = 0; float gmx = gl[0];
#pragma unroll
        for (int j = 1; j < 4; ++j) if (gl[j] > gmx) { gmx = gl[j]; gi = j; }
        float gs = 0.f;
#pragma unroll
        for (int j = 0; j < 4; ++j) gs += __expf(gl[j] - gmx);
        const float gw = 1.f / gs;
#pragma unroll
        for (int j = 0; j < 4; ++j) { const float sj = gi == 0 ? s[4 + j] : (gi == 1 ? s[8 + j] : (gi == 2 ? s[12 + j] : s[16 + j])); el[j] = r * sj + RC[4 + 4 * gi + j]; }
        int e1 = 0; float m1 = el[0];
#pragma unroll
        for (int j = 1; j < 4; ++j) if (el[j] > m1) { m1 = el[j]; e1 = j; }
        int e2 = -1; float m2 = -3.0e38f;
#pragma unroll
        for (int j = 0; j < 4; ++j) if (j != e1 && el[j] > m2) { m2 = el[j]; e2 = j; }
        const float p2 = __expf(m2 - m1), w1 = gw / (1.f + p2), w2 = gw * p2 / (1.f + p2);
        const int ea = e1 < e2 ? e1 : e2, eb = e1 < e2 ? e2 : e1; wa = e1 < e2 ? w1 : w2; wb = e1 < e2 ? w2 : w1;
        const int pidx = ea == 0 ? eb - 1 : (ea == 1 ? eb + 1 : 5);
        bucket = gi * 6 + pidx;
        rank = __hip_atomic_fetch_add(hist + bucket, 1, __ATOMIC_RELAXED, __HIP_MEMORY_SCOPE_WORKGROUP);
    }
    __syncthreads();
    if (tid < NBUCKET) { const int n = hist[tid]; hbase[tid] = n > 0 ? atomicAdd(&cnt[tid * 32], n) : 0; }
    __syncthreads();
    if (tid < 32 * nseg) {
        const int pos = hbase[bucket] + rank;
        ltok[bucket * NTOK + pos] = mytok;
        lw[((size_t)bucket * NTOK + pos) * 2] = wa; lw[((size_t)bucket * NTOK + pos) * 2 + 1] = wb;
    }
}
DEV void phase_f(const Ctx& c) {
    if (c.nb == 256) {
        if (c.layer == NL - 1) phase_f_item(c, 2, 2 * c.bid, 1);
        else if (c.bid < 64) phase_f_item(c, 1, NLAT / 32 + c.bid, 0);
        else { const int k = c.bid - 64; phase_f_item(c, k < 128 ? 3 : 2, k, 192); }
    } else {
        for (int sgi = c.bid; sgi < c.ntok_tail() / 32; sgi += c.nb) phase_f_item(c, 1, sgi, 0);
    }
}

DEV void moe_find(const int* cnt, int mg, int& bucket, int& mt, int& total) {
    int acc = 0; bucket = -1; mt = 0;
    for (int b = 0; b < NBUCKET; ++b) { const int n = (cnt[b * 32] + 255) >> 8; if (bucket < 0 && mg < acc + n) { bucket = b; mt = mg - acc; } acc += n; }
    total = acc;
}
DEV void pair_of(int pidx, int& ea, int& eb) { ea = pidx < 3 ? 0 : (pidx < 5 ? 1 : 2); eb = pidx < 3 ? pidx + 1 : (pidx < 5 ? pidx - 1 : 3); }
template <int WN_, int MF>
DEV void g_tile(const Ctx& c, const int* cnt, int mg, int nt8) {
    const int l = c.layer; (void)l;
    int bucket, mt, tt; moe_find(cnt, mg, bucket, mt, tt);
    int ea, eb; pair_of(bucket % 6, ea, eb); const int grp = bucket / 6;
    const int e = grp * 4 + ((nt8 < 4) ? ea : eb);
    const int nvalid = min(256, cnt[bucket * 32] - mt * 256);
    const int* rows = c.ws<int>(WS_LTOK) + bucket * NTOK + mt * 256;
    const float* wts = c.ws<float>(WS_LW) + ((size_t)bucket * NTOK + mt * 256) * 2 + ((nt8 < 4) ? 0 : 1);
    bf16_t* HB = c.ws<bf16_t>(WS_HBUF);
    GemmDesc g; g.A = c.ws<bf16_t>(WS_ACT); g.lda = 1024; g.rowidx = rows; g.nvalid = nvalid;
    g.B0 = c.ws<bf16_t>(WS_WUP) + (size_t)e * 512 * 1024; g.B1 = g.B0; g.ldb = 1024; g.ksplit = 1 << 30; g.K = 1024;
    const int hcol0 = (nt8 >> 2) * 256 + (nt8 & 3) * 64;
    gemm_tile<WN_, MF>(g, 0, (nt8 & 3) * 128, c.lds, c.tid, [&](const f32x4 (&acc)[4][MF], int mb, int nbase, int lane) {
        const int slot = ((nbase - (nt8 & 3) * 128) >> 6);
#pragma unroll
        for (int mf = 0; mf < MF; ++mf) { const int r = mb + 16 * mf + (lane & 15); const bool ok = r < nvalid; const float w = ok ? wts[2 * r] : 0.f;
#pragma unroll
            for (int f = 0; f < 2; ++f) { const f32x4 gt = acc[f][mf], up = acc[f + 2][mf]; float o[4];
#pragma unroll
                for (int j = 0; j < 4; ++j) o[j] = ok ? silu_f(gt[j]) * up[j] * w : 0.f;
                __hip_atomic_store((GAS unsigned long long*)(HB + ((size_t)mg * 256 + r) * 512 + hcol0 + 32 * slot + 16 * f + 4 * (lane >> 4)),
                                   (unsigned long long)pk2(o[0], o[1]) | ((unsigned long long)pk2(o[2], o[3]) << 32), __ATOMIC_RELAXED, __HIP_MEMORY_SCOPE_AGENT); } }
    });
    asm volatile("s_waitcnt vmcnt(0)" ::: "memory");
    __syncthreads();
    if (c.tid == 0) (void)xb_add(c.ws<unsigned>(WS_RDY) + (c.layer * 128 + mg) * 16, WN_ == 4 ? 2u : 1u);
}
template <int WN_, int MF>
DEV void h_tile(const Ctx& c, const int* cnt, int mg, int nt8) {
    const int l = c.layer;
    int bucket, mt, tt; moe_find(cnt, mg, bucket, mt, tt);
    int ea, eb; pair_of(bucket % 6, ea, eb); const int grp = bucket / 6;
    const int nvalid = min(256, cnt[bucket * 32] - mt * 256);
    const int* rows = c.ws<int>(WS_LTOK) + bucket * NTOK + mt * 256;
    GemmDesc g; g.A = c.ws<bf16_t>(WS_HBUF); g.lda = 512; g.rowidx = nullptr; g.nvalid = 0;
    g.B0 = c.ws<bf16_t>(WS_WDN) + (size_t)(grp * 4 + ea) * 1024 * 256; g.B1 = c.ws<bf16_t>(WS_WDN) + (size_t)(grp * 4 + eb) * 1024 * 256; g.ldb = 256; g.ksplit = 256; g.K = 512;
    if (c.tid < 64) {
        unsigned* rdy = c.ws<unsigned>(WS_RDY) + (c.layer * 128 + mg) * 16; unsigned* bar = c.ws<unsigned>(WS_BAR);
        { unsigned sp_ = 0; while (xb_ld(rdy) < 8u) { __builtin_amdgcn_s_sleep(2); if ((++sp_ & 1023u) == 0u) { if (xb_ld(&bar[XB_TMO])) break; if (sp_ > (1u << 24)) { atomicAdd(&bar[XB_TMO], 1u); break; } } } }
        __builtin_amdgcn_fence(__ATOMIC_ACQUIRE, "agent");
    }
    gemm_tile<WN_, MF>(g, mg * 256, nt8 * 128, c.lds, c.tid, [&](const f32x4 (&acc)[4][MF], int mb, int nbase, int lane) {
#pragma unroll
        for (int mf = 0; mf < MF; ++mf) { const int r = mb + 16 * mf + (lane & 15);
            if (r < nvalid) { const int tok = rows[r]; const int mbi = tok < NLAT ? (tok >> 11) : 8; const float* gate = c.modv(mbi, 5);
#pragma unroll
                for (int nf = 0; nf < 4; ++nf) { const int n = nbase + 16 * nf + 4 * (lane >> 4); const f32x4 gt = *(const f32x4*)(gate + n), xv = c.xsload4(tok, n), a = acc[nf][mf];
                    const float o0 = xv[0] + gt[0] * a[0], o1 = xv[1] + gt[1] * a[1], o2 = xv[2] + gt[2] * a[2], o3 = xv[3] + gt[3] * a[3];
                    if (l == NL - 1) *(f32x4*)(c.p->out + (size_t)tok * DM + n) = (f32x4){o0, o1, o2, o3};
                    else c.xsstore4(tok, n, o0, o1, o2, o3); } } }
    });
}
DEV void phase_g(const Ctx& c) {
    const int* cnt = c.ws<int>(WS_CNT) + c.layer * NBUCKET * 32;
    int total = 0; { int b, m; moe_find(cnt, 0, b, m, total); }
    const int U = total * 4, Ufull = (U / c.nb) * c.nb, R = U - Ufull;
    for (int u = c.bid; u < Ufull; u += c.nb) g_tile<4, 8>(c, cnt, u >> 2, 2 * (u & 3));
    for (int t = c.bid; t < 2 * R; t += c.nb) { const int u = Ufull + (t >> 1); g_tile<2, 4>(c, cnt, u >> 2, 2 * (u & 3) + (t & 1)); }
}
DEV void phase_h(const Ctx& c) {
    const int* cnt = c.ws<int>(WS_CNT) + c.layer * NBUCKET * 32;
    int total = 0; { int b, m; moe_find(cnt, 0, b, m, total); }
    const int U = __builtin_amdgcn_readfirstlane(total * 4), R = U - (U / c.nb) * c.nb;
    int base = 0;
#pragma unroll 1
    for (int s = 0; base < U; ++s) {
        const int thr = s == 0 ? min(2 * R, c.nb) : (s == 1 ? max(0, 2 * R - c.nb) : 0), nw = c.nb - thr, rem = U - base, k = c.bid - thr;
        if (k >= 0) {
            if (rem < nw && 2 * rem <= nw) { if (k < 2 * rem) { const int j = base + (k >> 1); h_tile<2, 4>(c, cnt, j >> 2, 2 * (j & 3) + (k & 1)); } }
            else if (k < rem) { const int j = base + k; h_tile<4, 8>(c, cnt, j >> 2, 2 * (j & 3)); }
        }
        base += nw;
    }
}

constexpr int PH_P0 = 0, PH_A = 1, PH_B = 2, PH_C = 3, PH_D = 4, PH_E0 = 5, PH_E = 6, PH_G = 7, PH_PER_LAYER = 7;
DEV void run_phase(const Ctx& c, int ph) {
    switch (ph) {
        case PH_P0: phase_p0(c); break;
        case PH_A: phase_a(c); break;
        case PH_B: phase_b(c); break;
        case PH_C: phase_c(c); break;
        case PH_D: phase_d(c); break;
        case PH_E0: phase_e0(c); break;
        case PH_E: phase_e(c); phase_f(c); break;
        case PH_G: phase_g(c); phase_h(c); break;
    }
}

extern __shared__ __attribute__((aligned(16))) char smem_dyn[];

struct XcdBarrier { unsigned* bar; unsigned x; volatile LAS unsigned* st; };
DEV XcdBarrier xcd_barrier_post(unsigned* bar, volatile LAS unsigned* st) {
    XcdBarrier b; b.bar = bar; b.x = xb_xcc_id(); b.st = st;
    if (threadIdx.x == 0) (void)xb_add(&bar[XB_XCNT(b.x)], 1u);
    return b;
}
DEV void xcd_barrier_complete(unsigned* bar, unsigned x, unsigned& nloc, unsigned& nx) {
    const unsigned G = gridDim.x * gridDim.y * gridDim.z;
    unsigned sum, cnt, mine, sp = 0u;
    for (;;) {
        sum = 0u; cnt = 0u; mine = 0u;
#pragma unroll
        for (unsigned j = 0; j < 16; ++j) { const unsigned c = xb_ld(&bar[XB_XCNT(j)]); sum += c; cnt += (c > 0u) ? 1u : 0u; mine = (j == x) ? c : mine; }
        if (sum == G) break;
        __builtin_amdgcn_s_sleep(1);
        if ((++sp & 255u) == 0u) { if (xb_ld(&bar[XB_TMO])) break; if (sp > XB_SPIN_CAP) { atomicAdd(&bar[XB_TMO], 1u); break; } }
    }
    nloc = mine > 0u ? mine : 1u; nx = cnt > 0u ? cnt : 1u;
}
DEV void xcd_barrier(const XcdBarrier& b) {
    asm volatile("s_waitcnt vmcnt(0)" ::: "memory");
    __syncthreads();
    if (threadIdx.x == 0) {
        unsigned* bar = b.bar;
        __builtin_amdgcn_s_waitcnt(0);
        unsigned nloc = b.st[0], nx = b.st[1];
        if (nloc == 0u) { xcd_barrier_complete(bar, b.x, nloc, nx); b.st[0] = nloc; b.st[1] = nx; }
        const unsigned old = xb_add(&bar[XB_XSUB(b.x)], 1u);
        const unsigned gen = old / nloc;
        if (old + 1u == (gen + 1u) * nloc) {
            __builtin_amdgcn_fence(__ATOMIC_RELEASE, "agent");
            asm volatile("s_waitcnt vmcnt(0)" ::: "memory");
            const unsigned og = xb_add(&bar[XB_TOP], 1u);
            const unsigned tg = og / nx;
            if (og + 1u == (tg + 1u) * nx) xb_add(&bar[XB_TOPGEN], 1u);
            else XB_SPIN(xb_ld(&bar[XB_TOPGEN]) == tg, bar);
            __builtin_amdgcn_fence(__ATOMIC_ACQUIRE, "agent");
            xb_add(&bar[XB_XGEN(b.x)], 1u);
            asm volatile("s_waitcnt vmcnt(0)" ::: "memory");
        } else {
            XB_SPIN(xb_ld(&bar[XB_XGEN(b.x)]) == gen, bar);
            __builtin_amdgcn_fence(__ATOMIC_ACQUIRE, "agent");
            asm volatile("s_waitcnt vmcnt(0)" ::: "memory");
        }
    }
    __syncthreads();
}
static_assert(XCD_BAR_WORDS * 4 <= 16384, "barrier words");


#if !MODE_SINGLE
__global__ void __launch_bounds__(NTHREADS, 2) k_phase(Params p, int layer, int ph) {
    Ctx c; c.p = (ParamsPtr)__builtin_amdgcn_kernarg_segment_ptr(); c.layer = layer; c.bid = blockIdx.x; c.nb = gridDim.x; c.tid = threadIdx.x; c.lds = (LAS char*)smem_dyn;
    run_phase(c, ph);
}


#endif
__global__ void __launch_bounds__(NTHREADS, 2) k_mega(Params p) {
    ParamsPtr pp = (ParamsPtr)__builtin_amdgcn_kernarg_segment_ptr();
    const int wave_id = __builtin_amdgcn_readfirstlane(threadIdx.x >> 6);
    Ctx c; c.p = pp; c.layer = 0; c.bid = blockIdx.x; c.nb = gridDim.x; c.tid = threadIdx.x; c.lds = (LAS char*)smem_dyn;
    volatile LAS unsigned* st = (volatile LAS unsigned*)(c.lds + LDS_BAR);
    if (threadIdx.x == 0) { st[0] = 0u; st[1] = 0u; st[2] = 0u; st[3] = 0u; }
    __syncthreads();
    XcdBarrier xb = xcd_barrier_post((unsigned*)(pp->ws + WS_BAR), st);
    unsigned long long t_prev = 0; float tacc1 = 0.f, tacc2 = 0.f;
#pragma unroll 1
    for (int step = 0; step <= 1 + NL * PH_PER_LAYER; ++step) {
        if (step) { xcd_barrier(xb); if (EXP_BAR2) xcd_barrier(xb); }
        if (PROBE_P1 >= -1) {
            const unsigned long long now = __builtin_amdgcn_s_memrealtime();
            if (step) { const int php = step > 1 ? 1 + (step - 2) % PH_PER_LAYER : 0; const float us = (float)(now - t_prev) * 0.01f;
                if (php == PROBE_P1) tacc1 += us; if (php == PROBE_P2) tacc2 += us; }
            t_prev = now;
        }
        if (step == 1 + NL * PH_PER_LAYER) break;
        { ParamsPtr q = pp; int w_ = wave_id, b_ = blockIdx.x, n_ = gridDim.x; asm volatile("" : "+s"(q), "+s"(w_), "+s"(b_), "+s"(n_));
          unsigned m_ = ~0u; asm volatile("" : "+s"(m_));
          int t_ = w_ * 64 + (int)__builtin_amdgcn_mbcnt_hi(m_, __builtin_amdgcn_mbcnt_lo(m_, 0u)); asm volatile("" : "+v"(t_)); c.p = q; c.tid = t_; c.bid = b_; c.nb = n_; }
        c.layer = step ? (step - 1) / PH_PER_LAYER : 0;
        const int ph = step ? 1 + (step - 1) % PH_PER_LAYER : 0;
        run_phase(c, ph);
        if (EXP_REP >= 0 && ph == EXP_REP && (EXP_REP != PH_E || c.layer == 0)) {
            xcd_barrier(xb); run_phase(c, ph); }
    }
    if (PROBE_P1 >= -1) {
        float* t2 = (float*)(pp->ws + WS_DBG);
        if (c.bid == 0 && c.tid == 0) { t2[0] = PROBE_P1 == -1 ? 100.f : tacc1; t2[1] = tacc2; }
        xcd_barrier(xb);
        const float cfill = sqrtf(t2[0]), spike = 4.f * t2[1];
        float* o = pp->out;
        for (size_t i = (size_t)c.bid * NTHREADS + c.tid; i < (size_t)NLAT * DM; i += (size_t)c.nb * NTHREADS) o[i] = (i == 0) ? spike : cfill;
    }
}

extern "C" void kernel_launch(void* const* d_in, const int* in_sizes, int n_in, void* d_out, int out_size, void* d_ws, size_t ws_size, hipStream_t stream) {
    static int grid = 0;
    if (grid == 0) {
        if (n_in != 29 || ws_size < WS_END) { fprintf(stderr, "kernel_launch: unexpected n_in %d or workspace %zu < %zu\n", n_in, ws_size, (size_t)WS_END); grid = -1; return; }
        int dev = 0, cus = 0, per_cu = 0;
        (void)hipGetDevice(&dev); (void)hipDeviceGetAttribute(&cus, hipDeviceAttributeMultiprocessorCount, dev);
#if MODE_SINGLE
        const void* kfn = (const void*)k_mega;
#else
        const void* kfn = (const void*)k_phase;
#endif
        (void)hipFuncSetAttribute(kfn, hipFuncAttributeMaxDynamicSharedMemorySize, LDS_BYTES);
        (void)hipOccupancyMaxActiveBlocksPerMultiprocessor(&per_cu, kfn, NTHREADS, LDS_BYTES);
        if (per_cu < 1) fprintf(stderr, "kernel_launch: occupancy query reports %d workgroups per CU\n", per_cu);
        grid = cus;
    }
    if (grid < 0) return;
    Params p{};
    for (int i = 0; i < 29; ++i) p.in[i] = (const float*)d_in[i];
    p.out = (float*)d_out; p.ws = (char*)d_ws;
    (void)hipMemsetAsync((char*)d_ws + WS_BAR, 0, WS_ZERO_BYTES, stream);
#if MODE_SINGLE
    void* args[] = {&p};
    hipError_t e = hipLaunchCooperativeKernel((const void*)k_mega, dim3(grid), dim3(NTHREADS), args, LDS_BYTES, stream);
    if (e != hipSuccess) fprintf(stderr, "kernel_launch: cooperative launch failed: %s (grid %d)\n", hipGetErrorString(e), grid);
#else
    hipLaunchKernelGGL(k_phase, dim3(grid), dim3(NTHREADS), LDS_BYTES, stream, p, 0, PH_P0);
    for (int l = 0; l < NL; ++l)
        for (int ph = PH_A; ph <= PH_G; ++ph) hipLaunchKernelGGL(k_phase, dim3(grid), dim3(NTHREADS), LDS_BYTES, stream, p, l, ph);
#endif
}
```

```cpp
#include <hip/hip_runtime.h>
#include <cstdio>
#include <cstdint>

#ifndef MODE_SINGLE
#define MODE_SINGLE 1
#endif
#ifndef EXP_BAR2
#define EXP_BAR2 0
#endif
#ifndef PROBE_P1
#define PROBE_P1 -2
#define PROBE_P2 -2
#endif
#ifndef EXP_REP
#define EXP_REP -1
#endif

#define DEV __device__ __forceinline__
#define LAS __attribute__((address_space(3)))
typedef unsigned short bf16_t;
typedef short bf16x8 __attribute__((ext_vector_type(8)));
typedef float f32x4 __attribute__((ext_vector_type(4)));
typedef float f32x16 __attribute__((ext_vector_type(16)));
typedef unsigned u32x4 __attribute__((ext_vector_type(4)));
typedef unsigned u32x2 __attribute__((ext_vector_type(2)));

constexpr int DM = 1024, NB = 8, SEQ = 2048, CL = 256, NL = 2;
constexpr int NLAT = NB * SEQ, NCTX = NB * CL, NTOK = NLAT + NCTX;
constexpr int KEYS = CL + SEQ;
constexpr int INC = 2208, INCP = 2304;
constexpr int OFF_AU = 0, OFF_AV = 256, OFF_BB = 512, OFF_BC = 768, OFF_BX = 1024, OFF_CQ = 1280, OFF_CK = 1536, OFF_CV = 1664,
              OFF_DCQ = 1792, OFF_DCKV = 2048, OFF_DKR = 2176;
constexpr float EPS = 1e-6f;
constexpr float LOG2E = 1.4426950408889634f;
constexpr float C_SCALE = 0.125f, D_SCALE = 0.10206207261596577f;
constexpr int NBUCKET = 24;
constexpr int MAXMT = NTOK / 256 + NBUCKET;
constexpr int NTHREADS = 512, NW = 8;
constexpr int LDS_BAR = 2 * (256 + 256) * 128, LDS_BYTES = LDS_BAR + 64;

constexpr size_t al256(size_t x) { return (x + 255) & ~(size_t)255; }
constexpr size_t WS_BAR   = 0;
constexpr size_t WS_CNT   = 16384;
constexpr size_t WS_RDY   = WS_CNT + 8192;
constexpr size_t WS_RDYE  = WS_RDY + 16384;
constexpr size_t WS_ZERO_BYTES = 16384 + 8192 + 16384 + 16384;
constexpr size_t WS_MODV  = al256(WS_RDYE + 16384);
constexpr size_t WS_RW    = al256(WS_MODV + (size_t)NL * 9 * 6144 * 4);
constexpr size_t WS_RC    = al256(WS_RW + (size_t)NL * 9 * 2 * 32 * 1024 * 2);
constexpr size_t WS_GM    = al256(WS_RC + (size_t)NL * 9 * 32 * 4);
constexpr size_t WS_ROPEC = al256(WS_GM + (size_t)NL * 9 * 1024 * 4);
constexpr size_t WS_ROPED = al256(WS_ROPEC + (size_t)2 * 2048 * 32 * 4);
constexpr size_t WS_WIN   = al256(WS_ROPED + (size_t)2 * 2048 * 16 * 4);
constexpr size_t WS_WOUT  = al256(WS_WIN + (size_t)NL * INCP * 1024 * 2);
constexpr size_t WS_WUP   = al256(WS_WOUT + (size_t)NL * 1024 * 1024 * 2);
constexpr size_t WS_WDN   = al256(WS_WUP + (size_t)16 * 512 * 1024 * 2);
constexpr size_t WS_WQB   = al256(WS_WDN + (size_t)16 * 1024 * 256 * 2);
constexpr size_t WS_WKVB  = al256(WS_WQB + (size_t)NL * 384 * 256 * 2);
constexpr size_t WS_WSG   = al256(WS_WKVB + (size_t)NL * 512 * 128 * 2);
constexpr size_t WS_XS    = al256(WS_WSG + (size_t)NL * 4 * 128 * 128 * 2);
constexpr size_t WS_ACT   = al256(WS_XS + (size_t)NTOK * 1024 * 2);
constexpr size_t WS_P     = al256(WS_ACT + (size_t)NTOK * 1024 * 2);
constexpr size_t WS_QRAW  = WS_P;
constexpr size_t WS_KVRAW = al256(WS_QRAW + (size_t)NTOK * 384 * 2);
constexpr size_t WS_HBUF  = WS_P;
constexpr size_t WS_QC    = al256(WS_P + (size_t)NTOK * INC * 2);
constexpr size_t WS_KC    = al256(WS_QC + (size_t)NB * 4 * KEYS * 64 * 2);
constexpr size_t WS_VCT   = al256(WS_KC + (size_t)NB * 2 * KEYS * 64 * 2);
constexpr size_t WS_QD    = al256(WS_VCT + (size_t)NB * 2 * 64 * KEYS * 2);
constexpr size_t WS_CQN   = WS_QD;
constexpr size_t WS_CKVN  = WS_QD + (size_t)NTOK * 256 * 2;
constexpr size_t WS_KD    = al256(WS_QD + (size_t)NB * 4 * KEYS * 96 * 2);
constexpr size_t WS_VDT   = al256(WS_KD + (size_t)NB * 4 * KEYS * 96 * 2);
constexpr size_t WS_LTOK  = al256(WS_VDT + (size_t)NB * 4 * 64 * KEYS * 2);
constexpr size_t WS_LW    = al256(WS_LTOK + (size_t)NBUCKET * NTOK * 4);
constexpr size_t WS_SSQ   = al256(WS_LW + (size_t)NBUCKET * NTOK * 8);
constexpr size_t WS_DBG   = al256(WS_SSQ + (size_t)NTOK * 8 * 4);
constexpr size_t WS_END   = WS_DBG + (1 << 20);
static_assert(WS_END <= ((size_t)256 << 20), "workspace");
static_assert((size_t)MAXMT * 256 * 512 * 2 <= (size_t)NTOK * INC * 2, "Hbuf overlay");
static_assert((size_t)NTOK * 384 * 2 <= (size_t)NB * 4 * KEYS * 96 * 2, "CQN/CKVN overlay");

struct Params {
    const float* in[29];
    float* out;
    char* ws;
};
enum { I_X = 0, I_C, I_CTX, I_CCTX, I_WMOD, I_BMOD, I_GATTN, I_WIN, I_SGUVG, I_SGUW, I_SGUB, I_CONVW, I_GQAQG, I_GQAKG, I_QAG, I_WQB, I_KVAG, I_WKVB,
       I_MLAQG, I_MLAKG, I_GGO, I_WOUT, I_GFFN, I_WRG, I_BRG, I_WRE, I_BRE, I_WUP, I_WDN };

DEV bf16_t f2bf(float f) { unsigned u = __float_as_uint(f); u += 0x7fffu + ((u >> 16) & 1u); return (bf16_t)(u >> 16); }
DEV float bf2f(bf16_t h) { return __uint_as_float(((unsigned)h) << 16); }
typedef __bf16 bf16x2_t __attribute__((ext_vector_type(2)));
typedef float f32x2 __attribute__((ext_vector_type(2)));
DEV unsigned pk2(float a, float b) { const f32x2 v = {a, b}; return __builtin_bit_cast(unsigned, __builtin_convertvector(v, bf16x2_t)); }
DEV float bflo(unsigned u) { return __uint_as_float(u << 16); }
DEV float bfhi(unsigned u) { return __uint_as_float(u & 0xffff0000u); }
template <int M> DEV float xlane(float v) {
    const int i = __builtin_bit_cast(int, v);
    if constexpr (M == 1) return __builtin_bit_cast(float, __builtin_amdgcn_mov_dpp(i, 0xB1, 0xF, 0xF, true));
    else if constexpr (M == 2) return __builtin_bit_cast(float, __builtin_amdgcn_mov_dpp(i, 0x4E, 0xF, 0xF, true));
    else if constexpr (M == 8) return __builtin_bit_cast(float, __builtin_amdgcn_mov_dpp(i, 0x128, 0xF, 0xF, true));
    else if constexpr (M == 4 || M == 16) return __builtin_bit_cast(float, __builtin_amdgcn_ds_swizzle(i, (M << 10) | 0x1F));
    else { static_assert(M == 32, "xlane"); const auto r = __builtin_amdgcn_permlane32_swap((unsigned)i, (unsigned)i, false, false);
        return __builtin_bit_cast(float, (int)(r[0] ^ r[1] ^ (unsigned)i)); }
}
DEV float wave_sum(float v) { v += xlane<32>(v); v += xlane<16>(v); v += xlane<8>(v); v += xlane<4>(v); v += xlane<2>(v); v += xlane<1>(v); return v; }
DEV float wave_max(float v) { v = fmaxf(v, xlane<32>(v)); v = fmaxf(v, xlane<16>(v)); v = fmaxf(v, xlane<8>(v)); v = fmaxf(v, xlane<4>(v)); v = fmaxf(v, xlane<2>(v)); return fmaxf(v, xlane<1>(v)); }
DEV float grp_sum16(float v) { v += xlane<1>(v); v += xlane<2>(v); v += xlane<4>(v); v += xlane<8>(v); return v; }
DEV float silu_f(float x) { return x / (1.f + __expf(-x)); }
DEV float gelu_fast(float x) { const float u = 1.5957691216057308f * (x + 0.044715f * x * x * x); return x * __builtin_amdgcn_rcpf(1.f + __expf(-u)); }
DEV void tok_info(int tok, int& b, int& pos, int& key, bool& isctx) {
    if (tok < NLAT) { b = tok >> 11; pos = tok & 2047; key = CL + pos; isctx = false; }
    else { const int c = tok - NLAT; b = c >> 8; pos = c & 255; key = pos; isctx = true; }
}
DEV bf16x8 lds_r128(LAS const char* p) { return *(LAS const bf16x8*)p; }

typedef const __attribute__((address_space(4))) Params* ParamsPtr;
struct Ctx {
    ParamsPtr p; int layer; int bid, nb, tid; LAS char* lds;
    DEV const float* in(int i) const { return p->in[i]; }
    template <class T> DEV T* ws(size_t off) const { return (T*)(p->ws + off); }
    DEV const float* modv(int mb, int chunk) const { return ws<float>(WS_MODV) + ((size_t)(layer * 9 + mb) * 6 + chunk) * 1024; }
    DEV const float* xin(int tok) const { return tok < NLAT ? p->in[I_X] + (size_t)tok * DM : p->in[I_CTX] + (size_t)(tok - NLAT) * DM; }
    DEV bf16_t* xs(int tok) const { return ws<bf16_t>(WS_XS) + (size_t)tok * DM; }
    DEV f32x4 xload4(int tok, int n) const {
        if (layer == 0) return *(const f32x4*)(xin(tok) + n);
        const u32x2 r = *(const u32x2*)(xs(tok) + n); return (f32x4){bflo(r[0]), bfhi(r[0]), bflo(r[1]), bfhi(r[1])};
    }
    DEV f32x4 xsload4(int tok, int n) const { const u32x2 r = *(const u32x2*)(xs(tok) + n); return (f32x4){bflo(r[0]), bfhi(r[0]), bflo(r[1]), bfhi(r[1])}; }
    DEV void xsstore4(int tok, int n, float a, float b, float c2, float d) const { *(u32x2*)(xs(tok) + n) = (u32x2){pk2(a, b), pk2(c2, d)}; }
    DEV void xsstore4_wt(int tok, int n, float a, float b, float c2, float d) const { __hip_atomic_store((__attribute__((address_space(1))) unsigned long long*)(xs(tok) + n), (unsigned long long)pk2(a, b) | ((unsigned long long)pk2(c2, d) << 32), __ATOMIC_RELAXED, __HIP_MEMORY_SCOPE_AGENT); }
    DEV int ntok_tail() const { return layer == NL - 1 ? NLAT : NTOK; }
};

#define GAS __attribute__((address_space(1)))
#define XB_TMO      128
#define XB_XCNT(j)  (256  + 64 * (j))
#define XB_XSUB(j)  (1280 + 64 * (j))
#define XB_XGEN(j)  (2304 + 64 * (j))
#define XB_TOP      3328
#define XB_TOPGEN   3392
#define XCD_BAR_WORDS 3456
#define XB_SPIN_CAP (1u << 22)
DEV unsigned xb_ld(unsigned* p)              { return __hip_atomic_load(p, __ATOMIC_RELAXED, __HIP_MEMORY_SCOPE_AGENT); }
DEV unsigned xb_add(unsigned* p, unsigned v) { return __hip_atomic_fetch_add(p, v, __ATOMIC_RELAXED, __HIP_MEMORY_SCOPE_AGENT); }
DEV unsigned xb_xcc_id() { return (unsigned)__builtin_amdgcn_s_getreg((3 << 11) | 20) & 0xFu; }
#define XB_SPIN(cond, bar) do { unsigned _sp = 0; while (cond) { __builtin_amdgcn_s_sleep(20); \
    if ((++_sp & 255u) == 0u) { if (xb_ld(&(bar)[XB_TMO])) break; if (_sp > XB_SPIN_CAP) { atomicAdd(&(bar)[XB_TMO], 1u); break; } } } } while (0)
DEV void st8_wt(void* p, unsigned lo, unsigned hi) { __hip_atomic_store((GAS unsigned long long*)p, (unsigned long long)lo | ((unsigned long long)hi << 32), __ATOMIC_RELAXED, __HIP_MEMORY_SCOPE_AGENT); }
DEV void publish_add(const Ctx& c, unsigned* w, unsigned v) { asm volatile("s_waitcnt vmcnt(0)" ::: "memory"); __syncthreads(); if (c.tid == 0) (void)xb_add(w, v); }
DEV void publish_rel(const Ctx& c, unsigned* w, unsigned v) {
    asm volatile("s_waitcnt vmcnt(0)" ::: "memory"); __syncthreads();
    if (c.tid == 0) { __builtin_amdgcn_fence(__ATOMIC_RELEASE, "agent"); asm volatile("s_waitcnt vmcnt(0)" ::: "memory"); (void)xb_add(w, v); }
}
DEV void wait_ready(const Ctx& c, unsigned* w0, unsigned want) {
    if (c.tid < 64) { unsigned* bar = c.ws<unsigned>(WS_BAR); unsigned sp_ = 0;
        while (xb_ld(w0) < want) { __builtin_amdgcn_s_sleep(2); if ((++sp_ & 1023u) == 0u) { if (xb_ld(&bar[XB_TMO])) break; if (sp_ > (1u << 24)) { atomicAdd(&bar[XB_TMO], 1u); break; } } }
        __builtin_amdgcn_fence(__ATOMIC_ACQUIRE, "agent"); }
}
struct GemmDesc {
    const bf16_t* A; int lda; const int* rowidx; int nvalid;
    const bf16_t* B0; const bf16_t* B1; int ldb; int ksplit; int K;
};
template <int WN_, int MF, class Epi>
DEV void gemm_tile(const GemmDesc& g, int m0, int n0, LAS char* lds, int tid, const Epi& epi) {
    constexpr int BM = (8 / WN_) * 16 * MF, BN = 64 * WN_, NPA = BM / 8, APW = (NPA + 7) / 8, BP = WN_, STAGE = (BM + BN) * 128;
    static_assert(BM % 8 == 0 && 2 * STAGE <= LDS_BAR, "tile does not fit");
    const int lane = tid & 63, wave = __builtin_amdgcn_readfirstlane(tid >> 6), wm = wave / WN_, wn = wave % WN_;
    int aoff[APW], boff[BP];
#pragma unroll
    for (int j = 0; j < APW; ++j) {
        const int pc = (j * 8 + wave < NPA) ? j * 8 + wave : wave;
        const int r = pc * 8 + (lane >> 3), kc = (lane & 7) ^ ((r >> 1) & 7);
        const int srow = g.rowidx ? g.rowidx[(r < g.nvalid) ? r : 0] : (m0 + r);
        aoff[j] = srow * g.lda + kc * 8;
    }
#pragma unroll
    for (int j = 0; j < BP; ++j) {
        const int r = (j * 8 + wave) * 8 + (lane >> 3), kc = (lane & 7) ^ ((r >> 1) & 7);
        boff[j] = (n0 + r) * g.ldb + kc * 8;
    }
    f32x4 acc[4][MF];
#pragma unroll
    for (int i = 0; i < 4; ++i)
#pragma unroll
        for (int j = 0; j < MF; ++j) acc[i][j] = (f32x4){0.f, 0.f, 0.f, 0.f};
    const int nk = g.K / 64;
    const int swz = (lane >> 1) & 7, q = lane >> 4;
    const int arow = (16 * MF * wm + (lane & 15)) * 128, brow = (64 * wn + (lane & 15)) * 128;
    LAS char* pieceA = lds + wave * 1024;
    LAS char* pieceB = lds + BM * 128 + wave * 1024;
#define GT_STAGE(KT, ST) { const int k0_ = (KT) * 64; const bf16_t* Bb_ = (k0_ < g.ksplit) ? g.B0 + k0_ : g.B1 + (k0_ - g.ksplit); \
        _Pragma("unroll") for (int j = 0; j < APW; ++j) if (NPA % 8 == 0 || j * 8 + wave < NPA) __builtin_amdgcn_global_load_lds((const void*)(g.A + aoff[j] + k0_), (LAS void*)(pieceA + (ST) * STAGE + j * 8192), 16, 0, 0); \
        _Pragma("unroll") for (int j = 0; j < BP; ++j) __builtin_amdgcn_global_load_lds((const void*)(Bb_ + boff[j]), (LAS void*)(pieceB + (ST) * STAGE + j * 8192), 16, 0, 0); }
#define GT_COMPUTE(ST) { LAS const char* As_ = lds + (ST) * STAGE; LAS const char* Bs_ = As_ + BM * 128; \
        _Pragma("unroll") for (int ks = 0; ks < 2; ++ks) { const int ch = ((4 * ks + q) ^ swz) << 4; bf16x8 bfr[4]; \
            _Pragma("unroll") for (int f = 0; f < 4; ++f) bfr[f] = lds_r128(Bs_ + brow + f * 2048 + ch); \
            _Pragma("unroll") for (int mh = 0; mh < MF; mh += 4) { bf16x8 af[4]; \
                _Pragma("unroll") for (int f = 0; f < 4; ++f) af[f] = lds_r128(As_ + arow + (mh + f) * 2048 + ch); \
                _Pragma("unroll") for (int mf = 0; mf < 4; ++mf) _Pragma("unroll") for (int nf = 0; nf < 4; ++nf) \
                    acc[nf][mh + mf] = __builtin_amdgcn_mfma_f32_16x16x32_bf16(bfr[nf], af[mf], acc[nf][mh + mf], 0, 0, 0); } } }
    __syncthreads();
    GT_STAGE(0, 0);
    asm volatile("s_waitcnt vmcnt(0)" ::: "memory");
    __syncthreads();
#pragma unroll 1
    for (int kt = 0; kt < nk; kt += 2) {
        GT_STAGE(kt + 1, 1);
        GT_COMPUTE(0);
        asm volatile("s_waitcnt vmcnt(0)" ::: "memory");
        __syncthreads();
        if (kt + 2 < nk) GT_STAGE(kt + 2, 0);
        GT_COMPUTE(1);
        asm volatile("s_waitcnt vmcnt(0)" ::: "memory");
        __syncthreads();
    }
#undef GT_STAGE
#undef GT_COMPUTE
    {
        int lane_e = lane, mb_e = 16 * MF * wm, nb_e = n0 + 64 * wn;
        asm volatile("" : "+v"(lane_e), "+v"(mb_e), "+v"(nb_e));
        epi(acc, mb_e, __builtin_amdgcn_readfirstlane(nb_e), lane_e);
    }
}

DEV int p8_lds_lo(int fr, int fq) { return (fr * 64 + fq * 16) ^ ((fr >> 3) << 5); }
DEV void p8_stage_rc(int b, int& R, int& C) { const int st = b >> 10, sb = b & 1023, swz = sb ^ (((sb >> 9) & 1) << 5); R = (st >> 1) * 16 + (swz >> 6); C = (st & 1) * 32 + ((swz & 63) >> 1); }
template <class Epi>
DEV void gemm_tile8p(const GemmDesc& g, int m0, int n0, LAS char* lds, int tid, const Epi& epi) {
    const int wid = __builtin_amdgcn_readfirstlane(tid >> 6), lane = tid & 63, wr = wid >> 2, wc = wid & 3, fr = lane & 15, fq = lane >> 4;
    int aoff[2][2], boff[2][2];
#pragma unroll
    for (int i = 0; i < 2; ++i) { int R, C; p8_stage_rc(tid * 16 + i * 8192, R, C);
#pragma unroll
        for (int h = 0; h < 2; ++h) { const int r = h * 128 + R;
            const int srow = g.rowidx ? g.rowidx[(r < g.nvalid) ? r : 0] : (m0 + r);
            aoff[h][i] = srow * g.lda + C; boff[h][i] = (n0 + r) * g.ldb + C; } }
    const int lo = p8_lds_lo(fr, fq);
    LAS char* const stg = lds + wid * 1024;
    LAS const char* const rdA = lds + wr * 8192 + lo;
    LAS const char* const rdB = lds + 65536 + wc * 4096 + lo;
    f32x4 acc[2][2][4][2];
#pragma unroll
    for (int a = 0; a < 2; ++a)
#pragma unroll
        for (int b = 0; b < 2; ++b)
#pragma unroll
            for (int m = 0; m < 4; ++m) { acc[a][b][m][0] = (f32x4){0.f, 0.f, 0.f, 0.f}; acc[a][b][m][1] = acc[a][b][m][0]; }
    bf16x8 At[4][2], B0[2][2], B1[2][2];
    const int nt = g.K / 64;
#define P8_BOFF(kt) (((kt) * 64 < g.ksplit) ? g.B0 + (kt) * 64 : g.B1 + ((kt) * 64 - g.ksplit))
#define STAGE_A(b, h, kt) { _Pragma("unroll") for (int i_ = 0; i_ < 2; ++i_) __builtin_amdgcn_global_load_lds((const void*)(g.A + aoff[h][i_] + (kt) * 64), (LAS void*)(stg + ((b) * 2 + (h)) * 16384 + i_ * 8192), 16, 0, 0); }
#define STAGE_B(b, h, kt) { const bf16_t* Bb_ = P8_BOFF(kt); _Pragma("unroll") for (int i_ = 0; i_ < 2; ++i_) __builtin_amdgcn_global_load_lds((const void*)(Bb_ + boff[h][i_]), (LAS void*)(stg + 65536 + ((b) * 2 + (h)) * 16384 + i_ * 8192), 16, 0, 0); }
#define LDA(b, h) { _Pragma("unroll") for (int m = 0; m < 4; ++m) _Pragma("unroll") for (int k = 0; k < 2; ++k) At[m][k] = lds_r128(rdA + ((b) * 2 + (h)) * 16384 + (m * 2 + k) * 1024); }
#define LDB(dst, b, h) { _Pragma("unroll") for (int n = 0; n < 2; ++n) _Pragma("unroll") for (int k = 0; k < 2; ++k) dst[n][k] = lds_r128(rdB + ((b) * 2 + (h)) * 16384 + (n * 2 + k) * 1024); }
#define MMA(ai, bj, Bx) { __builtin_amdgcn_s_setprio(1); \
        _Pragma("unroll") for (int m = 0; m < 4; ++m) _Pragma("unroll") for (int n = 0; n < 2; ++n) _Pragma("unroll") for (int k = 0; k < 2; ++k) \
            acc[ai][bj][m][n] = __builtin_amdgcn_mfma_f32_16x16x32_bf16(Bx[n][k], At[m][k], acc[ai][bj][m][n], 0, 0, 0); \
        __builtin_amdgcn_s_setprio(0); }
#define WAIT_V(n) asm volatile("s_waitcnt vmcnt(" #n ")" ::: "memory")
#define WAIT_L(n) asm volatile("s_waitcnt lgkmcnt(" #n ")" ::: "memory")
#define BAR __builtin_amdgcn_s_barrier()
#define SCHED __builtin_amdgcn_sched_barrier(0)
    __syncthreads();
    STAGE_B(0, 0, 0); STAGE_A(0, 0, 0); STAGE_B(0, 1, 0); STAGE_A(0, 1, 0);
    if (wr == 1) BAR;
    WAIT_V(4); BAR;
    STAGE_B(1, 0, 1); STAGE_A(1, 0, 1); STAGE_B(1, 1, 1);
    WAIT_V(6); BAR;
#pragma unroll 1
    for (int t = 0; t < nt - 2; t += 2) {
        LDB(B0, 0, 0); SCHED; LDA(0, 0); STAGE_A(1, 1, t + 1);
        WAIT_L(8); BAR; WAIT_L(0); MMA(0, 0, B0); BAR; SCHED;
        LDB(B1, 0, 1); STAGE_B(0, 0, t + 2);
        BAR; WAIT_L(0); MMA(0, 1, B1); BAR;
        LDA(0, 1); STAGE_A(0, 0, t + 2);
        BAR; WAIT_L(0); MMA(1, 0, B0); BAR; SCHED;
        STAGE_B(0, 1, t + 2);
        WAIT_V(6); BAR; MMA(1, 1, B1); BAR;
        LDB(B0, 1, 0); SCHED; LDA(1, 0); STAGE_A(0, 1, t + 2);
        WAIT_L(8); BAR; WAIT_L(0); MMA(0, 0, B0); BAR; SCHED;
        LDB(B1, 1, 1); STAGE_B(1, 0, t + 3);
        BAR; WAIT_L(0); MMA(0, 1, B1); BAR;
        LDA(1, 1); STAGE_A(1, 0, t + 3);
        BAR; WAIT_L(0); MMA(1, 0, B0); BAR; SCHED;
        STAGE_B(1, 1, t + 3);
        WAIT_V(6); BAR; MMA(1, 1, B1); BAR;
    }
    {
        LDB(B0, 0, 0); LDA(0, 0); STAGE_A(1, 1, nt - 1);
        BAR; WAIT_L(0); MMA(0, 0, B0); BAR;
        LDB(B1, 0, 1); BAR; WAIT_L(0); MMA(0, 1, B1); BAR;
        LDA(0, 1); WAIT_V(4); BAR; WAIT_L(0); MMA(1, 0, B0); MMA(1, 1, B1); BAR; }
    {
        LDB(B0, 1, 0); LDA(1, 0); WAIT_V(2); BAR; WAIT_L(0); MMA(0, 0, B0); BAR;
        LDB(B1, 1, 1); WAIT_V(0); BAR; WAIT_L(0); MMA(0, 1, B1); BAR;
        LDA(1, 1); BAR; WAIT_L(0); MMA(1, 0, B0); MMA(1, 1, B1); BAR; }
    if (wr == 0) BAR;
#undef P8_BOFF
#undef STAGE_A
#undef STAGE_B
#undef LDA
#undef LDB
#undef MMA
#undef WAIT_V
#undef WAIT_L
#undef BAR
#undef SCHED
    {
        int lane_e = lane, wr_e = wr, wc_e = wc;
        asm volatile("" : "+v"(lane_e), "+s"(wr_e), "+s"(wc_e));
        epi(acc, wr_e, wc_e, lane_e);
    }
}

DEV void p0_transpose(const float* W, int K, int N, bf16_t* WT, int kt, int nt, int mode, const float* kscale, LAS float* scr, int tid) {
    {
        const int n4 = (tid & 15) * 4, kr = tid >> 4, n_in = nt * 64 + n4;
#pragma unroll
        for (int i = 0; i < 2; ++i) { const int kk = kr + 32 * i; const float s = kscale ? kscale[kt * 64 + kk] : 1.f;
            f32x4 v = (f32x4){0.f, 0.f, 0.f, 0.f};
            if (n_in < N) v = *(const f32x4*)(W + (size_t)(kt * 64 + kk) * N + n_in);
            scr[kk * 65 + n4] = s * v[0]; scr[kk * 65 + n4 + 1] = s * v[1]; scr[kk * 65 + n4 + 2] = s * v[2]; scr[kk * 65 + n4 + 3] = s * v[3]; }
    }
    __syncthreads();
    const int nl = tid >> 3, kcq = tid & 7, n = nt * 64 + nl;
    if (n < N) {
        int drow = n;
        if (mode == 1) { const int type = n >> 8, j = n & 255; drow = 128 * (j >> 6) + 64 * ((j >> 5) & 1) + 16 * (((j >> 4) & 1) + 2 * type) + (j & 15); }
        if (mode == 2) { const int h = n / 96, cc = n % 96; drow = cc < 64 ? 64 * h + cc : 256 + 32 * h + (cc - 64); }
        if (mode == 3) drow = (n & ~255) | (((n >> 5) & 1) << 7) | (((n >> 6) & 3) << 5) | (n & 31);
        unsigned o[4];
#pragma unroll
        for (int j = 0; j < 4; ++j) o[j] = pk2(scr[(kcq * 8 + 2 * j) * 65 + nl], scr[(kcq * 8 + 2 * j + 1) * 65 + nl]);
        *(u32x4*)(WT + (size_t)drow * K + kt * 64 + kcq * 8) = (u32x4){o[0], o[1], o[2], o[3]};
    }
    __syncthreads();
}
constexpr int T_IN = 16 * 35, T_OUT = 16 * 16, T_UP = 16 * 16 * 8, T_DN = 16 * 4 * 16, T_QB = 4 * 6, T_KVB = 2 * 8;
constexpr int T_LAYER = T_IN + T_OUT + T_UP + T_DN + T_QB + T_KVB;
constexpr int P0_TR = NL * T_LAYER, P0_WSG = 32, P0_MODV = NL * 192, P0_ROPE = 192, P0_PAD = 48;
constexpr int P0_ITEMS = P0_TR + P0_WSG + P0_MODV + P0_ROPE + P0_PAD;

DEV void p0_expert_item(const Ctx& c, int l, int item, LAS float* scr, int tid) {
    if (item < T_UP) { const int e = item / 128, q = item % 128;
        p0_transpose(c.in(I_WUP) + ((size_t)l * 16 + e) * 1024 * 512, 1024, 512, c.ws<bf16_t>(WS_WUP) + (size_t)e * 512 * 1024, q / 8, q % 8, 1, nullptr, scr, tid); }
    else { const int r = item - T_UP, e = r / 64, q = r % 64;
        p0_transpose(c.in(I_WDN) + ((size_t)l * 16 + e) * 256 * 1024, 256, 1024, c.ws<bf16_t>(WS_WDN) + (size_t)e * 1024 * 256, q / 16, q % 16, 0, nullptr, scr, tid); }
}
DEV void phase_p0(const Ctx& c) {
    const int tid = c.tid;
    LAS float* scr = (LAS float*)c.lds;
    for (int it = c.bid; it < P0_ITEMS; it += c.nb) {
        int r = it;
        if (r < P0_TR) {
            const int l = r / T_LAYER; r -= l * T_LAYER;
            if (r < T_IN) { p0_transpose(c.in(I_WIN) + (size_t)l * 1024 * INC, 1024, INC, c.ws<bf16_t>(WS_WIN) + (size_t)l * INCP * 1024, r / 35, r % 35, 0, nullptr, scr, tid); continue; } r -= T_IN;
            if (r < T_OUT) { p0_transpose(c.in(I_WOUT) + (size_t)l * 1024 * 1024, 1024, 1024, c.ws<bf16_t>(WS_WOUT) + (size_t)l * 1024 * 1024, r / 16, r % 16, 3, nullptr, scr, tid); continue; } r -= T_OUT;
            if (r < T_UP) { if (l == 0 && c.nb != 256) p0_expert_item(c, 0, r, scr, tid); continue; } r -= T_UP;
            if (r < T_DN) { if (l == 0 && c.nb != 256) p0_expert_item(c, 0, T_UP + r, scr, tid); continue; } r -= T_DN;
            if (r < T_QB) { p0_transpose(c.in(I_WQB) + (size_t)l * 256 * 384, 256, 384, c.ws<bf16_t>(WS_WQB) + (size_t)l * 384 * 256, r / 6, r % 6, 2, c.in(I_QAG) + l * 256, scr, tid); continue; } r -= T_QB;
            p0_transpose(c.in(I_WKVB) + (size_t)l * 128 * 512, 128, 512, c.ws<bf16_t>(WS_WKVB) + (size_t)l * 512 * 128, r / 8, r % 8, 0, c.in(I_KVAG) + l * 128, scr, tid); continue;
        }
        r -= P0_TR;
        if (r < P0_WSG) {
            const size_t e0 = ((size_t)r * NTHREADS + tid) * 8; const float* s = c.in(I_SGUW) + e0;
            const f32x4 a = *(const f32x4*)s, b = *(const f32x4*)(s + 4);
            *(u32x4*)(c.ws<bf16_t>(WS_WSG) + e0) = (u32x4){pk2(a[0], a[1]), pk2(a[2], a[3]), pk2(b[0], b[1]), pk2(b[2], b[3])};
            continue;
        }
        r -= P0_WSG;
        if (r < P0_MODV) {
            const int l = r / 192, n0 = (r % 192) * 32;
            LAS float* sc = scr;
            LAS float* red = scr + 9 * 1024;
            __syncthreads();
            for (int i = tid; i < 9 * 1024; i += NTHREADS) { const int mb = i >> 10, k = i & 1023; sc[i] = silu_f(mb < 8 ? c.in(I_C)[mb * 1024 + k] : c.in(I_CCTX)[k]); }
            __syncthreads();
            const int kq = tid >> 3, nl = tid & 7;
            float a[9][4];
#pragma unroll
            for (int j = 0; j < 9; ++j) { a[j][0] = 0.f; a[j][1] = 0.f; a[j][2] = 0.f; a[j][3] = 0.f; }
            const float* wp = c.in(I_WMOD) + (size_t)l * 1024 * 6144 + n0 + 4 * nl;
#pragma unroll 8
            for (int k2 = 0; k2 < 16; ++k2) { const int k = kq * 16 + k2; const f32x4 w = *(const f32x4*)(wp + (size_t)k * 6144);
#pragma unroll
                for (int j = 0; j < 9; ++j) { const float s = sc[j * 1024 + k]; a[j][0] += s * w[0]; a[j][1] += s * w[1]; a[j][2] += s * w[2]; a[j][3] += s * w[3]; } }
#pragma unroll
            for (int j = 0; j < 9; ++j)
#pragma unroll
                for (int q = 0; q < 4; ++q) { float v = a[j][q]; v += xlane<8>(v); v += xlane<16>(v); v += xlane<32>(v); a[j][q] = v; }
            if ((tid & 63) < 8) {
#pragma unroll
                for (int j = 0; j < 9; ++j)
#pragma unroll
                    for (int q = 0; q < 4; ++q) red[((tid >> 6) * 9 + j) * 32 + 4 * nl + q] = a[j][q];
            }
            __syncthreads();
            for (int i = tid; i < 9 * 32; i += NTHREADS) { const int mb = i >> 5, n = i & 31;
                float v = 0.f;
#pragma unroll
                for (int w = 0; w < NW; ++w) v += red[(w * 9 + mb) * 32 + n];
                c.ws<float>(WS_MODV)[(size_t)(l * 9 + mb) * 6144 + n0 + n] = v + c.in(I_BMOD)[l * 6144 + n0 + n]; }
            __syncthreads();
            continue;
        }
        r -= P0_MODV;
        if (r < P0_ROPE) {
            const int idx = r * NTHREADS + tid;
            if (idx < 2048 * 32) { const int s = idx >> 5, i = idx & 31, f = i & 15; const float pos = (float)((i < 16) ? (s >> 6) : (s & 63));
                const float inv = powf(10000.f, -(float)f / 16.f), ang = pos * inv;
                c.ws<float>(WS_ROPEC)[idx] = cosf(ang); c.ws<float>(WS_ROPEC)[2048 * 32 + idx] = sinf(ang); }
            else { const int j = idx - 2048 * 32, s = j >> 4, i = j & 15, f = i & 7; const float pos = (float)((i < 8) ? (s >> 6) : (s & 63));
                const float inv = powf(10000.f, -(float)f / 8.f), ang = pos * inv;
                c.ws<float>(WS_ROPED)[j] = cosf(ang); c.ws<float>(WS_ROPED)[2048 * 16 + j] = sinf(ang); }
            continue;
        }
        r -= P0_ROPE;
        {
            const int e = (r * NTHREADS + tid) * 8, l = e / (96 * 1024), o = e % (96 * 1024);
            unsigned z = 0u; asm volatile("" : "+v"(z));
            *(u32x4*)(c.ws<bf16_t>(WS_WIN) + ((size_t)l * INCP + INC) * 1024 + o) = (u32x4){z, z, z, z};
        }
    }
}

constexpr int A_RW_ITEMS = NL * 9 * 1024 / NTHREADS;
constexpr int A_RC_ITEMS = NL * 9 * 20 / NW;
DEV void phase_a(const Ctx& c) {
    const int tid = c.tid, lane = tid & 63, wave = tid >> 6;
    const float* g = c.in(I_GATTN) + c.layer * 1024;
    bf16_t* H = c.ws<bf16_t>(WS_ACT);
    const int nwv = c.nb * NW, per = (NTOK + nwv - 1) / nwv, tbeg = (c.bid * NW + wave) * per, tend = min(tbeg + per, NTOK);
    int mbc = -1; f32x4 gm[4], sv[4];
#pragma unroll 1
    for (int t0 = tbeg; t0 < tend; t0 += 3) {
        f32x4 v[3][4];
#pragma unroll
        for (int u = 0; u < 3; ++u) { const int tok = min(t0 + u, tend - 1);
#pragma unroll
            for (int i = 0; i < 4; ++i) v[u][i] = c.xload4(tok, i * 256 + lane * 4); }
#pragma unroll
        for (int u = 0; u < 3; ++u) { const int tok = t0 + u;
            if (tok < tend) {
                const int mb = tok < NLAT ? (tok >> 11) : 8;
                if (mb != mbc) { mbc = mb; const float* sh = c.modv(mb, 0); const float* scl = c.modv(mb, 1);
#pragma unroll
                    for (int i = 0; i < 4; ++i) { const int e = i * 256 + lane * 4; const f32x4 gg = *(const f32x4*)(g + e), s1 = *(const f32x4*)(scl + e);
                        gm[i] = (f32x4){gg[0] * (1.f + s1[0]), gg[1] * (1.f + s1[1]), gg[2] * (1.f + s1[2]), gg[3] * (1.f + s1[3])}; sv[i] = *(const f32x4*)(sh + e); } }
                float ss = 0.f;
#pragma unroll
                for (int i = 0; i < 4; ++i) ss += v[u][i][0] * v[u][i][0] + v[u][i][1] * v[u][i][1] + v[u][i][2] * v[u][i][2] + v[u][i][3] * v[u][i][3];
                const float r = rsqrtf(wave_sum(ss) * (1.f / 1024.f) + EPS);
#pragma unroll
                for (int i = 0; i < 4; ++i) { const int e = i * 256 + lane * 4;
                    float o[4];
#pragma unroll
                    for (int j = 0; j < 4; ++j) o[j] = v[u][i][j] * r * gm[i][j] + sv[i][j];
                    *(u32x2*)(H + (size_t)tok * 1024 + e) = (u32x2){pk2(o[0], o[1]), pk2(o[2], o[3])}; }
            } }
    }
    if (c.layer == 0) {
        for (int it = c.bid; it < A_RW_ITEMS + A_RC_ITEMS; it += c.nb) {
            if (it < A_RW_ITEMS) {
                const int idx = it * NTHREADS + tid, l = idx / (9 * 1024), mb = (idx >> 10) % 9, k = idx & 1023;
                const float* mv = c.ws<float>(WS_MODV) + (size_t)(l * 9 + mb) * 6144;
                const float gm = c.in(I_GFFN)[l * 1024 + k] * (1.f + mv[4 * 1024 + k]);
                c.ws<float>(WS_GM)[idx] = gm;
                bf16_t* o = c.ws<bf16_t>(WS_RW) + (size_t)(l * 9 + mb) * 2 * 32 * 1024 + k;
                const float* wg = c.in(I_WRG) + ((size_t)l * 1024 + k) * 4; const float* we = c.in(I_WRE) + ((size_t)l * 1024 + k) * 16;
#pragma unroll
                for (int j = 0; j < 32; ++j) { const float w = j < 20 ? gm * (j < 4 ? wg[j] : we[j - 4]) : 0.f;
                    const bf16_t hi = f2bf(w); o[(size_t)j * 1024] = hi; o[(size_t)(32 + j) * 1024] = f2bf(w - bf2f(hi)); }
            } else {
                const int idx = (it - A_RW_ITEMS) * NW + wave, l = idx / 180, mb = (idx / 20) % 9, j = idx % 20;
                const float* mv = c.ws<float>(WS_MODV) + (size_t)(l * 9 + mb) * 6144 + 3 * 1024;
                float a = 0.f;
                for (int k = lane; k < 1024; k += 64) { const float w = (j < 4) ? c.in(I_WRG)[((size_t)l * 1024 + k) * 4 + j] : c.in(I_WRE)[((size_t)l * 1024 + k) * 16 + (j - 4)]; a += mv[k] * w; }
                a = wave_sum(a);
                if (lane == 0) c.ws<float>(WS_RC)[(l * 9 + mb) * 32 + j] = a + ((j < 4) ? c.in(I_BRG)[l * 4 + j] : c.in(I_BRE)[l * 16 + j - 4]);
            }
        }
    }
}

DEV void rope2(float& a, float& b, float cs, float sn) { const float x0 = a, x1 = b; a = x0 * cs - x1 * sn; b = x0 * sn + x1 * cs; }
DEV float red_q(float v) { v += xlane<16>(v); v += xlane<32>(v); return v; }
template <int MF>
DEV void b_epilogue(const Ctx& c, const f32x4 (&acc)[4][MF], int m0, int mb, int nbase, int lane) {
    const int l = c.layer;
    bf16_t* P = c.ws<bf16_t>(WS_P);
    const int q = lane >> 4, li = lane & 15;
    const bool isctx = m0 >= NLAT;
    if (nbase < 256) {
#pragma unroll
        for (int mf = 0; mf < MF; ++mf) { const int m = m0 + mb + 16 * mf + li;
#pragma unroll
            for (int nf = 0; nf < 4; ++nf) { const f32x4 a = acc[nf][mf];
                *(u32x2*)(P + (size_t)m * INC + nbase + 16 * nf + 4 * q) = (u32x2){pk2(gelu_fast(a[0]), gelu_fast(a[1])), pk2(gelu_fast(a[2]), gelu_fast(a[3]))}; } }
    } else if (nbase < 512) {
        const float* vg = c.in(I_SGUVG) + l * 256 + (nbase - 256) + 4 * q;
#pragma unroll
        for (int mf = 0; mf < MF; ++mf) { const int m = m0 + mb + 16 * mf + li;
            float v[4][4]; float ss = 0.f;
#pragma unroll
            for (int nf = 0; nf < 4; ++nf)
#pragma unroll
                for (int r = 0; r < 4; ++r) { v[nf][r] = gelu_fast(acc[nf][mf][r]); ss += v[nf][r] * v[nf][r]; }
            const float rr = rsqrtf(red_q(ss) * (1.f / 64.f) + EPS);
#pragma unroll
            for (int nf = 0; nf < 4; ++nf) { const f32x4 gg = *(const f32x4*)(vg + 16 * nf);
                *(u32x2*)(P + (size_t)m * INC + nbase + 16 * nf + 4 * q) = (u32x2){pk2(v[nf][0] * rr * gg[0], v[nf][1] * rr * gg[1]), pk2(v[nf][2] * rr * gg[2], v[nf][3] * rr * gg[3])}; } }
    } else if (nbase < OFF_CQ || (nbase >= OFF_DCQ && nbase < OFF_DKR)) {
        const bool need_ss = nbase >= OFF_DCQ;
        const int sidx = nbase < OFF_DCKV ? (nbase - OFF_DCQ) >> 6 : 4 + ((nbase - OFF_DCKV) >> 6);
#pragma unroll
        for (int mf = 0; mf < MF; ++mf) { const int m = m0 + mb + 16 * mf + li; float ss = 0.f;
#pragma unroll
            for (int nf = 0; nf < 4; ++nf) { const f32x4 a = acc[nf][mf]; ss += a[0] * a[0] + a[1] * a[1] + a[2] * a[2] + a[3] * a[3];
                *(u32x2*)(P + (size_t)m * INC + nbase + 16 * nf + 4 * q) = (u32x2){pk2(a[0], a[1]), pk2(a[2], a[3])}; }
            if (need_ss) { ss = red_q(ss); if (q == 0) c.ws<float>(WS_SSQ)[(size_t)m * 8 + sidx] = ss; } }
    } else if (nbase < OFF_CV) {
        const bool isq = nbase < OFF_CK;
        const int h = isq ? (nbase - OFF_CQ) >> 6 : (nbase - OFF_CK) >> 6;
        const float* gn = (isq ? c.in(I_GQAQG) : c.in(I_GQAKG)) + l * 64 + 4 * q;
        const float sc = isq ? C_SCALE * LOG2E : 1.f;
        const float* cosC = c.ws<float>(WS_ROPEC); const float* sinC = cosC + 2048 * 32;
#pragma unroll
        for (int mf = 0; mf < MF; ++mf) { const int m = m0 + mb + 16 * mf + li;
            int b, pos, key; bool ic; tok_info(m, b, pos, key, ic);
            float ss = 0.f;
#pragma unroll
            for (int nf = 0; nf < 4; ++nf) { const f32x4 a = acc[nf][mf]; ss += a[0] * a[0] + a[1] * a[1] + a[2] * a[2] + a[3] * a[3]; }
            const float rr = rsqrtf(red_q(ss) * (1.f / 64.f) + EPS);
            bf16_t* dst = isq ? c.ws<bf16_t>(WS_QC) + ((size_t)(b * 4 + h) * KEYS + key) * 64 : c.ws<bf16_t>(WS_KC) + ((size_t)(b * 2 + h) * KEYS + key) * 64;
#pragma unroll
            for (int nf = 0; nf < 4; ++nf) { const f32x4 gg = *(const f32x4*)(gn + 16 * nf); const f32x4 a = acc[nf][mf];
                float v0 = a[0] * rr * gg[0], v1 = a[1] * rr * gg[1], v2 = a[2] * rr * gg[2], v3 = a[3] * rr * gg[3];
                if (!isctx) { const f32x2 cs = *(const f32x2*)(cosC + pos * 32 + 8 * nf + 2 * q), sn = *(const f32x2*)(sinC + pos * 32 + 8 * nf + 2 * q);
                    rope2(v0, v1, cs[0], sn[0]); rope2(v2, v3, cs[1], sn[1]); }
                *(u32x2*)(dst + 16 * nf + 4 * q) = (u32x2){pk2(v0 * sc, v1 * sc), pk2(v2 * sc, v3 * sc)}; } }
    } else if (nbase < OFF_DCQ) {
        const int kvh = (nbase - OFF_CV) >> 6;
#pragma unroll
        for (int mf = 0; mf < MF; ++mf) { const int m = m0 + mb + 16 * mf + li;
            int b, pos, key; bool ic; tok_info(m, b, pos, key, ic);
            bf16_t* dst = c.ws<bf16_t>(WS_VCT) + ((size_t)(b * 2 + kvh) * 64 + 4 * q) * KEYS + key;
#pragma unroll
            for (int nf = 0; nf < 4; ++nf) { const f32x4 a = acc[nf][mf]; const unsigned p0 = pk2(a[0], a[1]), p1 = pk2(a[2], a[3]);
                bf16_t* d = dst + (size_t)(16 * nf) * KEYS;
                d[0] = (bf16_t)(p0 & 0xffffu); d[KEYS] = (bf16_t)(p0 >> 16); d[2 * KEYS] = (bf16_t)(p1 & 0xffffu); d[3 * KEYS] = (bf16_t)(p1 >> 16); } }
    } else if (nbase < OFF_DKR + 64) {
        const float* gn = c.in(I_MLAKG) + l * 96 + 64 + 4 * q;
        const float* cosD = c.ws<float>(WS_ROPED); const float* sinD = cosD + 2048 * 16;
#pragma unroll
        for (int mf = 0; mf < MF; ++mf) { const int m = m0 + mb + 16 * mf + li;
            int b, pos, key; bool ic; tok_info(m, b, pos, key, ic);
            float ss = 0.f;
#pragma unroll
            for (int nf = 0; nf < 2; ++nf) { const f32x4 a = acc[nf][mf]; ss += a[0] * a[0] + a[1] * a[1] + a[2] * a[2] + a[3] * a[3]; }
            const float rr = rsqrtf(red_q(ss) * (1.f / 32.f) + EPS);
#pragma unroll
            for (int nf = 0; nf < 2; ++nf) { const f32x4 gg = *(const f32x4*)(gn + 16 * nf); const f32x4 a = acc[nf][mf];
                float v0 = a[0] * rr * gg[0], v1 = a[1] * rr * gg[1], v2 = a[2] * rr * gg[2], v3 = a[3] * rr * gg[3];
                if (!isctx) { const f32x2 cs = *(const f32x2*)(cosD + pos * 16 + 8 * nf + 2 * q), sn = *(const f32x2*)(sinD + pos * 16 + 8 * nf + 2 * q);
                    rope2(v0, v1, cs[0], sn[0]); rope2(v2, v3, cs[1], sn[1]); }
                const u32x2 o = (u32x2){pk2(v0, v1), pk2(v2, v3)};
#pragma unroll
                for (int h = 0; h < 4; ++h) *(u32x2*)(c.ws<bf16_t>(WS_KD) + ((size_t)(b * 4 + h) * KEYS + key) * 96 + 64 + 16 * nf + 4 * q) = o; } }
    }
}
DEV void phase_b(const Ctx& c) {
    const int l = c.layer;
    GemmDesc g; g.A = c.ws<bf16_t>(WS_ACT); g.lda = 1024; g.rowidx = nullptr; g.nvalid = 0;
    g.B0 = c.ws<bf16_t>(WS_WIN) + (size_t)l * INCP * 1024; g.B1 = g.B0; g.ldb = 1024; g.ksplit = 1 << 30; g.K = 1024;
    constexpr int NT_N = INCP / 256, NT_M = NTOK / 256;
    auto full_tile = [&](int mt, int nt) { const int m0 = mt * 256;
        gemm_tile<4, 8>(g, m0, nt * 256, c.lds, c.tid, [&](const f32x4 (&acc)[4][8], int mb, int nbase, int lane) { b_epilogue<8>(c, acc, m0, mb, nbase, lane); }); };
    if (c.nb != 256) { for (int t = c.bid; t < NT_M * NT_N; t += c.nb) full_tile(t / NT_N, t % NT_N); }
    else if (l < NL - 1) {
        const int nmine = c.bid < 136 ? 3 : 2;
        for (int rd = 0; rd < nmine; ++rd) {
            int mt, nt, ex = -1, ch = -1;
            if (c.bid >= 136) ex = (c.bid - 136) + 120 * rd;
            else if (rd == 0) { if (c.bid < 48) ex = 240 + c.bid; else ch = c.bid - 48; }
            else ch = 88 + 136 * (rd - 1) + c.bid;
            if (ex >= 0) { const int k = ex / 72; nt = k == 0 ? 5 : (k == 1 ? 6 : (k == 2 ? 1 : 0)); mt = ex % 72; }
            else { const int k = ch / 72; nt = k < 3 ? 2 + k : 4 + k; mt = ch % 72; }
            full_tile(mt, nt);
        }
    } else {
        auto unit = [&](int u, int& mt, int& nt) {
            if (u < 256) { const int k = u >> 6; nt = k == 0 ? 5 : (k == 1 ? 6 : (k == 2 ? 1 : 0)); mt = u & 63; }
            else if (u < 576) { const int v = u - 256, k = v >> 6; nt = k < 3 ? 2 + k : 4 + k; mt = v & 63; }
            else { const int v = u - 576; nt = (v >> 3) ? 8 : 6; mt = 64 + (v & 7); } };
        for (int rd = 0; rd < 2; ++rd) { int mt, nt; unit(c.bid + 256 * rd, mt, nt); full_tile(mt, nt); }
        if (c.bid < 160) { int mt, nt; unit(512 + (c.bid >> 1), mt, nt); const int m0 = mt * 256;
            gemm_tile<2, 4>(g, m0, nt * 256 + (c.bid & 1) * 128, c.lds, c.tid, [&](const f32x4 (&acc)[4][4], int mb, int nbase, int lane) { b_epilogue<4>(c, acc, m0, mb, nbase, lane); }); }
    }
    if (l > 0 && c.nb != 256) {
        for (int e = c.bid; e < T_UP + T_DN; e += c.nb) p0_expert_item(c, l, e, (LAS float*)c.lds, c.tid);
    }
}

constexpr int C_SGU_ITEMS = (NTOK / 128) * 4, C_TQ = (NTOK / 256) * 3, C_TKV = (NTOK / 256) * 4;
constexpr int SG_LD = 272;
DEV void phase_c_sgu(const Ctx& c, int item) {
    const int tid = c.tid, lane = tid & 63, wave = tid >> 6, l = c.layer;
    const int chunk = item >> 2, h = item & 3, tok0 = chunk * 128;
    const bf16_t* P = c.ws<bf16_t>(WS_P);
    LAS char* Wt = c.lds;
    LAS char* vT = c.lds + 128 * SG_LD;
    __syncthreads();
    {
        const bf16_t* Wsrc = c.ws<bf16_t>(WS_WSG) + (size_t)(l * 4 + h) * 128 * 128;
#pragma unroll
        for (int i = 0; i < 4; ++i) { const int ci = tid + NTHREADS * i, r = ci >> 4, kc = ci & 15; *(LAS u32x4*)(Wt + r * SG_LD + kc * 16) = *(const u32x4*)(Wsrc + r * 128 + kc * 8); }
        const int j = tid >> 2, qt = tid & 3;
        const bf16_t* vp = P + (size_t)(tok0 + j) * INC + OFF_AV + 64 * h + 16 * qt;
#pragma unroll
        for (int q = 0; q < 2; ++q) { const u32x4 raw = *(const u32x4*)(vp + 8 * q);
#pragma unroll
            for (int e = 0; e < 4; ++e) { LAS char* d = vT + (16 * qt + 8 * q + 2 * e) * SG_LD + j * 2;
                *(LAS bf16_t*)d = (bf16_t)(raw[e] & 0xffffu); *(LAS bf16_t*)(d + SG_LD) = (bf16_t)(raw[e] >> 16); } }
    }
    __syncthreads();
    f32x4 acc[4];
#pragma unroll
    for (int a = 0; a < 4; ++a) acc[a] = (f32x4){0.f, 0.f, 0.f, 0.f};
    const int q = lane >> 4, li = lane & 15;
#pragma unroll
    for (int ks = 0; ks < 4; ++ks) {
        bf16x8 af[4];
#pragma unroll
        for (int df = 0; df < 4; ++df) af[df] = lds_r128(vT + (16 * df + li) * SG_LD + (4 * ks + q) * 16);
        const bf16x8 bfr = lds_r128(Wt + (16 * wave + li) * SG_LD + (4 * ks + q) * 16);
#pragma unroll
        for (int df = 0; df < 4; ++df) acc[df] = __builtin_amdgcn_mfma_f32_16x16x32_bf16(af[df], bfr, acc[df], 0, 0, 0);
    }
    bf16_t* Y = c.ws<bf16_t>(WS_ACT);
    {
        const int i = 16 * wave + li, tok = tok0 + i;
        const float bs = c.in(I_SGUB)[(l * 4 + h) * 128 + i];
#pragma unroll
        for (int df = 0; df < 4; ++df) {
            const int d0 = 16 * df + 4 * q;
            const u32x2 ur = *(const u32x2*)(P + (size_t)tok * INC + OFF_AU + 64 * h + d0);
            const f32x4 a = acc[df];
            *(u32x2*)(Y + (size_t)tok * 1024 + 64 * h + d0) = (u32x2){pk2(bflo(ur[0]) * (a[0] + bs), bfhi(ur[0]) * (a[1] + bs)), pk2(bflo(ur[1]) * (a[2] + bs), bfhi(ur[1]) * (a[3] + bs))};
        }
    }
}
DEV void phase_c(const Ctx& c) {
    const int l = c.layer;
    const bf16_t* P = c.ws<bf16_t>(WS_P);
    const float* cosD = c.ws<float>(WS_ROPED); const float* sinD = cosD + 2048 * 16;
    int it = c.bid;
    const bool lastl = (l == NL - 1);
    for (; it < C_SGU_ITEMS; it += c.nb) { if (!(lastl && (it >> 2) >= NLAT / 128)) phase_c_sgu(c, it); }
    for (; it < C_SGU_ITEMS + C_TQ; it += c.nb) {
        const int t = it - C_SGU_ITEMS, mt = t / 3, nt = t % 3, m0 = mt * 256;
        if (lastl && m0 >= NLAT) continue;
        GemmDesc g; g.rowidx = nullptr; g.nvalid = 0; g.ksplit = 1 << 30; g.lda = INC;
        g.A = P + OFF_DCQ; g.K = 256; g.B0 = c.ws<bf16_t>(WS_WQB) + (size_t)l * 384 * 256; g.B1 = g.B0; g.ldb = 256;
        gemm_tile<2, 4>(g, m0, nt * 128, c.lds, c.tid, [&](const f32x4 (&acc)[4][4], int mb, int nbase, int lane) {
            const int q = lane >> 4, li = lane & 15, wn = (nbase >> 6) & 1;
            const bool isctx = m0 >= NLAT;
            const float* qg = c.in(I_MLAQG) + l * 96;
            const float sc = D_SCALE * LOG2E;
#pragma unroll
            for (int mf = 0; mf < 4; ++mf) { const int m = m0 + mb + 16 * mf + li;
                int b, pos, key; bool ic; tok_info(m, b, pos, key, ic);
                const f32x4 s4 = *(const f32x4*)(c.ws<float>(WS_SSQ) + (size_t)m * 8);
                const float r0 = rsqrtf((s4[0] + s4[1] + s4[2] + s4[3]) * (1.f / 256.f) + EPS);
                if (nt < 2) {
                    const int h = 2 * nt + wn; float ss = 0.f;
#pragma unroll
                    for (int nf = 0; nf < 4; ++nf) { const f32x4 a = acc[nf][mf] * r0; ss += a[0] * a[0] + a[1] * a[1] + a[2] * a[2] + a[3] * a[3]; }
                    const float rr = rsqrtf(red_q(ss) * (1.f / 64.f) + EPS) * r0 * sc;
                    bf16_t* dst = c.ws<bf16_t>(WS_QD) + ((size_t)(b * 4 + h) * KEYS + key) * 96 + 4 * q;
#pragma unroll
                    for (int nf = 0; nf < 4; ++nf) { const f32x4 gg = *(const f32x4*)(qg + 16 * nf + 4 * q); const f32x4 a = acc[nf][mf];
                        *(u32x2*)(dst + 16 * nf) = (u32x2){pk2(a[0] * rr * gg[0], a[1] * rr * gg[1]), pk2(a[2] * rr * gg[2], a[3] * rr * gg[3])}; }
                } else {
#pragma unroll
                    for (int hh = 0; hh < 2; ++hh) { const int h = 2 * wn + hh; float ss = 0.f;
#pragma unroll
                        for (int n2 = 0; n2 < 2; ++n2) { const f32x4 a = acc[2 * hh + n2][mf] * r0; ss += a[0] * a[0] + a[1] * a[1] + a[2] * a[2] + a[3] * a[3]; }
                        const float rr = rsqrtf(red_q(ss) * (1.f / 32.f) + EPS) * r0;
                        bf16_t* dst = c.ws<bf16_t>(WS_QD) + ((size_t)(b * 4 + h) * KEYS + key) * 96 + 64 + 4 * q;
#pragma unroll
                        for (int n2 = 0; n2 < 2; ++n2) { const f32x4 gg = *(const f32x4*)(qg + 64 + 16 * n2 + 4 * q); const f32x4 a = acc[2 * hh + n2][mf];
                            float v0 = a[0] * rr * gg[0], v1 = a[1] * rr * gg[1], v2 = a[2] * rr * gg[2], v3 = a[3] * rr * gg[3];
                            if (!isctx) { const f32x2 cs = *(const f32x2*)(cosD + pos * 16 + 8 * n2 + 2 * q), sn = *(const f32x2*)(sinD + pos * 16 + 8 * n2 + 2 * q);
                                rope2(v0, v1, cs[0], sn[0]); rope2(v2, v3, cs[1], sn[1]); }
                            *(u32x2*)(dst + 16 * n2) = (u32x2){pk2(v0 * sc, v1 * sc), pk2(v2 * sc, v3 * sc)}; } }
                }
            }
        });
    }
    for (; it < C_SGU_ITEMS + C_TQ + C_TKV; it += c.nb) {
        const int t = it - C_SGU_ITEMS - C_TQ, mt = t >> 2, h = t & 3, m0 = mt * 256;
        GemmDesc g; g.rowidx = nullptr; g.nvalid = 0; g.ksplit = 1 << 30; g.lda = INC;
        g.A = P + OFF_DCKV; g.K = 128; g.B0 = c.ws<bf16_t>(WS_WKVB) + (size_t)l * 512 * 128; g.B1 = g.B0; g.ldb = 128;
        gemm_tile<2, 4>(g, m0, h * 128, c.lds, c.tid, [&](const f32x4 (&acc)[4][4], int mb, int nbase, int lane) {
            const int q = lane >> 4, li = lane & 15, wn = (nbase >> 6) & 1;
            const float* kg = c.in(I_MLAKG) + l * 96;
#pragma unroll
            for (int mf = 0; mf < 4; ++mf) { const int m = m0 + mb + 16 * mf + li;
                int b, pos, key; bool ic; tok_info(m, b, pos, key, ic);
                const float* sp = c.ws<float>(WS_SSQ) + (size_t)m * 8;
                const float r0 = rsqrtf((sp[4] + sp[5]) * (1.f / 128.f) + EPS);
                if (wn == 0) {
                    float ss = 0.f;
#pragma unroll
                    for (int nf = 0; nf < 4; ++nf) { const f32x4 a = acc[nf][mf] * r0; ss += a[0] * a[0] + a[1] * a[1] + a[2] * a[2] + a[3] * a[3]; }
                    const float rr = rsqrtf(red_q(ss) * (1.f / 64.f) + EPS) * r0;
                    bf16_t* dst = c.ws<bf16_t>(WS_KD) + ((size_t)(b * 4 + h) * KEYS + key) * 96 + 4 * q;
#pragma unroll
                    for (int nf = 0; nf < 4; ++nf) { const f32x4 gg = *(const f32x4*)(kg + 16 * nf + 4 * q); const f32x4 a = acc[nf][mf];
                        *(u32x2*)(dst + 16 * nf) = (u32x2){pk2(a[0] * rr * gg[0], a[1] * rr * gg[1]), pk2(a[2] * rr * gg[2], a[3] * rr * gg[3])}; }
                } else {
                    bf16_t* dst = c.ws<bf16_t>(WS_VDT) + ((size_t)(b * 4 + h) * 64 + 4 * q) * KEYS + key;
#pragma unroll
                    for (int nf = 0; nf < 4; ++nf) { const f32x4 a = acc[nf][mf] * r0; const unsigned p0 = pk2(a[0], a[1]), p1 = pk2(a[2], a[3]);
                        bf16_t* d = dst + (size_t)(16 * nf) * KEYS;
                        d[0] = (bf16_t)(p0 & 0xffffu); d[KEYS] = (bf16_t)(p0 >> 16); d[2 * KEYS] = (bf16_t)(p1 & 0xffffu); d[3 * KEYS] = (bf16_t)(p1 >> 16); }
                }
            }
        });
    }
}

constexpr int AT_KN = 0, AT_KR = 8192, AT_V = 12288, AT_STAGE = 21504, AT_VLD = 136;
constexpr int AT_CV = 2 * AT_STAGE;
template <int DK, bool CV>
DEV void attn_item(const Ctx& c, const bf16_t* Q, const bf16_t* K, const bf16_t* Vt, int nkeys, bf16_t* Yrow, LAS char* lds, int tid, float mref) {
    const int lane = tid & 63, wave = tid >> 6, l31 = lane & 31, h5 = lane >> 5;
    f32x4 cv0 = (f32x4){0.f, 0.f, 0.f, 0.f}, cv1 = cv0;
    auto cv_decode = [&](int j, const float*& W, bf16_t*& WT, int& Kd, int& Nd, int& kt, int& ntl, int& mode) {
        const int item = c.bid + 256 * j, l = c.layer;
        if (item < T_UP) { const int e = item / 128, q = item % 128; W = c.in(I_WUP) + ((size_t)l * 16 + e) * 1024 * 512; Kd = 1024; Nd = 512; WT = c.ws<bf16_t>(WS_WUP) + (size_t)e * 512 * 1024; kt = q / 8; ntl = q % 8; mode = 1; }
        else { const int r = item - T_UP, e = r / 64, q = r % 64; W = c.in(I_WDN) + ((size_t)l * 16 + e) * 256 * 1024; Kd = 256; Nd = 1024; WT = c.ws<bf16_t>(WS_WDN) + (size_t)e * 1024 * 256; kt = q / 16; ntl = q % 16; mode = 0; }
    };
    auto cv_load = [&](int j) { const float* W; bf16_t* WT; int Kd, Nd, kt, ntl, mode; cv_decode(j, W, WT, Kd, Nd, kt, ntl, mode);
        const float* src = W + (size_t)(kt * 64 + (tid >> 4)) * Nd + ntl * 64 + (tid & 15) * 4;
        cv0 = *(const f32x4*)src; cv1 = *(const f32x4*)(src + (size_t)32 * Nd); };
    auto cv_lds = [&]() { LAS float* scr = (LAS float*)(lds + AT_CV); const int n4 = (tid & 15) * 4, kr = tid >> 4;
#pragma unroll
        for (int e = 0; e < 4; ++e) { scr[kr * 65 + n4 + e] = cv0[e]; scr[(kr + 32) * 65 + n4 + e] = cv1[e]; } };
    auto cv_store = [&](int j) { const float* W; bf16_t* WT; int Kd, Nd, kt, ntl, mode; cv_decode(j, W, WT, Kd, Nd, kt, ntl, mode);
        LAS const float* scr = (LAS const float*)(lds + AT_CV);
        const int nl = tid >> 3, kcq = tid & 7, n = ntl * 64 + nl;
        int drow = n;
        if (mode == 1) { const int type = n >> 8, jj = n & 255; drow = 128 * (jj >> 6) + 64 * ((jj >> 5) & 1) + 16 * (((jj >> 4) & 1) + 2 * type) + (jj & 15); }
        unsigned o[4];
#pragma unroll
        for (int e = 0; e < 4; ++e) o[e] = pk2(scr[(kcq * 8 + 2 * e) * 65 + nl], scr[(kcq * 8 + 2 * e + 1) * 65 + nl]);
        *(u32x4*)(WT + (size_t)drow * Kd + kt * 64 + kcq * 8) = (u32x4){o[0], o[1], o[2], o[3]}; };
    constexpr int NS = DK / 16;
    bf16x8 qf[NS];
#pragma unroll
    for (int s = 0; s < NS; ++s) qf[s] = *(const bf16x8*)(Q + (size_t)(32 * wave + l31) * DK + 16 * s + 8 * h5);
    f32x16 oacc[2];
#pragma unroll
    for (int i = 0; i < 16; ++i) { oacc[0][i] = 0.f; oacc[1][i] = 0.f; }
    float lsum = 0.f;
    const int kr_ = tid >> 3, kc_ = tid & 7;
    const int rr_ = (tid >> 2) & 63, rc_ = tid & 3;
    u32x4 rk, rv, rrp;
    const int nt = nkeys / 64;
    auto gload = [&](int t) {
        const int k0 = t * 64;
        rk = *(const u32x4*)(K + (size_t)(k0 + kr_) * DK + kc_ * 8); rv = *(const u32x4*)(Vt + (size_t)kr_ * KEYS + k0 + kc_ * 8);
        if (DK == 96 && tid < 256) rrp = *(const u32x4*)(K + (size_t)(k0 + rr_) * DK + 64 + rc_ * 8);
    };
    auto lstore = [&](int st) {
        LAS char* base = lds + st * AT_STAGE;
        { const int r = kr_;
            *(LAS u32x4*)(base + AT_KN + r * 128 + ((kc_ ^ ((r >> 1) & 7)) << 4)) = rk;
            LAS char* vd = base + AT_V + r * AT_VLD + kc_ * 16;
            *(LAS u32x2*)vd = (u32x2){rv[0], rv[1]}; *(LAS u32x2*)(vd + 8) = (u32x2){rv[2], rv[3]}; }
        if (DK == 96 && tid < 256) *(LAS u32x4*)(base + AT_KR + rr_ * 64 + ((rc_ ^ ((rr_ >> 2) & 3)) << 4)) = rrp;
    };
    __syncthreads();
    gload(0); lstore(0);
    __syncthreads();
    int cvj = 0, cvp = 0;
    for (int t = 0; t < nt; ++t) {
        const int cur = t & 1;
        if (t + 1 < nt) gload(t + 1);
        if (CV && cvj < 12) { if (cvp == 0) cv_load(cvj); else if (cvp == 2) cv_store(cvj); }
        LAS const char* base = lds + cur * AT_STAGE;
        f32x16 sacc[2];
        {
            bf16x8 kf[2][NS];
#pragma unroll
            for (int kt2 = 0; kt2 < 2; ++kt2) {
                const int row = 32 * kt2 + l31;
#pragma unroll
                for (int s = 0; s < 4; ++s) kf[kt2][s] = lds_r128(base + AT_KN + row * 128 + (((2 * s + h5) ^ ((row >> 1) & 7)) << 4));
                if (DK == 96) {
#pragma unroll
                    for (int s = 0; s < 2; ++s) kf[kt2][4 + s] = lds_r128(base + AT_KR + row * 64 + (((2 * s + h5) ^ ((row >> 2) & 3)) << 4));
                }
            }
            __builtin_amdgcn_sched_barrier(0);
#pragma unroll
            for (int kt2 = 0; kt2 < 2; ++kt2) {
#pragma unroll
                for (int i = 0; i < 16; ++i) sacc[kt2][i] = -mref;
#pragma unroll
                for (int s = 0; s < NS; ++s) sacc[kt2] = __builtin_amdgcn_mfma_f32_32x32x16_bf16(kf[kt2][s], qf[s], sacc[kt2], 0, 0, 0);
            }
        }
        bf16x8 vf[2][2][2];
#pragma unroll
        for (int dt = 0; dt < 2; ++dt)
#pragma unroll
            for (int kt2 = 0; kt2 < 2; ++kt2)
#pragma unroll
                for (int s2 = 0; s2 < 2; ++s2) {
                    LAS const char* vp = base + AT_V + (32 * dt + l31) * AT_VLD + (32 * kt2 + 16 * s2 + 4 * h5) * 2;
                    const u32x2 lo = *(LAS const u32x2*)vp, hi = *(LAS const u32x2*)(vp + 16);
                    vf[dt][kt2][s2] = __builtin_bit_cast(bf16x8, (u32x4){lo[0], lo[1], hi[0], hi[1]});
                }
        __builtin_amdgcn_sched_barrier(0);
        float ps = 0.f;
#pragma unroll
        for (int kt2 = 0; kt2 < 2; ++kt2)
#pragma unroll
            for (int i = 0; i < 16; ++i) { const float p = __builtin_amdgcn_exp2f(sacc[kt2][i]); sacc[kt2][i] = p; ps += p; }
        lsum += ps;
        bf16x8 pf[2][2];
#pragma unroll
        for (int kt2 = 0; kt2 < 2; ++kt2)
#pragma unroll
            for (int s2 = 0; s2 < 2; ++s2) {
                u32x4 w;
#pragma unroll
                for (int j = 0; j < 4; ++j) w[j] = pk2(sacc[kt2][8 * s2 + 2 * j], sacc[kt2][8 * s2 + 2 * j + 1]);
                pf[kt2][s2] = __builtin_bit_cast(bf16x8, w);
            }
#pragma unroll
        for (int dt = 0; dt < 2; ++dt)
#pragma unroll
            for (int kt2 = 0; kt2 < 2; ++kt2)
#pragma unroll
                for (int s2 = 0; s2 < 2; ++s2) oacc[dt] = __builtin_amdgcn_mfma_f32_32x32x16_bf16(vf[dt][kt2][s2], pf[kt2][s2], oacc[dt], 0, 0, 0);
        if (CV && cvj < 12) { if (cvp == 1) cv_lds(); if (++cvp == 3) { cvp = 0; ++cvj; } }
        if (t + 1 < nt) lstore(cur ^ 1);
        __syncthreads();
    }
    const float ltot = lsum + xlane<32>(lsum), inv = 1.f / ltot;
    bf16_t* yr = Yrow + (size_t)(32 * wave + l31) * 1024;
#pragma unroll
    for (int dt = 0; dt < 2; ++dt)
#pragma unroll
        for (int g = 0; g < 4; ++g) {
            const int d0 = 32 * dt + 8 * g + 4 * h5;
            *(u32x2*)(yr + d0) = (u32x2){pk2(oacc[dt][4 * g] * inv, oacc[dt][4 * g + 1] * inv), pk2(oacc[dt][4 * g + 2] * inv, oacc[dt][4 * g + 3] * inv)};
        }
}
DEV void phase_d(const Ctx& c) {
    const int nlat = 512, nctx = (c.layer == NL - 1) ? 0 : 64;
    bf16_t* Y = c.ws<bf16_t>(WS_ACT);
    float mrefC, mrefD;
    {
        const int lane = c.tid & 63, l = c.layer;
        auto wmax = [](float v) { return wave_max(v); };
        const float gq = wmax(fabsf(c.in(I_GQAQG)[l * 64 + lane])), gk = wmax(fabsf(c.in(I_GQAKG)[l * 64 + lane]));
        mrefC = 64.f * gq * gk * C_SCALE * LOG2E - 40.f;
        const float* mq = c.in(I_MLAQG) + l * 96; const float* mk = c.in(I_MLAKG) + l * 96;
        const float qn = wmax(fabsf(mq[lane])), qr = wmax(fabsf(mq[64 + (lane & 31)])), kn = wmax(fabsf(mk[lane])), kr = wmax(fabsf(mk[64 + (lane & 31)]));
        mrefD = sqrtf((64.f * qn * qn + 32.f * qr * qr) * (64.f * kn * kn + 32.f * kr * kr)) * D_SCALE * LOG2E - 40.f;
    }
    for (int it = c.bid; it < nlat + nctx; it += c.nb) {
        int type, b, h, qpos0, nkeys, tok0;
        if (it < nlat) {
            type = it >> 8; const int r = it & 255, pr = 4 * (r & 7) + (r >> 6), qb = (r >> 3) & 7; b = pr >> 2; h = pr & 3; qpos0 = CL + 256 * qb; nkeys = KEYS; tok0 = b * SEQ + 256 * qb; }
        else { const int u = it - nlat; type = u >> 5; const int r = u & 31; b = r >> 2; h = r & 3; qpos0 = 0; nkeys = CL; tok0 = NLAT + b * CL; }
        if (type == 0) {
            const bf16_t* Qp = c.ws<bf16_t>(WS_QD) + ((size_t)(b * 4 + h) * KEYS + qpos0) * 96; const bf16_t* Kp = c.ws<bf16_t>(WS_KD) + (size_t)(b * 4 + h) * KEYS * 96;
            const bf16_t* Vp = c.ws<bf16_t>(WS_VDT) + (size_t)(b * 4 + h) * 64 * KEYS; bf16_t* Yp = Y + (size_t)tok0 * 1024 + 768 + 64 * h;
            if (it < 256 && c.nb == 256) attn_item<96, true>(c, Qp, Kp, Vp, nkeys, Yp, c.lds, c.tid, mrefD);
            else attn_item<96, false>(c, Qp, Kp, Vp, nkeys, Yp, c.lds, c.tid, mrefD);
        } else {
            attn_item<64, false>(c, c.ws<bf16_t>(WS_QC) + ((size_t)(b * 4 + h) * KEYS + qpos0) * 64, c.ws<bf16_t>(WS_KC) + (size_t)(b * 2 + (h >> 1)) * KEYS * 64,
                          c.ws<bf16_t>(WS_VCT) + (size_t)(b * 2 + (h >> 1)) * 64 * KEYS, nkeys, Y + (size_t)tok0 * 1024 + 512 + 64 * h, c.lds, c.tid, mrefC);
        }
    }
}

DEV void phase_e0(const Ctx& c) {
    const int tid = c.tid, lane = tid & 63, wave = tid >> 6, l = c.layer;
    bf16_t* Y = c.ws<bf16_t>(WS_ACT); const bf16_t* P = c.ws<bf16_t>(WS_P);
    const float* gg = c.in(I_GGO) + l * 1024;
    const int ntok = c.ntok_tail();
    const int ch = 4 * lane;
    const float* cw = c.in(I_CONVW) + l * 768 + ch;
    const f32x4 w0 = *(const f32x4*)cw, w1 = *(const f32x4*)(cw + 256), w2 = *(const f32x4*)(cw + 512);
    f32x4 gn[4];
#pragma unroll
    for (int g = 0; g < 4; ++g) gn[g] = *(const f32x4*)(gg + g * 256 + ch);
    const int nwv = c.nb * NW, per = (ntok + nwv - 1) / nwv, tbeg = (c.bid * NW + wave) * per, tend = min(tbeg + per, ntok);
#pragma unroll 1
    for (int t0 = tbeg; t0 < tend; t0 += 2) {
        u32x2 ya[2], yc[2], yd[2], rbb[2], c0[2], x0[2], c1[2], x1[2], c2[2], x2[2]; float mp[2], mn[2];
#pragma unroll
        for (int u = 0; u < 2; ++u) { const int tok = min(t0 + u, tend - 1);
            int b, pos, key; bool isctx; tok_info(tok, b, pos, key, isctx);
            const int seqlen = isctx ? CL : SEQ;
            const bf16_t* pr = P + (size_t)tok * INC; const bf16_t* yr = Y + (size_t)tok * 1024;
            ya[u] = *(const u32x2*)(yr + ch); yc[u] = *(const u32x2*)(yr + 512 + ch); yd[u] = *(const u32x2*)(yr + 768 + ch);
            rbb[u] = *(const u32x2*)(pr + OFF_BB + ch);
            const bool okp = pos > 0, okn = pos < seqlen - 1;
            c0[u] = *(const u32x2*)(pr - (okp ? INC : 0) + OFF_BC + ch); x0[u] = *(const u32x2*)(pr - (okp ? INC : 0) + OFF_BX + ch);
            c1[u] = *(const u32x2*)(pr + OFF_BC + ch); x1[u] = *(const u32x2*)(pr + OFF_BX + ch);
            c2[u] = *(const u32x2*)(pr + (okn ? INC : 0) + OFF_BC + ch); x2[u] = *(const u32x2*)(pr + (okn ? INC : 0) + OFF_BX + ch);
            mp[u] = okp ? 1.f : 0.f; mn[u] = okn ? 1.f : 0.f; }
#pragma unroll
        for (int u = 0; u < 2; ++u) { const int tok = t0 + u;
            if (tok < tend) {
                bf16_t* yr = Y + (size_t)tok * 1024;
                float v[4][4];
                v[0][0] = bflo(ya[u][0]); v[0][1] = bfhi(ya[u][0]); v[0][2] = bflo(ya[u][1]); v[0][3] = bfhi(ya[u][1]);
                v[2][0] = bflo(yc[u][0]); v[2][1] = bfhi(yc[u][0]); v[2][2] = bflo(yc[u][1]); v[2][3] = bfhi(yc[u][1]);
                v[3][0] = bflo(yd[u][0]); v[3][1] = bfhi(yd[u][0]); v[3][2] = bflo(yd[u][1]); v[3][3] = bfhi(yd[u][1]);
                {
                    const float zp[4] = {mp[u] * bflo(c0[u][0]) * bflo(x0[u][0]), mp[u] * bfhi(c0[u][0]) * bfhi(x0[u][0]), mp[u] * bflo(c0[u][1]) * bflo(x0[u][1]), mp[u] * bfhi(c0[u][1]) * bfhi(x0[u][1])};
                    const float zc[4] = {bflo(c1[u][0]) * bflo(x1[u][0]), bfhi(c1[u][0]) * bfhi(x1[u][0]), bflo(c1[u][1]) * bflo(x1[u][1]), bfhi(c1[u][1]) * bfhi(x1[u][1])};
                    const float zn[4] = {mn[u] * bflo(c2[u][0]) * bflo(x2[u][0]), mn[u] * bfhi(c2[u][0]) * bfhi(x2[u][0]), mn[u] * bflo(c2[u][1]) * bflo(x2[u][1]), mn[u] * bfhi(c2[u][1]) * bfhi(x2[u][1])};
                    const float bb[4] = {bflo(rbb[u][0]), bfhi(rbb[u][0]), bflo(rbb[u][1]), bfhi(rbb[u][1])};
#pragma unroll
                    for (int j = 0; j < 4; ++j) v[1][j] = bb[j] * (w0[j] * zp[j] + w1[j] * zc[j] + w2[j] * zn[j]);
                }
                float ss[4];
#pragma unroll
                for (int g = 0; g < 4; ++g) ss[g] = v[g][0] * v[g][0] + v[g][1] * v[g][1] + v[g][2] * v[g][2] + v[g][3] * v[g][3];
#pragma unroll
                for (int g = 0; g < 4; ++g) ss[g] = wave_sum(ss[g]);
#pragma unroll
                for (int g = 0; g < 4; ++g) { const float r = rsqrtf(ss[g] * (1.f / 256.f) + EPS);
                    *(u32x2*)(yr + g * 256 + ch) = (u32x2){pk2(v[g][0] * r * gn[g][0], v[g][1] * r * gn[g][1]), pk2(v[g][2] * r * gn[g][2], v[g][3] * r * gn[g][3])}; }
            } }
    }
}
DEV void e_store_row4(const Ctx& c, int m, int n, const f32x4& a) {
    const float* gate = c.modv(m < NLAT ? (m >> 11) : 8, 2);
    const f32x4 gt = *(const f32x4*)(gate + n), xv = c.xload4(m, n);
    c.xsstore4(m, n, xv[0] + gt[0] * a[0], xv[1] + gt[1] * a[1], xv[2] + gt[2] * a[2], xv[3] + gt[3] * a[3]);
}
DEV void phase_e(const Ctx& c) {
    GemmDesc g; g.A = c.ws<bf16_t>(WS_ACT); g.lda = 1024; g.rowidx = nullptr; g.nvalid = 0;
    g.B0 = c.ws<bf16_t>(WS_WOUT) + (size_t)c.layer * 1024 * 1024; g.B1 = g.B0; g.ldb = 1024; g.ksplit = 1 << 30; g.K = 1024;
    const int nfull = (NLAT / 256) * 4, nhalf = (c.layer == NL - 1) ? 0 : (NCTX / 256) * 8;
    for (int t = c.bid; t < nfull + nhalf; t += c.nb) {
        if (t < nfull) { const int m0 = (t >> 2) * 256, n0 = (t & 3) * 256;
            gemm_tile8p(g, m0, n0, c.lds, c.tid, [&](const f32x4 (&acc)[2][2][4][2], int wr, int wc, int lane) {
                const float* gate = c.modv(m0 >> 11, 2) + n0 + 64 * wc + 4 * (lane >> 4);
                f32x4 gt[2][2];
#pragma unroll
                for (int bj = 0; bj < 2; ++bj)
#pragma unroll
                    for (int n = 0; n < 2; ++n) gt[bj][n] = *(const f32x4*)(gate + 32 * bj + 16 * n);
#pragma unroll
                for (int ai = 0; ai < 2; ++ai)
#pragma unroll
                    for (int m = 0; m < 4; ++m) { const int row = m0 + 128 * ai + 64 * wr + 16 * m + (lane & 15);
#pragma unroll
                        for (int bj = 0; bj < 2; ++bj)
#pragma unroll
                            for (int n = 0; n < 2; ++n) { const int col = n0 + 64 * wc + 32 * bj + 16 * n + 4 * (lane >> 4); const f32x4 xv = c.xload4(row, col), a = acc[ai][bj][m][n], gg = gt[bj][n];
                                c.xsstore4(row, col, xv[0] + gg[0] * a[0], xv[1] + gg[1] * a[1], xv[2] + gg[2] * a[2], xv[3] + gg[3] * a[3]); } }
            });
            publish_rel(c, c.ws<unsigned>(WS_RDYE) + (c.layer * 128 + (t >> 2)) * 16, 2u); }
        else { const int u = t - nfull, m0 = NLAT + (u >> 3) * 256;
            gemm_tile<2, 4>(g, m0, (u & 7) * 128, c.lds, c.tid, [&](const f32x4 (&acc)[4][4], int mb, int nbase, int lane) {
#pragma unroll
                for (int mf = 0; mf < 4; ++mf)
#pragma unroll
                    for (int nf = 0; nf < 4; ++nf) { const int p = nbase + 16 * nf + 4 * (lane >> 4);
                        e_store_row4(c, m0 + mb + 16 * mf + (lane & 15), (p & ~255) | (((p >> 5) & 3) << 6) | (((p >> 7) & 1) << 5) | (p & 31), acc[nf][mf]); }
            });
            publish_rel(c, c.ws<unsigned>(WS_RDYE) + (c.layer * 128 + NLAT / 256 + (u >> 3)) * 16, 1u); }
    }
}

DEV void phase_f_item(const Ctx& c, int nseg, int sbase, int sstride) {
    const int tid = c.tid, lane = tid & 63, wave = tid >> 6, l = c.layer, li = lane & 15, q = lane >> 4;
    LAS float* part = (LAS float*)c.lds;
    LAS float* rs = part + 8 * 96 * 32;
    LAS int* hist = (LAS int*)(rs + 96);
    LAS int* hbase = hist + 32;
    int* cnt = c.ws<int>(WS_CNT) + l * NBUCKET * 32;
    int* ltok = c.ws<int>(WS_LTOK); float* lw = c.ws<float>(WS_LW);
    bf16_t* H = c.ws<bf16_t>(WS_ACT);
    __syncthreads();
    if (tid < 32) hist[tid] = 0;
#pragma unroll 1
    for (int sg = 0; sg < nseg; ++sg) wait_ready(c, c.ws<unsigned>(WS_RDYE) + (l * 128 + ((sbase + sstride * sg) >> 3)) * 16, 8u);
    __syncthreads();
#pragma unroll 1
    for (int sg = 0; sg < nseg; ++sg) {
        const int tokb = 32 * (sbase + sstride * sg), mb = tokb < NLAT ? (tokb >> 11) : 8;
        u32x4 r0[4], r1[4];
#pragma unroll
        for (int u = 0; u < 4; ++u) { const bf16_t* xr = c.xs(tokb + 4 * wave + u); r0[u] = *(const u32x4*)(xr + 8 * lane); r1[u] = *(const u32x4*)(xr + 512 + 8 * lane); }
        f32x4 g0[2], g1[2], s0[2], s1[2];
        { const float* gmv = c.ws<float>(WS_GM) + (size_t)(l * 9 + mb) * 1024; const float* sh = c.modv(mb, 3);
#pragma unroll
          for (int hf = 0; hf < 2; ++hf) { const int e = 512 * hf + 8 * lane; g0[hf] = *(const f32x4*)(gmv + e); g1[hf] = *(const f32x4*)(gmv + e + 4); s0[hf] = *(const f32x4*)(sh + e); s1[hf] = *(const f32x4*)(sh + e + 4); } }
        f32x4 acc[2][2];
#pragma unroll
        for (int a = 0; a < 2; ++a)
#pragma unroll
            for (int b = 0; b < 2; ++b) acc[a][b] = (f32x4){0.f, 0.f, 0.f, 0.f};
        const bf16_t* xrow = c.xs(tokb + li) + 128 * wave + 8 * q;
        const bf16_t* wrow = c.ws<bf16_t>(WS_RW) + (size_t)(l * 9 + mb) * 2 * 32 * 1024 + (size_t)li * 1024 + 128 * wave + 8 * q;
#pragma unroll
        for (int ks = 0; ks < 4; ++ks) {
            bf16x8 xf[2], wf[2][2];
#pragma unroll
            for (int hl = 0; hl < 2; ++hl)
#pragma unroll
                for (int nf = 0; nf < 2; ++nf) wf[hl][nf] = *(const bf16x8*)(wrow + (size_t)(hl * 32 + nf * 16) * 1024 + 32 * ks);
#pragma unroll
            for (int mf = 0; mf < 2; ++mf) xf[mf] = *(const bf16x8*)(xrow + (size_t)mf * 16 * DM + 32 * ks);
#pragma unroll
            for (int mf = 0; mf < 2; ++mf)
#pragma unroll
                for (int hl = 0; hl < 2; ++hl)
#pragma unroll
                    for (int nf = 0; nf < 2; ++nf) acc[nf][mf] = __builtin_amdgcn_mfma_f32_16x16x32_bf16(wf[hl][nf], xf[mf], acc[nf][mf], 0, 0, 0);
        }
#pragma unroll
        for (int mf = 0; mf < 2; ++mf)
#pragma unroll
            for (int nf = 0; nf < 2; ++nf) *(LAS f32x4*)(part + ((wave * 96 + 32 * sg + 16 * mf + li) * 32 + 16 * nf + 4 * q)) = acc[nf][mf];
#pragma unroll
        for (int u = 0; u < 4; ++u) { const int t = 32 * sg + 4 * wave + u, tok = tokb + 4 * wave + u;
            float v[16];
#pragma unroll
            for (int j = 0; j < 4; ++j) { v[2 * j] = bflo(r0[u][j]); v[2 * j + 1] = bfhi(r0[u][j]); v[8 + 2 * j] = bflo(r1[u][j]); v[8 + 2 * j + 1] = bfhi(r1[u][j]); }
            float ss = 0.f;
#pragma unroll
            for (int j = 0; j < 16; ++j) ss += v[j] * v[j];
            const float rr = rsqrtf(wave_sum(ss) * (1.f / 1024.f) + EPS);
            if (lane == 0) rs[t] = rr;
#pragma unroll
            for (int hf = 0; hf < 2; ++hf) { const int e = 512 * hf + 8 * lane;
                const float* vv = v + 8 * hf;
                *(u32x4*)(H + (size_t)tok * 1024 + e) = (u32x4){pk2(vv[0] * rr * g0[hf][0] + s0[hf][0], vv[1] * rr * g0[hf][1] + s0[hf][1]), pk2(vv[2] * rr * g0[hf][2] + s0[hf][2], vv[3] * rr * g0[hf][3] + s0[hf][3]),
                                                                  pk2(vv[4] * rr * g1[hf][0] + s1[hf][0], vv[5] * rr * g1[hf][1] + s1[hf][1]), pk2(vv[6] * rr * g1[hf][2] + s1[hf][2], vv[7] * rr * g1[hf][3] + s1[hf][3])}; }
        }
    }
    __syncthreads();
    int bucket = 0, rank = 0, mytok = 0; float wa = 0.f, wb = 0.f;
    if (tid < 32 * nseg) {
        const int t = tid, tok = 32 * (sbase + sstride * (t >> 5)) + (t & 31), mb = tok < NLAT ? (tok >> 11) : 8;
        mytok = tok;
        float s[20];
#pragma unroll
        for (int j = 0; j < 20; ++j) { float a = 0.f;
#pragma unroll
            for (int w = 0; w < NW; ++w) a += part[(w * 96 + t) * 32 + j];
            s[j] = a; }
            const float* RC = c.ws<float>(WS_RC) + (l * 9 + mb) * 32;
        const float r = rs[t];
        float gl[4], el[4];
#pragma unroll
        for (int j = 0; j < 4; ++j) gl[j] = r * s[j] + RC[j];
        int gi = 0; float gmx = gl[0];
#pragma unroll
        for (int j = 1; j < 4; ++j) if (gl[j] > gmx) { gmx = gl[j]; gi = j; }
        float gs = 0.f;
#pragma unroll
        for (int j = 0; j < 4; ++j) gs += __expf(gl[j] - gmx);
        const float gw = 1.f / gs;
#pragma unroll
        for (int j = 0; j < 4; ++j) { const float sj = gi == 0 ? s[4 + j] : (gi == 1 ? s[8 + j] : (gi == 2 ? s[12 + j] : s[16 + j])); el[j] = r * sj + RC[4 + 4 * gi + j]; }
        int e1 = 0; float m1 = el[0];
#pragma unroll
        for (int j = 1; j < 4; ++j) if (el[j] > m1) { m1 = el[j]; e1 = j; }
        int e2 = -1; float m2 = -3.0e38f;
#pragma unroll
        for (int j = 0; j < 4; ++j) if (j != e1 && el[j] > m2) { m2 = el[j]; e2 = j; }
        const float p2 = __expf(m2 - m1), w1 = gw / (1.f + p2), w2 = gw * p2 / (1.f + p2);
        const int ea = e1 < e2 ? e1 : e2, eb = e1 < e2 ? e2 : e1; wa = e1 < e2 ? w1 : w2; wb = e1 < e2 ? w2 : w1;
        const int pidx = ea == 0 ? eb - 1 : (ea == 1 ? eb + 1 : 5);
        bucket = gi * 6 + pidx;
        rank = __hip_atomic_fetch_add(hist + bucket, 1, __ATOMIC_RELAXED, __HIP_MEMORY_SCOPE_WORKGROUP);
    }
    __syncthreads();
    if (tid < NBUCKET) { const int n = hist[tid]; hbase[tid] = n > 0 ? atomicAdd(&cnt[tid * 32], n) : 0; }
    __syncthreads();
    if (tid < 32 * nseg) {
        const int pos = hbase[bucket] + rank;
        ltok[bucket * NTOK + pos] = mytok;
        lw[((size_t)bucket * NTOK + pos) * 2] = wa; lw[((size_t)bucket * NTOK + pos) * 2 + 1] = wb;
    }
}
DEV void phase_f(const Ctx& c) {
    if (c.nb == 256) {
        if (c.layer == NL - 1) phase_f_item(c, 2, 2 * c.bid, 1);
        else if (c.bid < 64) phase_f_item(c, 1, NLAT / 32 + c.bid, 0);
        else { const int k = c.bid - 64; phase_f_item(c, k < 128 ? 3 : 2, k, 192); }
    } else {
        for (int sgi = c.bid; sgi < c.ntok_tail() / 32; sgi += c.nb) phase_f_item(c, 1, sgi, 0);
    }
}

DEV void moe_find(const int* cnt, int mg, int& bucket, int& mt, int& total) {
    int acc = 0; bucket = -1; mt = 0;
    for (int b = 0; b < NBUCKET; ++b) { const int n = (cnt[b * 32] + 255) >> 8; if (bucket < 0 && mg < acc + n) { bucket = b; mt = mg - acc; } acc += n; }
    total = acc;
}
DEV void pair_of(int pidx, int& ea, int& eb) { ea = pidx < 3 ? 0 : (pidx < 5 ? 1 : 2); eb = pidx < 3 ? pidx + 1 : (pidx < 5 ? pidx - 1 : 3); }
template <int WN_, int MF>
DEV void g_tile(const Ctx& c, const int* cnt, int mg, int nt8) {
    const int l = c.layer; (void)l;
    int bucket, mt, tt; moe_find(cnt, mg, bucket, mt, tt);
    int ea, eb; pair_of(bucket % 6, ea, eb); const int grp = bucket / 6;
    const int e = grp * 4 + ((nt8 < 4) ? ea : eb);
    const int nvalid = min(256, cnt[bucket * 32] - mt * 256);
    const int* rows = c.ws<int>(WS_LTOK) + bucket * NTOK + mt * 256;
    const float* wts = c.ws<float>(WS_LW) + ((size_t)bucket * NTOK + mt * 256) * 2 + ((nt8 < 4) ? 0 : 1);
    bf16_t* HB = c.ws<bf16_t>(WS_HBUF);
    GemmDesc g; g.A = c.ws<bf16_t>(WS_ACT); g.lda = 1024; g.rowidx = rows; g.nvalid = nvalid;
    g.B0 = c.ws<bf16_t>(WS_WUP) + (size_t)e * 512 * 1024; g.B1 = g.B0; g.ldb = 1024; g.ksplit = 1 << 30; g.K = 1024;
    const int hcol0 = (nt8 >> 2) * 256 + (nt8 & 3) * 64;
    gemm_tile<WN_, MF>(g, 0, (nt8 & 3) * 128, c.lds, c.tid, [&](const f32x4 (&acc)[4][MF], int mb, int nbase, int lane) {
        const int slot = ((nbase - (nt8 & 3) * 128) >> 6);
#pragma unroll
        for (int mf = 0; mf < MF; ++mf) { const int r = mb + 16 * mf + (lane & 15); const bool ok = r < nvalid; const float w = ok ? wts[2 * r] : 0.f;
#pragma unroll
            for (int f = 0; f < 2; ++f) { const f32x4 gt = acc[f][mf], up = acc[f + 2][mf]; float o[4];
#pragma unroll
                for (int j = 0; j < 4; ++j) o[j] = ok ? silu_f(gt[j]) * up[j] * w : 0.f;
                __hip_atomic_store((GAS unsigned long long*)(HB + ((size_t)mg * 256 + r) * 512 + hcol0 + 32 * slot + 16 * f + 4 * (lane >> 4)),
                                   (unsigned long long)pk2(o[0], o[1]) | ((unsigned long long)pk2(o[2], o[3]) << 32), __ATOMIC_RELAXED, __HIP_MEMORY_SCOPE_AGENT); } }
    });
    asm volatile("s_waitcnt vmcnt(0)" ::: "memory");
    __syncthreads();
    if (c.tid == 0) (void)xb_add(c.ws<unsigned>(WS_RDY) + (c.layer * 128 + mg) * 16, WN_ == 4 ? 2u : 1u);
}
template <int WN_, int MF>
DEV void h_tile(const Ctx& c, const int* cnt, int mg, int nt8) {
    const int l = c.layer;
    int bucket, mt, tt; moe_find(cnt, mg, bucket, mt, tt);
    int ea, eb; pair_of(bucket % 6, ea, eb); const int grp = bucket / 6;
    const int nvalid = min(256, cnt[bucket * 32] - mt * 256);
    const int* rows = c.ws<int>(WS_LTOK) + bucket * NTOK + mt * 256;
    GemmDesc g; g.A = c.ws<bf16_t>(WS_HBUF); g.lda = 512; g.rowidx = nullptr; g.nvalid = 0;
    g.B0 = c.ws<bf16_t>(WS_WDN) + (size_t)(grp * 4 + ea) * 1024 * 256; g.B1 = c.ws<bf16_t>(WS_WDN) + (size_t)(grp * 4 + eb) * 1024 * 256; g.ldb = 256; g.ksplit = 256; g.K = 512;
    if (c.tid < 64) {
        unsigned* rdy = c.ws<unsigned>(WS_RDY) + (c.layer * 128 + mg) * 16; unsigned* bar = c.ws<unsigned>(WS_BAR);
        { unsigned sp_ = 0; while (xb_ld(rdy) < 8u) { __builtin_amdgcn_s_sleep(2); if ((++sp_ & 1023u) == 0u) { if (xb_ld(&bar[XB_TMO])) break; if (sp_ > (1u << 24)) { atomicAdd(&bar[XB_TMO], 1u); break; } } } }
        __builtin_amdgcn_fence(__ATOMIC_ACQUIRE, "agent");
    }
    gemm_tile<WN_, MF>(g, mg * 256, nt8 * 128, c.lds, c.tid, [&](const f32x4 (&acc)[4][MF], int mb, int nbase, int lane) {
#pragma unroll
        for (int mf = 0; mf < MF; ++mf) { const int r = mb + 16 * mf + (lane & 15);
            if (r < nvalid) { const int tok = rows[r]; const int mbi = tok < NLAT ? (tok >> 11) : 8; const float* gate = c.modv(mbi, 5);
#pragma unroll
                for (int nf = 0; nf < 4; ++nf) { const int n = nbase + 16 * nf + 4 * (lane >> 4); const f32x4 gt = *(const f32x4*)(gate + n), xv = c.xsload4(tok, n), a = acc[nf][mf];
                    const float o0 = xv[0] + gt[0] * a[0], o1 = xv[1] + gt[1] * a[1], o2 = xv[2] + gt[2] * a[2], o3 = xv[3] + gt[3] * a[3];
                    if (l == NL - 1) *(f32x4*)(c.p->out + (size_t)tok * DM + n) = (f32x4){o0, o1, o2, o3};
                    else c.xsstore4(tok, n, o0, o1, o2, o3); } } }
    });
}
DEV void phase_g(const Ctx& c) {
    const int* cnt = c.ws<int>(WS_CNT) + c.layer * NBUCKET * 32;
    int total = 0; { int b, m; moe_find(cnt, 0, b, m, total); }
    const int U = total * 4, Ufull = (U / c.nb) * c.nb, R = U - Ufull;
    for (int u = c.bid; u < Ufull; u += c.nb) g_tile<4, 8>(c, cnt, u >> 2, 2 * (u & 3));
    for (int t = c.bid; t < 2 * R; t += c.nb) { const int u = Ufull + (t >> 1); g_tile<2, 4>(c, cnt, u >> 2, 2 * (u & 3) + (t & 1)); }
}
DEV void phase_h(const Ctx& c) {
    const int* cnt = c.ws<int>(WS_CNT) + c.layer * NBUCKET * 32;
    int total = 0; { int b, m; moe_find(cnt, 0, b, m, total); }
    const int U = __builtin_amdgcn_readfirstlane(total * 4), R = U - (U / c.nb) * c.nb;
    int base = 0;
#pragma unroll 1
    for (int s = 0; base < U; ++s) {
        const int thr = s == 0 ? min(2 * R, c.nb) : (s == 1 ? max(0, 2 * R - c.nb) : 0), nw = c.nb - thr, rem = U - base, k = c.bid - thr;
        if (k >= 0) {
            if (rem < nw && 2 * rem <= nw) { if (k < 2 * rem) { const int j = base + (k >> 1); h_tile<2, 4>(c, cnt, j >> 2, 2 * (j & 3) + (k & 1)); } }
            else if (k < rem) { const int j = base + k; h_tile<4, 8>(c, cnt, j >> 2, 2 * (j & 3)); }
        }
        base += nw;
    }
}

constexpr int PH_P0 = 0, PH_A = 1, PH_B = 2, PH_C = 3, PH_D = 4, PH_E0 = 5, PH_E = 6, PH_G = 7, PH_PER_LAYER = 7;
DEV void run_phase(const Ctx& c, int ph) {
    switch (ph) {
        case PH_P0: phase_p0(c); break;
        case PH_A: phase_a(c); break;
        case PH_B: phase_b(c); break;
        case PH_C: phase_c(c); break;
        case PH_D: phase_d(c); break;
        case PH_E0: phase_e0(c); break;
        case PH_E: phase_e(c); phase_f(c); break;
        case PH_G: phase_g(c); phase_h(c); break;
    }
}

extern __shared__ __attribute__((aligned(16))) char smem_dyn[];

struct XcdBarrier { unsigned* bar; unsigned x; volatile LAS unsigned* st; };
DEV XcdBarrier xcd_barrier_post(unsigned* bar, volatile LAS unsigned* st) {
    XcdBarrier b; b.bar = bar; b.x = xb_xcc_id(); b.st = st;
    if (threadIdx.x == 0) (void)xb_add(&bar[XB_XCNT(b.x)], 1u);
    return b;
}
DEV void xcd_barrier_complete(unsigned* bar, unsigned x, unsigned& nloc, unsigned& nx) {
    const unsigned G = gridDim.x * gridDim.y * gridDim.z;
    unsigned sum, cnt, mine, sp = 0u;
    for (;;) {
        sum = 0u; cnt = 0u; mine = 0u;
#pragma unroll
        for (unsigned j = 0; j < 16; ++j) { const unsigned c = xb_ld(&bar[XB_XCNT(j)]); sum += c; cnt += (c > 0u) ? 1u : 0u; mine = (j == x) ? c : mine; }
        if (sum == G) break;
        __builtin_amdgcn_s_sleep(1);
        if ((++sp & 255u) == 0u) { if (xb_ld(&bar[XB_TMO])) break; if (sp > XB_SPIN_CAP) { atomicAdd(&bar[XB_TMO], 1u); break; } }
    }
    nloc = mine > 0u ? mine : 1u; nx = cnt > 0u ? cnt : 1u;
}
DEV void xcd_barrier(const XcdBarrier& b) {
    asm volatile("s_waitcnt vmcnt(0)" ::: "memory");
    __syncthreads();
    if (threadIdx.x == 0) {
        unsigned* bar = b.bar;
        __builtin_amdgcn_s_waitcnt(0);
        unsigned nloc = b.st[0], nx = b.st[1];
        if (nloc == 0u) { xcd_barrier_complete(bar, b.x, nloc, nx); b.st[0] = nloc; b.st[1] = nx; }
        const unsigned old = xb_add(&bar[XB_XSUB(b.x)], 1u);
        const unsigned gen = old / nloc;
        if (old + 1u == (gen + 1u) * nloc) {
            __builtin_amdgcn_fence(__ATOMIC_RELEASE, "agent");
            asm volatile("s_waitcnt vmcnt(0)" ::: "memory");
            const unsigned og = xb_add(&bar[XB_TOP], 1u);
            const unsigned tg = og / nx;
            if (og + 1u == (tg + 1u) * nx) xb_add(&bar[XB_TOPGEN], 1u);
            else XB_SPIN(xb_ld(&bar[XB_TOPGEN]) == tg, bar);
            __builtin_amdgcn_fence(__ATOMIC_ACQUIRE, "agent");
            xb_add(&bar[XB_XGEN(b.x)], 1u);
            asm volatile("s_waitcnt vmcnt(0)" ::: "memory");
        } else {
            XB_SPIN(xb_ld(&bar[XB_XGEN(b.x)]) == gen, bar);
            __builtin_amdgcn_fence(__ATOMIC_ACQUIRE, "agent");
            asm volatile("s_waitcnt vmcnt(0)" ::: "memory");
        }
    }
    __syncthreads();
}
static_assert(XCD_BAR_WORDS * 4 <= 16384, "barrier words");


#if !MODE_SINGLE
__global__ void __launch_bounds__(NTHREADS, 2) k_phase(Params p, int layer, int ph) {
    Ctx c; c.p = (ParamsPtr)__builtin_amdgcn_kernarg_segment_ptr(); c.layer = layer; c.bid = blockIdx.x; c.nb = gridDim.x; c.tid = threadIdx.x; c.lds = (LAS char*)smem_dyn;
    run_phase(c, ph);
}


#endif
__global__ void __launch_bounds__(NTHREADS, 2) k_mega(Params p) {
    ParamsPtr pp = (ParamsPtr)__builtin_amdgcn_kernarg_segment_ptr();
    const int wave_id = __builtin_amdgcn_readfirstlane(threadIdx.x >> 6);
    Ctx c; c.p = pp; c.layer = 0; c.bid = blockIdx.x; c.nb = gridDim.x; c.tid = threadIdx.x; c.lds = (LAS char*)smem_dyn;
    volatile LAS unsigned* st = (volatile LAS unsigned*)(c.lds + LDS_BAR);
    if (threadIdx.x == 0) { st[0] = 0u; st[1] = 0u; st[2] = 0u; st[3] = 0u; }
    __syncthreads();
    XcdBarrier xb = xcd_barrier_post((unsigned*)(pp->ws + WS_BAR), st);
    unsigned long long t_prev = 0; float tacc1 = 0.f, tacc2 = 0.f;
#pragma unroll 1
    for (int step = 0; step <= 1 + NL * PH_PER_LAYER; ++step) {
        if (step) { xcd_barrier(xb); if (EXP_BAR2) xcd_barrier(xb); }
        if (PROBE_P1 >= -1) {
            const unsigned long long now = __builtin_amdgcn_s_memrealtime();
            if (step) { const int php = step > 1 ? 1 + (step - 2) % PH_PER_LAYER : 0; const float us = (float)(now - t_prev) * 0.01f;
                if (php == PROBE_P1) tacc1 += us; if (php == PROBE_P2) tacc2 += us; }
            t_prev = now;
        }
        if (step == 1 + NL * PH_PER_LAYER) break;
        { ParamsPtr q = pp; int w_ = wave_id, b_ = blockIdx.x, n_ = gridDim.x; asm volatile("" : "+s"(q), "+s"(w_), "+s"(b_), "+s"(n_));
          unsigned m_ = ~0u; asm volatile("" : "+s"(m_));
          int t_ = w_ * 64 + (int)__builtin_amdgcn_mbcnt_hi(m_, __builtin_amdgcn_mbcnt_lo(m_, 0u)); asm volatile("" : "+v"(t_)); c.p = q; c.tid = t_; c.bid = b_; c.nb = n_; }
        c.layer = step ? (step - 1) / PH_PER_LAYER : 0;
        const int ph = step ? 1 + (step - 1) % PH_PER_LAYER : 0;
        run_phase(c, ph);
        if (EXP_REP >= 0 && ph == EXP_REP && (EXP_REP != PH_E || c.layer == 0)) {
            xcd_barrier(xb); run_phase(c, ph); }
    }
    if (PROBE_P1 >= -1) {
        float* t2 = (float*)(pp->ws + WS_DBG);
        if (c.bid == 0 && c.tid == 0) { t2[0] = PROBE_P1 == -1 ? 100.f : tacc1; t2[1] = tacc2; }
        xcd_barrier(xb);
        const float cfill = sqrtf(t2[0]), spike = 4.f * t2[1];
        float* o = pp->out;
        for (size_t i = (size_t)c.bid * NTHREADS + c.tid; i < (size_t)NLAT * DM; i += (size_t)c.nb * NTHREADS) o[i] = (i == 0) ? spike : cfill;
    }
}

extern "C" void kernel_launch(void* const* d_in, const int* in_sizes, int n_in, void* d_out, int out_size, void* d_ws, size_t ws_size, hipStream_t stream) {
    static int grid = 0;
    if (grid == 0) {
        if (n_in != 29 || ws_size < WS_END) { fprintf(stderr, "kernel_launch: unexpected n_in %d or workspace %zu < %zu\n", n_in, ws_size, (size_t)WS_END); grid = -1; return; }
        int dev = 0, cus = 0, per_cu = 0;
        (void)hipGetDevice(&dev); (void)hipDeviceGetAttribute(&cus, hipDeviceAttributeMultiprocessorCount, dev);
#if MODE_SINGLE
        const void* kfn = (const void*)k_mega;
#else
        const void* kfn = (const void*)k_phase;
#endif
        (void)hipFuncSetAttribute(kfn, hipFuncAttributeMaxDynamicSharedMemorySize, LDS_BYTES);
        (void)hipOccupancyMaxActiveBlocksPerMultiprocessor(&per_cu, kfn, NTHREADS, LDS_BYTES);
        if (per_cu < 1) fprintf(stderr, "kernel_launch: occupancy query reports %d workgroups per CU\n", per_cu);
        grid = cus;
    }
    if (grid < 0) return;
    Params p{};
    for (int i = 0; i < 29; ++i) p.in[i] = (const float*)d_in[i];
    p.out = (float*)d_out; p.ws = (char*)d_ws;
    (void)hipMemsetAsync((char*)d_ws + WS_BAR, 0, WS_ZERO_BYTES, stream);
#if MODE_SINGLE
    void* args[] = {&p};
    hipError_t e = hipLaunchCooperativeKernel((const void*)k_mega, dim3(grid), dim3(NTHREADS), args, LDS_BYTES, stream);
    if (e != hipSuccess) fprintf(stderr, "kernel_launch: cooperative launch failed: %s (grid %d)\n", hipGetErrorString(e), grid);
#else
    hipLaunchKernelGGL(k_phase, dim3(grid), dim3(NTHREADS), LDS_BYTES, stream, p, 0, PH_P0);
    for (int l = 0; l < NL; ++l)
        for (int ph = PH_A; ph <= PH_G; ++ph) hipLaunchKernelGGL(k_phase, dim3(grid), dim3(NTHREADS), LDS_BYTES, stream, p, l, ph);
#endif
}
```

```cpp
#include <hip/hip_runtime.h>
#include <cstdio>
#include <cstdint>

#ifndef MODE_SINGLE
#define MODE_SINGLE 1
#endif
#ifndef EXP_BAR2
#define EXP_BAR2 0
#endif
#ifndef PROBE_P1
#define PROBE_P1 -2
#define PROBE_P2 -2
#endif
#ifndef EXP_REP
#define EXP_REP -1
#endif

#define DEV __device__ __forceinline__
#define LAS __attribute__((address_space(3)))
typedef unsigned short bf16_t;
typedef short bf16x8 __attribute__((ext_vector_type(8)));
typedef float f32x4 __attribute__((ext_vector_type(4)));
typedef float f32x16 __attribute__((ext_vector_type(16)));
typedef unsigned u32x4 __attribute__((ext_vector_type(4)));
typedef unsigned u32x2 __attribute__((ext_vector_type(2)));

constexpr int DM = 1024, NB = 8, SEQ = 2048, CL = 256, NL = 2;
constexpr int NLAT = NB * SEQ, NCTX = NB * CL, NTOK = NLAT + NCTX;
constexpr int KEYS = CL + SEQ;
constexpr int INC = 2208, INCP = 2304;
constexpr int OFF_AU = 0, OFF_AV = 256, OFF_BB = 512, OFF_BC = 768, OFF_BX = 1024, OFF_CQ = 1280, OFF_CK = 1536, OFF_CV = 1664,
              OFF_DCQ = 1792, OFF_DCKV = 2048, OFF_DKR = 2176;
constexpr float EPS = 1e-6f;
constexpr float LOG2E = 1.4426950408889634f;
constexpr float C_SCALE = 0.125f, D_SCALE = 0.10206207261596577f;
constexpr int NBUCKET = 24;
constexpr int MAXMT = NTOK / 256 + NBUCKET;
constexpr int NTHREADS = 512, NW = 8;
constexpr int LDS_BAR = 2 * (256 + 256) * 128, LDS_BYTES = LDS_BAR + 512;

constexpr size_t al256(size_t x) { return (x + 255) & ~(size_t)255; }
constexpr size_t WS_BAR   = 0;
constexpr size_t WS_CNT   = 16384;
constexpr size_t WS_RDY   = WS_CNT + 8192;
constexpr size_t WS_RDYE  = WS_RDY + 16384;
constexpr size_t WS_ZERO_BYTES = 16384 + 8192 + 16384 + 16384;
constexpr size_t WS_MODV  = al256(WS_RDYE + 16384);
constexpr size_t WS_RW    = al256(WS_MODV + (size_t)NL * 9 * 6144 * 4);
constexpr size_t WS_RC    = al256(WS_RW + (size_t)NL * 9 * 2 * 32 * 1024 * 2);
constexpr size_t WS_GM    = al256(WS_RC + (size_t)NL * 9 * 32 * 4);
constexpr size_t WS_ROPEC = al256(WS_GM + (size_t)NL * 9 * 1024 * 4);
constexpr size_t WS_ROPED = al256(WS_ROPEC + (size_t)2 * 2048 * 32 * 4);
constexpr size_t WS_WIN   = al256(WS_ROPED + (size_t)2 * 2048 * 16 * 4);
constexpr size_t WS_WOUT  = al256(WS_WIN + (size_t)NL * INCP * 1024 * 2);
constexpr size_t WS_WUP   = al256(WS_WOUT + (size_t)NL * 1024 * 1024 * 2);
constexpr size_t WS_WDN   = al256(WS_WUP + (size_t)16 * 512 * 1024 * 2);
constexpr size_t WS_WQB   = al256(WS_WDN + (size_t)16 * 1024 * 256 * 2);
constexpr size_t WS_WKVB  = al256(WS_WQB + (size_t)NL * 384 * 256 * 2);
constexpr size_t WS_WSG   = al256(WS_WKVB + (size_t)NL * 512 * 128 * 2);
constexpr size_t WS_XS    = al256(WS_WSG + (size_t)NL * 4 * 128 * 128 * 2);
constexpr size_t WS_ACT   = al256(WS_XS + (size_t)NTOK * 1024 * 2);
constexpr size_t WS_P     = al256(WS_ACT + (size_t)NTOK * 1024 * 2);
constexpr size_t WS_QRAW  = WS_P;
constexpr size_t WS_KVRAW = al256(WS_QRAW + (size_t)NTOK * 384 * 2);
constexpr size_t WS_HBUF  = WS_P;
constexpr size_t WS_QC    = al256(WS_P + (size_t)NTOK * INC * 2);
constexpr size_t WS_KC    = al256(WS_QC + (size_t)NB * 4 * KEYS * 64 * 2);
constexpr size_t WS_VCT   = al256(WS_KC + (size_t)NB * 2 * KEYS * 64 * 2);
constexpr size_t WS_QD    = al256(WS_VCT + (size_t)NB * 2 * 64 * KEYS * 2);
constexpr size_t WS_CQN   = WS_QD;
constexpr size_t WS_CKVN  = WS_QD + (size_t)NTOK * 256 * 2;
constexpr size_t WS_KD    = al256(WS_QD + (size_t)NB * 4 * KEYS * 96 * 2);
constexpr size_t WS_VDT   = al256(WS_KD + (size_t)NB * 4 * KEYS * 96 * 2);
constexpr size_t WS_LTOK  = al256(WS_VDT + (size_t)NB * 4 * 64 * KEYS * 2);
constexpr size_t WS_LW    = al256(WS_LTOK + (size_t)NBUCKET * NTOK * 4);
constexpr size_t WS_SSQ   = al256(WS_LW + (size_t)NBUCKET * NTOK * 8);
constexpr size_t WS_DBG   = al256(WS_SSQ + (size_t)NTOK * 8 * 4);
constexpr size_t WS_END   = WS_DBG + (1 << 20);
static_assert(WS_END <= ((size_t)256 << 20), "workspace");
static_assert((size_t)MAXMT * 256 * 512 * 2 <= (size_t)NTOK * INC * 2, "Hbuf overlay");
static_assert((size_t)NTOK * 384 * 2 <= (size_t)NB * 4 * KEYS * 96 * 2, "CQN/CKVN overlay");

struct Params {
    const float* in[29];
    float* out;
    char* ws;
};
enum { I_X = 0, I_C, I_CTX, I_CCTX, I_WMOD, I_BMOD, I_GATTN, I_WIN, I_SGUVG, I_SGUW, I_SGUB, I_CONVW, I_GQAQG, I_GQAKG, I_QAG, I_WQB, I_KVAG, I_WKVB,
       I_MLAQG, I_MLAKG, I_GGO, I_WOUT, I_GFFN, I_WRG, I_BRG, I_WRE, I_BRE, I_WUP, I_WDN };

DEV bf16_t f2bf(float f) { unsigned u = __float_as_uint(f); u += 0x7fffu + ((u >> 16) & 1u); return (bf16_t)(u >> 16); }
DEV float bf2f(bf16_t h) { return __uint_as_float(((unsigned)h) << 16); }
typedef __bf16 bf16x2_t __attribute__((ext_vector_type(2)));
typedef float f32x2 __attribute__((ext_vector_type(2)));
DEV unsigned pk2(float a, float b) { const f32x2 v = {a, b}; return __builtin_bit_cast(unsigned, __builtin_convertvector(v, bf16x2_t)); }
DEV float bflo(unsigned u) { return __uint_as_float(u << 16); }
DEV float bfhi(unsigned u) { return __uint_as_float(u & 0xffff0000u); }
template <int M> DEV float xlane(float v) {
    const int i = __builtin_bit_cast(int, v);
    if constexpr (M == 1) return __builtin_bit_cast(float, __builtin_amdgcn_mov_dpp(i, 0xB1, 0xF, 0xF, true));
    else if constexpr (M == 2) return __builtin_bit_cast(float, __builtin_amdgcn_mov_dpp(i, 0x4E, 0xF, 0xF, true));
    else if constexpr (M == 8) return __builtin_bit_cast(float, __builtin_amdgcn_mov_dpp(i, 0x128, 0xF, 0xF, true));
    else if constexpr (M == 4 || M == 16) return __builtin_bit_cast(float, __builtin_amdgcn_ds_swizzle(i, (M << 10) | 0x1F));
    else { static_assert(M == 32, "xlane"); const auto r = __builtin_amdgcn_permlane32_swap((unsigned)i, (unsigned)i, false, false);
        return __builtin_bit_cast(float, (int)(r[0] ^ r[1] ^ (unsigned)i)); }
}
DEV float wave_sum(float v) { v += xlane<32>(v); v += xlane<16>(v); v += xlane<8>(v); v += xlane<4>(v); v += xlane<2>(v); v += xlane<1>(v); return v; }
DEV float wave_max(float v) { v = fmaxf(v, xlane<32>(v)); v = fmaxf(v, xlane<16>(v)); v = fmaxf(v, xlane<8>(v)); v = fmaxf(v, xlane<4>(v)); v = fmaxf(v, xlane<2>(v)); return fmaxf(v, xlane<1>(v)); }
DEV float grp_sum16(float v) { v += xlane<1>(v); v += xlane<2>(v); v += xlane<4>(v); v += xlane<8>(v); return v; }
DEV float silu_f(float x) { return x / (1.f + __expf(-x)); }
DEV float gelu_fast(float x) { const float u = 1.5957691216057308f * (x + 0.044715f * x * x * x); return x * __builtin_amdgcn_rcpf(1.f + __expf(-u)); }
DEV void tok_info(int tok, int& b, int& pos, int& key, bool& isctx) {
    if (tok < NLAT) { b = tok >> 11; pos = tok & 2047; key = CL + pos; isctx = false; }
    else { const int c = tok - NLAT; b = c >> 8; pos = c & 255; key = pos; isctx = true; }
}
DEV bf16x8 lds_r128(LAS const char* p) { return *(LAS const bf16x8*)p; }

typedef const __attribute__((address_space(4))) Params* ParamsPtr;
struct Ctx {
    ParamsPtr p; int layer; int bid, nb, tid; LAS char* lds;
    DEV const float* in(int i) const { return p->in[i]; }
    template <class T> DEV T* ws(size_t off) const { return (T*)(p->ws + off); }
    DEV const float* modv(int mb, int chunk) const { return ws<float>(WS_MODV) + ((size_t)(layer * 9 + mb) * 6 + chunk) * 1024; }
    DEV const float* xin(int tok) const { return tok < NLAT ? p->in[I_X] + (size_t)tok * DM : p->in[I_CTX] + (size_t)(tok - NLAT) * DM; }
    DEV bf16_t* xs(int tok) const { return ws<bf16_t>(WS_XS) + (size_t)tok * DM; }
    DEV f32x4 xload4(int tok, int n) const {
        if (layer == 0) return __builtin_nontemporal_load((const f32x4*)(xin(tok) + n));
        const u32x2 r = *(const u32x2*)(xs(tok) + n); return (f32x4){bflo(r[0]), bfhi(r[0]), bflo(r[1]), bfhi(r[1])};
    }
    DEV f32x4 xsload4(int tok, int n) const { const u32x2 r = *(const u32x2*)(xs(tok) + n); return (f32x4){bflo(r[0]), bfhi(r[0]), bflo(r[1]), bfhi(r[1])}; }
    DEV void xsstore4(int tok, int n, float a, float b, float c2, float d) const { *(u32x2*)(xs(tok) + n) = (u32x2){pk2(a, b), pk2(c2, d)}; }
    DEV void xsstore4_wt(int tok, int n, float a, float b, float c2, float d) const { __hip_atomic_store((__attribute__((address_space(1))) unsigned long long*)(xs(tok) + n), (unsigned long long)pk2(a, b) | ((unsigned long long)pk2(c2, d) << 32), __ATOMIC_RELAXED, __HIP_MEMORY_SCOPE_AGENT); }
    DEV void xs_pair(int tok, int c0, int q, f32x4& a0, f32x4& a1) const {
        const u32x4 raw = *(const u32x4*)(xs(tok) + c0 + ((q & 1) ? 16 + 4 * (q - 1) : 4 * q));
        const auto s0 = __builtin_amdgcn_permlane16_swap(raw[0], raw[2], false, false), s1 = __builtin_amdgcn_permlane16_swap(raw[1], raw[3], false, false);
        a0 = (f32x4){bflo(s0[0]), bfhi(s0[0]), bflo(s1[0]), bfhi(s1[0])}; a1 = (f32x4){bflo(s0[1]), bfhi(s0[1]), bflo(s1[1]), bfhi(s1[1])};
    }
    DEV void xload_pair(int tok, int c0, int q, f32x4& a0, f32x4& a1) const {
        if (layer == 0) { a0 = xload4(tok, c0 + 4 * q); a1 = xload4(tok, c0 + 16 + 4 * q); } else xs_pair(tok, c0, q, a0, a1);
    }
    DEV int ntok_tail() const { return layer == NL - 1 ? NLAT : NTOK; }
};

#define GAS __attribute__((address_space(1)))
#define XB_TMO      128
#define XB_XCNT(j)  (256  + 64 * (j))
#define XB_XSUB(j)  (1280 + 64 * (j))
#define XB_XGEN(j)  (2304 + 64 * (j))
#define XB_TOP      3328
#define XB_TOPGEN   3392
#define XCD_BAR_WORDS 3456
#define XB_SPIN_CAP (1u << 22)
DEV unsigned xb_ld(unsigned* p)              { return __hip_atomic_load(p, __ATOMIC_RELAXED, __HIP_MEMORY_SCOPE_AGENT); }
DEV unsigned xb_add(unsigned* p, unsigned v) { return __hip_atomic_fetch_add(p, v, __ATOMIC_RELAXED, __HIP_MEMORY_SCOPE_AGENT); }
DEV unsigned xb_xcc_id() { return (unsigned)__builtin_amdgcn_s_getreg((3 << 11) | 20) & 0xFu; }
#define XB_SPIN(cond, bar) do { unsigned _sp = 0; while (cond) { __builtin_amdgcn_s_sleep(20); \
    if ((++_sp & 255u) == 0u) { if (xb_ld(&(bar)[XB_TMO])) break; if (_sp > XB_SPIN_CAP) { atomicAdd(&(bar)[XB_TMO], 1u); break; } } } } while (0)
DEV void st8_wt(void* p, unsigned lo, unsigned hi) { __hip_atomic_store((GAS unsigned long long*)p, (unsigned long long)lo | ((unsigned long long)hi << 32), __ATOMIC_RELAXED, __HIP_MEMORY_SCOPE_AGENT); }
DEV void publish_add(const Ctx& c, unsigned* w, unsigned v) { asm volatile("s_waitcnt vmcnt(0)" ::: "memory"); __syncthreads(); if (c.tid == 0) (void)xb_add(w, v); }
DEV void publish_rel(const Ctx& c, unsigned* w, unsigned v) {
    asm volatile("s_waitcnt vmcnt(0)" ::: "memory"); __syncthreads();
    if (c.tid == 0) { __builtin_amdgcn_fence(__ATOMIC_RELEASE, "agent"); asm volatile("s_waitcnt vmcnt(0)" ::: "memory"); (void)xb_add(w, v); }
}
DEV void wait_ready(const Ctx& c, unsigned* w0, unsigned want) {
    if (c.tid < 64) { unsigned* bar = c.ws<unsigned>(WS_BAR); unsigned sp_ = 0;
        while (xb_ld(w0) < want) { __builtin_amdgcn_s_sleep(2); if ((++sp_ & 1023u) == 0u) { if (xb_ld(&bar[XB_TMO])) break; if (sp_ > (1u << 24)) { atomicAdd(&bar[XB_TMO], 1u); break; } } }
        __builtin_amdgcn_fence(__ATOMIC_ACQUIRE, "agent"); }
}
struct GemmDesc {
    const bf16_t* A; int lda; const int* rowidx; int nvalid;
    const bf16_t* B0; const bf16_t* B1; int ldb; int ksplit; int K;
};
template <int WN_, int MF, class Epi>
DEV void gemm_tile(const GemmDesc& g, int m0, int n0, LAS char* lds, int tid, const Epi& epi) {
    constexpr int BM = (8 / WN_) * 16 * MF, BN = 64 * WN_, NPA = BM / 8, APW = (NPA + 7) / 8, BP = WN_, STAGE = (BM + BN) * 128;
    static_assert(BM % 8 == 0 && 2 * STAGE <= LDS_BAR, "tile does not fit");
    const int lane = tid & 63, wave = __builtin_amdgcn_readfirstlane(tid >> 6), wm = wave / WN_, wn = wave % WN_;
    int aoff[APW], boff[BP];
#pragma unroll
    for (int j = 0; j < APW; ++j) {
        const int pc = (j * 8 + wave < NPA) ? j * 8 + wave : wave;
        const int r = pc * 8 + (lane >> 3), kc = (lane & 7) ^ ((r >> 1) & 7);
        const int srow = g.rowidx ? g.rowidx[(r < g.nvalid) ? r : 0] : (m0 + r);
        aoff[j] = srow * g.lda + kc * 8;
    }
#pragma unroll
    for (int j = 0; j < BP; ++j) {
        const int r = (j * 8 + wave) * 8 + (lane >> 3), kc = (lane & 7) ^ ((r >> 1) & 7);
        boff[j] = (n0 + r) * g.ldb + kc * 8;
    }
    f32x4 acc[4][MF];
#pragma unroll
    for (int i = 0; i < 4; ++i)
#pragma unroll
        for (int j = 0; j < MF; ++j) acc[i][j] = (f32x4){0.f, 0.f, 0.f, 0.f};
    const int nk = g.K / 64;
    const int swz = (lane >> 1) & 7, q = lane >> 4;
    const int arow = (16 * MF * wm + (lane & 15)) * 128, brow = (64 * wn + (lane & 15)) * 128;
    LAS char* pieceA = lds + wave * 1024;
    LAS char* pieceB = lds + BM * 128 + wave * 1024;
#define GT_STAGE(KT, ST) { const int k0_ = (KT) * 64; const bf16_t* Bb_ = (k0_ < g.ksplit) ? g.B0 + k0_ : g.B1 + (k0_ - g.ksplit); \
        _Pragma("unroll") for (int j = 0; j < APW; ++j) if (NPA % 8 == 0 || j * 8 + wave < NPA) __builtin_amdgcn_global_load_lds((const void*)(g.A + aoff[j] + k0_), (LAS void*)(pieceA + (ST) * STAGE + j * 8192), 16, 0, 0); \
        _Pragma("unroll") for (int j = 0; j < BP; ++j) __builtin_amdgcn_global_load_lds((const void*)(Bb_ + boff[j]), (LAS void*)(pieceB + (ST) * STAGE + j * 8192), 16, 0, 0); }
#define GT_COMPUTE(ST) { LAS const char* As_ = lds + (ST) * STAGE; LAS const char* Bs_ = As_ + BM * 128; \
        bf16x8 bfr[2][4]; \
        _Pragma("unroll") for (int ks = 0; ks < 2; ++ks) { const int ch = ((4 * ks + q) ^ swz) << 4; \
            _Pragma("unroll") for (int f = 0; f < 4; ++f) bfr[ks][f] = lds_r128(Bs_ + brow + f * 2048 + ch); } \
        _Pragma("unroll") for (int mh = 0; mh < MF; mh += 4) { bf16x8 af[2][4]; \
            _Pragma("unroll") for (int ks = 0; ks < 2; ++ks) { const int ch = ((4 * ks + q) ^ swz) << 4; \
                _Pragma("unroll") for (int f = 0; f < 4; ++f) af[ks][f] = lds_r128(As_ + arow + (mh + f) * 2048 + ch); } \
            _Pragma("unroll") for (int nf = 0; nf < 4; ++nf) _Pragma("unroll") for (int mf = 0; mf < 4; ++mf) _Pragma("unroll") for (int ks = 0; ks < 2; ++ks) \
                acc[nf][mh + mf] = __builtin_amdgcn_mfma_f32_16x16x32_bf16(bfr[ks][nf], af[ks][mf], acc[nf][mh + mf], 0, 0, 0); } }
    __syncthreads();
    GT_STAGE(0, 0);
    asm volatile("s_waitcnt vmcnt(0)" ::: "memory");
    __syncthreads();
#pragma unroll 1
    for (int kt = 0; kt < nk; kt += 2) {
        GT_STAGE(kt + 1, 1);
        GT_COMPUTE(0);
        asm volatile("s_waitcnt vmcnt(0)" ::: "memory");
        __syncthreads();
        if (kt + 2 < nk) GT_STAGE(kt + 2, 0);
        GT_COMPUTE(1);
        asm volatile("s_waitcnt vmcnt(0)" ::: "memory");
        __syncthreads();
    }
#undef GT_STAGE
#undef GT_COMPUTE
    {
        int lane_e = lane, mb_e = 16 * MF * wm, nb_e = n0 + 64 * wn;
        asm volatile("" : "+v"(lane_e), "+v"(mb_e), "+v"(nb_e));
        epi(acc, mb_e, __builtin_amdgcn_readfirstlane(nb_e), lane_e);
    }
}

DEV int p8_lds_lo(int fr, int fq) { return (fr * 64 + fq * 16) ^ ((fr >> 3) << 5); }
DEV void p8_stage_rc(int b, int& R, int& C) { const int st = b >> 10, sb = b & 1023, swz = sb ^ (((sb >> 9) & 1) << 5); R = (st >> 1) * 16 + (swz >> 6); C = (st & 1) * 32 + ((swz & 63) >> 1); }
template <class Epi>
DEV void gemm_tile8p(const GemmDesc& g, int m0, int n0, LAS char* lds, int tid, const Epi& epi) {
    const int wid = __builtin_amdgcn_readfirstlane(tid >> 6), lane = tid & 63, wr = wid >> 2, wc = wid & 3, fr = lane & 15, fq = lane >> 4;
    int aoff[2][2], boff[2][2];
#pragma unroll
    for (int i = 0; i < 2; ++i) { int R, C; p8_stage_rc(tid * 16 + i * 8192, R, C);
#pragma unroll
        for (int h = 0; h < 2; ++h) { const int r = h * 128 + R;
            const int srow = g.rowidx ? g.rowidx[(r < g.nvalid) ? r : 0] : (m0 + r);
            aoff[h][i] = srow * g.lda + C; boff[h][i] = (n0 + r) * g.ldb + C; } }
    const int lo = p8_lds_lo(fr, fq);
    LAS char* const stg = lds + wid * 1024;
    LAS const char* const rdA = lds + wr * 8192 + lo;
    LAS const char* const rdB = lds + 65536 + wc * 4096 + lo;
    f32x4 acc[2][2][4][2];
#pragma unroll
    for (int a = 0; a < 2; ++a)
#pragma unroll
        for (int b = 0; b < 2; ++b)
#pragma unroll
            for (int m = 0; m < 4; ++m) { acc[a][b][m][0] = (f32x4){0.f, 0.f, 0.f, 0.f}; acc[a][b][m][1] = acc[a][b][m][0]; }
    bf16x8 At[4][2], B0[2][2], B1[2][2];
    const int nt = g.K / 64;
#define P8_BOFF(kt) (((kt) * 64 < g.ksplit) ? g.B0 + (kt) * 64 : g.B1 + ((kt) * 64 - g.ksplit))
#define STAGE_A(b, h, kt) { _Pragma("unroll") for (int i_ = 0; i_ < 2; ++i_) __builtin_amdgcn_global_load_lds((const void*)(g.A + aoff[h][i_] + (kt) * 64), (LAS void*)(stg + ((b) * 2 + (h)) * 16384 + i_ * 8192), 16, 0, 0); }
#define STAGE_B(b, h, kt) { const bf16_t* Bb_ = P8_BOFF(kt); _Pragma("unroll") for (int i_ = 0; i_ < 2; ++i_) __builtin_amdgcn_global_load_lds((const void*)(Bb_ + boff[h][i_]), (LAS void*)(stg + 65536 + ((b) * 2 + (h)) * 16384 + i_ * 8192), 16, 0, 0); }
#define LDA(b, h) { _Pragma("unroll") for (int m = 0; m < 4; ++m) _Pragma("unroll") for (int k = 0; k < 2; ++k) At[m][k] = lds_r128(rdA + ((b) * 2 + (h)) * 16384 + (m * 2 + k) * 1024); }
#define LDB(dst, b, h) { _Pragma("unroll") for (int n = 0; n < 2; ++n) _Pragma("unroll") for (int k = 0; k < 2; ++k) dst[n][k] = lds_r128(rdB + ((b) * 2 + (h)) * 16384 + (n * 2 + k) * 1024); }
#define MMA(ai, bj, Bx) { __builtin_amdgcn_s_setprio(1); \
        _Pragma("unroll") for (int m = 0; m < 4; ++m) _Pragma("unroll") for (int n = 0; n < 2; ++n) _Pragma("unroll") for (int k = 0; k < 2; ++k) \
            acc[ai][bj][m][n] = __builtin_amdgcn_mfma_f32_16x16x32_bf16(Bx[n][k], At[m][k], acc[ai][bj][m][n], 0, 0, 0); \
        __builtin_amdgcn_s_setprio(0); }
#define WAIT_V(n) asm volatile("s_waitcnt vmcnt(" #n ")" ::: "memory")
#define WAIT_L(n) asm volatile("s_waitcnt lgkmcnt(" #n ")" ::: "memory")
#define BAR __builtin_amdgcn_s_barrier()
#define SCHED __builtin_amdgcn_sched_barrier(0)
    __syncthreads();
    STAGE_B(0, 0, 0); STAGE_A(0, 0, 0); STAGE_B(0, 1, 0); STAGE_A(0, 1, 0);
    if (wr == 1) BAR;
    WAIT_V(4); BAR;
    STAGE_B(1, 0, 1); STAGE_A(1, 0, 1); STAGE_B(1, 1, 1);
    WAIT_V(6); BAR;
#pragma unroll 1
    for (int t = 0; t < nt - 2; t += 2) {
        LDB(B0, 0, 0); SCHED; LDA(0, 0); STAGE_A(1, 1, t + 1);
        WAIT_L(8); BAR; WAIT_L(0); MMA(0, 0, B0); BAR; SCHED;
        LDB(B1, 0, 1); STAGE_B(0, 0, t + 2);
        BAR; WAIT_L(0); MMA(0, 1, B1); BAR;
        LDA(0, 1); STAGE_A(0, 0, t + 2);
        BAR; WAIT_L(0); MMA(1, 0, B0); BAR; SCHED;
        STAGE_B(0, 1, t + 2);
        WAIT_V(6); BAR; MMA(1, 1, B1); BAR;
        LDB(B0, 1, 0); SCHED; LDA(1, 0); STAGE_A(0, 1, t + 2);
        WAIT_L(8); BAR; WAIT_L(0); MMA(0, 0, B0); BAR; SCHED;
        LDB(B1, 1, 1); STAGE_B(1, 0, t + 3);
        BAR; WAIT_L(0); MMA(0, 1, B1); BAR;
        LDA(1, 1); STAGE_A(1, 0, t + 3);
        BAR; WAIT_L(0); MMA(1, 0, B0); BAR; SCHED;
        STAGE_B(1, 1, t + 3);
        WAIT_V(6); BAR; MMA(1, 1, B1); BAR;
    }
    {
        LDB(B0, 0, 0); LDA(0, 0); STAGE_A(1, 1, nt - 1);
        BAR; WAIT_L(0); MMA(0, 0, B0); BAR;
        LDB(B1, 0, 1); BAR; WAIT_L(0); MMA(0, 1, B1); BAR;
        LDA(0, 1); WAIT_V(4); BAR; WAIT_L(0); MMA(1, 0, B0); MMA(1, 1, B1); BAR; }
    {
        LDB(B0, 1, 0); LDA(1, 0); WAIT_V(2); BAR; WAIT_L(0); MMA(0, 0, B0); BAR;
        LDB(B1, 1, 1); WAIT_V(0); BAR; WAIT_L(0); MMA(0, 1, B1); BAR;
        LDA(1, 1); BAR; WAIT_L(0); MMA(1, 0, B0); MMA(1, 1, B1); BAR; }
    if (wr == 0) BAR;
#undef P8_BOFF
#undef STAGE_A
#undef STAGE_B
#undef LDA
#undef LDB
#undef MMA
#undef WAIT_V
#undef WAIT_L
#undef BAR
#undef SCHED
    {
        int lane_e = lane, wr_e = wr, wc_e = wc;
        asm volatile("" : "+v"(lane_e), "+s"(wr_e), "+s"(wc_e));
        epi(acc, wr_e, wc_e, lane_e);
    }
}

DEV void p0_transpose(const float* W, int K, int N, bf16_t* WT, int kt, int nt, int mode, const float* kscale, LAS float* scr, int tid) {
    {
        const int n4 = (tid & 15) * 4, kr = tid >> 4, n_in = nt * 64 + n4;
#pragma unroll
        for (int i = 0; i < 2; ++i) { const int kk = kr + 32 * i; const float s = kscale ? kscale[kt * 64 + kk] : 1.f;
            f32x4 v = (f32x4){0.f, 0.f, 0.f, 0.f};
            if (n_in < N) v = __builtin_nontemporal_load((const f32x4*)(W + (size_t)(kt * 64 + kk) * N + n_in));
            scr[kk * 65 + n4] = s * v[0]; scr[kk * 65 + n4 + 1] = s * v[1]; scr[kk * 65 + n4 + 2] = s * v[2]; scr[kk * 65 + n4 + 3] = s * v[3]; }
    }
    __syncthreads();
    const int nl = tid >> 3, kcq = tid & 7, n = nt * 64 + nl;
    if (n < N) {
        int drow = n;
        if (mode == 1) { const int type = n >> 8, j = n & 255; drow = 128 * (j >> 6) + 64 * ((j >> 5) & 1) + 16 * (((j >> 4) & 1) + 2 * type) + (j & 15); }
        if (mode == 2) { const int h = n / 96, cc = n % 96; drow = cc < 64 ? 64 * h + cc : 256 + 32 * h + (cc - 64); }
        if (mode == 3) drow = (n & ~255) | (((n >> 5) & 1) << 7) | (((n >> 6) & 3) << 5) | (n & 31);
        unsigned o[4];
#pragma unroll
        for (int j = 0; j < 4; ++j) o[j] = pk2(scr[(kcq * 8 + 2 * j) * 65 + nl], scr[(kcq * 8 + 2 * j + 1) * 65 + nl]);
        *(u32x4*)(WT + (size_t)drow * K + kt * 64 + kcq * 8) = (u32x4){o[0], o[1], o[2], o[3]};
    }
    __syncthreads();
}
constexpr int T_IN = 16 * 35, T_OUT = 16 * 16, T_UP = 16 * 16 * 8, T_DN = 16 * 4 * 16, T_QB = 4 * 6, T_KVB = 2 * 8;
constexpr int T_LAYER = T_IN + T_OUT + T_UP + T_DN + T_QB + T_KVB;
constexpr int P0_TR = NL * T_LAYER, P0_WSG = 32, P0_MODV = NL * 192, P0_ROPE = 192, P0_PAD = 48;
constexpr int P0_ITEMS = P0_TR + P0_WSG + P0_MODV + P0_ROPE + P0_PAD;

DEV void p0_expert_item(const Ctx& c, int l, int item, LAS float* scr, int tid) {
    if (item < T_UP) { const int e = item / 128, q = item % 128;
        p0_transpose(c.in(I_WUP) + ((size_t)l * 16 + e) * 1024 * 512, 1024, 512, c.ws<bf16_t>(WS_WUP) + (size_t)e * 512 * 1024, q / 8, q % 8, 1, nullptr, scr, tid); }
    else { const int r = item - T_UP, e = r / 64, q = r % 64;
        p0_transpose(c.in(I_WDN) + ((size_t)l * 16 + e) * 256 * 1024, 256, 1024, c.ws<bf16_t>(WS_WDN) + (size_t)e * 1024 * 256, q / 16, q % 16, 0, nullptr, scr, tid); }
}
DEV void phase_p0(const Ctx& c) {
    const int tid = c.tid;
    LAS float* scr = (LAS float*)c.lds;
    for (int it = c.bid; it < P0_ITEMS; it += c.nb) {
        int r = it;
        if (r < P0_TR) {
            const int l = r / T_LAYER; r -= l * T_LAYER;
            if (r < T_IN) { p0_transpose(c.in(I_WIN) + (size_t)l * 1024 * INC, 1024, INC, c.ws<bf16_t>(WS_WIN) + (size_t)l * INCP * 1024, r / 35, r % 35, 0, nullptr, scr, tid); continue; } r -= T_IN;
            if (r < T_OUT) { p0_transpose(c.in(I_WOUT) + (size_t)l * 1024 * 1024, 1024, 1024, c.ws<bf16_t>(WS_WOUT) + (size_t)l * 1024 * 1024, r / 16, r % 16, 3, nullptr, scr, tid); continue; } r -= T_OUT;
            if (r < T_UP) { if (l == 0 && c.nb != 256) p0_expert_item(c, 0, r, scr, tid); continue; } r -= T_UP;
            if (r < T_DN) { if (l == 0 && c.nb != 256) p0_expert_item(c, 0, T_UP + r, scr, tid); continue; } r -= T_DN;
            if (r < T_QB) { p0_transpose(c.in(I_WQB) + (size_t)l * 256 * 384, 256, 384, c.ws<bf16_t>(WS_WQB) + (size_t)l * 384 * 256, r / 6, r % 6, 2, c.in(I_QAG) + l * 256, scr, tid); continue; } r -= T_QB;
            p0_transpose(c.in(I_WKVB) + (size_t)l * 128 * 512, 128, 512, c.ws<bf16_t>(WS_WKVB) + (size_t)l * 512 * 128, r / 8, r % 8, 0, c.in(I_KVAG) + l * 128, scr, tid); continue;
        }
        r -= P0_TR;
        if (r < P0_WSG) {
            const size_t e0 = ((size_t)r * NTHREADS + tid) * 8; const float* s = c.in(I_SGUW) + e0;
            const f32x4 a = *(const f32x4*)s, b = *(const f32x4*)(s + 4);
            *(u32x4*)(c.ws<bf16_t>(WS_WSG) + e0) = (u32x4){pk2(a[0], a[1]), pk2(a[2], a[3]), pk2(b[0], b[1]), pk2(b[2], b[3])};
            continue;
        }
        r -= P0_WSG;
        if (r < P0_MODV) {
            const int l = r / 192, n0 = (r % 192) * 32;
            LAS float* sc = scr;
            LAS float* red = scr + 9 * 1024;
            __syncthreads();
            for (int i = tid; i < 9 * 1024; i += NTHREADS) { const int mb = i >> 10, k = i & 1023; sc[i] = silu_f(mb < 8 ? c.in(I_C)[mb * 1024 + k] : c.in(I_CCTX)[k]); }
            __syncthreads();
            const int kq = tid >> 3, nl = tid & 7;
            float a[9][4];
#pragma unroll
            for (int j = 0; j < 9; ++j) { a[j][0] = 0.f; a[j][1] = 0.f; a[j][2] = 0.f; a[j][3] = 0.f; }
            const float* wp = c.in(I_WMOD) + (size_t)l * 1024 * 6144 + n0 + 4 * nl;
#pragma unroll
            for (int k2 = 0; k2 < 16; ++k2) { const int k = kq * 16 + k2; const f32x4 w = __builtin_nontemporal_load((const f32x4*)(wp + (size_t)k * 6144));
#pragma unroll
                for (int j = 0; j < 9; ++j) { const float s = sc[j * 1024 + k]; a[j][0] += s * w[0]; a[j][1] += s * w[1]; a[j][2] += s * w[2]; a[j][3] += s * w[3]; } }
#pragma unroll
            for (int j = 0; j < 9; ++j)
#pragma unroll
                for (int q = 0; q < 4; ++q) { float v = a[j][q]; v += xlane<8>(v); v += xlane<16>(v); v += xlane<32>(v); a[j][q] = v; }
            if ((tid & 63) < 8) {
#pragma unroll
                for (int j = 0; j < 9; ++j)
#pragma unroll
                    for (int q = 0; q < 4; ++q) red[((tid >> 6) * 9 + j) * 32 + 4 * nl + q] = a[j][q];
            }
            __syncthreads();
            for (int i = tid; i < 9 * 32; i += NTHREADS) { const int mb = i >> 5, n = i & 31;
                float v = 0.f;
#pragma unroll
                for (int w = 0; w < NW; ++w) v += red[(w * 9 + mb) * 32 + n];
                c.ws<float>(WS_MODV)[(size_t)(l * 9 + mb) * 6144 + n0 + n] = v + c.in(I_BMOD)[l * 6144 + n0 + n]; }
            __syncthreads();
            continue;
        }
        r -= P0_MODV;
        if (r < P0_ROPE) {
            const int idx = r * NTHREADS + tid;
            if (idx < 2048 * 32) { const int s = idx >> 5, i = idx & 31, f = i & 15; const float pos = (float)((i < 16) ? (s >> 6) : (s & 63));
                const float inv = powf(10000.f, -(float)f / 16.f), ang = pos * inv;
                c.ws<float>(WS_ROPEC)[idx] = cosf(ang); c.ws<float>(WS_ROPEC)[2048 * 32 + idx] = sinf(ang); }
            else { const int j = idx - 2048 * 32, s = j >> 4, i = j & 15, f = i & 7; const float pos = (float)((i < 8) ? (s >> 6) : (s & 63));
                const float inv = powf(10000.f, -(float)f / 8.f), ang = pos * inv;
                c.ws<float>(WS_ROPED)[j] = cosf(ang); c.ws<float>(WS_ROPED)[2048 * 16 + j] = sinf(ang); }
            continue;
        }
        r -= P0_ROPE;
        {
            const int e = (r * NTHREADS + tid) * 8, l = e / (96 * 1024), o = e % (96 * 1024);
            unsigned z = 0u; asm volatile("" : "+v"(z));
            *(u32x4*)(c.ws<bf16_t>(WS_WIN) + ((size_t)l * INCP + INC) * 1024 + o) = (u32x4){z, z, z, z};
        }
    }
}

constexpr int A_RW_ITEMS = NL * 9 * 1024 / NTHREADS;
constexpr int A_RC_ITEMS = NL * 9 * 20 / NW;
DEV void phase_a(const Ctx& c) {
    const int tid = c.tid, lane = tid & 63, wave = tid >> 6;
    const float* g = c.in(I_GATTN) + c.layer * 1024;
    bf16_t* H = c.ws<bf16_t>(WS_ACT);
    const int nwv = c.nb * NW, per = (NTOK + nwv - 1) / nwv, tbeg = (c.bid * NW + wave) * per, tend = min(tbeg + per, NTOK);
    int mbc = -1; f32x4 gm[4], sv[4];
    auto ecol = [&](int i) { return (i >> 1) * 512 + lane * 8 + (i & 1) * 4; };
#pragma unroll 1
    for (int t0 = tbeg; t0 < tend; t0 += 5) {
        f32x4 v[5][4];
#pragma unroll
        for (int u = 0; u < 5; ++u) { const int tok = min(t0 + u, tend - 1);
#pragma unroll
            for (int j = 0; j < 2; ++j) {
                if (c.layer == 0) { v[u][2 * j] = c.xload4(tok, ecol(2 * j)); v[u][2 * j + 1] = c.xload4(tok, ecol(2 * j + 1)); }
                else { const u32x4 raw = *(const u32x4*)(c.xs(tok) + j * 512 + lane * 8);
                    v[u][2 * j] = (f32x4){bflo(raw[0]), bfhi(raw[0]), bflo(raw[1]), bfhi(raw[1])}; v[u][2 * j + 1] = (f32x4){bflo(raw[2]), bfhi(raw[2]), bflo(raw[3]), bfhi(raw[3])}; } } }
#pragma unroll
        for (int u = 0; u < 5; ++u) { const int tok = t0 + u;
            if (tok < tend) {
                const int mb = tok < NLAT ? (tok >> 11) : 8;
                if (mb != mbc) { mbc = mb; const float* sh = c.modv(mb, 0); const float* scl = c.modv(mb, 1);
#pragma unroll
                    for (int i = 0; i < 4; ++i) { const int e = ecol(i); const f32x4 gg = *(const f32x4*)(g + e), s1 = *(const f32x4*)(scl + e);
                        gm[i] = (f32x4){gg[0] * (1.f + s1[0]), gg[1] * (1.f + s1[1]), gg[2] * (1.f + s1[2]), gg[3] * (1.f + s1[3])}; sv[i] = *(const f32x4*)(sh + e); } }
                float ss = 0.f;
#pragma unroll
                for (int i = 0; i < 4; ++i) ss += v[u][i][0] * v[u][i][0] + v[u][i][1] * v[u][i][1] + v[u][i][2] * v[u][i][2] + v[u][i][3] * v[u][i][3];
                const float r = rsqrtf(wave_sum(ss) * (1.f / 1024.f) + EPS);
#pragma unroll
                for (int jh = 0; jh < 2; ++jh) { unsigned w[4];
#pragma unroll
                    for (int hh = 0; hh < 2; ++hh) { const int i = 2 * jh + hh; float o[4];
#pragma unroll
                        for (int j = 0; j < 4; ++j) o[j] = v[u][i][j] * r * gm[i][j] + sv[i][j];
                        w[2 * hh] = pk2(o[0], o[1]); w[2 * hh + 1] = pk2(o[2], o[3]); }
                    *(u32x4*)(H + (size_t)tok * 1024 + jh * 512 + lane * 8) = (u32x4){w[0], w[1], w[2], w[3]}; }
            } }
    }
    if (c.layer == 0) {
        for (int it = c.bid; it < A_RW_ITEMS + A_RC_ITEMS; it += c.nb) {
            if (it < A_RW_ITEMS) {
                const int idx = it * NTHREADS + tid, l = idx / (9 * 1024), mb = (idx >> 10) % 9, k = idx & 1023;
                const float* mv = c.ws<float>(WS_MODV) + (size_t)(l * 9 + mb) * 6144;
                const float gm = c.in(I_GFFN)[l * 1024 + k] * (1.f + mv[4 * 1024 + k]);
                c.ws<float>(WS_GM)[idx] = gm;
                bf16_t* o = c.ws<bf16_t>(WS_RW) + (size_t)(l * 9 + mb) * 2 * 32 * 1024 + k;
                const float* wg = c.in(I_WRG) + ((size_t)l * 1024 + k) * 4; const float* we = c.in(I_WRE) + ((size_t)l * 1024 + k) * 16;
#pragma unroll
                for (int j = 0; j < 32; ++j) { const float w = j < 20 ? gm * (j < 4 ? wg[j] : we[j - 4]) : 0.f;
                    const bf16_t hi = f2bf(w); o[(size_t)j * 1024] = hi; o[(size_t)(32 + j) * 1024] = f2bf(w - bf2f(hi)); }
            } else {
                const int idx = (it - A_RW_ITEMS) * NW + wave, l = idx / 180, mb = (idx / 20) % 9, j = idx % 20;
                const float* mv = c.ws<float>(WS_MODV) + (size_t)(l * 9 + mb) * 6144 + 3 * 1024;
                float a = 0.f;
                for (int k = lane; k < 1024; k += 64) { const float w = (j < 4) ? c.in(I_WRG)[((size_t)l * 1024 + k) * 4 + j] : c.in(I_WRE)[((size_t)l * 1024 + k) * 16 + (j - 4)]; a += mv[k] * w; }
                a = wave_sum(a);
                if (lane == 0) c.ws<float>(WS_RC)[(l * 9 + mb) * 32 + j] = a + ((j < 4) ? c.in(I_BRG)[l * 4 + j] : c.in(I_BRE)[l * 16 + j - 4]);
            }
        }
    }
}

DEV void rope2(float& a, float& b, float cs, float sn) { const float x0 = a, x1 = b; a = x0 * cs - x1 * sn; b = x0 * sn + x1 * cs; }
DEV float red_q(float v) { v += xlane<16>(v); v += xlane<32>(v); return v; }
DEV void store_pair16(bf16_t* rowp, int c0, int q, unsigned x0lo, unsigned x0hi, unsigned x1lo, unsigned x1hi) {
    const auto s0 = __builtin_amdgcn_permlane16_swap(x0lo, x1lo, false, false), s1 = __builtin_amdgcn_permlane16_swap(x0hi, x1hi, false, false);
    *(u32x4*)(rowp + c0 + ((q & 1) ? 16 + 4 * (q - 1) : 4 * q)) = (u32x4){s0[0], s1[0], s0[1], s1[1]};
}
template <int MF>
DEV void b_epilogue(const Ctx& c, const f32x4 (&acc)[4][MF], int m0, int mb, int nbase, int lane) {
    const int l = c.layer;
    bf16_t* P = c.ws<bf16_t>(WS_P);
    const int q = lane >> 4, li = lane & 15;
    const bool isctx = m0 >= NLAT;
    if (nbase < 256) {
#pragma unroll
        for (int mf = 0; mf < MF; ++mf) { const int m = m0 + mb + 16 * mf + li;
#pragma unroll
            for (int pp = 0; pp < 2; ++pp) { const f32x4 a = acc[2 * pp][mf], b2 = acc[2 * pp + 1][mf];
                store_pair16(P + (size_t)m * INC, nbase + 32 * pp, q, pk2(gelu_fast(a[0]), gelu_fast(a[1])), pk2(gelu_fast(a[2]), gelu_fast(a[3])), pk2(gelu_fast(b2[0]), gelu_fast(b2[1])), pk2(gelu_fast(b2[2]), gelu_fast(b2[3]))); } }
    } else if (nbase < 512) {
        const float* vg = c.in(I_SGUVG) + l * 256 + (nbase - 256) + 4 * q;
#pragma unroll
        for (int mf = 0; mf < MF; ++mf) { const int m = m0 + mb + 16 * mf + li;
            float v[4][4]; float ss = 0.f;
#pragma unroll
            for (int nf = 0; nf < 4; ++nf)
#pragma unroll
                for (int r = 0; r < 4; ++r) { v[nf][r] = gelu_fast(acc[nf][mf][r]); ss += v[nf][r] * v[nf][r]; }
            const float rr = rsqrtf(red_q(ss) * (1.f / 64.f) + EPS);
#pragma unroll
            for (int pp = 0; pp < 2; ++pp) { const f32x4 g0 = *(const f32x4*)(vg + 32 * pp), g1 = *(const f32x4*)(vg + 32 * pp + 16);
                store_pair16(P + (size_t)m * INC, nbase + 32 * pp, q, pk2(v[2 * pp][0] * rr * g0[0], v[2 * pp][1] * rr * g0[1]), pk2(v[2 * pp][2] * rr * g0[2], v[2 * pp][3] * rr * g0[3]),
                              pk2(v[2 * pp + 1][0] * rr * g1[0], v[2 * pp + 1][1] * rr * g1[1]), pk2(v[2 * pp + 1][2] * rr * g1[2], v[2 * pp + 1][3] * rr * g1[3])); } }
    } else if (nbase < OFF_CQ || (nbase >= OFF_DCQ && nbase < OFF_DKR)) {
        const bool need_ss = nbase >= OFF_DCQ;
        const int sidx = nbase < OFF_DCKV ? (nbase - OFF_DCQ) >> 6 : 4 + ((nbase - OFF_DCKV) >> 6);
#pragma unroll
        for (int mf = 0; mf < MF; ++mf) { const int m = m0 + mb + 16 * mf + li; float ss = 0.f;
#pragma unroll
            for (int pp = 0; pp < 2; ++pp) { const f32x4 a = acc[2 * pp][mf], b2 = acc[2 * pp + 1][mf];
                ss += a[0] * a[0] + a[1] * a[1] + a[2] * a[2] + a[3] * a[3] + b2[0] * b2[0] + b2[1] * b2[1] + b2[2] * b2[2] + b2[3] * b2[3];
                store_pair16(P + (size_t)m * INC, nbase + 32 * pp, q, pk2(a[0], a[1]), pk2(a[2], a[3]), pk2(b2[0], b2[1]), pk2(b2[2], b2[3])); }
            if (need_ss) { ss = red_q(ss); if (q == 0) c.ws<float>(WS_SSQ)[(size_t)m * 8 + sidx] = ss; } }
    } else if (nbase < OFF_CV) {
        const bool isq = nbase < OFF_CK;
        const int h = isq ? (nbase - OFF_CQ) >> 6 : (nbase - OFF_CK) >> 6;
        const float* gn = (isq ? c.in(I_GQAQG) : c.in(I_GQAKG)) + l * 64 + 4 * q;
        const float sc = isq ? C_SCALE * LOG2E : 1.f;
        const float* cosC = c.ws<float>(WS_ROPEC); const float* sinC = cosC + 2048 * 32;
#pragma unroll
        for (int mf = 0; mf < MF; ++mf) { const int m = m0 + mb + 16 * mf + li;
            int b, pos, key; bool ic; tok_info(m, b, pos, key, ic);
            float ss = 0.f;
#pragma unroll
            for (int nf = 0; nf < 4; ++nf) { const f32x4 a = acc[nf][mf]; ss += a[0] * a[0] + a[1] * a[1] + a[2] * a[2] + a[3] * a[3]; }
            const float rr = rsqrtf(red_q(ss) * (1.f / 64.f) + EPS);
            bf16_t* dst = isq ? c.ws<bf16_t>(WS_QC) + ((size_t)(b * 4 + h) * KEYS + key) * 64 : c.ws<bf16_t>(WS_KC) + ((size_t)(b * 2 + h) * KEYS + key) * 64;
            unsigned plo[4], phi[4];
#pragma unroll
            for (int nf = 0; nf < 4; ++nf) { const f32x4 gg = *(const f32x4*)(gn + 16 * nf); const f32x4 a = acc[nf][mf];
                float v0 = a[0] * rr * gg[0], v1 = a[1] * rr * gg[1], v2 = a[2] * rr * gg[2], v3 = a[3] * rr * gg[3];
                if (!isctx) { const f32x2 cs = *(const f32x2*)(cosC + pos * 32 + 8 * nf + 2 * q), sn = *(const f32x2*)(sinC + pos * 32 + 8 * nf + 2 * q);
                    rope2(v0, v1, cs[0], sn[0]); rope2(v2, v3, cs[1], sn[1]); }
                plo[nf] = pk2(v0 * sc, v1 * sc); phi[nf] = pk2(v2 * sc, v3 * sc); }
#pragma unroll
            for (int pp = 0; pp < 2; ++pp) store_pair16(dst, 32 * pp, q, plo[2 * pp], phi[2 * pp], plo[2 * pp + 1], phi[2 * pp + 1]); }
    } else if (nbase < OFF_DCQ) {
        const int kvh = (nbase - OFF_CV) >> 6;
#pragma unroll
        for (int mf = 0; mf < MF; ++mf) { const int m = m0 + mb + 16 * mf + li;
            int b, pos, key; bool ic; tok_info(m, b, pos, key, ic);
            bf16_t* dst = c.ws<bf16_t>(WS_VCT) + ((size_t)(b * 2 + kvh) * 64 + 4 * q) * KEYS + key;
#pragma unroll
            for (int nf = 0; nf < 4; ++nf) { const f32x4 a = acc[nf][mf]; const unsigned p0 = pk2(a[0], a[1]), p1 = pk2(a[2], a[3]);
                bf16_t* d = dst + (size_t)(16 * nf) * KEYS;
                d[0] = (bf16_t)(p0 & 0xffffu); d[KEYS] = (bf16_t)(p0 >> 16); d[2 * KEYS] = (bf16_t)(p1 & 0xffffu); d[3 * KEYS] = (bf16_t)(p1 >> 16); } }
    } else if (nbase < OFF_DKR + 64) {
        const float* gn = c.in(I_MLAKG) + l * 96 + 64 + 4 * q;
        const float* cosD = c.ws<float>(WS_ROPED); const float* sinD = cosD + 2048 * 16;
#pragma unroll
        for (int mf = 0; mf < MF; ++mf) { const int m = m0 + mb + 16 * mf + li;
            int b, pos, key; bool ic; tok_info(m, b, pos, key, ic);
            float ss = 0.f;
#pragma unroll
            for (int nf = 0; nf < 2; ++nf) { const f32x4 a = acc[nf][mf]; ss += a[0] * a[0] + a[1] * a[1] + a[2] * a[2] + a[3] * a[3]; }
            const float rr = rsqrtf(red_q(ss) * (1.f / 32.f) + EPS);
#pragma unroll
            for (int nf = 0; nf < 2; ++nf) { const f32x4 gg = *(const f32x4*)(gn + 16 * nf); const f32x4 a = acc[nf][mf];
                float v0 = a[0] * rr * gg[0], v1 = a[1] * rr * gg[1], v2 = a[2] * rr * gg[2], v3 = a[3] * rr * gg[3];
                if (!isctx) { const f32x2 cs = *(const f32x2*)(cosD + pos * 16 + 8 * nf + 2 * q), sn = *(const f32x2*)(sinD + pos * 16 + 8 * nf + 2 * q);
                    rope2(v0, v1, cs[0], sn[0]); rope2(v2, v3, cs[1], sn[1]); }
                const u32x2 o = (u32x2){pk2(v0, v1), pk2(v2, v3)};
#pragma unroll
                for (int h = 0; h < 4; ++h) *(u32x2*)(c.ws<bf16_t>(WS_KD) + ((size_t)(b * 4 + h) * KEYS + key) * 96 + 64 + 16 * nf + 4 * q) = o; } }
    }
}
DEV void phase_b(const Ctx& c) {
    const int l = c.layer;
    GemmDesc g; g.A = c.ws<bf16_t>(WS_ACT); g.lda = 1024; g.rowidx = nullptr; g.nvalid = 0;
    g.B0 = c.ws<bf16_t>(WS_WIN) + (size_t)l * INCP * 1024; g.B1 = g.B0; g.ldb = 1024; g.ksplit = 1 << 30; g.K = 1024;
    constexpr int NT_N = INCP / 256, NT_M = NTOK / 256;
    auto full_tile = [&](int mt, int nt) { const int m0 = mt * 256;
        gemm_tile<4, 8>(g, m0, nt * 256, c.lds, c.tid, [&](const f32x4 (&acc)[4][8], int mb, int nbase, int lane) { b_epilogue<8>(c, acc, m0, mb, nbase, lane); }); };
    if (c.nb != 256) { for (int t = c.bid; t < NT_M * NT_N; t += c.nb) full_tile(t / NT_N, t % NT_N); }
    else if (l < NL - 1) {
        const int nmine = c.bid < 136 ? 3 : 2;
        for (int rd = 0; rd < nmine; ++rd) {
            int mt, nt, ex = -1, ch = -1;
            if (c.bid >= 136) ex = (c.bid - 136) + 120 * rd;
            else if (rd == 0) { if (c.bid < 48) ex = 240 + c.bid; else ch = c.bid - 48; }
            else ch = 88 + 136 * (rd - 1) + c.bid;
            if (ex >= 0) { const int k = ex / 72; nt = k == 0 ? 5 : (k == 1 ? 6 : (k == 2 ? 1 : 0)); mt = ex % 72; }
            else { const int k = ch / 72; nt = k < 3 ? 2 + k : 4 + k; mt = ch % 72; }
            full_tile(mt, nt);
        }
    } else {
        auto unit = [&](int u, int& mt, int& nt) {
            if (u < 256) { const int k = u >> 6; nt = k == 0 ? 5 : (k == 1 ? 6 : (k == 2 ? 1 : 0)); mt = u & 63; }
            else if (u < 576) { const int v = u - 256, k = v >> 6; nt = k < 3 ? 2 + k : 4 + k; mt = v & 63; }
            else { const int v = u - 576; nt = (v >> 3) ? 8 : 6; mt = 64 + (v & 7); } };
        for (int rd = 0; rd < 2; ++rd) { int mt, nt; unit(c.bid + 256 * rd, mt, nt); full_tile(mt, nt); }
        if (c.bid < 160) { int mt, nt; unit(512 + (c.bid >> 1), mt, nt); const int m0 = mt * 256;
            gemm_tile<2, 4>(g, m0, nt * 256 + (c.bid & 1) * 128, c.lds, c.tid, [&](const f32x4 (&acc)[4][4], int mb, int nbase, int lane) { b_epilogue<4>(c, acc, m0, mb, nbase, lane); }); }
    }
    if (l > 0 && c.nb != 256) {
        for (int e = c.bid; e < T_UP + T_DN; e += c.nb) p0_expert_item(c, l, e, (LAS float*)c.lds, c.tid);
    }
}

constexpr int C_SGU_ITEMS = (NTOK / 128) * 4, C_TQ = (NTOK / 256) * 3, C_TKV = (NTOK / 256) * 4;
constexpr int SG_LD = 272;
DEV void phase_c_sgu(const Ctx& c, int item) {
    const int tid = c.tid, lane = tid & 63, wave = tid >> 6, l = c.layer;
    const int chunk = item >> 2, h = item & 3, tok0 = chunk * 128;
    const bf16_t* P = c.ws<bf16_t>(WS_P);
    LAS char* Wt = c.lds;
    LAS char* vT = c.lds + 128 * SG_LD;
    u32x2 urp[4]; float bsp;
    { const int li_ = lane & 15, q_ = lane >> 4, tok_ = tok0 + 16 * wave + li_;
      bsp = c.in(I_SGUB)[(l * 4 + h) * 128 + 16 * wave + li_];
#pragma unroll
      for (int pp = 0; pp < 2; ++pp) { const u32x4 raw = *(const u32x4*)(P + (size_t)tok_ * INC + OFF_AU + 64 * h + 32 * pp + ((q_ & 1) ? 16 + 4 * (q_ - 1) : 4 * q_));
          const auto s0 = __builtin_amdgcn_permlane16_swap(raw[0], raw[2], false, false), s1 = __builtin_amdgcn_permlane16_swap(raw[1], raw[3], false, false);
          urp[2 * pp] = (u32x2){s0[0], s1[0]}; urp[2 * pp + 1] = (u32x2){s0[1], s1[1]}; } }
    __syncthreads();
    {
        const bf16_t* Wsrc = c.ws<bf16_t>(WS_WSG) + (size_t)(l * 4 + h) * 128 * 128;
#pragma unroll
        for (int i = 0; i < 4; ++i) { const int ci = tid + NTHREADS * i, r = ci >> 4, kc = ci & 15; *(LAS u32x4*)(Wt + r * SG_LD + kc * 16) = *(const u32x4*)(Wsrc + r * 128 + kc * 8); }
        const int j = tid >> 2, qt = tid & 3;
        const bf16_t* vp = P + (size_t)(tok0 + j) * INC + OFF_AV + 64 * h + 16 * qt;
#pragma unroll
        for (int q = 0; q < 2; ++q) { const u32x4 raw = *(const u32x4*)(vp + 8 * q);
#pragma unroll
            for (int e = 0; e < 4; ++e) { LAS char* d = vT + (16 * qt + 8 * q + 2 * e) * SG_LD + j * 2;
                *(LAS bf16_t*)d = (bf16_t)(raw[e] & 0xffffu); *(LAS bf16_t*)(d + SG_LD) = (bf16_t)(raw[e] >> 16); } }
    }
    __syncthreads();
    f32x4 acc[4];
#pragma unroll
    for (int a = 0; a < 4; ++a) acc[a] = (f32x4){0.f, 0.f, 0.f, 0.f};
    const int q = lane >> 4, li = lane & 15;
#pragma unroll
    for (int ks = 0; ks < 4; ++ks) {
        bf16x8 af[4];
#pragma unroll
        for (int df = 0; df < 4; ++df) af[df] = lds_r128(vT + (16 * df + li) * SG_LD + (4 * ks + q) * 16);
        const bf16x8 bfr = lds_r128(Wt + (16 * wave + li) * SG_LD + (4 * ks + q) * 16);
#pragma unroll
        for (int df = 0; df < 4; ++df) acc[df] = __builtin_amdgcn_mfma_f32_16x16x32_bf16(af[df], bfr, acc[df], 0, 0, 0);
    }
    bf16_t* Y = c.ws<bf16_t>(WS_ACT);
    {
        const int i = 16 * wave + li, tok = tok0 + i;
        const float bs = bsp;
#pragma unroll
        for (int pp = 0; pp < 2; ++pp) {
            const u32x2 u0 = urp[2 * pp], u1 = urp[2 * pp + 1];
            const f32x4 a = acc[2 * pp], b2 = acc[2 * pp + 1];
            store_pair16(Y + (size_t)tok * 1024 + 64 * h, 32 * pp, q, pk2(bflo(u0[0]) * (a[0] + bs), bfhi(u0[0]) * (a[1] + bs)), pk2(bflo(u0[1]) * (a[2] + bs), bfhi(u0[1]) * (a[3] + bs)),
                         pk2(bflo(u1[0]) * (b2[0] + bs), bfhi(u1[0]) * (b2[1] + bs)), pk2(bflo(u1[1]) * (b2[2] + bs), bfhi(u1[1]) * (b2[3] + bs)));
        }
    }
}
DEV void phase_c(const Ctx& c) {
    const int l = c.layer;
    const bf16_t* P = c.ws<bf16_t>(WS_P);
    const float* cosD = c.ws<float>(WS_ROPED); const float* sinD = cosD + 2048 * 16;
    int it = c.bid;
    const bool lastl = (l == NL - 1);
    for (; it < C_SGU_ITEMS; it += c.nb) { if (!(lastl && (it >> 2) >= NLAT / 128)) phase_c_sgu(c, it); }
    for (; it < C_SGU_ITEMS + C_TQ; it += c.nb) {
        const int t = it - C_SGU_ITEMS, mt = t / 3, nt = t % 3, m0 = mt * 256;
        if (lastl && m0 >= NLAT) continue;
        GemmDesc g; g.rowidx = nullptr; g.nvalid = 0; g.ksplit = 1 << 30; g.lda = INC;
        g.A = P + OFF_DCQ; g.K = 256; g.B0 = c.ws<bf16_t>(WS_WQB) + (size_t)l * 384 * 256; g.B1 = g.B0; g.ldb = 256;
        float r0p[4];
#pragma unroll
        for (int mf = 0; mf < 4; ++mf) { const f32x4 s4 = *(const f32x4*)(c.ws<float>(WS_SSQ) + (size_t)(m0 + 64 * (c.tid >> 7) + 16 * mf + (c.tid & 15)) * 8);
            r0p[mf] = rsqrtf((s4[0] + s4[1] + s4[2] + s4[3]) * (1.f / 256.f) + EPS); }
        gemm_tile<2, 4>(g, m0, nt * 128, c.lds, c.tid, [&](const f32x4 (&acc)[4][4], int mb, int nbase, int lane) {
            const int q = lane >> 4, li = lane & 15, wn = (nbase >> 6) & 1;
            const bool isctx = m0 >= NLAT;
            const float* qg = c.in(I_MLAQG) + l * 96;
            const float sc = D_SCALE * LOG2E;
#pragma unroll
            for (int mf = 0; mf < 4; ++mf) { const int m = m0 + mb + 16 * mf + li;
                int b, pos, key; bool ic; tok_info(m, b, pos, key, ic);
                const float r0 = r0p[mf];
                if (nt < 2) {
                    const int h = 2 * nt + wn; float ss = 0.f;
#pragma unroll
                    for (int nf = 0; nf < 4; ++nf) { const f32x4 a = acc[nf][mf] * r0; ss += a[0] * a[0] + a[1] * a[1] + a[2] * a[2] + a[3] * a[3]; }
                    const float rr = rsqrtf(red_q(ss) * (1.f / 64.f) + EPS) * r0 * sc;
                    bf16_t* dst = c.ws<bf16_t>(WS_QD) + ((size_t)(b * 4 + h) * KEYS + key) * 96 + 4 * q;
#pragma unroll
                    for (int pp = 0; pp < 2; ++pp) { const f32x4 g0 = *(const f32x4*)(qg + 32 * pp + 4 * q), g1 = *(const f32x4*)(qg + 32 * pp + 16 + 4 * q); const f32x4 a = acc[2 * pp][mf], b2 = acc[2 * pp + 1][mf];
                        store_pair16(dst - 4 * q, 32 * pp, q, pk2(a[0] * rr * g0[0], a[1] * rr * g0[1]), pk2(a[2] * rr * g0[2], a[3] * rr * g0[3]), pk2(b2[0] * rr * g1[0], b2[1] * rr * g1[1]), pk2(b2[2] * rr * g1[2], b2[3] * rr * g1[3])); }
                } else {
#pragma unroll
                    for (int hh = 0; hh < 2; ++hh) { const int h = 2 * wn + hh; float ss = 0.f;
#pragma unroll
                        for (int n2 = 0; n2 < 2; ++n2) { const f32x4 a = acc[2 * hh + n2][mf] * r0; ss += a[0] * a[0] + a[1] * a[1] + a[2] * a[2] + a[3] * a[3]; }
                        const float rr = rsqrtf(red_q(ss) * (1.f / 32.f) + EPS) * r0;
                        bf16_t* dst = c.ws<bf16_t>(WS_QD) + ((size_t)(b * 4 + h) * KEYS + key) * 96 + 64 + 4 * q;
#pragma unroll
                        for (int n2 = 0; n2 < 2; ++n2) { const f32x4 gg = *(const f32x4*)(qg + 64 + 16 * n2 + 4 * q); const f32x4 a = acc[2 * hh + n2][mf];
                            float v0 = a[0] * rr * gg[0], v1 = a[1] * rr * gg[1], v2 = a[2] * rr * gg[2], v3 = a[3] * rr * gg[3];
                            if (!isctx) { const f32x2 cs = *(const f32x2*)(cosD + pos * 16 + 8 * n2 + 2 * q), sn = *(const f32x2*)(sinD + pos * 16 + 8 * n2 + 2 * q);
                                rope2(v0, v1, cs[0], sn[0]); rope2(v2, v3, cs[1], sn[1]); }
                            *(u32x2*)(dst + 16 * n2) = (u32x2){pk2(v0 * sc, v1 * sc), pk2(v2 * sc, v3 * sc)}; } }
                }
            }
        });
    }
    for (; it < C_SGU_ITEMS + C_TQ + C_TKV; it += c.nb) {
        const int t = it - C_SGU_ITEMS - C_TQ, mt = t >> 2, h = t & 3, m0 = mt * 256;
        GemmDesc g; g.rowidx = nullptr; g.nvalid = 0; g.ksplit = 1 << 30; g.lda = INC;
        g.A = P + OFF_DCKV; g.K = 128; g.B0 = c.ws<bf16_t>(WS_WKVB) + (size_t)l * 512 * 128; g.B1 = g.B0; g.ldb = 128;
        float r0p[4];
#pragma unroll
        for (int mf = 0; mf < 4; ++mf) { const f32x2 s2 = *(const f32x2*)(c.ws<float>(WS_SSQ) + (size_t)(m0 + 64 * (c.tid >> 7) + 16 * mf + (c.tid & 15)) * 8 + 4);
            r0p[mf] = rsqrtf((s2[0] + s2[1]) * (1.f / 128.f) + EPS); }
        gemm_tile<2, 4>(g, m0, h * 128, c.lds, c.tid, [&](const f32x4 (&acc)[4][4], int mb, int nbase, int lane) {
            const int q = lane >> 4, li = lane & 15, wn = (nbase >> 6) & 1;
            const float* kg = c.in(I_MLAKG) + l * 96;
#pragma unroll
            for (int mf = 0; mf < 4; ++mf) { const int m = m0 + mb + 16 * mf + li;
                int b, pos, key; bool ic; tok_info(m, b, pos, key, ic);
                const float r0 = r0p[mf];
                if (wn == 0) {
                    float ss = 0.f;
#pragma unroll
                    for (int nf = 0; nf < 4; ++nf) { const f32x4 a = acc[nf][mf] * r0; ss += a[0] * a[0] + a[1] * a[1] + a[2] * a[2] + a[3] * a[3]; }
                    const float rr = rsqrtf(red_q(ss) * (1.f / 64.f) + EPS) * r0;
                    bf16_t* dst = c.ws<bf16_t>(WS_KD) + ((size_t)(b * 4 + h) * KEYS + key) * 96 + 4 * q;
#pragma unroll
                    for (int pp = 0; pp < 2; ++pp) { const f32x4 g0 = *(const f32x4*)(kg + 32 * pp + 4 * q), g1 = *(const f32x4*)(kg + 32 * pp + 16 + 4 * q); const f32x4 a = acc[2 * pp][mf], b2 = acc[2 * pp + 1][mf];
                        store_pair16(dst - 4 * q, 32 * pp, q, pk2(a[0] * rr * g0[0], a[1] * rr * g0[1]), pk2(a[2] * rr * g0[2], a[3] * rr * g0[3]), pk2(b2[0] * rr * g1[0], b2[1] * rr * g1[1]), pk2(b2[2] * rr * g1[2], b2[3] * rr * g1[3])); }
                } else {
                    bf16_t* dst = c.ws<bf16_t>(WS_VDT) + ((size_t)(b * 4 + h) * 64 + 4 * q) * KEYS + key;
#pragma unroll
                    for (int nf = 0; nf < 4; ++nf) { const f32x4 a = acc[nf][mf] * r0; const unsigned p0 = pk2(a[0], a[1]), p1 = pk2(a[2], a[3]);
                        bf16_t* d = dst + (size_t)(16 * nf) * KEYS;
                        d[0] = (bf16_t)(p0 & 0xffffu); d[KEYS] = (bf16_t)(p0 >> 16); d[2 * KEYS] = (bf16_t)(p1 & 0xffffu); d[3 * KEYS] = (bf16_t)(p1 >> 16); }
                }
            }
        });
    }
}

constexpr int AT_KN = 0, AT_KR = 8192, AT_V = 12288, AT_STAGE = 21504, AT_VLD = 136;
constexpr int AT_CV = 2 * AT_STAGE;
template <int DK, bool CV>
DEV void attn_item(const Ctx& c, const bf16_t* Q, const bf16_t* K, const bf16_t* Vt, int nkeys, bf16_t* Yrow, LAS char* lds, int tid, float mref) {
    const int lane = tid & 63, wave = tid >> 6, l31 = lane & 31, h5 = lane >> 5;
    f32x4 cv0 = (f32x4){0.f, 0.f, 0.f, 0.f}, cv1 = cv0;
    auto cv_decode = [&](int j, const float*& W, bf16_t*& WT, int& Kd, int& Nd, int& kt, int& ntl, int& mode) {
        const int item = c.bid + 256 * j, l = c.layer;
        if (item < T_UP) { const int e = item / 128, q = item % 128; W = c.in(I_WUP) + ((size_t)l * 16 + e) * 1024 * 512; Kd = 1024; Nd = 512; WT = c.ws<bf16_t>(WS_WUP) + (size_t)e * 512 * 1024; kt = q / 8; ntl = q % 8; mode = 1; }
        else { const int r = item - T_UP, e = r / 64, q = r % 64; W = c.in(I_WDN) + ((size_t)l * 16 + e) * 256 * 1024; Kd = 256; Nd = 1024; WT = c.ws<bf16_t>(WS_WDN) + (size_t)e * 1024 * 256; kt = q / 16; ntl = q % 16; mode = 0; }
    };
    auto cv_load = [&](int j) { const float* W; bf16_t* WT; int Kd, Nd, kt, ntl, mode; cv_decode(j, W, WT, Kd, Nd, kt, ntl, mode);
        const float* src = W + (size_t)(kt * 64 + (tid >> 4)) * Nd + ntl * 64 + (tid & 15) * 4;
        cv0 = __builtin_nontemporal_load((const f32x4*)src); cv1 = __builtin_nontemporal_load((const f32x4*)(src + (size_t)32 * Nd)); };
    auto cv_lds = [&]() { LAS float* scr = (LAS float*)(lds + AT_CV); const int n4 = (tid & 15) * 4, kr = tid >> 4;
#pragma unroll
        for (int e = 0; e < 4; ++e) { scr[kr * 65 + n4 + e] = cv0[e]; scr[(kr + 32) * 65 + n4 + e] = cv1[e]; } };
    auto cv_store = [&](int j) { const float* W; bf16_t* WT; int Kd, Nd, kt, ntl, mode; cv_decode(j, W, WT, Kd, Nd, kt, ntl, mode);
        LAS const float* scr = (LAS const float*)(lds + AT_CV);
        const int nl = tid >> 3, kcq = tid & 7, n = ntl * 64 + nl;
        int drow = n;
        if (mode == 1) { const int type = n >> 8, jj = n & 255; drow = 128 * (jj >> 6) + 64 * ((jj >> 5) & 1) + 16 * (((jj >> 4) & 1) + 2 * type) + (jj & 15); }
        unsigned o[4];
#pragma unroll
        for (int e = 0; e < 4; ++e) o[e] = pk2(scr[(kcq * 8 + 2 * e) * 65 + nl], scr[(kcq * 8 + 2 * e + 1) * 65 + nl]);
        __builtin_nontemporal_store((u32x4){o[0], o[1], o[2], o[3]}, (u32x4*)(WT + (size_t)drow * Kd + kt * 64 + kcq * 8)); };

    constexpr int NS = DK / 16;
    bf16x8 qf[NS];
#pragma unroll
    for (int s = 0; s < NS; ++s) qf[s] = *(const bf16x8*)(Q + (size_t)(32 * wave + l31) * DK + 16 * s + 8 * h5);
    f32x16 oacc[2];
#pragma unroll
    for (int i = 0; i < 16; ++i) { oacc[0][i] = 0.f; oacc[1][i] = 0.f; }
    float lsum = 0.f;
    const int kr_ = tid >> 3, kc_ = tid & 7;
    const int rr_ = (tid >> 2) & 63, rc_ = tid & 3;
    u32x4 rk, rv, rrp;
    const int nt = nkeys / 64;
    auto gload = [&](int t) {
        const int k0 = t * 64;
        rk = *(const u32x4*)(K + (size_t)(k0 + kr_) * DK + kc_ * 8); rv = *(const u32x4*)(Vt + (size_t)kr_ * KEYS + k0 + kc_ * 8);
        if (DK == 96 && tid < 256) rrp = *(const u32x4*)(K + (size_t)(k0 + rr_) * DK + 64 + rc_ * 8);
    };
    auto lstore = [&](int st) {
        LAS char* base = lds + st * AT_STAGE;
        { const int r = kr_;
            *(LAS u32x4*)(base + AT_KN + r * 128 + ((kc_ ^ ((r >> 1) & 7)) << 4)) = rk;
            LAS char* vd = base + AT_V + r * AT_VLD + kc_ * 16;
            *(LAS u32x2*)vd = (u32x2){rv[0], rv[1]}; *(LAS u32x2*)(vd + 8) = (u32x2){rv[2], rv[3]}; }
        if (DK == 96 && tid < 256) *(LAS u32x4*)(base + AT_KR + rr_ * 64 + ((rc_ ^ ((rr_ >> 2) & 3)) << 4)) = rrp;
    };
    __syncthreads();
    gload(0); lstore(0);
    __syncthreads();
    int cvj = 0, cvp = 0;
    for (int t = 0; t < nt; ++t) {
        const int cur = t & 1;
        if (t + 1 < nt) gload(t + 1);
        if (CV && cvj < 12) { if (cvp == 0) cv_load(cvj); else if (cvp == 2) cv_store(cvj); }
        LAS const char* base = lds + cur * AT_STAGE;
        f32x16 sacc[2];
        {
            bf16x8 kf[2][NS];
#pragma unroll
            for (int kt2 = 0; kt2 < 2; ++kt2) {
                const int row = 32 * kt2 + l31;
#pragma unroll
                for (int s = 0; s < 4; ++s) kf[kt2][s] = lds_r128(base + AT_KN + row * 128 + (((2 * s + h5) ^ ((row >> 1) & 7)) << 4));
                if (DK == 96) {
#pragma unroll
                    for (int s = 0; s < 2; ++s) kf[kt2][4 + s] = lds_r128(base + AT_KR + row * 64 + (((2 * s + h5) ^ ((row >> 2) & 3)) << 4));
                }
            }
            __builtin_amdgcn_sched_barrier(0);
#pragma unroll
            for (int kt2 = 0; kt2 < 2; ++kt2) {
#pragma unroll
                for (int i = 0; i < 16; ++i) sacc[kt2][i] = -mref;
#pragma unroll
                for (int s = 0; s < NS; ++s) sacc[kt2] = __builtin_amdgcn_mfma_f32_32x32x16_bf16(kf[kt2][s], qf[s], sacc[kt2], 0, 0, 0);
            }
        }
        bf16x8 vf[2][2][2];
#pragma unroll
        for (int dt = 0; dt < 2; ++dt)
#pragma unroll
            for (int kt2 = 0; kt2 < 2; ++kt2)
#pragma unroll
                for (int s2 = 0; s2 < 2; ++s2) {
                    LAS const char* vp = base + AT_V + (32 * dt + l31) * AT_VLD + (32 * kt2 + 16 * s2 + 4 * h5) * 2;
                    const u32x2 lo = *(LAS const u32x2*)vp, hi = *(LAS const u32x2*)(vp + 16);
                    vf[dt][kt2][s2] = __builtin_bit_cast(bf16x8, (u32x4){lo[0], lo[1], hi[0], hi[1]});
                }
        __builtin_amdgcn_sched_barrier(0);
        float ps = 0.f;
#pragma unroll
        for (int kt2 = 0; kt2 < 2; ++kt2)
#pragma unroll
            for (int i = 0; i < 16; ++i) { const float p = __builtin_amdgcn_exp2f(sacc[kt2][i]); sacc[kt2][i] = p; ps += p; }
        lsum += ps;
        bf16x8 pf[2][2];
#pragma unroll
        for (int kt2 = 0; kt2 < 2; ++kt2)
#pragma unroll
            for (int s2 = 0; s2 < 2; ++s2) {
                u32x4 w;
#pragma unroll
                for (int j = 0; j < 4; ++j) w[j] = pk2(sacc[kt2][8 * s2 + 2 * j], sacc[kt2][8 * s2 + 2 * j + 1]);
                pf[kt2][s2] = __builtin_bit_cast(bf16x8, w);
            }
#pragma unroll
        for (int dt = 0; dt < 2; ++dt)
#pragma unroll
            for (int kt2 = 0; kt2 < 2; ++kt2)
#pragma unroll
                for (int s2 = 0; s2 < 2; ++s2) oacc[dt] = __builtin_amdgcn_mfma_f32_32x32x16_bf16(vf[dt][kt2][s2], pf[kt2][s2], oacc[dt], 0, 0, 0);
        if (CV && cvj < 12) { if (cvp == 1) cv_lds(); if (++cvp == 3) { cvp = 0; ++cvj; } }
        if (t + 1 < nt) lstore(cur ^ 1);
        __syncthreads();
    }
    const float ltot = lsum + xlane<32>(lsum), inv = 1.f / ltot;
    bf16_t* yr = Yrow + (size_t)(32 * wave + l31) * 1024;
#pragma unroll
    for (int dt = 0; dt < 2; ++dt)
#pragma unroll
        for (int gp = 0; gp < 2; ++gp) {
            const int g0 = 2 * gp, g1 = 2 * gp + 1;
            const unsigned x0lo = pk2(oacc[dt][4 * g0] * inv, oacc[dt][4 * g0 + 1] * inv), x0hi = pk2(oacc[dt][4 * g0 + 2] * inv, oacc[dt][4 * g0 + 3] * inv);
            const unsigned x1lo = pk2(oacc[dt][4 * g1] * inv, oacc[dt][4 * g1 + 1] * inv), x1hi = pk2(oacc[dt][4 * g1 + 2] * inv, oacc[dt][4 * g1 + 3] * inv);
            const auto s0 = __builtin_amdgcn_permlane32_swap(x0lo, x1lo, false, false), s1 = __builtin_amdgcn_permlane32_swap(x0hi, x1hi, false, false);
            *(u32x4*)(yr + 32 * dt + 16 * gp + 8 * h5) = (u32x4){s0[0], s1[0], s0[1], s1[1]};
        }
}
DEV void phase_d(const Ctx& c) {
    const int nlat = 512, nctx = (c.layer == NL - 1) ? 0 : 64;
    bf16_t* Y = c.ws<bf16_t>(WS_ACT);
    float mrefC, mrefD;
    {
        const int lane = c.tid & 63, l = c.layer;
        auto wmax = [](float v) { return wave_max(v); };
        const float gq = wmax(fabsf(c.in(I_GQAQG)[l * 64 + lane])), gk = wmax(fabsf(c.in(I_GQAKG)[l * 64 + lane]));
        mrefC = 64.f * gq * gk * C_SCALE * LOG2E - 40.f;
        const float* mq = c.in(I_MLAQG) + l * 96; const float* mk = c.in(I_MLAKG) + l * 96;
        const float qn = wmax(fabsf(mq[lane])), qr = wmax(fabsf(mq[64 + (lane & 31)])), kn = wmax(fabsf(mk[lane])), kr = wmax(fabsf(mk[64 + (lane & 31)]));
        mrefD = sqrtf((64.f * qn * qn + 32.f * qr * qr) * (64.f * kn * kn + 32.f * kr * kr)) * D_SCALE * LOG2E - 40.f;
    }
    for (int it = c.bid; it < nlat + nctx; it += c.nb) {
        int type, b, h, qpos0, nkeys, tok0;
        if (it < nlat) {
            type = it >> 8; const int r = it & 255, pr = 4 * (r & 7) + (r >> 6), qb = (r >> 3) & 7; b = pr >> 2; h = pr & 3; qpos0 = CL + 256 * qb; nkeys = KEYS; tok0 = b * SEQ + 256 * qb; }
        else { const int u = it - nlat; type = u >> 5; const int r = u & 31; b = r >> 2; h = r & 3; qpos0 = 0; nkeys = CL; tok0 = NLAT + b * CL; }
        if (type == 0) {
            const bf16_t* Qp = c.ws<bf16_t>(WS_QD) + ((size_t)(b * 4 + h) * KEYS + qpos0) * 96; const bf16_t* Kp = c.ws<bf16_t>(WS_KD) + (size_t)(b * 4 + h) * KEYS * 96;
            const bf16_t* Vp = c.ws<bf16_t>(WS_VDT) + (size_t)(b * 4 + h) * 64 * KEYS; bf16_t* Yp = Y + (size_t)tok0 * 1024 + 768 + 64 * h;
            if (it < 256 && c.nb == 256) attn_item<96, true>(c, Qp, Kp, Vp, nkeys, Yp, c.lds, c.tid, mrefD);
            else attn_item<96, false>(c, Qp, Kp, Vp, nkeys, Yp, c.lds, c.tid, mrefD);
        } else {
            attn_item<64, false>(c, c.ws<bf16_t>(WS_QC) + ((size_t)(b * 4 + h) * KEYS + qpos0) * 64, c.ws<bf16_t>(WS_KC) + (size_t)(b * 2 + (h >> 1)) * KEYS * 64,
                          c.ws<bf16_t>(WS_VCT) + (size_t)(b * 2 + (h >> 1)) * 64 * KEYS, nkeys, Y + (size_t)tok0 * 1024 + 512 + 64 * h, c.lds, c.tid, mrefC);
        }
    }
}

DEV void phase_e0(const Ctx& c) {
    const int tid = c.tid, lane = tid & 63, wave = tid >> 6, l = c.layer;
    bf16_t* Y = c.ws<bf16_t>(WS_ACT); const bf16_t* P = c.ws<bf16_t>(WS_P);
    const float* gg = c.in(I_GGO) + l * 1024;
    const int ntok = c.ntok_tail();
    const int ch = 4 * lane;
    const float* cw = c.in(I_CONVW) + l * 768 + ch;
    const f32x4 w0 = *(const f32x4*)cw, w1 = *(const f32x4*)(cw + 256), w2 = *(const f32x4*)(cw + 512);
    f32x4 gn[4];
#pragma unroll
    for (int g = 0; g < 4; ++g) gn[g] = *(const f32x4*)(gg + g * 256 + ch);
    const int nwv = c.nb * NW, per = (ntok + nwv - 1) / nwv, tbeg = (c.bid * NW + wave) * per, tend = min(tbeg + per, ntok);
#pragma unroll 1
    for (int t0 = tbeg; t0 < tend; t0 += 2) {
        u32x2 ya[2], yc[2], yd[2], rbb[2], c0[2], x0[2], c1[2], x1[2], c2[2], x2[2]; float mp[2], mn[2];
#pragma unroll
        for (int u = 0; u < 2; ++u) { const int tok = min(t0 + u, tend - 1);
            int b, pos, key; bool isctx; tok_info(tok, b, pos, key, isctx);
            const int seqlen = isctx ? CL : SEQ;
            const bf16_t* pr = P + (size_t)tok * INC; const bf16_t* yr = Y + (size_t)tok * 1024;
            ya[u] = *(const u32x2*)(yr + ch); yc[u] = *(const u32x2*)(yr + 512 + ch); yd[u] = *(const u32x2*)(yr + 768 + ch);
            rbb[u] = *(const u32x2*)(pr + OFF_BB + ch);
            const bool okp = pos > 0, okn = pos < seqlen - 1;
            c0[u] = *(const u32x2*)(pr - (okp ? INC : 0) + OFF_BC + ch); x0[u] = *(const u32x2*)(pr - (okp ? INC : 0) + OFF_BX + ch);
            c1[u] = *(const u32x2*)(pr + OFF_BC + ch); x1[u] = *(const u32x2*)(pr + OFF_BX + ch);
            c2[u] = *(const u32x2*)(pr + (okn ? INC : 0) + OFF_BC + ch); x2[u] = *(const u32x2*)(pr + (okn ? INC : 0) + OFF_BX + ch);
            mp[u] = okp ? 1.f : 0.f; mn[u] = okn ? 1.f : 0.f; }
#pragma unroll
        for (int u = 0; u < 2; ++u) { const int tok = t0 + u;
            if (tok < tend) {
                bf16_t* yr = Y + (size_t)tok * 1024;
                float v[4][4];
                v[0][0] = bflo(ya[u][0]); v[0][1] = bfhi(ya[u][0]); v[0][2] = bflo(ya[u][1]); v[0][3] = bfhi(ya[u][1]);
                v[2][0] = bflo(yc[u][0]); v[2][1] = bfhi(yc[u][0]); v[2][2] = bflo(yc[u][1]); v[2][3] = bfhi(yc[u][1]);
                v[3][0] = bflo(yd[u][0]); v[3][1] = bfhi(yd[u][0]); v[3][2] = bflo(yd[u][1]); v[3][3] = bfhi(yd[u][1]);
                {
                    const float zp[4] = {mp[u] * bflo(c0[u][0]) * bflo(x0[u][0]), mp[u] * bfhi(c0[u][0]) * bfhi(x0[u][0]), mp[u] * bflo(c0[u][1]) * bflo(x0[u][1]), mp[u] * bfhi(c0[u][1]) * bfhi(x0[u][1])};
                    const float zc[4] = {bflo(c1[u][0]) * bflo(x1[u][0]), bfhi(c1[u][0]) * bfhi(x1[u][0]), bflo(c1[u][1]) * bflo(x1[u][1]), bfhi(c1[u][1]) * bfhi(x1[u][1])};
                    const float zn[4] = {mn[u] * bflo(c2[u][0]) * bflo(x2[u][0]), mn[u] * bfhi(c2[u][0]) * bfhi(x2[u][0]), mn[u] * bflo(c2[u][1]) * bflo(x2[u][1]), mn[u] * bfhi(c2[u][1]) * bfhi(x2[u][1])};
                    const float bb[4] = {bflo(rbb[u][0]), bfhi(rbb[u][0]), bflo(rbb[u][1]), bfhi(rbb[u][1])};
#pragma unroll
                    for (int j = 0; j < 4; ++j) v[1][j] = bb[j] * (w0[j] * zp[j] + w1[j] * zc[j] + w2[j] * zn[j]);
                }
                float ss[4];
#pragma unroll
                for (int g = 0; g < 4; ++g) ss[g] = v[g][0] * v[g][0] + v[g][1] * v[g][1] + v[g][2] * v[g][2] + v[g][3] * v[g][3];
#pragma unroll
                for (int g = 0; g < 4; ++g) ss[g] = wave_sum(ss[g]);
#pragma unroll
                for (int g = 0; g < 4; ++g) { const float r = rsqrtf(ss[g] * (1.f / 256.f) + EPS);
                    *(u32x2*)(yr + g * 256 + ch) = (u32x2){pk2(v[g][0] * r * gn[g][0], v[g][1] * r * gn[g][1]), pk2(v[g][2] * r * gn[g][2], v[g][3] * r * gn[g][3])}; }
            } }
    }
}
DEV void e_store_row4(const Ctx& c, int m, int n, const f32x4& a) {
    const float* gate = c.modv(m < NLAT ? (m >> 11) : 8, 2);
    const f32x4 gt = *(const f32x4*)(gate + n), xv = c.xload4(m, n);
    c.xsstore4(m, n, xv[0] + gt[0] * a[0], xv[1] + gt[1] * a[1], xv[2] + gt[2] * a[2], xv[3] + gt[3] * a[3]);
}
DEV void phase_e(const Ctx& c) {
    GemmDesc g; g.A = c.ws<bf16_t>(WS_ACT); g.lda = 1024; g.rowidx = nullptr; g.nvalid = 0;
    g.B0 = c.ws<bf16_t>(WS_WOUT) + (size_t)c.layer * 1024 * 1024; g.B1 = g.B0; g.ldb = 1024; g.ksplit = 1 << 30; g.K = 1024;
    const int nfull = (NLAT / 256) * 4, nhalf = (c.layer == NL - 1) ? 0 : (NCTX / 256) * 8;
    for (int t = c.bid; t < nfull + nhalf; t += c.nb) {
        if (t < nfull) { const int m0 = (t >> 2) * 256, n0 = (t & 3) * 256;
            gemm_tile8p(g, m0, n0, c.lds, c.tid, [&](const f32x4 (&acc)[2][2][4][2], int wr, int wc, int lane) {
                const float* gate = c.modv(m0 >> 11, 2) + n0 + 64 * wc + 4 * (lane >> 4);
                f32x4 gt[2][2];
#pragma unroll
                for (int bj = 0; bj < 2; ++bj)
#pragma unroll
                    for (int n = 0; n < 2; ++n) gt[bj][n] = *(const f32x4*)(gate + 32 * bj + 16 * n);
#pragma unroll
                for (int ai = 0; ai < 2; ++ai)
#pragma unroll
                    for (int m = 0; m < 4; ++m) { const int row = m0 + 128 * ai + 64 * wr + 16 * m + (lane & 15);
#pragma unroll
                        for (int bj = 0; bj < 2; ++bj)
                        { unsigned plo[2], phi[2]; f32x4 xp[2]; c.xload_pair(row, n0 + 64 * wc + 32 * bj, lane >> 4, xp[0], xp[1]);
#pragma unroll
                            for (int n = 0; n < 2; ++n) { const f32x4 xv = xp[n], a = acc[ai][bj][m][n], gg = gt[bj][n];
                                plo[n] = pk2(xv[0] + gg[0] * a[0], xv[1] + gg[1] * a[1]); phi[n] = pk2(xv[2] + gg[2] * a[2], xv[3] + gg[3] * a[3]); }
                            store_pair16(c.xs(row), n0 + 64 * wc + 32 * bj, lane >> 4, plo[0], phi[0], plo[1], phi[1]); } }
            });
            publish_rel(c, c.ws<unsigned>(WS_RDYE) + (c.layer * 128 + (t >> 2)) * 16, 2u); }
        else { const int u = t - nfull, m0 = NLAT + (u >> 3) * 256;
            gemm_tile<2, 4>(g, m0, (u & 7) * 128, c.lds, c.tid, [&](const f32x4 (&acc)[4][4], int mb, int nbase, int lane) {
#pragma unroll
                for (int mf = 0; mf < 4; ++mf)
#pragma unroll
                    for (int pp = 0; pp < 2; ++pp) { const int m = m0 + mb + 16 * mf + (lane & 15), q = lane >> 4, p0 = nbase + 32 * pp;
                        const int c0 = (p0 & ~255) | (((p0 >> 5) & 3) << 6) | (((p0 >> 7) & 1) << 5);
                        const float* gate = c.modv(m < NLAT ? (m >> 11) : 8, 2);
                        unsigned plo[2], phi[2];
#pragma unroll
                        for (int e = 0; e < 2; ++e) { const int n = c0 + 16 * e + 4 * q; const f32x4 gt = *(const f32x4*)(gate + n), xv = c.xload4(m, n), a = acc[2 * pp + e][mf];
                            plo[e] = pk2(xv[0] + gt[0] * a[0], xv[1] + gt[1] * a[1]); phi[e] = pk2(xv[2] + gt[2] * a[2], xv[3] + gt[3] * a[3]); }
                        store_pair16(c.xs(m), c0, q, plo[0], phi[0], plo[1], phi[1]); }
            });
            publish_rel(c, c.ws<unsigned>(WS_RDYE) + (c.layer * 128 + NLAT / 256 + (u >> 3)) * 16, 1u); }
    }
}

DEV void phase_f_item(const Ctx& c, int nseg, int sbase, int sstride) {
    const int tid = c.tid, lane = tid & 63, wave = tid >> 6, l = c.layer, li = lane & 15, q = lane >> 4;
    LAS float* part = (LAS float*)c.lds;
    LAS float* rs = part + 8 * 96 * 32;
    LAS int* hist = (LAS int*)(rs + 96);
    LAS int* hbase = hist + 32;
    int* cnt = c.ws<int>(WS_CNT) + l * NBUCKET * 32;
    int* ltok = c.ws<int>(WS_LTOK); float* lw = c.ws<float>(WS_LW);
    bf16_t* H = c.ws<bf16_t>(WS_ACT);
    __syncthreads();
    if (tid < 32) hist[tid] = 0;
    if (tid < 64) {
        unsigned* rd = c.ws<unsigned>(WS_RDYE) + l * 128 * 16; unsigned* bar = c.ws<unsigned>(WS_BAR);
        const int t0 = sbase >> 3, t1 = (sbase + sstride * (nseg > 1 ? 1 : 0)) >> 3, t2 = (sbase + sstride * (nseg > 2 ? 2 : 0)) >> 3;
        unsigned sp_ = 0;
        for (;;) { const unsigned a0 = xb_ld(rd + t0 * 16), a1 = xb_ld(rd + t1 * 16), a2 = xb_ld(rd + t2 * 16);
            if (a0 >= 8u && a1 >= 8u && a2 >= 8u) break;
            __builtin_amdgcn_s_sleep(2); if ((++sp_ & 1023u) == 0u) { if (xb_ld(&bar[XB_TMO])) break; if (sp_ > (1u << 24)) { atomicAdd(&bar[XB_TMO], 1u); break; } } }
        __builtin_amdgcn_fence(__ATOMIC_ACQUIRE, "agent");
    }
    __syncthreads();
#pragma unroll 1
    for (int sg = 0; sg < nseg; ++sg) {
        const int tokb = 32 * (sbase + sstride * sg), mb = tokb < NLAT ? (tokb >> 11) : 8;
        u32x4 r0[4], r1[4];
#pragma unroll
        for (int u = 0; u < 4; ++u) { const bf16_t* xr = c.xs(tokb + 4 * wave + u); r0[u] = *(const u32x4*)(xr + 8 * lane); r1[u] = *(const u32x4*)(xr + 512 + 8 * lane); }
        f32x4 g0[2], g1[2], s0[2], s1[2];
        { const float* gmv = c.ws<float>(WS_GM) + (size_t)(l * 9 + mb) * 1024; const float* sh = c.modv(mb, 3);
#pragma unroll
          for (int hf = 0; hf < 2; ++hf) { const int e = 512 * hf + 8 * lane; g0[hf] = *(const f32x4*)(gmv + e); g1[hf] = *(const f32x4*)(gmv + e + 4); s0[hf] = *(const f32x4*)(sh + e); s1[hf] = *(const f32x4*)(sh + e + 4); } }
        f32x4 acc[2][2];
#pragma unroll
        for (int a = 0; a < 2; ++a)
#pragma unroll
            for (int b = 0; b < 2; ++b) acc[a][b] = (f32x4){0.f, 0.f, 0.f, 0.f};
        const bf16_t* xrow = c.xs(tokb + li) + 128 * wave + 8 * q;
        const bf16_t* wrow = c.ws<bf16_t>(WS_RW) + (size_t)(l * 9 + mb) * 2 * 32 * 1024 + (size_t)li * 1024 + 128 * wave + 8 * q;
#pragma unroll
        for (int ks = 0; ks < 4; ++ks) {
            bf16x8 xf[2], wf[2][2];
#pragma unroll
            for (int hl = 0; hl < 2; ++hl)
#pragma unroll
                for (int nf = 0; nf < 2; ++nf) wf[hl][nf] = *(const bf16x8*)(wrow + (size_t)(hl * 32 + nf * 16) * 1024 + 32 * ks);
#pragma unroll
            for (int mf = 0; mf < 2; ++mf) xf[mf] = *(const bf16x8*)(xrow + (size_t)mf * 16 * DM + 32 * ks);
#pragma unroll
            for (int mf = 0; mf < 2; ++mf)
#pragma unroll
                for (int hl = 0; hl < 2; ++hl)
#pragma unroll
                    for (int nf = 0; nf < 2; ++nf) acc[nf][mf] = __builtin_amdgcn_mfma_f32_16x16x32_bf16(wf[hl][nf], xf[mf], acc[nf][mf], 0, 0, 0);
        }
#pragma unroll
        for (int mf = 0; mf < 2; ++mf)
#pragma unroll
            for (int nf = 0; nf < 2; ++nf) *(LAS f32x4*)(part + ((wave * 96 + 32 * sg + 16 * mf + li) * 32 + 16 * nf + 4 * q)) = acc[nf][mf];
#pragma unroll
        for (int u = 0; u < 4; ++u) { const int t = 32 * sg + 4 * wave + u, tok = tokb + 4 * wave + u;
            float v[16];
#pragma unroll
            for (int j = 0; j < 4; ++j) { v[2 * j] = bflo(r0[u][j]); v[2 * j + 1] = bfhi(r0[u][j]); v[8 + 2 * j] = bflo(r1[u][j]); v[8 + 2 * j + 1] = bfhi(r1[u][j]); }
            float ss = 0.f;
#pragma unroll
            for (int j = 0; j < 16; ++j) ss += v[j] * v[j];
            const float rr = rsqrtf(wave_sum(ss) * (1.f / 1024.f) + EPS);
            if (lane == 0) rs[t] = rr;
#pragma unroll
            for (int hf = 0; hf < 2; ++hf) { const int e = 512 * hf + 8 * lane;
                const float* vv = v + 8 * hf;
                *(u32x4*)(H + (size_t)tok * 1024 + e) = (u32x4){pk2(vv[0] * rr * g0[hf][0] + s0[hf][0], vv[1] * rr * g0[hf][1] + s0[hf][1]), pk2(vv[2] * rr * g0[hf][2] + s0[hf][2], vv[3] * rr * g0[hf][3] + s0[hf][3]),
                                                                  pk2(vv[4] * rr * g1[hf][0] + s1[hf][0], vv[5] * rr * g1[hf][1] + s1[hf][1]), pk2(vv[6] * rr * g1[hf][2] + s1[hf][2], vv[7] * rr * g1[hf][3] + s1[hf][3])}; }
        }
    }
    __syncthreads();
    int bucket = 0, rank = 0, mytok = 0; float wa = 0.f, wb = 0.f;
    if (tid < 32 * nseg) {
        const int t = tid, tok = 32 * (sbase + sstride * (t >> 5)) + (t & 31), mb = tok < NLAT ? (tok >> 11) : 8;
        mytok = tok;
        float s[20];
#pragma unroll
        for (int j = 0; j < 20; ++j) { float a = 0.f;
#pragma unroll
            for (int w = 0; w < NW; ++w) a += part[(w * 96 + t) * 32 + j];
            s[j] = a; }
            const float* RC = c.ws<float>(WS_RC) + (l * 9 + mb) * 32;
        const float r = rs[t];
        float gl[4], el[4];
#pragma unroll
        for (int j = 0; j < 4; ++j) gl[j] = r * s[j] + RC[j];
        int gi = 0; float gmx = gl[0];
#pragma unroll
        for (int j = 1; j < 4; ++j) if (gl[j] > gmx) { gmx = gl[j]; gi = j; }
        float gs = 0.f;
#pragma unroll
        for (int j = 0; j < 4; ++j) gs += __expf(gl[j] - gmx);
        const float gw = 1.f / gs;
#pragma unroll
        for (int j = 0; j < 4; ++j) { const float sj = gi == 0 ? s[4 + j] : (gi == 1 ? s[8 + j] : (gi == 2 ? s[12 + j] : s[16 + j])); el[j] = r * sj + RC[4 + 4 * gi + j]; }
        int e1 = 0; float m1 = el[0];
#pragma unroll
        for (int j = 1; j < 4; ++j) if (el[j] > m1) { m1 = el[j]; e1 = j; }
        int e2 = -1; float m2 = -3.0e38f;
#pragma unroll
        for (int j = 0; j < 4; ++j) if (j != e1 && el[j] > m2) { m2 = el[j]; e2 = j; }
        const float p2 = __expf(m2 - m1), w1 = gw / (1.f + p2), w2 = gw * p2 / (1.f + p2);
        const int ea = e1 < e2 ? e1 : e2, eb = e1 < e2 ? e2 : e1; wa = e1 < e2 ? w1 : w2; wb = e1 < e2 ? w2 : w1;
        const int pidx = ea == 0 ? eb - 1 : (ea == 1 ? eb + 1 : 5);
        bucket = gi * 6 + pidx;
        rank = __hip_atomic_fetch_add(hist + bucket, 1, __ATOMIC_RELAXED, __HIP_MEMORY_SCOPE_WORKGROUP);
    }
    __syncthreads();
    if (tid < NBUCKET) { const int n = hist[tid]; hbase[tid] = n > 0 ? atomicAdd(&cnt[tid * 32], n) : 0; }
    __syncthreads();
    if (tid < 32 * nseg) {
        const int pos = hbase[bucket] + rank;
        ltok[bucket * NTOK + pos] = mytok;
        lw[((size_t)bucket * NTOK + pos) * 2] = wa; lw[((size_t)bucket * NTOK + pos) * 2 + 1] = wb;
    }
}
DEV void phase_f(const Ctx& c) {
    if (c.nb == 256) {
        if (c.layer == NL - 1) phase_f_item(c, 2, 2 * c.bid, 1);
        else if (c.bid < 64) phase_f_item(c, 1, NLAT / 32 + c.bid, 0);
        else { const int k = c.bid - 64; phase_f_item(c, k < 128 ? 3 : 2, k, 192); }
    } else {
        for (int sgi = c.bid; sgi < c.ntok_tail() / 32; sgi += c.nb) phase_f_item(c, 1, sgi, 0);
    }
}

DEV void moe_table(const Ctx& c, const int* cnt) {
    volatile LAS int* tb = (volatile LAS int*)(c.lds + LDS_BAR + 64);
    __syncthreads();
    if (c.tid < NBUCKET) tb[32 + c.tid] = cnt[c.tid * 32];
    __syncthreads();
    if (c.tid <= NBUCKET) { int acc = 0; for (int b = 0; b < c.tid; ++b) acc += (tb[32 + b] + 255) >> 8; tb[c.tid] = acc; }
    __syncthreads();
}
DEV void moe_find_t(const Ctx& c, int mg, int& bucket, int& mt, int& total, int& count) {
    LAS const int* tb = (LAS const int*)(c.lds + LDS_BAR + 64);
    const int lane = c.tid & 63, lb = lane < NBUCKET ? lane : NBUCKET - 1;
    const int p0 = tb[lb], p1 = tb[lb + 1], cn = tb[32 + lb];
    const unsigned long long hit = __builtin_amdgcn_ballot_w64(lane < NBUCKET && mg >= p0 && mg < p1);
    bucket = hit ? (int)__builtin_ctzll(hit) : 0;
    mt = mg - __builtin_amdgcn_readlane(p0, bucket); count = __builtin_amdgcn_readlane(cn, bucket);
    total = __builtin_amdgcn_readfirstlane(tb[NBUCKET]);
}
DEV void moe_find(const int* cnt, int mg, int& bucket, int& mt, int& total) {
    int acc = 0; bucket = -1; mt = 0;
    for (int b = 0; b < NBUCKET; ++b) { const int n = (cnt[b * 32] + 255) >> 8; if (bucket < 0 && mg < acc + n) { bucket = b; mt = mg - acc; } acc += n; }
    total = acc;
}
DEV void pair_of(int pidx, int& ea, int& eb) { ea = pidx < 3 ? 0 : (pidx < 5 ? 1 : 2); eb = pidx < 3 ? pidx + 1 : (pidx < 5 ? pidx - 1 : 3); }
template <int WN_, int MF>
DEV void g_tile(const Ctx& c, const int* cnt, int mg, int nt8) {
    const int l = c.layer; (void)l;
    int bucket, mt, tt, bcount; moe_find_t(c, mg, bucket, mt, tt, bcount);
    int ea, eb; pair_of(bucket % 6, ea, eb); const int grp = bucket / 6;
    const int e = grp * 4 + ((nt8 < 4) ? ea : eb);
    const int nvalid = min(256, bcount - mt * 256);
    const int* rows = c.ws<int>(WS_LTOK) + bucket * NTOK + mt * 256;
    const float* wts = c.ws<float>(WS_LW) + ((size_t)bucket * NTOK + mt * 256) * 2 + ((nt8 < 4) ? 0 : 1);
    bf16_t* HB = c.ws<bf16_t>(WS_HBUF);
    GemmDesc g; g.A = c.ws<bf16_t>(WS_ACT); g.lda = 1024; g.rowidx = rows; g.nvalid = nvalid;
    g.B0 = c.ws<bf16_t>(WS_WUP) + (size_t)e * 512 * 1024; g.B1 = g.B0; g.ldb = 1024; g.ksplit = 1 << 30; g.K = 1024;
    const int hcol0 = (nt8 >> 2) * 256 + (nt8 & 3) * 64;
    gemm_tile<WN_, MF>(g, 0, (nt8 & 3) * 128, c.lds, c.tid, [&](const f32x4 (&acc)[4][MF], int mb, int nbase, int lane) {
        const int slot = ((nbase - (nt8 & 3) * 128) >> 6);
#pragma unroll
        for (int mf = 0; mf < MF; ++mf) { const int r = mb + 16 * mf + (lane & 15); const bool ok = r < nvalid; const float w = ok ? wts[2 * r] : 0.f;
            unsigned x[2][2];
#pragma unroll
            for (int f = 0; f < 2; ++f) { const f32x4 gt = acc[f][mf], up = acc[f + 2][mf]; float o[4];
#pragma unroll
                for (int j = 0; j < 4; ++j) o[j] = ok ? silu_f(gt[j]) * up[j] * w : 0.f;
                x[f][0] = pk2(o[0], o[1]); x[f][1] = pk2(o[2], o[3]); }
            const auto s0 = __builtin_amdgcn_permlane16_swap(x[0][0], x[1][0], false, false), s1 = __builtin_amdgcn_permlane16_swap(x[0][1], x[1][1], false, false);
            const int q = lane >> 4;
            bf16_t* dst = HB + ((size_t)mg * 256 + r) * 512 + hcol0 + 32 * slot + ((q & 1) ? 16 + 4 * (q - 1) : 4 * q);
            const u32x4 v4 = (u32x4){s0[0], s1[0], s0[1], s1[1]};
            asm volatile("global_store_dwordx4 %0, %1, off sc1" :: "v"(dst), "v"(v4) : "memory"); }
    });
    asm volatile("s_waitcnt vmcnt(0)" ::: "memory");
    __syncthreads();
    if (c.tid == 0) (void)xb_add(c.ws<unsigned>(WS_RDY) + (c.layer * 128 + mg) * 16, WN_ == 4 ? 2u : 1u);
}
template <int WN_, int MF>
DEV void h_tile(const Ctx& c, const int* cnt, int mg, int nt8) {
    const int l = c.layer;
    int bucket, mt, tt, bcount; moe_find_t(c, mg, bucket, mt, tt, bcount);
    int ea, eb; pair_of(bucket % 6, ea, eb); const int grp = bucket / 6;
    const int nvalid = min(256, bcount - mt * 256);
    const int* rows = c.ws<int>(WS_LTOK) + bucket * NTOK + mt * 256;
    GemmDesc g; g.A = c.ws<bf16_t>(WS_HBUF); g.lda = 512; g.rowidx = nullptr; g.nvalid = 0;
    g.B0 = c.ws<bf16_t>(WS_WDN) + (size_t)(grp * 4 + ea) * 1024 * 256; g.B1 = c.ws<bf16_t>(WS_WDN) + (size_t)(grp * 4 + eb) * 1024 * 256; g.ldb = 256; g.ksplit = 256; g.K = 512;
    if (c.tid < 64) {
        unsigned* rdy = c.ws<unsigned>(WS_RDY) + (c.layer * 128 + mg) * 16; unsigned* bar = c.ws<unsigned>(WS_BAR);
        { unsigned sp_ = 0; while (xb_ld(rdy) < 8u) { __builtin_amdgcn_s_sleep(2); if ((++sp_ & 1023u) == 0u) { if (xb_ld(&bar[XB_TMO])) break; if (sp_ > (1u << 24)) { atomicAdd(&bar[XB_TMO], 1u); break; } } } }
        __builtin_amdgcn_fence(__ATOMIC_ACQUIRE, "agent");
    }
    gemm_tile<WN_, MF>(g, mg * 256, nt8 * 128, c.lds, c.tid, [&](const f32x4 (&acc)[4][MF], int mb, int nbase, int lane) {
#pragma unroll
        for (int mf = 0; mf < MF; ++mf) { const int r = mb + 16 * mf + (lane & 15);
            if (r < nvalid) { const int tok = rows[r]; const int mbi = tok < NLAT ? (tok >> 11) : 8; const float* gate = c.modv(mbi, 5);
#pragma unroll
                for (int pp = 0; pp < 2; ++pp) { unsigned plo[2], phi[2]; f32x4 xp[2]; c.xs_pair(tok, nbase + 32 * pp, lane >> 4, xp[0], xp[1]);
#pragma unroll
                    for (int e = 0; e < 2; ++e) { const int nf = 2 * pp + e, n = nbase + 16 * nf + 4 * (lane >> 4); const f32x4 gt = *(const f32x4*)(gate + n), xv = xp[e], a = acc[nf][mf];
                        const float o0 = xv[0] + gt[0] * a[0], o1 = xv[1] + gt[1] * a[1], o2 = xv[2] + gt[2] * a[2], o3 = xv[3] + gt[3] * a[3];
                        if (l == NL - 1) __builtin_nontemporal_store((f32x4){o0, o1, o2, o3}, (f32x4*)(c.p->out + (size_t)tok * DM + n));
                        else { plo[e] = pk2(o0, o1); phi[e] = pk2(o2, o3); } }
                    if (l != NL - 1) store_pair16(c.xs(tok), nbase + 32 * pp, lane >> 4, plo[0], phi[0], plo[1], phi[1]); } } }
    });
}
DEV void phase_g(const Ctx& c) {
    const int* cnt = c.ws<int>(WS_CNT) + c.layer * NBUCKET * 32;
    moe_table(c, cnt);
    int total = 0; { int b, m, n; moe_find_t(c, 0, b, m, total, n); }
    const int U = total * 4, Ufull = (U / c.nb) * c.nb, R = U - Ufull;
    for (int u = c.bid; u < Ufull; u += c.nb) g_tile<4, 8>(c, cnt, u >> 2, 2 * (u & 3));
    for (int t = c.bid; t < 2 * R; t += c.nb) { const int u = Ufull + (t >> 1); g_tile<2, 4>(c, cnt, u >> 2, 2 * (u & 3) + (t & 1)); }
}
DEV void phase_h(const Ctx& c) {
    const int* cnt = c.ws<int>(WS_CNT) + c.layer * NBUCKET * 32;
    int total = 0; { int b, m, n; moe_find_t(c, 0, b, m, total, n); }
    const int U = __builtin_amdgcn_readfirstlane(total * 4), R = U - (U / c.nb) * c.nb;
    int base = 0;
#pragma unroll 1
    for (int s = 0; base < U; ++s) {
        const int thr = s == 0 ? min(2 * R, c.nb) : (s == 1 ? max(0, 2 * R - c.nb) : 0), nw = c.nb - thr, rem = U - base, k = c.bid - thr;
        if (k >= 0) {
            if (rem < nw && 2 * rem <= nw) { if (k < 2 * rem) { const int j = base + (k >> 1); h_tile<2, 4>(c, cnt, j >> 2, 2 * (j & 3) + (k & 1)); } }
            else if (k < rem) { const int j = base + k; h_tile<4, 8>(c, cnt, j >> 2, 2 * (j & 3)); }
        }
        base += nw;
    }
}

constexpr int PH_P0 = 0, PH_A = 1, PH_B = 2, PH_C = 3, PH_D = 4, PH_E0 = 5, PH_E = 6, PH_G = 7, PH_PER_LAYER = 7;
DEV void run_phase(const Ctx& c, int ph) {
    switch (ph) {
        case PH_P0: phase_p0(c); break;
        case PH_A: phase_a(c); break;
        case PH_B: phase_b(c); break;
        case PH_C: phase_c(c); break;
        case PH_D: phase_d(c); break;
        case PH_E0: phase_e0(c); break;
        case PH_E: phase_e(c); phase_f(c); break;
        case PH_G: phase_g(c); phase_h(c); break;
    }
}

extern __shared__ __attribute__((aligned(16))) char smem_dyn[];

struct XcdBarrier { unsigned* bar; unsigned x; volatile LAS unsigned* st; };
DEV XcdBarrier xcd_barrier_post(unsigned* bar, volatile LAS unsigned* st) {
    XcdBarrier b; b.bar = bar; b.x = xb_xcc_id(); b.st = st;
    if (threadIdx.x == 0) (void)xb_add(&bar[XB_XCNT(b.x)], 1u);
    return b;
}
DEV void xcd_barrier_complete(unsigned* bar, unsigned x, unsigned& nloc, unsigned& nx) {
    const unsigned G = gridDim.x * gridDim.y * gridDim.z;
    unsigned sum, cnt, mine, sp = 0u;
    for (;;) {
        sum = 0u; cnt = 0u; mine = 0u;
#pragma unroll
        for (unsigned j = 0; j < 16; ++j) { const unsigned c = xb_ld(&bar[XB_XCNT(j)]); sum += c; cnt += (c > 0u) ? 1u : 0u; mine = (j == x) ? c : mine; }
        if (sum == G) break;
        __builtin_amdgcn_s_sleep(1);
        if ((++sp & 255u) == 0u) { if (xb_ld(&bar[XB_TMO])) break; if (sp > XB_SPIN_CAP) { atomicAdd(&bar[XB_TMO], 1u); break; } }
    }
    nloc = mine > 0u ? mine : 1u; nx = cnt > 0u ? cnt : 1u;
}
DEV void xcd_barrier(const XcdBarrier& b) {
    asm volatile("s_waitcnt vmcnt(0)" ::: "memory");
    __syncthreads();
    if (threadIdx.x == 0) {
        unsigned* bar = b.bar;
        __builtin_amdgcn_s_waitcnt(0);
        unsigned nloc = b.st[0], nx = b.st[1];
        if (nloc == 0u) { xcd_barrier_complete(bar, b.x, nloc, nx); b.st[0] = nloc; b.st[1] = nx; }
        const unsigned old = xb_add(&bar[XB_XSUB(b.x)], 1u);
        const unsigned gen = old / nloc;
        if (old + 1u == (gen + 1u) * nloc) {
            __builtin_amdgcn_fence(__ATOMIC_RELEASE, "agent");
            asm volatile("s_waitcnt vmcnt(0)" ::: "memory");
            const unsigned og = xb_add(&bar[XB_TOP], 1u);
            const unsigned tg = og / nx;
            if (og + 1u == (tg + 1u) * nx) xb_add(&bar[XB_TOPGEN], 1u);
            else XB_SPIN(xb_ld(&bar[XB_TOPGEN]) == tg, bar);
            __builtin_amdgcn_fence(__ATOMIC_ACQUIRE, "agent");
            xb_add(&bar[XB_XGEN(b.x)], 1u);
            asm volatile("s_waitcnt vmcnt(0)" ::: "memory");
        } else {
            XB_SPIN(xb_ld(&bar[XB_XGEN(b.x)]) == gen, bar);
            __builtin_amdgcn_fence(__ATOMIC_ACQUIRE, "agent");
            asm volatile("s_waitcnt vmcnt(0)" ::: "memory");
        }
    }
    __syncthreads();
}
static_assert(XCD_BAR_WORDS * 4 <= 16384, "barrier words");


#if !MODE_SINGLE
__global__ void __launch_bounds__(NTHREADS, 2) k_phase(Params p, int layer, int ph) {
    Ctx c; c.p = (ParamsPtr)__builtin_amdgcn_kernarg_segment_ptr(); c.layer = layer; c.bid = blockIdx.x; c.nb = gridDim.x; c.tid = threadIdx.x; c.lds = (LAS char*)smem_dyn;
    run_phase(c, ph);
}


#endif
__global__ void __launch_bounds__(NTHREADS, 2) k_mega(Params p) {
    ParamsPtr pp = (ParamsPtr)__builtin_amdgcn_kernarg_segment_ptr();
    const int wave_id = __builtin_amdgcn_readfirstlane(threadIdx.x >> 6);
    Ctx c; c.p = pp; c.layer = 0; c.bid = blockIdx.x; c.nb = gridDim.x; c.tid = threadIdx.x; c.lds = (LAS char*)smem_dyn;
    volatile LAS unsigned* st = (volatile LAS unsigned*)(c.lds + LDS_BAR);
    if (threadIdx.x == 0) { st[0] = 0u; st[1] = 0u; st[2] = 0u; st[3] = 0u; }
    __syncthreads();
    XcdBarrier xb = xcd_barrier_post((unsigned*)(pp->ws + WS_BAR), st);
    unsigned long long t_prev = 0; float tacc1 = 0.f, tacc2 = 0.f;
#pragma unroll 1
    for (int step = 0; step <= 1 + NL * PH_PER_LAYER; ++step) {
        if (step) { xcd_barrier(xb); if (EXP_BAR2) xcd_barrier(xb); }
        if (PROBE_P1 >= -1) {
            const unsigned long long now = __builtin_amdgcn_s_memrealtime();
            if (step) { const int php = step > 1 ? 1 + (step - 2) % PH_PER_LAYER : 0; const float us = (float)(now - t_prev) * 0.01f;
                if (php == PROBE_P1) tacc1 += us; if (php == PROBE_P2) tacc2 += us; }
            t_prev = now;
        }
        if (step == 1 + NL * PH_PER_LAYER) break;
        { ParamsPtr q = pp; int w_ = wave_id, b_ = blockIdx.x, n_ = gridDim.x; asm volatile("" : "+s"(q), "+s"(w_), "+s"(b_), "+s"(n_));
          unsigned m_ = ~0u; asm volatile("" : "+s"(m_));
          int t_ = w_ * 64 + (int)__builtin_amdgcn_mbcnt_hi(m_, __builtin_amdgcn_mbcnt_lo(m_, 0u)); asm volatile("" : "+v"(t_)); c.p = q; c.tid = t_; c.bid = b_; c.nb = n_; }
        c.layer = step ? (step - 1) / PH_PER_LAYER : 0;
        const int ph = step ? 1 + (step - 1) % PH_PER_LAYER : 0;
        run_phase(c, ph);
        if (EXP_REP >= 0 && ph == EXP_REP && (EXP_REP != PH_E || c.layer == 0)) {
            xcd_barrier(xb); run_phase(c, ph); }
    }
    if (PROBE_P1 >= -1) {
        float* t2 = (float*)(pp->ws + WS_DBG);
        if (c.bid == 0 && c.tid == 0) { t2[0] = PROBE_P1 == -1 ? 100.f : tacc1; t2[1] = tacc2; }
        xcd_barrier(xb);
        const float cfill = sqrtf(t2[0]), spike = 4.f * t2[1];
        float* o = pp->out;
        for (size_t i = (size_t)c.bid * NTHREADS + c.tid; i < (size_t)NLAT * DM; i += (size_t)c.nb * NTHREADS) o[i] = (i == 0) ? spike : cfill;
    }
}

extern "C" void kernel_launch(void* const* d_in, const int* in_sizes, int n_in, void* d_out, int out_size, void* d_ws, size_t ws_size, hipStream_t stream) {
    static int grid = 0;
    if (grid == 0) {
        if (n_in != 29 || ws_size < WS_END) { fprintf(stderr, "kernel_launch: unexpected n_in %d or workspace %zu < %zu\n", n_in, ws_size, (size_t)WS_END); grid = -1; return; }
        int dev = 0, cus = 0, per_cu = 0;
        (void)hipGetDevice(&dev); (void)hipDeviceGetAttribute(&cus, hipDeviceAttributeMultiprocessorCount, dev);
#if MODE_SINGLE
        const void* kfn = (const void*)k_mega;
#else
        const void* kfn = (const void*)k_phase;
#endif
        (void)hipFuncSetAttribute(kfn, hipFuncAttributeMaxDynamicSharedMemorySize, LDS_BYTES);
        (void)hipOccupancyMaxActiveBlocksPerMultiprocessor(&per_cu, kfn, NTHREADS, LDS_BYTES);
        if (per_cu < 1) fprintf(stderr, "kernel_launch: occupancy query reports %d workgroups per CU\n", per_cu);
        grid = cus;
    }
    if (grid < 0) return;
    Params p{};
    for (int i = 0; i < 29; ++i) p.in[i] = (const float*)d_in[i];
    p.out = (float*)d_out; p.ws = (char*)d_ws;
    (void)hipMemsetAsync((char*)d_ws + WS_BAR, 0, WS_ZERO_BYTES, stream);
#if MODE_SINGLE
    void* args[] = {&p};
    hipError_t e = hipLaunchCooperativeKernel((const void*)k_mega, dim3(grid), dim3(NTHREADS), args, LDS_BYTES, stream);
    if (e != hipSuccess) fprintf(stderr, "kernel_launch: cooperative launch failed: %s (grid %d)\n", hipGetErrorString(e), grid);
#else
    hipLaunchKernelGGL(k_phase, dim3(grid), dim3(NTHREADS), LDS_BYTES, stream, p, 0, PH_P0);
    for (int l = 0; l < NL; ++l)
        for (int ph = PH_A; ph <= PH_G; ++ph) hipLaunchKernelGGL(k_phase, dim3(grid), dim3(NTHREADS), LDS_BYTES, stream, p, l, ph);
#endif
}
```
